# Optimizing an MI355X kernel written in HIP

```python
import math
import jax
import jax.numpy as jnp
from jax import lax
import numpy as np

D_MODEL = 1024
BATCH = 8
SEQ = 4096
DEPTH = 4

GRID_W = 64
CTX_LEN = 256
N_BRANCH = 4
BR_W = D_MODEL // N_BRANCH

HY_ORDER = 2
HY_BANDS = 8
HY_FEAT = 1 + 2 * HY_BANDS
HY_HID = 64
HY_CONV = 3
HY_TARGET = 1e-2
HY_FAST = 0.3
HY_SLOW = 1.5
HY_IN = (HY_ORDER + 1) * BR_W

RW_HEAD = 64
RW_HEADS = BR_W // RW_HEAD
RW_LORA = 64
RW_IN = 3 * BR_W + 3 * RW_LORA
RW_SPLIT = (BR_W, 2 * BR_W, 3 * BR_W, 3 * BR_W + RW_LORA, 3 * BR_W + 2 * RW_LORA)
RW_LN_EPS = 64e-5

LRU_BLOCKS = 4
LRU_BLOCK = BR_W // LRU_BLOCKS
LRU_CONV = 4
LRU_C = 8.0
LRU_IN = 2 * BR_W

RET_HEADS = 4
RET_HEAD = BR_W // RET_HEADS
RET_CHUNK = 128
ROPE_BASE = 10000.0
RET_IN = 4 * BR_W

GATE_IN = N_BRANCH * D_MODEL
N_IN = HY_IN + RW_IN + LRU_IN + RET_IN + GATE_IN
SPLIT_IN = (HY_IN, HY_IN + RW_IN, HY_IN + RW_IN + LRU_IN, HY_IN + RW_IN + LRU_IN + RET_IN)

D_FF = ((8 * D_MODEL // 3 + 255) // 256) * 256
EPS = 1e-6

kernel_name = 'hybrid_prefix_dit_trunk'


def rmsnorm(x, g):
    xf = x.astype(jnp.float32)
    y = xf * lax.rsqrt(jnp.mean(xf * xf, axis=-1, keepdims=True) + EPS)
    return (y * g.astype(jnp.float32)).astype(x.dtype)


def head_norm(y, eps=1e-5):
    mu = jnp.mean(y, axis=-1, keepdims=True)
    var = jnp.mean(jnp.square(y - mu), axis=-1, keepdims=True)
    return (y - mu) * lax.rsqrt(var + eps)


def dwconv(x, w, b, pad_left):
    K = w.shape[0]
    T = x.shape[1]
    xp = jnp.pad(x, ((0, 0), (pad_left, K - 1 - pad_left), (0, 0)))
    y = b + w[0] * xp[:, 0:T]
    for j in range(1, K):
        y = y + w[j] * xp[:, j:j + T]
    return y


def hyena_filter_spectrum(L, f_w1, f_b1, f_w2, f_b2, f_w3, freq):
    f32 = jnp.float32
    t = jnp.arange(L, dtype=f32) / L
    ang = (2.0 * math.pi) * t[:, None] * jnp.arange(1, HY_BANDS + 1, dtype=f32)
    feat = jnp.concatenate([t[:, None], jnp.sin(ang), jnp.cos(ang)], axis=-1)
    h = jnp.sin(freq[0].astype(f32) * (feat @ f_w1.astype(f32) + f_b1.astype(f32)))
    h = jnp.sin(freq[1].astype(f32) * (h @ f_w2.astype(f32) + f_b2.astype(f32)))
    h = (h @ f_w3.astype(f32)).reshape(L, HY_ORDER, 2, BR_W)
    rates = jnp.abs(jnp.linspace(math.log(HY_TARGET) / HY_SLOW, math.log(HY_TARGET) / HY_FAST, BR_W, dtype=f32))
    h = h * jnp.exp(-t[:, None] * rates)[:, None, None, :]
    fwd, bwd = h[:, :, 0], h[:, :, 1]
    two = jnp.concatenate([fwd, jnp.zeros((1, HY_ORDER, BR_W), f32), jnp.flip(bwd[1:], 0)], axis=0)
    two = two * lax.rsqrt(jnp.sum(two * two, axis=0, keepdims=True) + EPS)
    return jnp.fft.rfft(two, axis=0)


def hyena_branch(p, conv_w, conv_b, f_w1, f_b1, f_w2, f_b2, f_w3, freq, bias):
    L = p.shape[1]
    u = dwconv(p, conv_w, conv_b, 1).astype(jnp.float32)
    v, g1, g2 = jnp.split(u, 3, axis=-1)
    spec = hyena_filter_spectrum(L, f_w1, f_b1, f_w2, f_b2, f_w3, freq)
    z = v
    for o, gate in enumerate((g1, g2)):
        conv = jnp.fft.irfft(jnp.fft.rfft(z, n=2 * L, axis=1) * spec[:, o], n=2 * L, axis=1)[:, :L]
        z = gate * (conv + bias[o].astype(jnp.float32) * z)
    return z


def shift_grid(x, rows):
    B, T, C = x.shape
    g = x.reshape(B, rows, GRID_W, C // 4, 4)
    left = jnp.pad(g[:, :, :-1, :, 0], ((0, 0), (0, 0), (1, 0), (0, 0)))
    right = jnp.pad(g[:, :, 1:, :, 1], ((0, 0), (0, 0), (0, 1), (0, 0)))
    up = jnp.pad(g[:, :-1, :, :, 2], ((0, 0), (1, 0), (0, 0), (0, 0)))
    down = jnp.pad(g[:, 1:, :, :, 3], ((0, 0), (0, 1), (0, 0), (0, 0)))
    return jnp.stack([left, right, up, down], axis=-1).reshape(B, T, C)


def shift_seq(x):
    B, T, C = x.shape
    g = x.reshape(B, T, C // 4, 4)
    prev = jnp.pad(g[:, :-1], ((0, 0), (1, 0), (0, 0), (0, 0)))
    nxt = jnp.pad(g[:, 1:], ((0, 0), (0, 1), (0, 0), (0, 0)))
    return jnp.stack([prev[..., 0], nxt[..., 1], prev[..., 2], nxt[..., 3]], axis=-1).reshape(B, T, C)


def wkv_scan(r, w, k, v, a, b, s0):
    def step(s, inp):
        rt, wt, kt, vt, at, bt = inp
        sa = jnp.einsum('bhvk,bhk->bhv', s, at)
        s = s * wt[:, :, None, :] + sa[..., None] * bt[:, :, None, :] + vt[..., None] * kt[:, :, None, :]
        return s, jnp.einsum('bhvk,bhk->bhv', s, rt)
    xs = tuple(jnp.moveaxis(t, 1, 0) for t in (r, w, k, v, a, b))
    s_fin, y = lax.scan(step, s0, xs)
    return jnp.moveaxis(y, 0, 1), s_fin


def rwkv_branch(p, rows, states, mu, w0, w2, a0, a2, g2, k_k, k_a, r_k, ln_g):
    B, T, _ = p.shape
    shifted = shift_grid(p, rows) if rows is not None else shift_seq(p)
    xx = (p + (shifted - p) * mu).astype(jnp.float32)
    r, k, v, cw, ca, cg = jnp.split(xx, RW_SPLIT, axis=-1)
    hd = lambda t: t.reshape(B, T, RW_HEADS, RW_HEAD)
    kk = hd(k * k_k)
    kk = kk * lax.rsqrt(jnp.sum(kk * kk, axis=-1, keepdims=True) + 1e-12)
    ys, fins = [], []
    for d in range(2):
        logw = -jax.nn.softplus(-(w0[d] + jnp.tanh(cw) @ w2[d])) - 0.5
        decay = jnp.exp(-jnp.exp(logw))
        a = jax.nn.sigmoid(a0[d] + ca @ a2[d])
        k_t = k * (1.0 + (a - 1.0) * k_a)
        ins = (hd(r), hd(decay), hd(k_t), hd(v), -kk, kk * hd(a))
        if d == 1:
            ins = tuple(jnp.flip(t, 1) for t in ins)
        y_d, s_d = wkv_scan(*ins, states[d])
        ys.append(jnp.flip(y_d, 1) if d == 1 else y_d)
        fins.append(s_d)
    o = head_norm(ys[0] + ys[1], RW_LN_EPS) * ln_g.reshape(RW_HEADS, RW_HEAD)
    o = o + jnp.sum(hd(r) * hd(k) * r_k.reshape(RW_HEADS, RW_HEAD), axis=-1, keepdims=True) * hd(v)
    g = jax.nn.sigmoid(cg) @ g2
    return o.reshape(B, T, BR_W) * g, (fins[0], fins[1])


def linear_scan(a, b, h0):
    b = b.at[:, 0].add(a[:, 0] * h0)
    comb = lambda lhs, rhs: (lhs[0] * rhs[0], rhs[0] * lhs[1] + rhs[1])
    _, h = lax.associative_scan(comb, (a, b), axis=1)
    return h, h[:, -1]


def rglru_branch(p, states, conv_w, conv_b, wa, ba, wx, bx, lam):
    B, T, _ = p.shape
    xb, gb = jnp.split(p.astype(jnp.float32), 2, axis=-1)
    xc = dwconv(xb, conv_w, conv_b, LRU_CONV // 2)
    xg = xc.reshape(B, T, LRU_BLOCKS, LRU_BLOCK)
    hs, fins = [], []
    for d in range(2):
        r = jax.nn.sigmoid(jnp.einsum('btgi,gio->btgo', xg, wa[d].astype(jnp.float32)).reshape(B, T, BR_W) + ba[d])
        i = jax.nn.sigmoid(jnp.einsum('btgi,gio->btgo', xg, wx[d].astype(jnp.float32)).reshape(B, T, BR_W) + bx[d])
        log_a = -LRU_C * r * jax.nn.softplus(-lam[d].astype(jnp.float32))
        a = jnp.exp(log_a)
        b = jnp.sqrt(-jnp.expm1(2.0 * log_a)) * (i * xc)
        if d == 1:
            a, b = jnp.flip(a, 1), jnp.flip(b, 1)
        h, h_fin = linear_scan(a, b, states[d])
        hs.append(jnp.flip(h, 1) if d == 1 else h)
        fins.append(h_fin)
    return (hs[0] + hs[1]) * jax.nn.gelu(gb), (fins[0], fins[1])


def axial_rope(x):
    T = x.shape[1]
    pos = jnp.arange(T)
    q4 = RET_HEAD // 4
    half = RET_HEAD // 2
    inv = ROPE_BASE ** (-jnp.arange(q4, dtype=jnp.float32) / q4)
    def rot(xp, coord):
        ang = coord.astype(jnp.float32)[:, None] * inv
        cos, sin = jnp.cos(ang)[:, None, :], jnp.sin(ang)[:, None, :]
        x1, x2 = xp[..., :q4], xp[..., q4:]
        return jnp.concatenate([x1 * cos - x2 * sin, x1 * sin + x2 * cos], axis=-1)
    return jnp.concatenate([rot(x[..., :half], pos // GRID_W), rot(x[..., half:], pos % GRID_W)], axis=-1)


def retention_scan(q, k, v, log_g, s0):
    B, H, T, _ = q.shape
    C = RET_CHUNK
    n = T // C
    idx = jnp.arange(C, dtype=jnp.float32)
    diff = idx[:, None] - idx[None, :]
    dmat = jnp.exp(jnp.where(diff >= 0, diff * log_g[:, None, None], -jnp.inf))
    q_dec = jnp.exp((idx + 1.0) * log_g[:, None])[..., None]
    k_dec = jnp.exp((C - 1.0 - idx) * log_g[:, None])[..., None]
    c_dec = jnp.exp(C * log_g)[:, None, None]
    chunks = lambda t: jnp.moveaxis(t.reshape(B, H, n, C, t.shape[-1]), 2, 0)
    def step(s, inp):
        qc, kc, vc = inp
        sc = jnp.einsum('bhid,bhjd->bhij', qc, kc) * dmat
        y = jnp.einsum('bhij,bhjv->bhiv', sc, vc) + jnp.einsum('bhid,bhdv->bhiv', qc, s) * q_dec
        s = s * c_dec + jnp.einsum('bhjd,bhjv->bhdv', kc * k_dec, vc)
        return s, y
    s_fin, y = lax.scan(step, s0, (chunks(q), chunks(k), chunks(v)))
    return jnp.moveaxis(y, 0, 2).reshape(B, H, T, v.shape[-1]), s_fin


def retention_branch(p, rows, states, gamma_logit):
    B, T, _ = p.shape
    q, k, v, g = jnp.split(p.astype(jnp.float32), 4, axis=-1)
    hd = lambda t: t.reshape(B, T, RET_HEADS, RET_HEAD)
    q, k, v = hd(q), hd(k), hd(v)
    if rows is not None:
        q, k = axial_rope(q), axial_rope(k)
    k = k * (RET_HEAD ** -0.5)
    q, k, v = (jnp.swapaxes(t, 1, 2) for t in (q, k, v))
    log_g = jax.nn.log_sigmoid(gamma_logit.astype(jnp.float32))
    y_f, s_f = retention_scan(q, k, v, log_g[0], states[0])
    y_b, s_b = retention_scan(jnp.flip(q, 2), jnp.flip(k, 2), jnp.flip(v, 2), log_g[1], states[1])
    y = head_norm(jnp.swapaxes(y_f + jnp.flip(y_b, 2), 1, 2)).reshape(B, T, BR_W)
    return y * jax.nn.silu(g), (s_f, s_b)


def zero_states(batch):
    f32 = jnp.float32
    rw = jnp.zeros((batch, RW_HEADS, RW_HEAD, RW_HEAD), f32)
    lru = jnp.zeros((batch, BR_W), f32)
    ret = jnp.zeros((batch, RET_HEADS, RET_HEAD, RET_HEAD), f32)
    return ((rw, rw), (lru, lru), (ret, ret))


def token_mixer(p, rows, states, lp, with_output):
    hy_p, rw_p, lru_p, ret_p, gate_p = jnp.split(p, SPLIT_IN, axis=-1)
    y_rw, rw_st = rwkv_branch(rw_p, rows, states[0], *lp['rw'])
    y_lru, lru_st = rglru_branch(lru_p, states[1], *lp['lru'])
    y_ret, ret_st = retention_branch(ret_p, rows, states[2], lp['ret'])
    new_states = (rw_st, lru_st, ret_st)
    if not with_output:
        return None, new_states
    y_hy = hyena_branch(hy_p, *lp['hy'])
    B, T, _ = p.shape
    gates = jax.nn.sigmoid(gate_p.astype(jnp.float32)).reshape(B, T, N_BRANCH, D_MODEL)
    br = lp['br_proj'].astype(jnp.float32)
    branches = (y_hy, y_rw, y_lru, y_ret)
    merged = gates[:, :, 0] * (branches[0] @ br[0])
    for n in range(1, N_BRANCH):
        merged = merged + gates[:, :, n] * (branches[n] @ br[n])
    return merged.astype(p.dtype) @ lp['w_out'], new_states


def swiglu(u, w1, w2):
    gate, up = jnp.split(u @ w1, 2, axis=-1)
    return (jax.nn.silu(gate) * up) @ w2


def setup_inputs(seed: int = 0) -> dict:
    key = jax.random.key(seed)
    ks = iter(jax.random.split(key, 48))
    f32 = jnp.float32
    L = DEPTH
    def nrm(shape, scale):
        return scale * jax.random.normal(next(ks), shape, f32)
    def unif(shape, lo, hi):
        return jax.random.uniform(next(ks), shape, f32, lo, hi)
    x = nrm((BATCH, SEQ, D_MODEL), 1.0)
    c = nrm((BATCH, D_MODEL), 1.0)
    ctx = nrm((BATCH, CTX_LEN, D_MODEL), 1.0)
    c_ctx = nrm((D_MODEL,), 1.0)
    w_mod = nrm((L, D_MODEL, 6 * D_MODEL), 0.5 * D_MODEL ** -0.5)
    b_mod = nrm((L, 6 * D_MODEL), 0.02)
    norm1_g = 1.0 + nrm((L, D_MODEL), 0.02)
    norm2_g = 1.0 + nrm((L, D_MODEL), 0.02)
    w_in = nrm((L, D_MODEL, N_IN), D_MODEL ** -0.5)
    hy_conv_w = nrm((L, HY_CONV, HY_IN), HY_CONV ** -0.5)
    hy_conv_b = nrm((L, HY_IN), 0.02)
    hy_f_w1 = nrm((L, HY_FEAT, HY_HID), HY_FEAT ** -0.5)
    hy_f_b1 = nrm((L, HY_HID), 0.1)
    hy_f_w2 = nrm((L, HY_HID, HY_HID), HY_HID ** -0.5)
    hy_f_b2 = nrm((L, HY_HID), 0.1)
    hy_f_w3 = nrm((L, HY_HID, HY_ORDER * 2 * BR_W), HY_HID ** -0.5)
    hy_freq = 1.0 + nrm((L, 2, HY_HID), 0.02)
    hy_bias = nrm((L, HY_ORDER, BR_W), 0.5)
    rw_mu = unif((L, RW_IN), 0.0, 1.0)
    rw_w0 = jnp.linspace(-5.0, 1.0, BR_W, dtype=f32) + nrm((L, 2, BR_W), 0.1)
    rw_w2 = nrm((L, 2, RW_LORA, BR_W), 0.1 * RW_LORA ** -0.5)
    rw_a0 = nrm((L, 2, BR_W), 0.1)
    rw_a2 = nrm((L, 2, RW_LORA, BR_W), 0.5 * RW_LORA ** -0.5)
    rw_g2 = nrm((L, RW_LORA, BR_W), RW_LORA ** -0.5)
    rw_kk = 0.85 + nrm((L, BR_W), 0.02)
    rw_ka = 1.0 + nrm((L, BR_W), 0.02)
    rw_rk = nrm((L, BR_W), 0.1)
    rw_ln_g = 1.0 + nrm((L, BR_W), 0.02)
    lru_conv_w = nrm((L, LRU_CONV, BR_W), LRU_CONV ** -0.5)
    lru_conv_b = nrm((L, BR_W), 0.02)
    lru_wa = nrm((L, 2, LRU_BLOCKS, LRU_BLOCK, LRU_BLOCK), LRU_BLOCK ** -0.5)
    lru_ba = nrm((L, 2, BR_W), 0.02)
    lru_wx = nrm((L, 2, LRU_BLOCKS, LRU_BLOCK, LRU_BLOCK), LRU_BLOCK ** -0.5)
    lru_bx = nrm((L, 2, BR_W), 0.02)
    a_pow_c = unif((L, 2, BR_W), 0.9, 0.999)
    a_base = a_pow_c ** (1.0 / LRU_C)
    lru_lam = jnp.log(a_base) - jnp.log1p(-a_base)
    ret_base = 1.0 - 2.0 ** (-5.0 - jnp.arange(RET_HEADS, dtype=f32))
    ret_gamma = jnp.log(ret_base) - jnp.log1p(-ret_base) + nrm((L, 2, RET_HEADS), 0.1)
    br_proj = nrm((L, N_BRANCH, BR_W, D_MODEL), BR_W ** -0.5)
    w_out = nrm((L, D_MODEL, D_MODEL), D_MODEL ** -0.5)
    ffn_w1 = nrm((L, D_MODEL, 2 * D_FF), D_MODEL ** -0.5)
    ffn_w2 = nrm((L, D_FF, D_MODEL), D_FF ** -0.5)
    final_g = 1.0 + nrm((D_MODEL,), 0.02)
    return {'x': x, 'c': c, 'ctx': ctx, 'c_ctx': c_ctx, 'w_mod': w_mod, 'b_mod': b_mod,
            'norm1_g': norm1_g, 'norm2_g': norm2_g, 'w_in': w_in,
            'hy_conv_w': hy_conv_w, 'hy_conv_b': hy_conv_b, 'hy_f_w1': hy_f_w1, 'hy_f_b1': hy_f_b1,
            'hy_f_w2': hy_f_w2, 'hy_f_b2': hy_f_b2, 'hy_f_w3': hy_f_w3, 'hy_freq': hy_freq, 'hy_bias': hy_bias,
            'rw_mu': rw_mu, 'rw_w0': rw_w0, 'rw_w2': rw_w2, 'rw_a0': rw_a0, 'rw_a2': rw_a2, 'rw_g2': rw_g2,
            'rw_kk': rw_kk, 'rw_ka': rw_ka, 'rw_rk': rw_rk, 'rw_ln_g': rw_ln_g,
            'lru_conv_w': lru_conv_w, 'lru_conv_b': lru_conv_b, 'lru_wa': lru_wa, 'lru_ba': lru_ba,
            'lru_wx': lru_wx, 'lru_bx': lru_bx, 'lru_lam': lru_lam, 'ret_gamma': ret_gamma,
            'br_proj': br_proj, 'w_out': w_out, 'ffn_w1': ffn_w1, 'ffn_w2': ffn_w2, 'final_g': final_g}


def reference(x, c, ctx, c_ctx, w_mod, b_mod, norm1_g, norm2_g, w_in,
              hy_conv_w, hy_conv_b, hy_f_w1, hy_f_b1, hy_f_w2, hy_f_b2, hy_f_w3, hy_freq, hy_bias,
              rw_mu, rw_w0, rw_w2, rw_a0, rw_a2, rw_g2, rw_kk, rw_ka, rw_rk, rw_ln_g,
              lru_conv_w, lru_conv_b, lru_wa, lru_ba, lru_wx, lru_bx, lru_lam, ret_gamma,
              br_proj, w_out, ffn_w1, ffn_w2, final_g):
    rows = x.shape[1] // GRID_W
    xc = ctx
    for l in range(DEPTH):
        last = l == DEPTH - 1
        lp = {
            'hy': (hy_conv_w[l], hy_conv_b[l], hy_f_w1[l], hy_f_b1[l], hy_f_w2[l], hy_f_b2[l],
                   hy_f_w3[l], hy_freq[l], hy_bias[l]),
            'rw': (rw_mu[l], rw_w0[l], rw_w2[l], rw_a0[l], rw_a2[l], rw_g2[l], rw_kk[l], rw_ka[l],
                   rw_rk[l], rw_ln_g[l]),
            'lru': (lru_conv_w[l], lru_conv_b[l], lru_wa[l], lru_ba[l], lru_wx[l], lru_bx[l], lru_lam[l]),
            'ret': ret_gamma[l],
            'br_proj': br_proj[l],
            'w_out': w_out[l],
        }
        m_lat = jnp.split((jax.nn.silu(c) @ w_mod[l] + b_mod[l])[:, None, :], 6, axis=-1)
        m_ctx = jnp.split(jax.nn.silu(c_ctx) @ w_mod[l] + b_mod[l], 6, axis=-1)
        u_c = rmsnorm(xc, norm1_g[l]) * (1.0 + m_ctx[1]) + m_ctx[0]
        h_c, ctx_states = token_mixer(u_c @ w_in[l], None, zero_states(x.shape[0]), lp, not last)
        u_l = rmsnorm(x, norm1_g[l]) * (1.0 + m_lat[1]) + m_lat[0]
        h_l, _ = token_mixer(u_l @ w_in[l], rows, ctx_states, lp, True)
        x = x + m_lat[2] * h_l
        v_l = rmsnorm(x, norm2_g[l]) * (1.0 + m_lat[4]) + m_lat[3]
        x = x + m_lat[5] * swiglu(v_l, ffn_w1[l], ffn_w2[l])
        if not last:
            xc = xc + m_ctx[2] * h_c
            v_c = rmsnorm(xc, norm2_g[l]) * (1.0 + m_ctx[4]) + m_ctx[3]
            xc = xc + m_ctx[5] * swiglu(v_c, ffn_w1[l], ffn_w2[l])
    return rmsnorm(x, final_g)
```

```cpp
#include <hip/hip_runtime.h>
#include <cstdio>
#include <cstdint>

#ifndef SEQ_
#define SEQ_ 4096
#define CTXL_ 256
#endif
#ifndef MK_PER_PHASE
#define MK_PER_PHASE 1
#endif

namespace pg8 {
#define PG8_LAS __attribute__((address_space(3)))
typedef unsigned short bf16_t;
typedef short bf16x8 __attribute__((ext_vector_type(8)));
typedef float f32x4 __attribute__((ext_vector_type(4)));
typedef unsigned u32x4 __attribute__((ext_vector_type(4)));
constexpr int BM = 256, BK = 64, HALF = 128, HTB = HALF * BK * 2  , STAGE_BYTES = 8 * HTB, NXCD = 8, WGM = 8;

__host__ __device__ __forceinline__ int lds_byte(int r, int c) { const int st = (r >> 4) * 2 + (c >> 5), rr = r & 15, cc = c & 31, ob = rr * 64 + cc * 2; return st * 1024 + (ob ^ (((ob >> 9) & 1) << 5)); }
__host__ __device__ __forceinline__ void stage_rc(int b, int& R, int& C) { const int st = b / 1024, sb = b % 1024, swz = sb ^ (((sb >> 9) & 1) << 5); R = (st >> 1) * 16 + swz / 64; C = (st & 1) * 32 + (swz % 64) / 2; }
__host__ __device__ __forceinline__ int perm32(int rho) { const int n = rho >> 4, i = rho & 15; return 8 * (i >> 2) + 4 * n + (i & 3); }

struct Unit { int pm, pn; };
struct Gemm { const bf16_t* A; const bf16_t* Bt; int M, N, K; };

struct StaticOrder {
    int nM, nN, nwg, G, c;
    __host__ __device__ void init(int M, int N, int G_, int c_) { nM = M / BM; nN = N / BM; nwg = nM * nN; G = G_; c = c_; }
    __host__ __device__ bool next(int i, Unit& u) const {
        const long L = (long)i * G + c; if (L >= nwg) return false;
        int wgid = (int)L; { const int q = nwg / NXCD, r = nwg % NXCD, xcd = wgid % NXCD, off = wgid / NXCD; wgid = (xcd < r ? xcd * (q + 1) : r * (q + 1) + (xcd - r) * q) + off; }
        const int nig = WGM * nN, gid = wgid / nig, fm = gid * WGM, gsz = (nM - fm) < WGM ? (nM - fm) : WGM;
        u.pm = fm + ((wgid % nig) % gsz); u.pn = (wgid % nig) / gsz; return true;
    }
    __device__ __forceinline__ void a_ready(const Unit&) const {}
    __device__ __forceinline__ void done(const Unit&) const {}
};

#ifdef HOST_EMU
__device__ __forceinline__ unsigned cvt_pk_bf16(float lo, float hi) { auto f = [](float x) { unsigned u; memcpy(&u, &x, 4); return (u + 0x7fffu + ((u >> 16) & 1u)) >> 16; }; return f(lo) | (f(hi) << 16); }
#else
typedef __bf16 pg8_bf16x2 __attribute__((ext_vector_type(2)));
typedef float pg8_f32x2 __attribute__((ext_vector_type(2)));
__device__ __forceinline__ unsigned cvt_pk_bf16(float lo, float hi) { pg8_f32x2 v = {lo, hi}; pg8_bf16x2 b = __builtin_convertvector(v, pg8_bf16x2); return __builtin_bit_cast(unsigned, b); }
#endif
typedef float f32x2 __attribute__((ext_vector_type(2)));
__device__ __forceinline__ float bflo(unsigned u) { return __uint_as_float(u << 16); }
__device__ __forceinline__ float bfhi(unsigned u) { return __uint_as_float(u & 0xffff0000u); }
#ifdef HOST_EMU
__device__ __forceinline__ float fsigmoid(float x) { return 1.f / (1.f + expf(-x)); }
#else
__device__ __forceinline__ float fsigmoid(float x) { return __builtin_amdgcn_rcpf(1.f + __expf(-x)); }
#endif

template <int ACT> struct EpiBf {
    static constexpr bool PERM = true, AFTER_DRAIN = false;
    bf16_t* O; int ldc;
    __device__ __forceinline__ void operator()(const f32x4 (&acc)[2][2][4][2], const Unit& u, int wr, int wc, int fr, int fq) const {
        const int row0 = u.pm * BM + wr * 64 + fr, col0 = u.pn * BM + wc * 32 + 8 * fq;
#pragma unroll
        for (int ai = 0; ai < 2; ++ai)
#pragma unroll
            for (int m = 0; m < 4; ++m) { bf16_t* rowp = O + (size_t)(row0 + ai * HALF + m * 16) * ldc + col0;
#pragma unroll
                for (int bj = 0; bj < 2; ++bj) { f32x4 v0 = acc[ai][bj][m][0], v1 = acc[ai][bj][m][1];
                    if (ACT == 1) {
#pragma unroll
                        for (int j = 0; j < 4; ++j) { v0[j] = fsigmoid(v0[j]); v1[j] = fsigmoid(v1[j]); } }
                    u32x4 w; w.x = cvt_pk_bf16(v0[0], v0[1]); w.y = cvt_pk_bf16(v0[2], v0[3]); w.z = cvt_pk_bf16(v1[0], v1[1]); w.w = cvt_pk_bf16(v1[2], v1[3]);
                    *(u32x4*)(rowp + bj * HALF) = w; } }
    }
};

struct EpiMerge {
    static constexpr bool PERM = true, AFTER_DRAIN = false;
    const bf16_t* G; int ldg; int gcol0; bf16_t* Mg; int first;
    __device__ __forceinline__ void operator()(const f32x4 (&acc)[2][2][4][2], const Unit& u, int wr, int wc, int fr, int fq) const {
        const int row0 = u.pm * BM + wr * 64 + fr, col0 = u.pn * BM + wc * 32 + 8 * fq;
#pragma unroll
        for (int ai = 0; ai < 2; ++ai)
#pragma unroll
            for (int m = 0; m < 4; ++m) { const size_t row = (size_t)(row0 + ai * HALF + m * 16);
#pragma unroll
                for (int bj = 0; bj < 2; ++bj) { const int col = col0 + bj * HALF;
                    const u32x4 gv = *(const u32x4*)(G + row * ldg + gcol0 + col);
                    bf16_t* mp = Mg + row * 1024 + col;
                    u32x4 pv = (u32x4){0u, 0u, 0u, 0u}; if (!first) pv = *(const u32x4*)mp;
                    const f32x4 v0 = acc[ai][bj][m][0], v1 = acc[ai][bj][m][1];
                    float o[8];
                    o[0] = bflo(pv.x) + bflo(gv.x) * v0[0]; o[1] = bfhi(pv.x) + bfhi(gv.x) * v0[1];
                    o[2] = bflo(pv.y) + bflo(gv.y) * v0[2]; o[3] = bfhi(pv.y) + bfhi(gv.y) * v0[3];
                    o[4] = bflo(pv.z) + bflo(gv.z) * v1[0]; o[5] = bfhi(pv.z) + bfhi(gv.z) * v1[1];
                    o[6] = bflo(pv.w) + bflo(gv.w) * v1[2]; o[7] = bfhi(pv.w) + bfhi(gv.w) * v1[3];
                    u32x4 w; w.x = cvt_pk_bf16(o[0], o[1]); w.y = cvt_pk_bf16(o[2], o[3]); w.z = cvt_pk_bf16(o[4], o[5]); w.w = cvt_pk_bf16(o[6], o[7]);
                    *(u32x4*)mp = w; } }
    }
};

struct EpiResid {
    static constexpr bool PERM = false, AFTER_DRAIN = false;
    const float* src_c; const float* src_l; float* dst_c; float* dst_l; const float* modl; int gate_off; int row_off;
    __device__ __forceinline__ void operator()(const f32x4 (&acc)[2][2][4][2], const Unit& u, int wr, int wc, int fr, int fq) const {
        const int grow0 = row_off + u.pm * BM;
        const bool isctx = grow0 < 8 * CTXL_;
        const int jb = isctx ? 8 : (grow0 - 8 * CTXL_) / SEQ_;
        const float* gate = modl + (size_t)jb * 6144 + gate_off;
        const float* src = isctx ? src_c + (size_t)grow0 * 1024 : src_l + (size_t)(grow0 - 8 * CTXL_) * 1024;
        float* dst = isctx ? dst_c + (size_t)grow0 * 1024 : dst_l + (size_t)(grow0 - 8 * CTXL_) * 1024;
        const int rr0 = wr * 64 + fr, col0 = u.pn * BM + wc * 32 + 4 * fq;
        f32x4 gv[2][2];
#pragma unroll
        for (int bj = 0; bj < 2; ++bj)
#pragma unroll
            for (int n = 0; n < 2; ++n) gv[bj][n] = *(const f32x4*)(gate + col0 + bj * HALF + n * 16);
#pragma unroll
        for (int ai = 0; ai < 2; ++ai)
#pragma unroll
            for (int m = 0; m < 4; ++m) { const size_t ro = (size_t)(rr0 + ai * HALF + m * 16) * 1024 + col0;
#pragma unroll
                for (int bj = 0; bj < 2; ++bj)
#pragma unroll
                    for (int n = 0; n < 2; ++n) { const f32x4 s = *(const f32x4*)(src + ro + bj * HALF + n * 16);
                        *(f32x4*)(dst + ro + bj * HALF + n * 16) = s + gv[bj][n] * acc[ai][bj][m][n]; } }
    }
};

struct EpiSwiglu {
    static constexpr bool PERM = true, AFTER_DRAIN = false;
    bf16_t* O; int ldc;
    __device__ __forceinline__ void operator()(const f32x4 (&acc)[2][2][4][2], const Unit& u, int wr, int wc, int fr, int fq) const {
        const int row0 = u.pm * BM + wr * 64 + fr, col0 = u.pn * HALF + wc * 32 + 8 * fq;
#pragma unroll
        for (int ai = 0; ai < 2; ++ai)
#pragma unroll
            for (int m = 0; m < 4; ++m) { bf16_t* rowp = O + (size_t)(row0 + ai * HALF + m * 16) * ldc + col0;
                float o[8];
#pragma unroll
                for (int n = 0; n < 2; ++n)
#pragma unroll
                    for (int j = 0; j < 4; ++j) { const float g = acc[ai][0][m][n][j], up = acc[ai][1][m][n][j]; o[n * 4 + j] = g * fsigmoid(g) * up; }
                u32x4 w; w.x = cvt_pk_bf16(o[0], o[1]); w.y = cvt_pk_bf16(o[2], o[3]); w.z = cvt_pk_bf16(o[4], o[5]); w.w = cvt_pk_bf16(o[6], o[7]);
                *(u32x4*)rowp = w; }
    }
};

template <class Epi, class Sched, bool ALIGN_EPI = false, bool SP2 = false>
__device__ __forceinline__ void gemm_phase(PG8_LAS unsigned char* lds, const Gemm g, const Sched& S, const Epi& E) {
    const int tid = threadIdx.x, wid = __builtin_amdgcn_readfirstlane(tid >> 6), lane = tid & 63, wr = wid >> 2, wc = wid & 3, fr = lane & 15, fq = lane >> 4;
    const int K = g.K, nt = K / BK;
    unsigned voffA[2], voffB[2];
#pragma unroll
    for (int i = 0; i < 2; ++i) { int R, C; stage_rc(tid * 16 + i * 8192, R, C); const int Rb = Epi::PERM ? ((R & ~31) + perm32(R & 31)) : R;
        voffA[i] = (unsigned)(R * K + C) * 2u; voffB[i] = (unsigned)(Rb * K + C) * 2u; }
    const size_t kstep = (size_t)(BK * 2);
    const size_t hstep = (size_t)HALF * K * 2;
    const size_t tstep = 2 * hstep;
    const unsigned ldsw = (unsigned)wid * 1024u;
    const int aoff = lds_byte(wr * 64 + fr, fq * 8), boff = lds_byte(wc * 32 + fr, fq * 8);
#define PG8_SA(b, h) (((b) * 2 + (h)) * HTB)
#define PG8_SB(b, h) ((4 + (b) * 2 + (h)) * HTB)
#define PG8_STAGE(bufoff, gbase, voff) do { _Pragma("unroll") for (int _i = 0; _i < 2; ++_i) \
        __builtin_amdgcn_global_load_lds((const unsigned*)((const char*)(gbase) + (voff)[_i]), (PG8_LAS unsigned*)(lds + (bufoff) + ldsw + _i * 8192), 16, 0, 0); } while (0)
#define PG8_LDA(dst, b, h) do { _Pragma("unroll") for (int m = 0; m < 4; ++m) _Pragma("unroll") for (int k = 0; k < 2; ++k) dst[m][k] = *(const PG8_LAS bf16x8*)(lds + PG8_SA(b, h) + aoff + m * 2048 + k * 1024); } while (0)
#define PG8_LDB(dst, b, h) do { _Pragma("unroll") for (int n = 0; n < 2; ++n) _Pragma("unroll") for (int k = 0; k < 2; ++k) dst[n][k] = *(const PG8_LAS bf16x8*)(lds + PG8_SB(b, h) + boff + n * 2048 + k * 1024); } while (0)
#define PG8_MMA(ai, bj, At, Bt) do { __builtin_amdgcn_s_setprio(1); _Pragma("unroll") for (int m = 0; m < 4; ++m) _Pragma("unroll") for (int n = 0; n < 2; ++n) _Pragma("unroll") for (int k = 0; k < 2; ++k) \
        acc[ai][bj][m][n] = __builtin_amdgcn_mfma_f32_16x16x32_bf16(Bt[n][k], At[m][k], acc[ai][bj][m][n], 0, 0, 0); __builtin_amdgcn_s_setprio(0); } while (0)
#define PG8_WAIT_V(n) asm volatile("s_waitcnt vmcnt(" #n ")" ::: "memory")
#define PG8_WAIT_L(n) asm volatile("s_waitcnt lgkmcnt(" #n ")" ::: "memory")
#define PG8_BAR __builtin_amdgcn_s_barrier()
#define PG8_SCHED __builtin_amdgcn_sched_barrier(0)
    Unit cur, nxt; int ui = 0;
    if (!S.next(0, cur)) return;
    f32x4 acc[2][2][4][2];
#pragma unroll
    for (int a = 0; a < 2; ++a)
#pragma unroll
        for (int b = 0; b < 2; ++b)
#pragma unroll
            for (int m = 0; m < 4; ++m)
#pragma unroll
                for (int n = 0; n < 2; ++n) acc[a][b][m][n] = (f32x4){0.f, 0.f, 0.f, 0.f};
    bf16x8 At[4][2], B0[2][2], B1[2][2];
    const char* cA = (const char*)g.A + (size_t)cur.pm * tstep; const char* cB = (const char*)g.Bt + (size_t)cur.pn * tstep;
    S.a_ready(cur);
    if constexpr (SP2) {
        PG8_STAGE(PG8_SB(0, 0), cB, voffB); PG8_STAGE(PG8_SB(0, 1), cB + hstep, voffB); PG8_STAGE(PG8_SA(0, 0), cA, voffA); PG8_STAGE(PG8_SA(0, 1), cA + hstep, voffA);
        if (wr == 1) PG8_BAR;
        PG8_WAIT_V(2); PG8_BAR;
        PG8_STAGE(PG8_SB(1, 0), cB + kstep, voffB); PG8_STAGE(PG8_SA(1, 0), cA + kstep, voffA); PG8_STAGE(PG8_SB(1, 1), cB + hstep + kstep, voffB);
        PG8_WAIT_V(6); PG8_BAR;
    } else {
        PG8_STAGE(PG8_SB(0, 0), cB, voffB); PG8_STAGE(PG8_SA(0, 0), cA, voffA); PG8_STAGE(PG8_SB(0, 1), cB + hstep, voffB); PG8_STAGE(PG8_SA(0, 1), cA + hstep, voffA);
        if (wr == 1) PG8_BAR;
        PG8_WAIT_V(4); PG8_BAR;
        PG8_STAGE(PG8_SB(1, 0), cB + kstep, voffB); PG8_STAGE(PG8_SA(1, 0), cA + kstep, voffA); PG8_STAGE(PG8_SB(1, 1), cB + hstep + kstep, voffB);
        PG8_WAIT_V(6); PG8_BAR;
    }
    for (;;) {
        const bool has_next = S.next(ui + 1, nxt);
        const char* nA = has_next ? (const char*)g.A + (size_t)nxt.pm * tstep : cA; const char* nB = has_next ? (const char*)g.Bt + (size_t)nxt.pn * tstep : cB;
        for (int t = 0; t < nt; t += 2) {
            const bool last = (t == nt - 2);
            const char* a1 = cA + (size_t)(t + 1) * kstep;
            const char* a2 = last ? nA : cA + (size_t)(t + 2) * kstep; const char* b2 = last ? nB : cB + (size_t)(t + 2) * kstep;
            const char* a3 = a2 + kstep; const char* b3 = b2 + kstep;
            if (last && has_next) S.a_ready(nxt);
            if constexpr (SP2) {
            PG8_LDB(B0, 0, 0); PG8_LDB(B1, 0, 1); PG8_SCHED; PG8_LDA(At, 0, 0); PG8_STAGE(PG8_SA(1, 1), a1 + hstep, voffA);
            PG8_WAIT_V(8); PG8_WAIT_L(0); PG8_BAR; PG8_MMA(0, 0, At, B0); PG8_MMA(0, 1, At, B1); PG8_BAR; PG8_SCHED;
            PG8_LDA(At, 0, 1); PG8_STAGE(PG8_SB(0, 0), b2, voffB); PG8_STAGE(PG8_SB(0, 1), b2 + hstep, voffB); PG8_STAGE(PG8_SA(0, 0), a2, voffA);
            PG8_WAIT_V(8); PG8_WAIT_L(0); PG8_BAR; PG8_MMA(1, 0, At, B0); PG8_MMA(1, 1, At, B1); PG8_BAR; PG8_SCHED;
            PG8_LDB(B0, 1, 0); PG8_LDB(B1, 1, 1); PG8_SCHED; PG8_LDA(At, 1, 0); PG8_STAGE(PG8_SA(0, 1), a2 + hstep, voffA);
            PG8_WAIT_V(8); PG8_WAIT_L(0); PG8_BAR; PG8_MMA(0, 0, At, B0); PG8_MMA(0, 1, At, B1); PG8_BAR; PG8_SCHED;
            PG8_LDA(At, 1, 1); PG8_STAGE(PG8_SB(1, 0), b3, voffB); PG8_STAGE(PG8_SB(1, 1), b3 + hstep, voffB); PG8_STAGE(PG8_SA(1, 0), a3, voffA);
            PG8_WAIT_V(8); PG8_WAIT_L(0); PG8_BAR; PG8_MMA(1, 0, At, B0); PG8_MMA(1, 1, At, B1); PG8_BAR; PG8_SCHED;
            } else {
            PG8_LDB(B0, 0, 0); PG8_SCHED; PG8_LDA(At, 0, 0); PG8_STAGE(PG8_SA(1, 1), a1 + hstep, voffA);
            PG8_WAIT_L(8); PG8_BAR; PG8_WAIT_L(0); PG8_MMA(0, 0, At, B0); PG8_BAR; PG8_SCHED;
            PG8_LDB(B1, 0, 1); PG8_STAGE(PG8_SB(0, 0), b2, voffB);
            PG8_BAR; PG8_WAIT_L(0); PG8_MMA(0, 1, At, B1); PG8_BAR;
            PG8_LDA(At, 0, 1); PG8_STAGE(PG8_SA(0, 0), a2, voffA);
            PG8_BAR; PG8_WAIT_L(0); PG8_MMA(1, 0, At, B0); PG8_BAR; PG8_SCHED;
            PG8_STAGE(PG8_SB(0, 1), b2 + hstep, voffB);
            PG8_WAIT_V(6); PG8_BAR; PG8_MMA(1, 1, At, B1); PG8_BAR;
            PG8_LDB(B0, 1, 0); PG8_SCHED; PG8_LDA(At, 1, 0); PG8_STAGE(PG8_SA(0, 1), a2 + hstep, voffA);
            PG8_WAIT_L(8); PG8_BAR; PG8_WAIT_L(0); PG8_MMA(0, 0, At, B0); PG8_BAR; PG8_SCHED;
            PG8_LDB(B1, 1, 1); PG8_STAGE(PG8_SB(1, 0), b3, voffB);
            PG8_BAR; PG8_WAIT_L(0); PG8_MMA(0, 1, At, B1); PG8_BAR;
            PG8_LDA(At, 1, 1); PG8_STAGE(PG8_SA(1, 0), a3, voffA);
            PG8_BAR; PG8_WAIT_L(0); PG8_MMA(1, 0, At, B0); PG8_BAR; PG8_SCHED;
            PG8_STAGE(PG8_SB(1, 1), b3 + hstep, voffB);
            PG8_WAIT_V(6); PG8_BAR; PG8_MMA(1, 1, At, B1); PG8_BAR;
            }
        }
        if constexpr (ALIGN_EPI) { if (wr == 0) PG8_BAR; }
        if constexpr (!Epi::AFTER_DRAIN) { E(acc, cur, wr, wc, fr, fq); S.done(cur); }
        if (!has_next) break;
#pragma unroll
        for (int a = 0; a < 2; ++a)
#pragma unroll
            for (int b = 0; b < 2; ++b)
#pragma unroll
                for (int m = 0; m < 4; ++m)
#pragma unroll
                    for (int n = 0; n < 2; ++n) acc[a][b][m][n] = (f32x4){0.f, 0.f, 0.f, 0.f};
        cur = nxt; cA = nA; cB = nB; ++ui;
        if constexpr (ALIGN_EPI) { if (wr == 1) PG8_BAR; }
    }
    PG8_WAIT_V(0);
    if constexpr (!ALIGN_EPI) { if (wr == 0) PG8_BAR; }
    PG8_BAR;
    if constexpr (Epi::AFTER_DRAIN) { E.fused(acc, cur, wr, wc, fr, fq, lds, wid, lane); S.done(cur); }
#undef PG8_SA
#undef PG8_SB
#undef PG8_STAGE
#undef PG8_LDA
#undef PG8_LDB
#undef PG8_MMA
#undef PG8_WAIT_V
#undef PG8_WAIT_L
#undef PG8_BAR
#undef PG8_SCHED
}
}

#ifndef LAS
#define LAS __attribute__((address_space(3)))
#endif
typedef unsigned short bf16;
typedef float f32x4 __attribute__((ext_vector_type(4)));
typedef unsigned v4u __attribute__((ext_vector_type(4)));
typedef unsigned v2u __attribute__((ext_vector_type(2)));

#ifndef SEQ_
#define SEQ_ 4096
#define CTXL_ 256
#endif
constexpr int D = 1024, NB = 8, SEQ = SEQ_, CTXL = CTXL_, DEPTH = 4;
constexpr int RC = NB * CTXL;
constexpr int RL = NB * SEQ;
constexpr int RT = RC + RL;
constexpr int NIN = 7360, DFF = 2816;
constexpr int NTHR = 512, NWAVES = 8;
constexpr int LDS_BYTES = 147456;

constexpr size_t MiB = (size_t)1 << 20;
constexpr size_t WS_CTL = 0;
constexpr size_t WS_MOD = 1 * MiB;
constexpr size_t WS_W   = 2 * MiB;
constexpr size_t WS_XC  = 37 * MiB;
constexpr size_t WS_U   = 45 * MiB;
constexpr size_t WS_Y   = 113 * MiB;
constexpr size_t WS_BIG = 181 * MiB;
constexpr size_t WS_END = 471 * MiB;
constexpr size_t SZ17 = (size_t)RT * 256 * 2;
constexpr size_t SZ34 = (size_t)RT * 256 * 4;
constexpr size_t WO_WP = 0;
constexpr size_t WO_WG = WO_WP + (size_t)3328 * 1024;
constexpr size_t WO_BR = WO_WG + (size_t)4096 * 1024;
constexpr size_t WO_WO = WO_BR + (size_t)4 * 1024 * 256;
constexpr size_t WO_W1 = WO_WO + (size_t)1024 * 1024;
constexpr size_t WO_W2 = WO_W1 + (size_t)5632 * 1024;
static_assert((WO_W2 + (size_t)1024 * 2816) * 2 <= 35 * MiB, "weights region");
constexpr size_t BG_P = 0;
constexpr size_t BG_S = 68 * MiB;

struct Prm { const float* in[41]; float* out; unsigned char* ws; int lo, hi; };

__device__ __forceinline__ float bf2f(bf16 b) { return __uint_as_float(((unsigned)b) << 16); }
__device__ __forceinline__ bf16 f2bf(float f) { unsigned u = __float_as_uint(f); return (bf16)((u + 0x7fffu + ((u >> 16) & 1u)) >> 16); }
__device__ __forceinline__ unsigned pk2(float lo, float hi) { return (unsigned)f2bf(lo) | ((unsigned)f2bf(hi) << 16); }
__device__ __forceinline__ float blo(unsigned u) { return __uint_as_float(u << 16); }
__device__ __forceinline__ float bhi(unsigned u) { return __uint_as_float(u & 0xffff0000u); }
__device__ __forceinline__ float sigmoidf_(float x) { return 1.f / (1.f + __expf(-x)); }
__device__ __forceinline__ float softplusf_(float x) { return x > 20.f ? x : log1pf(__expf(x)); }
__device__ __forceinline__ float wave_sum(float v) {
#pragma unroll
    for (int o = 1; o < 64; o <<= 1) v += __shfl_xor(v, o);
    return v;
}
template <int CTRL> __device__ __forceinline__ float dpp_mov(float v) { return __int_as_float(__builtin_amdgcn_update_dpp(0, __float_as_int(v), CTRL, 0xF, 0xF, true)); }
__device__ __forceinline__ float row16_sum(float v) {
    v += dpp_mov<0xB1>(v);
    v += dpp_mov<0x4E>(v);
    v += dpp_mov<0x141>(v);
    v += dpp_mov<0x140>(v);
    return v;
}

#ifndef HOST_EMU
#define XB_TMO      128
#define XB_XCNT(j)  (256  + 64 * (j))
#define XB_XSUB(j)  (1280 + 64 * (j))
#define XB_XGEN(j)  (2304 + 64 * (j))
#define XB_TOP      3328
#define XB_TOPGEN   3392
#define XCD_BAR_WORDS 3456
#define XB_SPIN_CAP (1u << 18)
__device__ __forceinline__ unsigned xb_ld(unsigned* p)              { return __hip_atomic_load(p, __ATOMIC_RELAXED, __HIP_MEMORY_SCOPE_AGENT); }
__device__ __forceinline__ unsigned xb_add(unsigned* p, unsigned v) { return __hip_atomic_fetch_add(p, v, __ATOMIC_RELAXED, __HIP_MEMORY_SCOPE_AGENT); }
__device__ __forceinline__ unsigned xb_xcc_id() { return (unsigned)__builtin_amdgcn_s_getreg((3 << 11) | 20) & 0xFu; }
#define XB_SPIN(cond, bar) do { unsigned _sp = 0; while (cond) { __builtin_amdgcn_s_sleep(1); \
    if ((++_sp & 255u) == 0u) { if (xb_ld(&(bar)[XB_TMO])) break; if (_sp > XB_SPIN_CAP) { atomicAdd(&(bar)[XB_TMO], 1u); break; } } } } while (0)
struct XcdBarrier { unsigned* bar; unsigned x; volatile LAS unsigned* st; };
__device__ __forceinline__ XcdBarrier xcd_barrier_post(unsigned* bar, volatile LAS unsigned* st) {
    XcdBarrier b; b.bar = bar; b.x = xb_xcc_id(); b.st = st;
    if (threadIdx.x == 0) (void)xb_add(&bar[XB_XCNT(b.x)], 1u);
    return b;
}
__device__ __forceinline__ void xcd_barrier_complete(unsigned* bar, unsigned x, unsigned& nloc, unsigned& nx) {
    const unsigned G = gridDim.x * gridDim.y * gridDim.z;
    unsigned sum, cnt, mine, sp = 0u;
    for (;;) {
        sum = 0u; cnt = 0u; mine = 0u;
#pragma unroll
        for (unsigned j = 0; j < 16; ++j) { const unsigned c = xb_ld(&bar[XB_XCNT(j)]); sum += c; cnt += (c > 0u) ? 1u : 0u; mine = (j == x) ? c : mine; }
        if (sum == G) break;
        __builtin_amdgcn_s_sleep(1);
        if ((++sp & 255u) == 0u) { if (xb_ld(&bar[XB_TMO])) break; if (sp > XB_SPIN_CAP) { atomicAdd(&bar[XB_TMO], 1u); break; } }
    }
    nloc = mine > 0u ? mine : 1u; nx = cnt > 0u ? cnt : 1u;
}
__device__ __forceinline__ void xcd_barrier(const XcdBarrier& b) {
    asm volatile("s_waitcnt vmcnt(0)" ::: "memory");
    __syncthreads();
    if (threadIdx.x == 0) {
        unsigned* bar = b.bar;
        __builtin_amdgcn_s_waitcnt(0);
        unsigned nloc = b.st[0], nx = b.st[1];
        if (nloc == 0u) { xcd_barrier_complete(bar, b.x, nloc, nx); b.st[0] = nloc; b.st[1] = nx; }
        const unsigned old = xb_add(&bar[XB_XSUB(b.x)], 1u);
        const unsigned gen = old / nloc;
        if (old + 1u == (gen + 1u) * nloc) {
            __builtin_amdgcn_fence(__ATOMIC_RELEASE, "agent");
            asm volatile("s_waitcnt vmcnt(0)" ::: "memory");
            const unsigned og = xb_add(&bar[XB_TOP], 1u);
            const unsigned tg = og / nx;
            if (og + 1u == (tg + 1u) * nx) xb_add(&bar[XB_TOPGEN], 1u);
            else XB_SPIN(xb_ld(&bar[XB_TOPGEN]) == tg, bar);
            __builtin_amdgcn_fence(__ATOMIC_ACQUIRE, "agent");
            xb_add(&bar[XB_XGEN(b.x)], 1u);
            asm volatile("s_waitcnt vmcnt(0)" ::: "memory");
        } else {
            XB_SPIN(xb_ld(&bar[XB_XGEN(b.x)]) == gen, bar);
            __builtin_amdgcn_fence(__ATOMIC_ACQUIRE, "agent");
            asm volatile("s_waitcnt vmcnt(0)" ::: "memory");
        }
    }
    __syncthreads();
}

#endif
#define TID ((int)threadIdx.x)
#define BID ((int)blockIdx.x)
#define NBLK ((int)gridDim.x)

__device__ __forceinline__ void ph_mod(const Prm& p, LAS unsigned char* lds) {
    LAS float* sc = (LAS float*)lds;
    LAS float* red = sc + 9 * 1024;
    const float* c = p.in[1]; const float* cctx = p.in[3]; const float* w_mod = p.in[4]; const float* b_mod = p.in[5];
    float* mod = (float*)(p.ws + WS_MOD);
    const int tid = TID, lane = tid & 63, wave = tid >> 6;
    for (int i = tid; i < 9 * 1024; i += NTHR) { const int j = i >> 10, k = i & 1023; const float v = (j < 8) ? c[j * 1024 + k] : cctx[k]; sc[i] = v / (1.f + expf(-v)); }
    __syncthreads();
    for (int it = BID; it < 4 * 96; it += NBLK) {
        const int l = it / 96, cg = it % 96, col = cg * 64 + lane;
        float acc[9];
#pragma unroll
        for (int j = 0; j < 9; ++j) acc[j] = 0.f;
        const float* W = w_mod + (size_t)l * 1024 * 6144 + col;
        for (int k = wave * 128; k < wave * 128 + 128; ++k) { const float w = W[(size_t)k * 6144];
#pragma unroll
            for (int j = 0; j < 9; ++j) acc[j] += sc[j * 1024 + k] * w; }
#pragma unroll
        for (int j = 0; j < 9; ++j) red[(wave * 9 + j) * 64 + lane] = acc[j];
        __syncthreads();
        for (int i = tid; i < 9 * 64; i += NTHR) { const int j = i >> 6, ln = i & 63; float s = b_mod[l * 6144 + cg * 64 + ln];
#pragma unroll
            for (int w = 0; w < 8; ++w) s += red[(w * 9 + j) * 64 + ln];
            mod[((size_t)l * 9 + j) * 6144 + cg * 64 + ln] = s; }
        __syncthreads();
    }
}

#ifdef HOST_EMU
#define LGKM_WAIT() do { (void)emu_xchg(0, threadIdx.x & 63); } while (0)
#else
#define LGKM_WAIT() asm volatile("s_waitcnt lgkmcnt(0)" ::: "memory")
#endif
__device__ __forceinline__ void cvt_item(const float* W, size_t ldw, int k0, int n0, bf16* WT, int K, int drow0, LAS float* scr, int lane) {
#pragma unroll 8
    for (int i = 0; i < 32; ++i) { const int kk = 2 * i + (lane >> 5); scr[kk * 33 + (lane & 31)] = W[(size_t)(k0 + kk) * ldw + n0 + (lane & 31)]; }
    LGKM_WAIT();
    const int c = lane & 7;
#pragma unroll
    for (int j = 0; j < 4; ++j) { const int n = (lane >> 3) + 8 * j; const LAS float* s = scr + (8 * c) * 33 + n;
        v4u o; o.x = pk2(s[0 * 33], s[1 * 33]); o.y = pk2(s[2 * 33], s[3 * 33]); o.z = pk2(s[4 * 33], s[5 * 33]); o.w = pk2(s[6 * 33], s[7 * 33]);
        *(v4u*)(WT + (size_t)(drow0 + n) * K + k0 + 8 * c) = o; }
    LGKM_WAIT();
}
__device__ __forceinline__ void ph_cvt(const Prm& p, int l, LAS unsigned char* lds) {
    const int tid = TID, lane = tid & 63, wave = tid >> 6;
    LAS float* scr = (LAS float*)(lds + wave * 16384);
    bf16* WB = (bf16*)(p.ws + WS_W);
    const float* w_in = p.in[8] + (size_t)l * 1024 * NIN;
    const float* brp = p.in[36] + (size_t)l * 4 * 256 * 1024;
    const float* wout = p.in[37] + (size_t)l * 1024 * 1024;
    const float* w1 = p.in[38] + (size_t)l * 1024 * 5632;
    const float* w2 = p.in[39] + (size_t)l * 2816 * 1024;
    constexpr int I_IN = 16 * 230, I_BR = 4 * 4 * 32, I_WO = 16 * 32, I_W1 = 16 * 176, I_W2 = 44 * 32, I_PAD = 16;
    constexpr int NITEMS = I_IN + I_BR + I_WO + I_W1 + I_W2 + I_PAD;
    const int gw = BID * NWAVES + wave, NGW = NBLK * NWAVES;
    for (int it = gw; it < NITEMS; it += NGW) {
        int r = it;
        if (r < I_IN) { const int kb = r / 230, nb = r % 230, n0 = nb * 32;
            if (n0 < 3264) { const int drow = n0 < 1728 ? n0 : n0 + 64; cvt_item(w_in, NIN, kb * 64, n0, WB + WO_WP, 1024, drow, scr, lane);
            } else { cvt_item(w_in, NIN, kb * 64, n0, WB + WO_WG, 1024, n0 - 3264, scr, lane); }
            continue; }
        r -= I_IN;
        if (r < I_BR) { const int n = r / 128, q = r % 128, kb = q / 32, nb = q % 32;
            cvt_item(brp + (size_t)n * 256 * 1024, 1024, kb * 64, nb * 32, WB + WO_BR + (size_t)n * 1024 * 256, 256, nb * 32, scr, lane); continue; }
        r -= I_BR;
        if (r < I_WO) { const int kb = r / 32, nb = r % 32; cvt_item(wout, 1024, kb * 64, nb * 32, WB + WO_WO, 1024, nb * 32, scr, lane); continue; }
        r -= I_WO;
        if (r < I_W1) { const int kb = r / 176, nb = r % 176, n0 = nb * 32; const int hh = n0 / 2816, jj = n0 % 2816, pn = jj / 128, j2 = jj % 128;
            cvt_item(w1, 5632, kb * 64, n0, WB + WO_W1, 1024, 256 * pn + 128 * hh + j2, scr, lane); continue; }
        r -= I_W1;
        if (r < I_W2) { const int kb = r / 32, nb = r % 32; cvt_item(w2, 1024, kb * 64, nb * 32, WB + WO_W2, 2816, nb * 32, scr, lane); continue; }
        r -= I_W2;
        {
            v4u z = (v4u){0u, 0u, 0u, 0u};
            for (int i = lane; i < 4 * 128; i += 64) { const int rr = 1728 + r * 4 + i / 128, cc = (i % 128) * 8; *(v4u*)(WB + WO_WP + (size_t)rr * 1024 + cc) = z; }
        }
    }
}

__device__ __forceinline__ void ph_norm(const Prm& p, int l, int which, const float* xc_src, const float* xl_src, int r_begin) {
    const int tid = TID, lane = tid & 63, wave = tid >> 6;
    const float* mod = (const float*)(p.ws + WS_MOD) + (size_t)l * 9 * 6144;
    const float* g = (which ? p.in[7] : p.in[6]) + l * 1024;
    bf16* U = (bf16*)(p.ws + WS_U);
    const int gw = BID * NWAVES + wave, NGW = NBLK * NWAVES;
    for (int r = r_begin + gw; r < RT; r += NGW) {
        const float* xr = (r < RC) ? xc_src + (size_t)r * 1024 : xl_src + (size_t)(r - RC) * 1024;
        const int jb = (r < RC) ? 8 : (r - RC) / SEQ;
        const float* shift = mod + (size_t)jb * 6144 + (which ? 3 * 1024 : 0);
        const float* scale = shift + 1024;
        f32x4 v[4]; float s = 0.f;
#pragma unroll
        for (int j = 0; j < 4; ++j) { v[j] = *(const f32x4*)(xr + 4 * lane + 256 * j); s += (v[j].x * v[j].x + v[j].y * v[j].y) + (v[j].z * v[j].z + v[j].w * v[j].w); }
        const float rstd = rsqrtf(wave_sum(s) * (1.f / 1024.f) + 1e-6f);
#pragma unroll
        for (int j = 0; j < 4; ++j) { const int c0 = 4 * lane + 256 * j;
            const f32x4 gg = *(const f32x4*)(g + c0), sc = *(const f32x4*)(scale + c0), sh = *(const f32x4*)(shift + c0);
            const f32x4 o = v[j] * rstd * gg * (1.f + sc) + sh;
            v2u w; w.x = pk2(o.x, o.y); w.y = pk2(o.z, o.w);
            *(v2u*)(U + (size_t)r * 1024 + c0) = w; }
    }
}
__device__ __forceinline__ void ph_final(const Prm& p) {
    const int tid = TID, lane = tid & 63, wave = tid >> 6;
    const float* g = p.in[40];
    const int gw = BID * NWAVES + wave, NGW = NBLK * NWAVES;
    for (int r = gw; r < RL; r += NGW) {
        float* xr = p.out + (size_t)r * 1024;
        f32x4 v[4]; float s = 0.f;
#pragma unroll
        for (int j = 0; j < 4; ++j) { v[j] = *(const f32x4*)(xr + 4 * lane + 256 * j); s += (v[j].x * v[j].x + v[j].y * v[j].y) + (v[j].z * v[j].z + v[j].w * v[j].w); }
        const float rstd = rsqrtf(wave_sum(s) * (1.f / 1024.f) + 1e-6f);
#pragma unroll
        for (int j = 0; j < 4; ++j) { const int c0 = 4 * lane + 256 * j; const f32x4 gg = *(const f32x4*)(g + c0); *(f32x4*)(xr + c0) = v[j] * rstd * gg; }
    }
}

struct RowInfo { int lat, b, t, T, base; };
__device__ __forceinline__ RowInfo row_info(int r) {
    RowInfo q;
    if (r < RC) { q.lat = 0; q.b = r / CTXL; q.t = r % CTXL; q.T = CTXL; q.base = q.b * CTXL; }
    else { const int x = r - RC; q.lat = 1; q.b = x / SEQ; q.t = x % SEQ; q.T = SEQ; q.base = RC + q.b * SEQ; }
    return q;
}
__device__ __forceinline__ int scan_row(int b, int d, int tau) {
    if (tau < CTXL) return b * CTXL + (d ? (CTXL - 1 - tau) : tau);
    const int t = tau - CTXL; return RC + b * SEQ + (d ? (SEQ - 1 - t) : t);
}

constexpr size_t RW_R = 0, RW_K = SZ17, RW_V = 2 * SZ17, RW_KK = 3 * SZ17, RW_OM = 4 * SZ17  , RW_A = 6 * SZ17  , RW_G = 8 * SZ17, RW_Y = 9 * SZ17  , RW_BON = 9 * SZ17 + 2 * SZ34;
static_assert(RW_BON + (size_t)RT * 16 <= 222 * MiB, "rwkv scratch");

__device__ __forceinline__ void ph_rw_prep(const Prm& p, int l, LAS unsigned char* lds) {
    LAS float* xx = (LAS float*)lds;
    const int tid = TID, lane = tid & 63;
    const bf16* P = (const bf16*)(p.ws + WS_BIG + BG_P);
    unsigned char* S = p.ws + WS_BIG + BG_S;
    bf16* oR = (bf16*)(S + RW_R); bf16* oK = (bf16*)(S + RW_K); bf16* oV = (bf16*)(S + RW_V); bf16* oKK = (bf16*)(S + RW_KK);
    bf16* oOM = (bf16*)(S + RW_OM); bf16* oA = (bf16*)(S + RW_A); bf16* oG = (bf16*)(S + RW_G); float* oBon = (float*)(S + RW_BON);
    const float* mu = p.in[18] + l * 960;
    const float* w0 = p.in[19] + l * 512; const float* w2 = p.in[20] + (size_t)l * 2 * 64 * 256;
    const float* a0 = p.in[21] + l * 512; const float* a2 = p.in[22] + (size_t)l * 2 * 64 * 256;
    const float* g2 = p.in[23] + (size_t)l * 64 * 256;
    const float* k_k = p.in[24] + l * 256; const float* r_k = p.in[26] + l * 256;
    const int j = tid & 255, half = tid >> 8, h = j >> 6;
    for (int tile = BID; tile < RT / 16; tile += NBLK) {
        const int r0 = tile * 16;
        for (int i = tid; i < 16 * 960; i += NTHR) {
            const int rr = i / 960, c = i % 960, r = r0 + rr, q = c & 3;
            const RowInfo ri = row_info(r);
            int nb = -1;
            if (ri.lat) {
                const int gc = ri.t & 63, gr = ri.t >> 6;
                if (q == 0) { if (gc >= 1) nb = r - 1; } else if (q == 1) { if (gc <= 62) nb = r + 1; }
                else if (q == 2) { if (gr >= 1) nb = r - 64; } else { if (gr <= SEQ / 64 - 2) nb = r + 64; }
            } else {
                if ((q & 1) == 0) { if (ri.t >= 1) nb = r - 1; } else { if (ri.t <= CTXL - 2) nb = r + 1; }
            }
            const float pv = bf2f(P[(size_t)r * 1024 + c]);
            const float sv = nb >= 0 ? bf2f(P[(size_t)nb * 1024 + c]) : 0.f;
            float x = pv + (sv - pv) * mu[c];
            if (c >= 768 && c < 832) x = tanhf(x); else if (c >= 896) x = sigmoidf_(x);
            xx[rr * 960 + c] = x;
        }
        __syncthreads();
        float aw0[8], aw1[8], aa0[8], aa1[8], ag[8];
#pragma unroll
        for (int q = 0; q < 8; ++q) { aw0[q] = 0.f; aw1[q] = 0.f; aa0[q] = 0.f; aa1[q] = 0.f; ag[q] = 0.f; }
        for (int i = 0; i < 64; ++i) {
            const float w20 = w2[i * 256 + j], w21 = w2[64 * 256 + i * 256 + j], a20 = a2[i * 256 + j], a21 = a2[64 * 256 + i * 256 + j], g2v = g2[i * 256 + j];
#pragma unroll
            for (int q = 0; q < 8; ++q) { const LAS float* xr = xx + (half * 8 + q) * 960;
                const float cw = xr[768 + i], ca = xr[832 + i], cg = xr[896 + i];
                aw0[q] += cw * w20; aw1[q] += cw * w21; aa0[q] += ca * a20; aa1[q] += ca * a21; ag[q] += cg * g2v; }
        }
        const float kkj = k_k[j], rkj = r_k[j], w00 = w0[j], w01 = w0[256 + j], a00 = a0[j], a01 = a0[256 + j];
#pragma unroll
        for (int q = 0; q < 8; ++q) {
            const int rr = half * 8 + q; const size_t r = (size_t)(r0 + rr);
            const float rv = xx[rr * 960 + j], kv = xx[rr * 960 + 256 + j], vv = xx[rr * 960 + 512 + j];
            const float kkr = kv * kkj;
            const float ss = wave_sum(kkr * kkr);
            const float kkn = kkr * rsqrtf(ss + 1e-12f);
            const float bon = wave_sum(rv * kv * rkj);
            oR[r * 256 + j] = f2bf(rv); oK[r * 256 + j] = f2bf(kv); oV[r * 256 + j] = f2bf(vv); oKK[r * 256 + j] = f2bf(kkn);
            oG[r * 256 + j] = f2bf(ag[q]);
            if (lane == 0) oBon[r * 4 + h] = bon;
#pragma unroll
            for (int d = 0; d < 2; ++d) {
                const float wv = (d ? w01 : w00) + (d ? aw1[q] : aw0[q]);
                const float logw = -softplusf_(-wv) - 0.5f;
                const float om = -expm1f(-expf(logw));
                const float av = sigmoidf_((d ? a01 : a00) + (d ? aa1[q] : aa0[q]));
                oOM[(size_t)d * RT * 256 + r * 256 + j] = f2bf(om);
                oA[(size_t)d * RT * 256 + r * 256 + j] = f2bf(av);
            }
        }
        __syncthreads();
    }
}

template <int MODE>
__device__ __forceinline__ void scan_phase(const unsigned char* Sb  , const bf16* Pv  , float* Yout  ,
                                           const float* ka  , const float* gam  , LAS unsigned char* lds) {
    constexpr int NA = MODE == 0 ? 6 : 3, CH = 32, STEPB = NA * 128, BUFB = CH * STEPB, NPIECE = CH * NA * 8, NLD = (NPIECE + NTHR - 1) / NTHR;
    const int tid = TID, lane = tid & 63, wave = tid >> 6;
    if (BID >= 128) return;
    const int prob = BID >> 1, b = prob >> 3, h = (prob >> 1) & 3, d = prob & 1;
    const int rowv = 32 * (BID & 1) + 4 * wave + (lane >> 4);
    const int kl = lane & 15;
    float kav[4] = {0.f, 0.f, 0.f, 0.f};
    float gamma = 0.f;
    if (MODE == 0) {
#pragma unroll
        for (int i = 0; i < 4; ++i) kav[i] = ka[h * 64 + 4 * kl + i];
    } else gamma = sigmoidf_(gam[d * 4 + h]);
    float S[4] = {0.f, 0.f, 0.f, 0.f};
    v4u pre[NLD];
    const unsigned char* gsrc[NLD]; int gld[NLD]; int gs[NLD]; int ldso[NLD];
#pragma unroll
    for (int i = 0; i < NLD; ++i) { const int e = tid + NTHR * i; const int s = e / (NA * 8), rem = e % (NA * 8), a = rem >> 3, piece = rem & 7;
        gs[i] = s; ldso[i] = s * STEPB + a * 128 + piece * 16;
        if (MODE == 0) { const int slot = a == 0 ? 0 : a == 1 ? 1 : a == 2 ? 3 : a == 3 ? 4 + d : a == 4 ? 6 + d : 2;
            gsrc[i] = Sb + (size_t)slot * SZ17 + (size_t)(h * 64 + piece * 8) * 2; gld[i] = 512; }
        else { if (a < 2) { gsrc[i] = Sb + (size_t)a * SZ17 + (size_t)(h * 64 + piece * 8) * 2; gld[i] = 512; }
               else { gsrc[i] = (const unsigned char*)Pv + (size_t)(512 + h * 64 + piece * 8) * 2; gld[i] = 2048; } }
    }
#define SCAN_ISSUE(c) do { _Pragma("unroll") for (int i = 0; i < NLD; ++i) { if (tid + NTHR * i < NPIECE) { const int row = scan_row(b, d, (c) * CH + gs[i]); \
        pre[i] = *(const v4u*)(gsrc[i] + (size_t)row * gld[i]); } } } while (0)
#define SCAN_COMMIT(buf) do { _Pragma("unroll") for (int i = 0; i < NLD; ++i) { if (tid + NTHR * i < NPIECE) *(LAS v4u*)(lds + (buf) * BUFB + ldso[i]) = pre[i]; } } while (0)
    constexpr int NCH = (CTXL + SEQ) / CH;
    SCAN_ISSUE(0); SCAN_COMMIT(0); __syncthreads();
    for (int c = 0; c < NCH; ++c) {
        if (c + 1 < NCH) SCAN_ISSUE(c + 1);
        const LAS unsigned char* bufp = lds + (c & 1) * BUFB;
#pragma unroll 4
        for (int s = 0; s < CH; ++s) {
            const LAS unsigned char* sp = bufp + s * STEPB;
            float y;
            if (MODE == 0) {
                const v2u r2 = *(const LAS v2u*)(sp + 0 * 128 + kl * 8), k2 = *(const LAS v2u*)(sp + 1 * 128 + kl * 8), kk2 = *(const LAS v2u*)(sp + 2 * 128 + kl * 8),
                          om2 = *(const LAS v2u*)(sp + 3 * 128 + kl * 8), a2 = *(const LAS v2u*)(sp + 4 * 128 + kl * 8);
                const float vv = bf2f(*(const LAS bf16*)(sp + 5 * 128 + rowv * 2));
                const float rr[4] = {blo(r2.x), bhi(r2.x), blo(r2.y), bhi(r2.y)};
                const float kr[4] = {blo(k2.x), bhi(k2.x), blo(k2.y), bhi(k2.y)};
                const float kk[4] = {blo(kk2.x), bhi(kk2.x), blo(kk2.y), bhi(kk2.y)};
                const float om[4] = {blo(om2.x), bhi(om2.x), blo(om2.y), bhi(om2.y)};
                const float as[4] = {blo(a2.x), bhi(a2.x), blo(a2.y), bhi(a2.y)};
                float sap = 0.f;
#pragma unroll
                for (int i = 0; i < 4; ++i) sap -= S[i] * kk[i];
                const float sa = row16_sum(sap);
                float yp = 0.f;
#pragma unroll
                for (int i = 0; i < 4; ++i) {
                    const float kt = kr[i] * (1.f + (as[i] - 1.f) * kav[i]);
                    const float bb = kk[i] * as[i];
                    S[i] = S[i] * (1.f - om[i]) + (sa * bb + vv * kt);
                    yp += S[i] * rr[i];
                }
                y = row16_sum(yp);
            } else {
                const v2u q2 = *(const LAS v2u*)(sp + 0 * 128 + kl * 8), k2 = *(const LAS v2u*)(sp + 1 * 128 + kl * 8);
                const float vv = bf2f(*(const LAS bf16*)(sp + 2 * 128 + rowv * 2));
                const float qq[4] = {blo(q2.x), bhi(q2.x), blo(q2.y), bhi(q2.y)};
                const float kr[4] = {blo(k2.x), bhi(k2.x), blo(k2.y), bhi(k2.y)};
                float yp = 0.f;
#pragma unroll
                for (int i = 0; i < 4; ++i) { S[i] = S[i] * gamma + vv * kr[i]; yp += S[i] * qq[i]; }
                y = row16_sum(yp);
            }
            if (kl == 0) { const int row = scan_row(b, d, c * CH + s); Yout[((size_t)d * RT + row) * 256 + h * 64 + rowv] = y; }
        }
        if (c + 1 < NCH) SCAN_COMMIT((c + 1) & 1);
        __syncthreads();
    }
#undef SCAN_ISSUE
#undef SCAN_COMMIT
}

__device__ __forceinline__ void ph_rw_post(const Prm& p, int l) {
    const int tid = TID, j = tid & 255, h = j >> 6;
    unsigned char* S = p.ws + WS_BIG + BG_S;
    const float* Y = (const float*)(S + RW_Y); const bf16* V = (const bf16*)(S + RW_V); const bf16* G = (const bf16*)(S + RW_G); const float* Bon = (const float*)(S + RW_BON);
    bf16* yrw = (bf16*)(p.ws + WS_Y + 1 * SZ17);
    const float lng = p.in[27][l * 256 + j];
    for (int r = BID * 2 + (tid >> 8); r < RT; r += NBLK * 2) {
        const size_t o = (size_t)r * 256 + j;
        const float y = Y[o] + Y[(size_t)RT * 256 + o];
        const float mean = wave_sum(y) * (1.f / 64.f); const float dv = y - mean;
        const float var = wave_sum(dv * dv) * (1.f / 64.f);
        float v = dv * rsqrtf(var + 64e-5f) * lng;
        v += Bon[(size_t)r * 4 + h] * bf2f(V[o]);
        v *= bf2f(G[o]);
        yrw[o] = f2bf(v);
    }
}

constexpr size_t RT_Q = 0, RT_K = SZ17, RT_Y = 2 * SZ17  ;
__device__ __forceinline__ void ph_ret_prep(const Prm& p) {
    const int tid = TID, j = tid & 255;
    const bf16* P = (const bf16*)(p.ws + WS_BIG + BG_P);
    unsigned char* S = p.ws + WS_BIG + BG_S;
    bf16* oQ = (bf16*)(S + RT_Q); bf16* oK = (bf16*)(S + RT_K);
    const int hh = j & 63, i32 = hh & 31, idx = i32 & 15; const bool second = i32 >= 16, colhalf = hh >= 32;
    const float inv = exp2f(-(float)idx * (13.287712379549449f / 16.f));
    for (int r = BID * 2 + (tid >> 8); r < RT; r += NBLK * 2) {
        const size_t o = (size_t)r * 1024;
        float q = bf2f(P[o + j]), k = bf2f(P[o + 256 + j]);
        if (r >= RC) {
            const int t = (r - RC) & (SEQ - 1);
            const float coord = (float)(colhalf ? (t & 63) : (t >> 6));
            float sn, cs; sincosf(coord * inv, &sn, &cs);
            const int pj = second ? j - 16 : j + 16;
            const float qp = bf2f(P[o + pj]), kp = bf2f(P[o + 256 + pj]);
            q = second ? (qp * sn + q * cs) : (q * cs - qp * sn);
            k = second ? (kp * sn + k * cs) : (k * cs - kp * sn);
        }
        oQ[(size_t)r * 256 + j] = f2bf(q); oK[(size_t)r * 256 + j] = f2bf(k * 0.125f);
    }
}
__device__ __forceinline__ void ph_ret_post(const Prm& p) {
    const int tid = TID, j = tid & 255;
    const bf16* P = (const bf16*)(p.ws + WS_BIG + BG_P);
    const float* Y = (const float*)(p.ws + WS_BIG + BG_S + RT_Y);
    bf16* yret = (bf16*)(p.ws + WS_Y + 3 * SZ17);
    for (int r = BID * 2 + (tid >> 8); r < RT; r += NBLK * 2) {
        const size_t o = (size_t)r * 256 + j;
        const float y = Y[o] + Y[(size_t)RT * 256 + o];
        const float mean = wave_sum(y) * (1.f / 64.f); const float dv = y - mean;
        const float var = wave_sum(dv * dv) * (1.f / 64.f);
        const float g = bf2f(P[(size_t)r * 1024 + 768 + j]);
        yret[o] = f2bf(dv * rsqrtf(var + 1e-5f) * (g * sigmoidf_(g)));
    }
}

constexpr size_t LR_A = 0  , LR_B = 2 * SZ34  ;
__device__ __forceinline__ void ph_lru_prep(const Prm& p, int l, LAS unsigned char* lds) {
    LAS float* xc = (LAS float*)lds;
    const int tid = TID;
    const bf16* P = (const bf16*)(p.ws + WS_BIG + BG_P);
    float* A = (float*)(p.ws + WS_BIG + BG_S + LR_A); float* B = (float*)(p.ws + WS_BIG + BG_S + LR_B);
    const float* cw = p.in[28] + l * 4 * 256; const float* cb = p.in[29] + l * 256;
    const float* wa = p.in[30] + (size_t)l * 2 * 4 * 64 * 64; const float* ba = p.in[31] + l * 512;
    const float* wx = p.in[32] + (size_t)l * 2 * 4 * 64 * 64; const float* bx = p.in[33] + l * 512;
    const float* lam = p.in[34] + l * 512;
    const int j = tid & 255, half = tid >> 8, g = j >> 6, o = j & 63;
    const float sp0 = softplusf_(-lam[j]), sp1 = softplusf_(-lam[256 + j]);
    for (int tile = BID; tile < RT / 16; tile += NBLK) {
        const int r0 = tile * 16;
        for (int i = tid; i < 16 * 256; i += NTHR) {
            const int rr = i >> 8, jj = i & 255, r = r0 + rr; const RowInfo ri = row_info(r);
            float acc = cb[jj];
#pragma unroll
            for (int q = 0; q < 4; ++q) { const int tt = ri.t + q - 2; if (tt >= 0 && tt < ri.T) acc += cw[q * 256 + jj] * bf2f(P[(size_t)(ri.base + tt) * 512 + jj]); }
            xc[i] = acc;
        }
        __syncthreads();
        float ra0[8], ra1[8], rx0[8], rx1[8];
#pragma unroll
        for (int q = 0; q < 8; ++q) { ra0[q] = 0.f; ra1[q] = 0.f; rx0[q] = 0.f; rx1[q] = 0.f; }
        for (int i = 0; i < 64; ++i) {
            const float wa0 = wa[((0 * 4 + g) * 64 + i) * 64 + o], wa1 = wa[((1 * 4 + g) * 64 + i) * 64 + o], wx0 = wx[((0 * 4 + g) * 64 + i) * 64 + o], wx1 = wx[((1 * 4 + g) * 64 + i) * 64 + o];
#pragma unroll
            for (int q = 0; q < 8; ++q) { const float x = xc[(half * 8 + q) * 256 + g * 64 + i]; ra0[q] += x * wa0; ra1[q] += x * wa1; rx0[q] += x * wx0; rx1[q] += x * wx1; }
        }
#pragma unroll
        for (int q = 0; q < 8; ++q) {
            const int rr = half * 8 + q; const size_t r = (size_t)(r0 + rr); const float xcv = xc[rr * 256 + j];
#pragma unroll
            for (int d = 0; d < 2; ++d) {
                const float rg = sigmoidf_((d ? ra1[q] : ra0[q]) + ba[d * 256 + j]);
                const float ig = sigmoidf_((d ? rx1[q] : rx0[q]) + bx[d * 256 + j]);
                const float log_a = -8.f * rg * (d ? sp1 : sp0);
                const float a = expf(log_a);
                const float bv = sqrtf(-expm1f(2.f * log_a)) * (ig * xcv);
                A[((size_t)d * RT + r) * 256 + j] = a; B[((size_t)d * RT + r) * 256 + j] = bv;
            }
        }
        __syncthreads();
    }
}
__device__ __forceinline__ void ph_lru_scan(const Prm& p) {
    const int gid = BID * NTHR + TID;
    if (gid >= 4096) return;
    const int d = gid >> 11, b = (gid >> 8) & 7, j = gid & 255;
    const float* A = (const float*)(p.ws + WS_BIG + BG_S + LR_A) + (size_t)d * RT * 256 + j;
    float* B = (float*)(p.ws + WS_BIG + BG_S + LR_B) + (size_t)d * RT * 256 + j;
    float h = 0.f;
    for (int tau = 0; tau < CTXL + SEQ; tau += 8) {
        float a[8], bb[8]; size_t ro[8];
#pragma unroll
        for (int q = 0; q < 8; ++q) { ro[q] = (size_t)scan_row(b, d, tau + q) * 256; a[q] = A[ro[q]]; bb[q] = B[ro[q]]; }
#pragma unroll
        for (int q = 0; q < 8; ++q) { h = a[q] * h + bb[q]; B[ro[q]] = h; }
    }
}
__device__ __forceinline__ void ph_lru_post(const Prm& p) {
    const int tid = TID, j = tid & 255;
    const bf16* P = (const bf16*)(p.ws + WS_BIG + BG_P);
    const float* H = (const float*)(p.ws + WS_BIG + BG_S + LR_B);
    bf16* ylru = (bf16*)(p.ws + WS_Y + 2 * SZ17);
    for (int r = BID * 2 + (tid >> 8); r < RT; r += NBLK * 2) {
        const size_t o = (size_t)r * 256 + j;
        const float hsum = H[o] + H[(size_t)RT * 256 + o];
        const float x = bf2f(P[(size_t)r * 512 + 256 + j]);
        const float ge = 0.5f * x * (1.f + tanhf(0.7978845608028654f * (x + 0.044715f * x * x * x)));
        ylru[o] = f2bf(hsum * ge);
    }
}

constexpr size_t HY_VL = 0, HY_VC = 96 * MiB, HY_FL = 102 * MiB, HY_FC = 118 * MiB;
__device__ __forceinline__ void ph_hy_filter(const Prm& p, int l, bool with_ctx, LAS unsigned char* lds) {
    LAS float* feat = (LAS float*)lds;
    LAS float* h1 = feat + 16 * 17;
    LAS float* h2 = h1 + 16 * 64;
    const int tid = TID;
    const float* w1 = p.in[11] + l * 17 * 64; const float* b1 = p.in[12] + l * 64; const float* w2 = p.in[13] + l * 64 * 64; const float* b2 = p.in[14] + l * 64;
    const float* w3 = p.in[15] + (size_t)l * 64 * 1024; const float* freq = p.in[16] + l * 128;
    float* FL = (float*)(p.ws + WS_BIG + BG_S + HY_FL); float* FC = (float*)(p.ws + WS_BIG + BG_S + HY_FC);
    const int ntile = with_ctx ? (SEQ + CTXL) / 16 : SEQ / 16;
    for (int tile = BID; tile < ntile; tile += NBLK) {
        const bool isctx = tile >= SEQ / 16; const int L = isctx ? CTXL : SEQ; const int pos0 = (isctx ? tile - SEQ / 16 : tile) * 16;
        float* F = isctx ? FC : FL;
        if (tid < 16 * 17) { const int pp = tid / 17, f = tid % 17; const float t = (float)(pos0 + pp) / (float)L;
            float v; if (f == 0) v = t; else if (f <= 8) v = sinf(6.283185307179586f * t * (float)f); else v = cosf(6.283185307179586f * t * (float)(f - 8));
            feat[tid] = v; }
        __syncthreads();
        for (int i = tid; i < 1024; i += NTHR) { const int pp = i >> 6, o = i & 63; float s = b1[o];
            for (int f = 0; f < 17; ++f) s += feat[pp * 17 + f] * w1[f * 64 + o];
            h1[i] = sinf(freq[o] * s); }
        __syncthreads();
        for (int i = tid; i < 1024; i += NTHR) { const int pp = i >> 6, o = i & 63; float s = b2[o];
            for (int q = 0; q < 64; ++q) s += h1[pp * 64 + q] * w2[q * 64 + o];
            h2[i] = sinf(freq[64 + o] * s); }
        __syncthreads();
        for (int cc = tid; cc < 1024; cc += NTHR) {
            float acc[16];
#pragma unroll
            for (int pp = 0; pp < 16; ++pp) acc[pp] = 0.f;
            for (int q = 0; q < 64; ++q) { const float w = w3[q * 1024 + cc];
#pragma unroll
                for (int pp = 0; pp < 16; ++pp) acc[pp] += h2[pp * 64 + q] * w; }
            const int o = cc >> 9, dd = (cc >> 8) & 1, c = cc & 255;
            const float rate = 3.0701134573253945f + (15.350567286626973f - 3.0701134573253945f) * (float)c * (1.f / 255.f);
            float* Fo = F + (size_t)(o * 256 + c) * (2 * L);
#pragma unroll
            for (int pp = 0; pp < 16; ++pp) { const int pos = pos0 + pp; const float t = (float)pos / (float)L;
                const float val = acc[pp] * expf(-t * rate);
                if (dd == 0) Fo[L + pos] = val; else if (pos >= 1) Fo[L - pos] = val; }
            if (pos0 == 0 && dd == 0) Fo[0] = 0.f;
        }
        __syncthreads();
    }
}
__device__ __forceinline__ void ph_hy_fnorm(const Prm& p, bool with_ctx) {
    const int tid = TID, lane = tid & 63, wave = tid >> 6;
    float* FL = (float*)(p.ws + WS_BIG + BG_S + HY_FL); float* FC = (float*)(p.ws + WS_BIG + BG_S + HY_FC);
    const int gw = BID * NWAVES + wave, NGW = NBLK * NWAVES;
    for (int it = gw; it < (with_ctx ? 1024 : 512); it += NGW) {
        const bool isctx = it >= 512; const int L = isctx ? CTXL : SEQ; float* F = (isctx ? FC : FL) + (size_t)(it & 511) * (2 * L);
        float s = 0.f;
        for (int i = lane; i < 2 * L; i += 64) { const float v = F[i]; s += v * v; }
        const float sc = rsqrtf(wave_sum(s) + 1e-6f);
        for (int i = lane; i < 2 * L; i += 64) F[i] *= sc;
    }
}
__device__ __forceinline__ void ph_hy_prep(const Prm& p, int l, bool with_ctx, LAS unsigned char* lds) {
    LAS float* tl = (LAS float*)lds;
    const int tid = TID;
    const bf16* P = (const bf16*)(p.ws + WS_BIG + BG_P);
    float* VL = (float*)(p.ws + WS_BIG + BG_S + HY_VL); float* VC = (float*)(p.ws + WS_BIG + BG_S + HY_VC);
    const float* cw = p.in[9] + l * 3 * 768; const float* cb = p.in[10] + l * 768;
    const int NTL = 8 * (SEQ / 64) * 12, NTC = with_ctx ? 8 * (CTXL / 64) * 12 : 0;
    for (int tile = BID; tile < NTL + NTC; tile += NBLK) {
        const bool isctx = tile >= NTL; const int tt = isctx ? tile - NTL : tile;
        const int T = isctx ? CTXL : SEQ, ntt = T / 64;
        const int ct = tt % 12, tb = (tt / 12) % ntt, b = tt / (12 * ntt);
        const int base = isctx ? b * CTXL : RC + b * SEQ, t0 = tb * 64, c0 = ct * 64;
        for (int i = tid; i < 66 * 64; i += NTHR) { const int rr = i >> 6, cc = i & 63, t = t0 - 1 + rr;
            tl[rr * 65 + cc] = (t >= 0 && t < T) ? bf2f(P[(size_t)(base + t) * 768 + c0 + cc]) : 0.f; }
        __syncthreads();
        const int part = c0 >> 8, cl0 = c0 & 255;
        float* dst = (isctx ? VC : VL) + ((size_t)(part * 8 + b) * 256 + cl0) * T + t0;
        for (int i = tid; i < 64 * 64; i += NTHR) { const int cc = i >> 6, ti = i & 63, col = c0 + cc;
            const float v = cb[col] + cw[col] * tl[ti * 65 + cc] + cw[768 + col] * tl[(ti + 1) * 65 + cc] + cw[1536 + col] * tl[(ti + 2) * 65 + cc];
            dst[(size_t)cc * T + ti] = v; }
        __syncthreads();
    }
}
template <int L>
__device__ __forceinline__ void hy_conv_item(const Prm& p, int l, int c, int b0, LAS unsigned char* lds) {
    constexpr int NI = (L + NTHR - 1) / NTHR;
    LAS float* hh = (LAS float*)lds;
    LAS float* z = hh + 2 * L;
    const int tid = TID;
    const bool isctx = (L == CTXL);
    const float* F = (const float*)(p.ws + WS_BIG + BG_S + (isctx ? HY_FC : HY_FL));
    const float* HV = (const float*)(p.ws + WS_BIG + BG_S + (isctx ? HY_VC : HY_VL));
    const float* bias = p.in[17] + l * 512;
    for (int bb = 0; bb < 4; ++bb) for (int t = tid; t < L; t += NTHR) z[t * 4 + bb] = HV[((size_t)(0 * 8 + b0 + bb) * 256 + c) * L + t];
    for (int o = 0; o < 2; ++o) {
        for (int i = tid; i < 2 * L; i += NTHR) hh[i] = F[(size_t)(o * 256 + c) * (2 * L) + i];
        __syncthreads();
        float acc[NI][4];
#pragma unroll
        for (int i = 0; i < NI; ++i) { acc[i][0] = 0.f; acc[i][1] = 0.f; acc[i][2] = 0.f; acc[i][3] = 0.f; }
        if (tid < L) {
            for (int s = 0; s < L; ++s) {
                const f32x4 zs = *(const LAS f32x4*)(z + s * 4);
#pragma unroll
                for (int i = 0; i < NI; ++i) { const float hv = hh[L + tid + NTHR * i - s];
                    acc[i][0] += hv * zs.x; acc[i][1] += hv * zs.y; acc[i][2] += hv * zs.z; acc[i][3] += hv * zs.w; }
            }
        }
        __syncthreads();
        const float bo = bias[o * 256 + c];
        if (tid < L) {
#pragma unroll
            for (int i = 0; i < NI; ++i) { const int t = tid + NTHR * i;
#pragma unroll
                for (int bb = 0; bb < 4; ++bb) { const float gate = HV[((size_t)((1 + o) * 8 + b0 + bb) * 256 + c) * L + t];
                    z[t * 4 + bb] = gate * (acc[i][bb] + bo * z[t * 4 + bb]); } }
        }
        __syncthreads();
    }
    float* HVw = (float*)(p.ws + WS_BIG + BG_S + (isctx ? HY_VC : HY_VL));
    if (tid < L) {
#pragma unroll
        for (int i = 0; i < NI; ++i) { const int t = tid + NTHR * i;
#pragma unroll
            for (int bb = 0; bb < 4; ++bb) HVw[((size_t)(0 * 8 + b0 + bb) * 256 + c) * L + t] = z[t * 4 + bb]; }
    }
    __syncthreads();
}
__device__ __forceinline__ void ph_hy_post(const Prm& p, bool with_ctx, LAS unsigned char* lds) {
    LAS float* tl = (LAS float*)lds;
    const int tid = TID;
    const float* VL = (const float*)(p.ws + WS_BIG + BG_S + HY_VL); const float* VC = (const float*)(p.ws + WS_BIG + BG_S + HY_VC);
    bf16* yhy = (bf16*)(p.ws + WS_Y);
    const int NTL = 8 * (SEQ / 64) * 4, NTC = with_ctx ? 8 * (CTXL / 64) * 4 : 0;
    for (int tile = BID; tile < NTL + NTC; tile += NBLK) {
        const bool isctx = tile >= NTL; const int tt = isctx ? tile - NTL : tile;
        const int T = isctx ? CTXL : SEQ, ntt = T / 64;
        const int ct = tt % 4, tb = (tt / 4) % ntt, b = tt / (4 * ntt);
        const int base = isctx ? b * CTXL : RC + b * SEQ, t0 = tb * 64, c0 = ct * 64;
        const float* src = (isctx ? VC : VL) + ((size_t)b * 256 + c0) * T + t0;
        for (int i = tid; i < 64 * 64; i += NTHR) { const int cc = i >> 6, ti = i & 63; tl[cc * 65 + ti] = src[(size_t)cc * T + ti]; }
        __syncthreads();
        for (int i = tid; i < 64 * 32; i += NTHR) { const int ti = i >> 5, cp = i & 31;
            *(unsigned*)(yhy + (size_t)(base + t0 + ti) * 256 + c0 + 2 * cp) = pk2(tl[(2 * cp) * 65 + ti], tl[(2 * cp + 1) * 65 + ti]); }
        __syncthreads();
    }
}
__device__ __forceinline__ void ph_hy_conv(const Prm& p, int l, bool with_ctx, LAS unsigned char* lds) {
    for (int it = BID; it < 512; it += NBLK) hy_conv_item<SEQ>(p, l, it >> 1, (it & 1) * 4, lds);
    if (with_ctx) for (int it = BID; it < 512; it += NBLK) hy_conv_item<CTXL>(p, l, it >> 1, (it & 1) * 4, lds);
}

constexpr int PPL = 30;
constexpr int NPH = 1 + DEPTH * PPL + 1;

template <unsigned MASK> __global__ void __launch_bounds__(NTHR, 2) fwd(Prm p) {
#ifdef HOST_EMU
    unsigned char* lds_raw = g_lds_emu;
#else
    extern __shared__ __attribute__((aligned(16))) unsigned char lds_raw[];
#endif
    LAS unsigned char* lds = (LAS unsigned char*)lds_raw;
    volatile LAS unsigned* misc = (volatile LAS unsigned*)(lds + LDS_BYTES - 256);
    if (TID < 64) misc[TID] = 0u;
    __syncthreads();
    const int lo = p.lo, hi = p.hi;
    XcdBarrier bar; bar.bar = (unsigned*)(p.ws + WS_CTL); bar.x = 0; bar.st = misc + 8;
    if (hi - lo > 1) bar = xcd_barrier_post((unsigned*)(p.ws + WS_CTL), misc + 8);
    int ph = 0;
#define PH_BEGIN(k) if (((MASK >> ((k) & 31)) & 1u) && ph >= lo && ph < hi) {
#define PH_END   if (ph + 1 < hi) xcd_barrier(bar); } ++ph;
    bf16* const WB = (bf16*)(p.ws + WS_W);
    bf16* const U = (bf16*)(p.ws + WS_U);
    float* const XC = (float*)(p.ws + WS_XC);
    bf16* const PB = (bf16*)(p.ws + WS_BIG + BG_P);
    unsigned char* const SB = p.ws + WS_BIG + BG_S;
    bf16* const GH = (bf16*)(p.ws + WS_BIG);
    bf16* const MG = (bf16*)(p.ws + WS_BIG + 136 * MiB);
    bf16* const ACT = (bf16*)(p.ws + WS_BIG);
    const float* const MOD = (const float*)(p.ws + WS_MOD);
    typedef pg8::StaticOrder SO;

    PH_BEGIN(1) ph_mod(p, lds); PH_END

    for (int l = 0; l < DEPTH; ++l) {
        const bool last = (l == DEPTH - 1), wctx = !last;
        const float* xc_src = (l == 0) ? p.in[2] : XC;
        const float* xl_src = (l == 0) ? p.in[0] : p.out;
        const int ro = last ? RC : 0, Mpost = last ? RL : RT;
        const float* modl = MOD + (size_t)l * 9 * 6144;

        PH_BEGIN(2) ph_cvt(p, l, lds); PH_END
        PH_BEGIN(3) ph_norm(p, l, 0, xc_src, xl_src, 0); PH_END
        PH_BEGIN(4) { pg8::Gemm g{U, WB + WO_WP + (size_t)768 * 1024, RT, 1024, 1024}; SO S; S.init(RT, 1024, NBLK, BID); pg8::EpiBf<0> E{PB, 1024};
                   pg8::gemm_phase<pg8::EpiBf<0>, SO, true, true>(lds, g, S, E); } PH_END
        PH_BEGIN(5) ph_rw_prep(p, l, lds); PH_END
        PH_BEGIN(6) scan_phase<0>(SB, PB, (float*)(SB + RW_Y), p.in[25] + l * 256, nullptr, lds); PH_END
        PH_BEGIN(7) ph_rw_post(p, l); PH_END
        PH_BEGIN(8) { pg8::Gemm g{U, WB + WO_WP + (size_t)2304 * 1024, RT, 1024, 1024}; SO S; S.init(RT, 1024, NBLK, BID); pg8::EpiBf<0> E{PB, 1024};
                   pg8::gemm_phase<pg8::EpiBf<0>, SO, true, true>(lds, g, S, E); } PH_END
        PH_BEGIN(9) ph_ret_prep(p); PH_END
        PH_BEGIN(10) scan_phase<1>(SB, PB, (float*)(SB + RT_Y), nullptr, p.in[35] + l * 8, lds); PH_END
        PH_BEGIN(11) ph_ret_post(p); PH_END
        PH_BEGIN(12) { pg8::Gemm g{U, WB + WO_WP + (size_t)1792 * 1024, RT, 512, 1024}; SO S; S.init(RT, 512, NBLK, BID); pg8::EpiBf<0> E{PB, 512};
                   pg8::gemm_phase<pg8::EpiBf<0>, SO, true, true>(lds, g, S, E); } PH_END
        PH_BEGIN(13) ph_lru_prep(p, l, lds); PH_END
        PH_BEGIN(14) ph_lru_scan(p); PH_END
        PH_BEGIN(15) ph_lru_post(p); PH_END
        PH_BEGIN(16) { pg8::Gemm g{U, WB + WO_WP, RT, 768, 1024}; SO S; S.init(RT, 768, NBLK, BID); pg8::EpiBf<0> E{PB, 768};
                   pg8::gemm_phase<pg8::EpiBf<0>, SO, true, true>(lds, g, S, E); } PH_END
        PH_BEGIN(17) ph_hy_filter(p, l, wctx, lds); PH_END
        PH_BEGIN(18) ph_hy_fnorm(p, wctx); PH_END
        PH_BEGIN(19) ph_hy_prep(p, l, wctx, lds); PH_END
        PH_BEGIN(20) ph_hy_conv(p, l, wctx, lds); PH_END
        PH_BEGIN(32) ph_hy_post(p, wctx, lds); PH_END
        PH_BEGIN(21) { pg8::Gemm g{U + (size_t)ro * 1024, WB + WO_WG, Mpost, 2048, 1024}; SO S; S.init(Mpost, 2048, NBLK, BID); pg8::EpiBf<1> E{GH + (size_t)ro * 2048, 2048};
                   pg8::gemm_phase<pg8::EpiBf<1>, SO, true, true>(lds, g, S, E); } PH_END
        PH_BEGIN(22) { pg8::Gemm g{(const bf16*)(p.ws + WS_Y + 0 * SZ17) + (size_t)ro * 256, WB + WO_BR + (size_t)0 * 1024 * 256, Mpost, 1024, 256}; SO S; S.init(Mpost, 1024, NBLK, BID);
                   pg8::EpiMerge E{GH + (size_t)ro * 2048, 2048, 0, MG + (size_t)ro * 1024, 1};
                   pg8::gemm_phase<pg8::EpiMerge, SO, true, true>(lds, g, S, E); } PH_END
        PH_BEGIN(23) { pg8::Gemm g{(const bf16*)(p.ws + WS_Y + 1 * SZ17) + (size_t)ro * 256, WB + WO_BR + (size_t)1 * 1024 * 256, Mpost, 1024, 256}; SO S; S.init(Mpost, 1024, NBLK, BID);
                   pg8::EpiMerge E{GH + (size_t)ro * 2048, 2048, 1024, MG + (size_t)ro * 1024, 0};
                   pg8::gemm_phase<pg8::EpiMerge, SO, true, true>(lds, g, S, E); } PH_END
        PH_BEGIN(24) { pg8::Gemm g{U + (size_t)ro * 1024, WB + WO_WG + (size_t)2048 * 1024, Mpost, 2048, 1024}; SO S; S.init(Mpost, 2048, NBLK, BID); pg8::EpiBf<1> E{GH + (size_t)ro * 2048, 2048};
                   pg8::gemm_phase<pg8::EpiBf<1>, SO, true, true>(lds, g, S, E); } PH_END
        PH_BEGIN(25) { pg8::Gemm g{(const bf16*)(p.ws + WS_Y + 2 * SZ17) + (size_t)ro * 256, WB + WO_BR + (size_t)2 * 1024 * 256, Mpost, 1024, 256}; SO S; S.init(Mpost, 1024, NBLK, BID);
                   pg8::EpiMerge E{GH + (size_t)ro * 2048, 2048, 0, MG + (size_t)ro * 1024, 0};
                   pg8::gemm_phase<pg8::EpiMerge, SO, true, true>(lds, g, S, E); } PH_END
        PH_BEGIN(26) { pg8::Gemm g{(const bf16*)(p.ws + WS_Y + 3 * SZ17) + (size_t)ro * 256, WB + WO_BR + (size_t)3 * 1024 * 256, Mpost, 1024, 256}; SO S; S.init(Mpost, 1024, NBLK, BID);
                   pg8::EpiMerge E{GH + (size_t)ro * 2048, 2048, 1024, MG + (size_t)ro * 1024, 0};
                   pg8::gemm_phase<pg8::EpiMerge, SO, true, true>(lds, g, S, E); } PH_END
        PH_BEGIN(27) { pg8::Gemm g{MG + (size_t)ro * 1024, WB + WO_WO, Mpost, 1024, 1024}; SO S; S.init(Mpost, 1024, NBLK, BID);
                   pg8::EpiResid E{xc_src, xl_src, XC, p.out, modl, 2 * 1024, ro};
                   pg8::gemm_phase<pg8::EpiResid, SO, true, true>(lds, g, S, E); } PH_END
        PH_BEGIN(28) ph_norm(p, l, 1, XC, p.out, ro); PH_END
        PH_BEGIN(29) { pg8::Gemm g{U + (size_t)ro * 1024, WB + WO_W1, Mpost, 5632, 1024}; SO S; S.init(Mpost, 5632, NBLK, BID); pg8::EpiSwiglu E{ACT + (size_t)ro * 2816, 2816};
                   pg8::gemm_phase<pg8::EpiSwiglu, SO, true, true>(lds, g, S, E); } PH_END
        PH_BEGIN(30) { pg8::Gemm g{ACT + (size_t)ro * 2816, WB + WO_W2, Mpost, 1024, 2816}; SO S; S.init(Mpost, 1024, NBLK, BID);
                   pg8::EpiResid E{XC, p.out, XC, p.out, modl, 5 * 1024, ro};
                   pg8::gemm_phase<pg8::EpiResid, SO, true, true>(lds, g, S, E); } PH_END
    }
    PH_BEGIN(31) ph_final(p); PH_END
#undef PH_BEGIN
#undef PH_END
}

#ifndef HOST_EMU
#define SITE(k) (1u << (k))
constexpr int NG = 19;
constexpr unsigned GM[NG] = {
    SITE(0) | SITE(1) | SITE(2) | SITE(3) | SITE(28) | SITE(31) | SITE(7) | SITE(11) | SITE(15) | SITE(9) | SITE(18) | SITE(19),
    SITE(5),
    SITE(6) | SITE(10),
    SITE(13) | SITE(14),
    SITE(17) | SITE(20),
    SITE(4), SITE(8), SITE(12), SITE(16), SITE(21), SITE(24), SITE(22), SITE(23), SITE(25), SITE(26), SITE(27), SITE(30), SITE(29), 0u };
template <int G> static bool prep_group() { return hipFuncSetAttribute((const void*)fwd<GM[G]>, hipFuncAttributeMaxDynamicSharedMemorySize, LDS_BYTES) == hipSuccess; }
template <int G> static void launch_group(int grid, hipStream_t stream, const Prm& p) { hipLaunchKernelGGL(fwd<GM[G]>, dim3(grid), dim3(NTHR), LDS_BYTES, stream, p); }

extern "C" void kernel_launch(void* const* d_in, const int* in_sizes, int n_in, void* d_out, int out_size, void* d_ws, size_t ws_size, hipStream_t stream) {
    static int grid = 0;
    if (grid == 0) {
        if (n_in != 41 || out_size != RL * D || ws_size < WS_END) { fprintf(stderr, "kernel_launch: unexpected shapes (n_in %d out %d ws %zu); nothing launched\n", n_in, out_size, ws_size); grid = -1; return; }
        int dev = 0, cus = 0;
        if (hipGetDevice(&dev) != hipSuccess || hipDeviceGetAttribute(&cus, hipDeviceAttributeMultiprocessorCount, dev) != hipSuccess) { grid = -1; return; }
        bool ok = true;
        ok = ok && prep_group<0>(); ok = ok && prep_group<1>(); ok = ok && prep_group<2>(); ok = ok && prep_group<3>(); ok = ok && prep_group<4>(); ok = ok && prep_group<5>(); ok = ok && prep_group<6>(); ok = ok && prep_group<7>(); ok = ok && prep_group<8>(); ok = ok && prep_group<9>(); ok = ok && prep_group<10>(); ok = ok && prep_group<11>(); ok = ok && prep_group<12>(); ok = ok && prep_group<13>(); ok = ok && prep_group<14>(); ok = ok && prep_group<15>(); ok = ok && prep_group<16>(); ok = ok && prep_group<17>();
        if (!ok) { fprintf(stderr, "kernel_launch: hipFuncSetAttribute failed\n"); grid = -1; return; }
        (void)hipGetLastError();
        grid = cus > 0 ? cus : 256;
    }
    if (grid < 0) return;
    if (hipMemsetAsync((char*)d_ws + WS_CTL, 0, 1 * MiB, stream) != hipSuccess) return;
    Prm p{};
    for (int i = 0; i < 41; ++i) p.in[i] = (const float*)d_in[i];
    p.out = (float*)d_out; p.ws = (unsigned char*)d_ws;
    for (int ph = 0; ph < NPH; ++ph) {
        p.lo = ph; p.hi = ph + 1;
        static const int layer_sites[PPL] = {2, 3, 4, 5, 6, 7, 8, 9, 10, 11, 12, 13, 14, 15, 16, 17, 18, 19, 20, 0  , 21, 22, 23, 24, 25, 26, 27, 28, 29, 30};
        const int k = (ph == 0) ? 1 : (ph == NPH - 1) ? 31 : layer_sites[(ph - 1) % PPL];
        int g = -1;
        for (int q = 0; q < NG; ++q) if ((GM[q] >> k) & 1u) g = q;
        switch (g) {
            case 0: launch_group<0>(grid, stream, p); break;
            case 1: launch_group<1>(grid, stream, p); break;
            case 2: launch_group<2>(grid, stream, p); break;
            case 3: launch_group<3>(grid, stream, p); break;
            case 4: launch_group<4>(grid, stream, p); break;
            case 5: launch_group<5>(grid, stream, p); break;
            case 6: launch_group<6>(grid, stream, p); break;
            case 7: launch_group<7>(grid, stream, p); break;
            case 8: launch_group<8>(grid, stream, p); break;
            case 9: launch_group<9>(grid, stream, p); break;
            case 10: launch_group<10>(grid, stream, p); break;
            case 11: launch_group<11>(grid, stream, p); break;
            case 12: launch_group<12>(grid, stream, p); break;
            case 13: launch_group<13>(grid, stream, p); break;
            case 14: launch_group<14>(grid, stream, p); break;
            case 15: launch_group<15>(grid, stream, p); break;
            case 16: launch_group<16>(grid, stream, p); break;
            case 17: launch_group<17>(grid, stream, p); break;
            default: break; }
#ifdef DIAG_BUILD
        { static const int dg[8][2] = {{0, 0}, {2, 1}, {10, 2}, {14, 3}, {20, 4}, {22, 5}, {26, 6}, {28, 7}};
          for (int q = 0; q < 8; ++q) if (ph == 1 + dg[q][0]) hipLaunchKernelGGL(diag_k, dim3(32), dim3(NTHR), 0, stream, p, dg[q][1]);
          if (ph == 1 + 19) hipLaunchKernelGGL(diag_k, dim3(32), dim3(NTHR), 0, stream, p, 8);
          if (ph == NPH - 1) hipLaunchKernelGGL(diag_out_k, dim3(grid), dim3(NTHR), 0, stream, p); }
#endif
    }
}
#endif
```

```cpp
#include <hip/hip_runtime.h>
#include <cstdio>
#include <cstdint>

#ifndef SEQ_
#define SEQ_ 4096
#define CTXL_ 256
#endif
#ifndef MK_PER_PHASE
#define MK_PER_PHASE 0
#endif

#ifndef HOST_EMU
extern __shared__ __attribute__((aligned(16))) unsigned char g_dyn_lds[];
constexpr int TIDTAB_OFF = 147456 - 2048;
__device__ __forceinline__ unsigned hw_slot() { return (unsigned)__builtin_amdgcn_s_getreg((7 << 11) | 4) & 0xFFu; }
__device__ __forceinline__ int tid_opq() {
    const unsigned w = ((const volatile __attribute__((address_space(3))) unsigned*)((__attribute__((address_space(3))) unsigned char*)g_dyn_lds + TIDTAB_OFF))[hw_slot()];
    unsigned lane; asm volatile("v_mbcnt_lo_u32_b32 %0, -1, 0\n\tv_mbcnt_hi_u32_b32 %0, -1, %0" : "=v"(lane));
    int t = (int)((unsigned)__builtin_amdgcn_readfirstlane((int)w) * 64u + lane); asm volatile("" : "+v"(t)); return t;
}
#endif

namespace pg8 {
#define PG8_LAS __attribute__((address_space(3)))
typedef unsigned short bf16_t;
typedef short bf16x8 __attribute__((ext_vector_type(8)));
typedef float f32x4 __attribute__((ext_vector_type(4)));
typedef unsigned u32x4 __attribute__((ext_vector_type(4)));
constexpr int BM = 256, BK = 64, HALF = 128, HTB = HALF * BK * 2  , STAGE_BYTES = 8 * HTB, NXCD = 8, WGM = 8;

__host__ __device__ __forceinline__ int lds_byte(int r, int c) { const int st = (r >> 4) * 2 + (c >> 5), rr = r & 15, cc = c & 31, ob = rr * 64 + cc * 2; return st * 1024 + (ob ^ (((ob >> 9) & 1) << 5)); }
__host__ __device__ __forceinline__ void stage_rc(int b, int& R, int& C) { const int st = b / 1024, sb = b % 1024, swz = sb ^ (((sb >> 9) & 1) << 5); R = (st >> 1) * 16 + swz / 64; C = (st & 1) * 32 + (swz % 64) / 2; }
__host__ __device__ __forceinline__ int perm32(int rho) { const int n = rho >> 4, i = rho & 15; return 8 * (i >> 2) + 4 * n + (i & 3); }

struct Unit { int pm, pn; };
struct Gemm { const bf16_t* A; const bf16_t* Bt; int M, N, K; };

struct StaticOrder {
    int nM, nN, nwg, G, c;
    __host__ __device__ void init(int M, int N, int G_, int c_) { nM = M / BM; nN = N / BM; nwg = nM * nN; G = G_; c = c_; }
    __host__ __device__ bool next(int i, Unit& u) const {
        const long L = (long)i * G + c; if (L >= nwg) return false;
        int wgid = (int)L; { const int q = nwg / NXCD, r = nwg % NXCD, xcd = wgid % NXCD, off = wgid / NXCD; wgid = (xcd < r ? xcd * (q + 1) : r * (q + 1) + (xcd - r) * q) + off; }
        const int nig = WGM * nN, gid = wgid / nig, fm = gid * WGM, gsz = (nM - fm) < WGM ? (nM - fm) : WGM;
        u.pm = fm + ((wgid % nig) % gsz); u.pn = (wgid % nig) / gsz; return true;
    }
    __device__ __forceinline__ void a_ready(const Unit&) const {}
    __device__ __forceinline__ void done(const Unit&) const {}
};

#ifdef HOST_EMU
__device__ __forceinline__ unsigned cvt_pk_bf16(float lo, float hi) { auto f = [](float x) { unsigned u; memcpy(&u, &x, 4); return (u + 0x7fffu + ((u >> 16) & 1u)) >> 16; }; return f(lo) | (f(hi) << 16); }
#else
typedef __bf16 pg8_bf16x2 __attribute__((ext_vector_type(2)));
typedef float pg8_f32x2 __attribute__((ext_vector_type(2)));
__device__ __forceinline__ unsigned cvt_pk_bf16(float lo, float hi) { pg8_f32x2 v = {lo, hi}; pg8_bf16x2 b = __builtin_convertvector(v, pg8_bf16x2); return __builtin_bit_cast(unsigned, b); }
#endif
typedef float f32x2 __attribute__((ext_vector_type(2)));
__device__ __forceinline__ float bflo(unsigned u) { return __uint_as_float(u << 16); }
__device__ __forceinline__ float bfhi(unsigned u) { return __uint_as_float(u & 0xffff0000u); }
#ifdef HOST_EMU
__device__ __forceinline__ float fsigmoid(float x) { return 1.f / (1.f + expf(-x)); }
#else
__device__ __forceinline__ float fsigmoid(float x) { return __builtin_amdgcn_rcpf(1.f + __expf(-x)); }
#endif

#ifdef HOST_EMU
#define EPI_PIN() do { } while (0)
#define EPI_LATE(fr, fq) do { } while (0)
#define EPI_Z(z) do { } while (0)
#else
#define EPI_Z(z) asm volatile("" : "+v"(z))
#define EPI_LATE(fr, fq) asm volatile("" : "+v"(fr), "+v"(fq))

#define EPI_PIN() asm volatile("" ::: "memory")
#endif
template <int ACT> struct EpiBf {
    static constexpr bool PERM = true, AFTER_DRAIN = false;
    bf16_t* O; int ldc;
    __device__ __forceinline__ void operator()(const f32x4 (&acc)[2][2][4][2], const Unit& u, int wr, int wc, int fr, int fq) const {
        EPI_LATE(fr, fq);
        const int row0 = u.pm * BM + wr * 64 + fr, col0 = u.pn * BM + wc * 32 + 8 * fq;
#pragma unroll
        for (int ai = 0; ai < 2; ++ai)
#pragma unroll
            for (int m = 0; m < 4; ++m) { bf16_t* rowp = O + (size_t)(row0 + ai * HALF + m * 16) * ldc + col0;
#pragma unroll
                for (int bj = 0; bj < 2; ++bj) { f32x4 v0 = acc[ai][bj][m][0], v1 = acc[ai][bj][m][1];
                    if (ACT == 1) {
#pragma unroll
                        for (int j = 0; j < 4; ++j) { v0[j] = fsigmoid(v0[j]); v1[j] = fsigmoid(v1[j]); } }
                    u32x4 w; w.x = cvt_pk_bf16(v0[0], v0[1]); w.y = cvt_pk_bf16(v0[2], v0[3]); w.z = cvt_pk_bf16(v1[0], v1[1]); w.w = cvt_pk_bf16(v1[2], v1[3]);
                    *(u32x4*)(rowp + bj * HALF) = w; } }
    }
};

struct EpiMerge {
    static constexpr bool PERM = true, AFTER_DRAIN = false;
    const bf16_t* G; int ldg; int gcol0; bf16_t* Mg; int first;
    __device__ __forceinline__ void operator()(const f32x4 (&acc)[2][2][4][2], const Unit& u, int wr, int wc, int fr, int fq) const {
        EPI_LATE(fr, fq);
        const int row0 = u.pm * BM + wr * 64 + fr, col0 = u.pn * BM + wc * 32 + 8 * fq;
#pragma unroll
        for (int ai = 0; ai < 2; ++ai)
#pragma unroll
            for (int m = 0; m < 4; ++m) { const size_t row = (size_t)(row0 + ai * HALF + m * 16);
#pragma unroll
                for (int bj = 0; bj < 2; ++bj) { const int col = col0 + bj * HALF;
                    const u32x4 gv = *(const u32x4*)(G + row * ldg + gcol0 + col);
                    bf16_t* mp = Mg + row * 1024 + col;
                    u32x4 pv; if (!first) pv = *(const u32x4*)mp; else { unsigned z0 = 0u; EPI_Z(z0); pv = (u32x4){z0, z0, z0, z0}; }
                    const f32x4 v0 = acc[ai][bj][m][0], v1 = acc[ai][bj][m][1];
                    float o[8];
                    o[0] = bflo(pv.x) + bflo(gv.x) * v0[0]; o[1] = bfhi(pv.x) + bfhi(gv.x) * v0[1];
                    o[2] = bflo(pv.y) + bflo(gv.y) * v0[2]; o[3] = bfhi(pv.y) + bfhi(gv.y) * v0[3];
                    o[4] = bflo(pv.z) + bflo(gv.z) * v1[0]; o[5] = bfhi(pv.z) + bfhi(gv.z) * v1[1];
                    o[6] = bflo(pv.w) + bflo(gv.w) * v1[2]; o[7] = bfhi(pv.w) + bfhi(gv.w) * v1[3];
                    u32x4 w; w.x = cvt_pk_bf16(o[0], o[1]); w.y = cvt_pk_bf16(o[2], o[3]); w.z = cvt_pk_bf16(o[4], o[5]); w.w = cvt_pk_bf16(o[6], o[7]);
                    *(u32x4*)mp = w; }
                EPI_PIN(); }
    }
};

struct EpiResid {
    static constexpr bool PERM = false, AFTER_DRAIN = false;
    const float* src_c; const float* src_l; float* dst_c; float* dst_l; const float* modl; int gate_off; int row_off;
    __device__ __forceinline__ void operator()(const f32x4 (&acc)[2][2][4][2], const Unit& u, int wr, int wc, int fr, int fq) const {
        EPI_LATE(fr, fq);
        const int grow0 = row_off + u.pm * BM;
        const bool isctx = grow0 < 8 * CTXL_;
        const int jb = isctx ? 8 : (grow0 - 8 * CTXL_) / SEQ_;
        const float* gate = modl + (size_t)jb * 6144 + gate_off;
        const float* src = isctx ? src_c + (size_t)grow0 * 1024 : src_l + (size_t)(grow0 - 8 * CTXL_) * 1024;
        float* dst = isctx ? dst_c + (size_t)grow0 * 1024 : dst_l + (size_t)(grow0 - 8 * CTXL_) * 1024;
        const int rr0 = wr * 64 + fr, col0 = u.pn * BM + wc * 32 + 4 * fq;
        f32x4 gv[2][2];
#pragma unroll
        for (int bj = 0; bj < 2; ++bj)
#pragma unroll
            for (int n = 0; n < 2; ++n) gv[bj][n] = *(const f32x4*)(gate + col0 + bj * HALF + n * 16);
#pragma unroll
        for (int ai = 0; ai < 2; ++ai)
#pragma unroll
            for (int m = 0; m < 4; ++m) { const size_t ro = (size_t)(rr0 + ai * HALF + m * 16) * 1024 + col0;
#pragma unroll
                for (int bj = 0; bj < 2; ++bj)
#pragma unroll
                    for (int n = 0; n < 2; ++n) { const f32x4 s = *(const f32x4*)(src + ro + bj * HALF + n * 16);
                        *(f32x4*)(dst + ro + bj * HALF + n * 16) = s + gv[bj][n] * acc[ai][bj][m][n]; }
                EPI_PIN(); }
    }
};

struct EpiSwiglu {
    static constexpr bool PERM = true, AFTER_DRAIN = false;
    bf16_t* O; int ldc;
    __device__ __forceinline__ void operator()(const f32x4 (&acc)[2][2][4][2], const Unit& u, int wr, int wc, int fr, int fq) const {
        EPI_LATE(fr, fq);
        const int row0 = u.pm * BM + wr * 64 + fr, col0 = u.pn * HALF + wc * 32 + 8 * fq;
#pragma unroll
        for (int ai = 0; ai < 2; ++ai)
#pragma unroll
            for (int m = 0; m < 4; ++m) { bf16_t* rowp = O + (size_t)(row0 + ai * HALF + m * 16) * ldc + col0;
                float o[8];
#pragma unroll
                for (int n = 0; n < 2; ++n)
#pragma unroll
                    for (int j = 0; j < 4; ++j) { const float g = acc[ai][0][m][n][j], up = acc[ai][1][m][n][j]; o[n * 4 + j] = g * fsigmoid(g) * up; }
                u32x4 w; w.x = cvt_pk_bf16(o[0], o[1]); w.y = cvt_pk_bf16(o[2], o[3]); w.z = cvt_pk_bf16(o[4], o[5]); w.w = cvt_pk_bf16(o[6], o[7]);
                *(u32x4*)rowp = w; }
    }
};

template <class Epi, class Sched, bool ALIGN_EPI = false, bool SP2 = false>
__device__ __forceinline__ void gemm_phase(PG8_LAS unsigned char* lds, const Gemm g, const Sched& S, const Epi& E) {
    const int tid = tid_opq();
    const int wid = __builtin_amdgcn_readfirstlane(tid >> 6), lane = tid & 63, wr = wid >> 2, wc = wid & 3, fr = lane & 15, fq = lane >> 4;
    const int K = g.K, nt = K / BK;
    unsigned voffA[2], voffB[2];
#pragma unroll
    for (int i = 0; i < 2; ++i) { int R, C; stage_rc(tid * 16 + i * 8192, R, C); const int Rb = Epi::PERM ? ((R & ~31) + perm32(R & 31)) : R;
        voffA[i] = (unsigned)(R * K + C) * 2u; voffB[i] = (unsigned)(Rb * K + C) * 2u; }
    const size_t kstep = (size_t)(BK * 2);
    const size_t hstep = (size_t)HALF * K * 2;
    const size_t tstep = 2 * hstep;
    const unsigned ldsw = (unsigned)wid * 1024u;
    const int aoff = lds_byte(wr * 64 + fr, fq * 8), boff = lds_byte(wc * 32 + fr, fq * 8);
#define PG8_SA(b, h) (((b) * 2 + (h)) * HTB)
#define PG8_SB(b, h) ((4 + (b) * 2 + (h)) * HTB)
#define PG8_STAGE(bufoff, gbase, voff) do { _Pragma("unroll") for (int _i = 0; _i < 2; ++_i) \
        __builtin_amdgcn_global_load_lds((const unsigned*)((const char*)(gbase) + (voff)[_i]), (PG8_LAS unsigned*)(lds + (bufoff) + ldsw + _i * 8192), 16, 0, 0); } while (0)
#define PG8_LDA(dst, b, h) do { _Pragma("unroll") for (int m = 0; m < 4; ++m) _Pragma("unroll") for (int k = 0; k < 2; ++k) dst[m][k] = *(const PG8_LAS bf16x8*)(lds + PG8_SA(b, h) + aoff + m * 2048 + k * 1024); } while (0)
#define PG8_LDB(dst, b, h) do { _Pragma("unroll") for (int n = 0; n < 2; ++n) _Pragma("unroll") for (int k = 0; k < 2; ++k) dst[n][k] = *(const PG8_LAS bf16x8*)(lds + PG8_SB(b, h) + boff + n * 2048 + k * 1024); } while (0)
#define PG8_MMA(ai, bj, At, Bt) do { __builtin_amdgcn_s_setprio(1); _Pragma("unroll") for (int m = 0; m < 4; ++m) _Pragma("unroll") for (int n = 0; n < 2; ++n) _Pragma("unroll") for (int k = 0; k < 2; ++k) \
        acc[ai][bj][m][n] = __builtin_amdgcn_mfma_f32_16x16x32_bf16(Bt[n][k], At[m][k], acc[ai][bj][m][n], 0, 0, 0); __builtin_amdgcn_s_setprio(0); } while (0)
#define PG8_WAIT_V(n) asm volatile("s_waitcnt vmcnt(" #n ")" ::: "memory")
#define PG8_WAIT_L(n) asm volatile("s_waitcnt lgkmcnt(" #n ")" ::: "memory")
#define PG8_BAR __builtin_amdgcn_s_barrier()
#define PG8_SCHED __builtin_amdgcn_sched_barrier(0)
    Unit cur, nxt; int ui = 0;
    if (!S.next(0, cur)) return;
    f32x4 acc[2][2][4][2];
    { float zf = 0.f; asm volatile("" : "+v"(zf));
#pragma unroll
    for (int a = 0; a < 2; ++a)
#pragma unroll
        for (int b = 0; b < 2; ++b)
#pragma unroll
            for (int m = 0; m < 4; ++m)
#pragma unroll
                for (int n = 0; n < 2; ++n) acc[a][b][m][n] = (f32x4){zf, zf, zf, zf}; }
    bf16x8 At[4][2], B0[2][2], B1[2][2];
    const char* cA = (const char*)g.A + (size_t)cur.pm * tstep; const char* cB = (const char*)g.Bt + (size_t)cur.pn * tstep;
    S.a_ready(cur);
    if constexpr (SP2) {
        PG8_STAGE(PG8_SB(0, 0), cB, voffB); PG8_STAGE(PG8_SB(0, 1), cB + hstep, voffB); PG8_STAGE(PG8_SA(0, 0), cA, voffA); PG8_STAGE(PG8_SA(0, 1), cA + hstep, voffA);
        if (wr == 1) PG8_BAR;
        PG8_WAIT_V(2); PG8_BAR;
        PG8_STAGE(PG8_SB(1, 0), cB + kstep, voffB); PG8_STAGE(PG8_SA(1, 0), cA + kstep, voffA); PG8_STAGE(PG8_SB(1, 1), cB + hstep + kstep, voffB);
        PG8_WAIT_V(6); PG8_BAR;
    } else {
        PG8_STAGE(PG8_SB(0, 0), cB, voffB); PG8_STAGE(PG8_SA(0, 0), cA, voffA); PG8_STAGE(PG8_SB(0, 1), cB + hstep, voffB); PG8_STAGE(PG8_SA(0, 1), cA + hstep, voffA);
        if (wr == 1) PG8_BAR;
        PG8_WAIT_V(4); PG8_BAR;
        PG8_STAGE(PG8_SB(1, 0), cB + kstep, voffB); PG8_STAGE(PG8_SA(1, 0), cA + kstep, voffA); PG8_STAGE(PG8_SB(1, 1), cB + hstep + kstep, voffB);
        PG8_WAIT_V(6); PG8_BAR;
    }
    for (;;) {
        const bool has_next = S.next(ui + 1, nxt);
        const char* nA = has_next ? (const char*)g.A + (size_t)nxt.pm * tstep : cA; const char* nB = has_next ? (const char*)g.Bt + (size_t)nxt.pn * tstep : cB;
        for (int t = 0; t < nt; t += 2) {
            const bool last = (t == nt - 2);
            const char* a1 = cA + (size_t)(t + 1) * kstep;
            const char* a2 = last ? nA : cA + (size_t)(t + 2) * kstep; const char* b2 = last ? nB : cB + (size_t)(t + 2) * kstep;
            const char* a3 = a2 + kstep; const char* b3 = b2 + kstep;
            if (last && has_next) S.a_ready(nxt);
            if constexpr (SP2) {
            PG8_LDB(B0, 0, 0); PG8_LDB(B1, 0, 1); PG8_SCHED; PG8_LDA(At, 0, 0); PG8_STAGE(PG8_SA(1, 1), a1 + hstep, voffA);
            PG8_WAIT_V(8); PG8_WAIT_L(0); PG8_BAR; PG8_MMA(0, 0, At, B0); PG8_MMA(0, 1, At, B1); PG8_BAR; PG8_SCHED;
            PG8_LDA(At, 0, 1); PG8_STAGE(PG8_SB(0, 0), b2, voffB); PG8_STAGE(PG8_SB(0, 1), b2 + hstep, voffB); PG8_STAGE(PG8_SA(0, 0), a2, voffA);
            PG8_WAIT_V(8); PG8_WAIT_L(0); PG8_BAR; PG8_MMA(1, 0, At, B0); PG8_MMA(1, 1, At, B1); PG8_BAR; PG8_SCHED;
            PG8_LDB(B0, 1, 0); PG8_LDB(B1, 1, 1); PG8_SCHED; PG8_LDA(At, 1, 0); PG8_STAGE(PG8_SA(0, 1), a2 + hstep, voffA);
            PG8_WAIT_V(8); PG8_WAIT_L(0); PG8_BAR; PG8_MMA(0, 0, At, B0); PG8_MMA(0, 1, At, B1); PG8_BAR; PG8_SCHED;
            PG8_LDA(At, 1, 1); PG8_STAGE(PG8_SB(1, 0), b3, voffB); PG8_STAGE(PG8_SB(1, 1), b3 + hstep, voffB); PG8_STAGE(PG8_SA(1, 0), a3, voffA);
            PG8_WAIT_V(8); PG8_WAIT_L(0); PG8_BAR; PG8_MMA(1, 0, At, B0); PG8_MMA(1, 1, At, B1); PG8_BAR; PG8_SCHED;
            } else {
            PG8_LDB(B0, 0, 0); PG8_SCHED; PG8_LDA(At, 0, 0); PG8_STAGE(PG8_SA(1, 1), a1 + hstep, voffA);
            PG8_WAIT_L(8); PG8_BAR; PG8_WAIT_L(0); PG8_MMA(0, 0, At, B0); PG8_BAR; PG8_SCHED;
            PG8_LDB(B1, 0, 1); PG8_STAGE(PG8_SB(0, 0), b2, voffB);
            PG8_BAR; PG8_WAIT_L(0); PG8_MMA(0, 1, At, B1); PG8_BAR;
            PG8_LDA(At, 0, 1); PG8_STAGE(PG8_SA(0, 0), a2, voffA);
            PG8_BAR; PG8_WAIT_L(0); PG8_MMA(1, 0, At, B0); PG8_BAR; PG8_SCHED;
            PG8_STAGE(PG8_SB(0, 1), b2 + hstep, voffB);
            PG8_WAIT_V(6); PG8_BAR; PG8_MMA(1, 1, At, B1); PG8_BAR;
            PG8_LDB(B0, 1, 0); PG8_SCHED; PG8_LDA(At, 1, 0); PG8_STAGE(PG8_SA(0, 1), a2 + hstep, voffA);
            PG8_WAIT_L(8); PG8_BAR; PG8_WAIT_L(0); PG8_MMA(0, 0, At, B0); PG8_BAR; PG8_SCHED;
            PG8_LDB(B1, 1, 1); PG8_STAGE(PG8_SB(1, 0), b3, voffB);
            PG8_BAR; PG8_WAIT_L(0); PG8_MMA(0, 1, At, B1); PG8_BAR;
            PG8_LDA(At, 1, 1); PG8_STAGE(PG8_SA(1, 0), a3, voffA);
            PG8_BAR; PG8_WAIT_L(0); PG8_MMA(1, 0, At, B0); PG8_BAR; PG8_SCHED;
            PG8_STAGE(PG8_SB(1, 1), b3 + hstep, voffB);
            PG8_WAIT_V(6); PG8_BAR; PG8_MMA(1, 1, At, B1); PG8_BAR;
            }
        }
        if constexpr (ALIGN_EPI) { if (wr == 0) PG8_BAR; }
        if constexpr (!Epi::AFTER_DRAIN) { E(acc, cur, wr, wc, fr, fq); S.done(cur); }
        if (!has_next) break;
{ float zf = 0.f; asm volatile("" : "+v"(zf));
#pragma unroll
        for (int a = 0; a < 2; ++a)
#pragma unroll
            for (int b = 0; b < 2; ++b)
#pragma unroll
                for (int m = 0; m < 4; ++m)
#pragma unroll
                    for (int n = 0; n < 2; ++n) acc[a][b][m][n] = (f32x4){zf, zf, zf, zf}; }
        cur = nxt; cA = nA; cB = nB; ++ui;
        if constexpr (ALIGN_EPI) { if (wr == 1) PG8_BAR; }
    }
    PG8_WAIT_V(0);
    if constexpr (!ALIGN_EPI) { if (wr == 0) PG8_BAR; }
    PG8_BAR;
    if constexpr (Epi::AFTER_DRAIN) { E.fused(acc, cur, wr, wc, fr, fq, lds, wid, lane); S.done(cur); }
#undef PG8_SA
#undef PG8_SB
#undef PG8_STAGE
#undef PG8_LDA
#undef PG8_LDB
#undef PG8_MMA
#undef PG8_WAIT_V
#undef PG8_WAIT_L
#undef PG8_BAR
#undef PG8_SCHED
}
}

#ifndef LAS
#define LAS __attribute__((address_space(3)))
#endif
#ifdef HOST_EMU
#define PAS
#else
#define PAS __attribute__((address_space(4)))
#endif
typedef unsigned short bf16;
typedef float f32x4 __attribute__((ext_vector_type(4)));
typedef unsigned v4u __attribute__((ext_vector_type(4)));
typedef unsigned v2u __attribute__((ext_vector_type(2)));

#ifndef SEQ_
#define SEQ_ 4096
#define CTXL_ 256
#endif
constexpr int D = 1024, NB = 8, SEQ = SEQ_, CTXL = CTXL_, DEPTH = 4;
constexpr int RC = NB * CTXL;
constexpr int RL = NB * SEQ;
constexpr int RT = RC + RL;
constexpr int NIN = 7360, DFF = 2816;
constexpr int NTHR = 512, NWAVES = 8;
constexpr int LDS_BYTES = 147456;

constexpr size_t MiB = (size_t)1 << 20;
constexpr size_t WS_CTL = 0;
constexpr size_t WS_MOD = 1 * MiB;
constexpr size_t WS_W   = 2 * MiB;
constexpr size_t WS_XC  = 37 * MiB;
constexpr size_t WS_U   = 45 * MiB;
constexpr size_t WS_Y   = 113 * MiB;
constexpr size_t WS_BIG = 181 * MiB;
constexpr size_t WS_END = 471 * MiB;
constexpr size_t SZ17 = (size_t)RT * 256 * 2;
constexpr size_t SZ34 = (size_t)RT * 256 * 4;
constexpr size_t WO_WP = 0;
constexpr size_t WO_WG = WO_WP + (size_t)3328 * 1024;
constexpr size_t WO_BR = WO_WG + (size_t)4096 * 1024;
constexpr size_t WO_WO = WO_BR + (size_t)4 * 1024 * 256;
constexpr size_t WO_W1 = WO_WO + (size_t)1024 * 1024;
constexpr size_t WO_W2 = WO_W1 + (size_t)5632 * 1024;
static_assert((WO_W2 + (size_t)1024 * 2816) * 2 <= 35 * MiB, "weights region");
constexpr size_t BG_P = 0;
constexpr size_t BG_S = 68 * MiB;

struct Prm { const float* in[41]; float* out; unsigned char* ws; int lo, hi; };

__device__ __forceinline__ float bf2f(bf16 b) { return __uint_as_float(((unsigned)b) << 16); }
__device__ __forceinline__ bf16 f2bf(float f) { unsigned u = __float_as_uint(f); return (bf16)((u + 0x7fffu + ((u >> 16) & 1u)) >> 16); }
__device__ __forceinline__ unsigned pk2(float lo, float hi) { return (unsigned)f2bf(lo) | ((unsigned)f2bf(hi) << 16); }
__device__ __forceinline__ float blo(unsigned u) { return __uint_as_float(u << 16); }
__device__ __forceinline__ float bhi(unsigned u) { return __uint_as_float(u & 0xffff0000u); }
__device__ __forceinline__ float sigmoidf_(float x) { return 1.f / (1.f + __expf(-x)); }
__device__ __forceinline__ float softplusf_(float x) { return x > 20.f ? x : log1pf(__expf(x)); }
__device__ __forceinline__ float wave_sum(float v) {
#pragma unroll
    for (int o = 1; o < 64; o <<= 1) v += __shfl_xor(v, o);
    return v;
}
template <int CTRL> __device__ __forceinline__ float dpp_mov(float v) { return __int_as_float(__builtin_amdgcn_update_dpp(0, __float_as_int(v), CTRL, 0xF, 0xF, true)); }
__device__ __forceinline__ float row16_sum(float v) {
    v += dpp_mov<0xB1>(v);
    v += dpp_mov<0x4E>(v);
    v += dpp_mov<0x141>(v);
    v += dpp_mov<0x140>(v);
    return v;
}

#ifndef HOST_EMU
#define XB_TMO      128
#define XB_XCNT(j)  (256  + 64 * (j))
#define XB_XSUB(j)  (1280 + 64 * (j))
#define XB_XGEN(j)  (2304 + 64 * (j))
#define XB_TOP      3328
#define XB_TOPGEN   3392
#define XCD_BAR_WORDS 3456
#define XB_SPIN_CAP (1u << 18)
__device__ __forceinline__ unsigned xb_ld(unsigned* p)              { return __hip_atomic_load(p, __ATOMIC_RELAXED, __HIP_MEMORY_SCOPE_AGENT); }
__device__ __forceinline__ unsigned xb_add(unsigned* p, unsigned v) { return __hip_atomic_fetch_add(p, v, __ATOMIC_RELAXED, __HIP_MEMORY_SCOPE_AGENT); }
__device__ __forceinline__ unsigned xb_xcc_id() { return (unsigned)__builtin_amdgcn_s_getreg((3 << 11) | 20) & 0xFu; }
#define XB_SPIN(cond, bar) do { unsigned _sp = 0; while (cond) { __builtin_amdgcn_s_sleep(1); \
    if ((++_sp & 255u) == 0u) { if (xb_ld(&(bar)[XB_TMO])) break; if (_sp > XB_SPIN_CAP) { atomicAdd(&(bar)[XB_TMO], 1u); break; } } } } while (0)
struct XcdBarrier { unsigned* bar; unsigned x; volatile LAS unsigned* st; };
__device__ __forceinline__ XcdBarrier xcd_barrier_post(unsigned* bar, volatile LAS unsigned* st) {
    XcdBarrier b; b.bar = bar; b.x = xb_xcc_id(); b.st = st;
    if (threadIdx.x == 0) (void)xb_add(&bar[XB_XCNT(b.x)], 1u);
    return b;
}
__device__ __forceinline__ void xcd_barrier_complete(unsigned* bar, unsigned x, unsigned& nloc, unsigned& nx) {
    const unsigned G = gridDim.x * gridDim.y * gridDim.z;
    unsigned sum, cnt, mine, sp = 0u;
    for (;;) {
        sum = 0u; cnt = 0u; mine = 0u;
#pragma unroll
        for (unsigned j = 0; j < 16; ++j) { const unsigned c = xb_ld(&bar[XB_XCNT(j)]); sum += c; cnt += (c > 0u) ? 1u : 0u; mine = (j == x) ? c : mine; }
        if (sum == G) break;
        __builtin_amdgcn_s_sleep(1);
        if ((++sp & 255u) == 0u) { if (xb_ld(&bar[XB_TMO])) break; if (sp > XB_SPIN_CAP) { atomicAdd(&bar[XB_TMO], 1u); break; } }
    }
    nloc = mine > 0u ? mine : 1u; nx = cnt > 0u ? cnt : 1u;
}
__device__ __forceinline__ void xcd_barrier(const XcdBarrier& b) {
    asm volatile("s_waitcnt vmcnt(0)" ::: "memory");
    __syncthreads();
    if (tid_opq() == 0) {
        unsigned* bar = b.bar; asm volatile("" : "+v"(bar));
        __builtin_amdgcn_s_waitcnt(0);
        unsigned nloc = b.st[0], nx = b.st[1];
        if (nloc == 0u) { xcd_barrier_complete(bar, b.x, nloc, nx); b.st[0] = nloc; b.st[1] = nx; }
        const unsigned old = xb_add(&bar[XB_XSUB(b.x)], 1u);
        const unsigned gen = old / nloc;
        if (old + 1u == (gen + 1u) * nloc) {
            __builtin_amdgcn_fence(__ATOMIC_RELEASE, "agent");
            asm volatile("s_waitcnt vmcnt(0)" ::: "memory");
            const unsigned og = xb_add(&bar[XB_TOP], 1u);
            const unsigned tg = og / nx;
            if (og + 1u == (tg + 1u) * nx) xb_add(&bar[XB_TOPGEN], 1u);
            else XB_SPIN(xb_ld(&bar[XB_TOPGEN]) == tg, bar);
            __builtin_amdgcn_fence(__ATOMIC_ACQUIRE, "agent");
            xb_add(&bar[XB_XGEN(b.x)], 1u);
            asm volatile("s_waitcnt vmcnt(0)" ::: "memory");
        } else {
            XB_SPIN(xb_ld(&bar[XB_XGEN(b.x)]) == gen, bar);
            __builtin_amdgcn_fence(__ATOMIC_ACQUIRE, "agent");
            asm volatile("s_waitcnt vmcnt(0)" ::: "memory");
        }
    }
    __syncthreads();
}

#endif
#ifdef HOST_EMU
#define TID ((int)threadIdx.x)
#define BID ((int)blockIdx.x)
#define NBLK ((int)gridDim.x)
#else
#define TID tid_opq()
#define BID ((int)blockIdx.x)
#define NBLK ((int)gridDim.x)
#endif

__device__ __forceinline__ void ph_mod(const PAS Prm& p, LAS unsigned char* lds) {
    LAS float* sc = (LAS float*)lds;
    LAS float* red = sc + 9 * 1024;
    const float* c = p.in[1]; const float* cctx = p.in[3]; const float* w_mod = p.in[4]; const float* b_mod = p.in[5];
    float* mod = (float*)(p.ws + WS_MOD);
    const int tid = TID, lane = tid & 63, wave = tid >> 6;
    for (int i = tid; i < 9 * 1024; i += NTHR) { const int j = i >> 10, k = i & 1023; const float v = (j < 8) ? c[j * 1024 + k] : cctx[k]; sc[i] = v / (1.f + expf(-v)); }
    __syncthreads();
    for (int it = BID; it < 4 * 96; it += NBLK) {
        const int l = it / 96, cg = it % 96, col = cg * 64 + lane;
        float acc[9];
#pragma unroll
        for (int j = 0; j < 9; ++j) acc[j] = 0.f;
        const float* W = w_mod + (size_t)l * 1024 * 6144 + col;
        for (int k = wave * 128; k < wave * 128 + 128; ++k) { const float w = W[(size_t)k * 6144];
#pragma unroll
            for (int j = 0; j < 9; ++j) acc[j] += sc[j * 1024 + k] * w; }
#pragma unroll
        for (int j = 0; j < 9; ++j) red[(wave * 9 + j) * 64 + lane] = acc[j];
        __syncthreads();
        for (int i = tid; i < 9 * 64; i += NTHR) { const int j = i >> 6, ln = i & 63; float s = b_mod[l * 6144 + cg * 64 + ln];
#pragma unroll
            for (int w = 0; w < 8; ++w) s += red[(w * 9 + j) * 64 + ln];
            mod[((size_t)l * 9 + j) * 6144 + cg * 64 + ln] = s; }
        __syncthreads();
    }
}

#ifdef HOST_EMU
#define PH_ZOPQ(z) do { } while (0)
#else
#define PH_ZOPQ(z) asm volatile("" : "+v"(z))
#endif
#ifdef HOST_EMU
#define LGKM_WAIT() do { (void)emu_xchg(0, threadIdx.x & 63); } while (0)
#else
#define LGKM_WAIT() asm volatile("s_waitcnt lgkmcnt(0)" ::: "memory")
#endif
__device__ __forceinline__ void cvt_item(const float* W, size_t ldw, int k0, int n0, bf16* WT, int K, int drow0, LAS float* scr, int lane) {
#pragma unroll 8
    for (int i = 0; i < 32; ++i) { const int kk = 2 * i + (lane >> 5); scr[kk * 33 + (lane & 31)] = W[(size_t)(k0 + kk) * ldw + n0 + (lane & 31)]; }
    LGKM_WAIT();
    const int c = lane & 7;
#pragma unroll
    for (int j = 0; j < 4; ++j) { const int n = (lane >> 3) + 8 * j; const LAS float* s = scr + (8 * c) * 33 + n;
        v4u o; o.x = pk2(s[0 * 33], s[1 * 33]); o.y = pk2(s[2 * 33], s[3 * 33]); o.z = pk2(s[4 * 33], s[5 * 33]); o.w = pk2(s[6 * 33], s[7 * 33]);
        *(v4u*)(WT + (size_t)(drow0 + n) * K + k0 + 8 * c) = o; }
    LGKM_WAIT();
}
__device__ __forceinline__ void ph_cvt(const PAS Prm& p, int l, LAS unsigned char* lds) {
    const int tid = TID, lane = tid & 63, wave = tid >> 6;
    LAS float* scr = (LAS float*)(lds + wave * 16384);
    bf16* WB = (bf16*)(p.ws + WS_W);
    const float* w_in = p.in[8] + (size_t)l * 1024 * NIN;
    const float* brp = p.in[36] + (size_t)l * 4 * 256 * 1024;
    const float* wout = p.in[37] + (size_t)l * 1024 * 1024;
    const float* w1 = p.in[38] + (size_t)l * 1024 * 5632;
    const float* w2 = p.in[39] + (size_t)l * 2816 * 1024;
    constexpr int I_IN = 16 * 230, I_BR = 4 * 4 * 32, I_WO = 16 * 32, I_W1 = 16 * 176, I_W2 = 44 * 32, I_PAD = 16;
    constexpr int NITEMS = I_IN + I_BR + I_WO + I_W1 + I_W2 + I_PAD;
    const int gw = BID * NWAVES + wave, NGW = NBLK * NWAVES;
    for (int it = gw; it < NITEMS; it += NGW) {
        int r = it;
        if (r < I_IN) { const int kb = r / 230, nb = r % 230, n0 = nb * 32;
            if (n0 < 3264) { const int drow = n0 < 1728 ? n0 : n0 + 64; cvt_item(w_in, NIN, kb * 64, n0, WB + WO_WP, 1024, drow, scr, lane);
            } else { cvt_item(w_in, NIN, kb * 64, n0, WB + WO_WG, 1024, n0 - 3264, scr, lane); }
            continue; }
        r -= I_IN;
        if (r < I_BR) { const int n = r / 128, q = r % 128, kb = q / 32, nb = q % 32;
            cvt_item(brp + (size_t)n * 256 * 1024, 1024, kb * 64, nb * 32, WB + WO_BR + (size_t)n * 1024 * 256, 256, nb * 32, scr, lane); continue; }
        r -= I_BR;
        if (r < I_WO) { const int kb = r / 32, nb = r % 32; cvt_item(wout, 1024, kb * 64, nb * 32, WB + WO_WO, 1024, nb * 32, scr, lane); continue; }
        r -= I_WO;
        if (r < I_W1) { const int kb = r / 176, nb = r % 176, n0 = nb * 32; const int hh = n0 / 2816, jj = n0 % 2816, pn = jj / 128, j2 = jj % 128;
            cvt_item(w1, 5632, kb * 64, n0, WB + WO_W1, 1024, 256 * pn + 128 * hh + j2, scr, lane); continue; }
        r -= I_W1;
        if (r < I_W2) { const int kb = r / 32, nb = r % 32; cvt_item(w2, 1024, kb * 64, nb * 32, WB + WO_W2, 2816, nb * 32, scr, lane); continue; }
        r -= I_W2;
        {
            unsigned z0 = 0u; PH_ZOPQ(z0); v4u z = (v4u){z0, z0, z0, z0};
            for (int i = lane; i < 4 * 128; i += 64) { const int rr = 1728 + r * 4 + i / 128, cc = (i % 128) * 8; *(v4u*)(WB + WO_WP + (size_t)rr * 1024 + cc) = z; }
        }
    }
}

__device__ __forceinline__ void ph_norm(const PAS Prm& p, int l, int which, const float* xc_src, const float* xl_src, int r_begin) {
    const int tid = TID, lane = tid & 63, wave = tid >> 6;
    const float* mod = (const float*)(p.ws + WS_MOD) + (size_t)l * 9 * 6144;
    const float* g = (which ? p.in[7] : p.in[6]) + l * 1024;
    bf16* U = (bf16*)(p.ws + WS_U);
    const int gw = BID * NWAVES + wave, NGW = NBLK * NWAVES;
    for (int r = r_begin + gw; r < RT; r += NGW) {
        const float* xr = (r < RC) ? xc_src + (size_t)r * 1024 : xl_src + (size_t)(r - RC) * 1024;
        const int jb = (r < RC) ? 8 : (r - RC) / SEQ;
        const float* shift = mod + (size_t)jb * 6144 + (which ? 3 * 1024 : 0);
        const float* scale = shift + 1024;
        f32x4 v[4]; float s = 0.f;
#pragma unroll
        for (int j = 0; j < 4; ++j) { v[j] = *(const f32x4*)(xr + 4 * lane + 256 * j); s += (v[j].x * v[j].x + v[j].y * v[j].y) + (v[j].z * v[j].z + v[j].w * v[j].w); }
        const float rstd = rsqrtf(wave_sum(s) * (1.f / 1024.f) + 1e-6f);
#pragma unroll
        for (int j = 0; j < 4; ++j) { const int c0 = 4 * lane + 256 * j;
            const f32x4 gg = *(const f32x4*)(g + c0), sc = *(const f32x4*)(scale + c0), sh = *(const f32x4*)(shift + c0);
            const f32x4 o = v[j] * rstd * gg * (1.f + sc) + sh;
            v2u w; w.x = pk2(o.x, o.y); w.y = pk2(o.z, o.w);
            *(v2u*)(U + (size_t)r * 1024 + c0) = w; }
    }
}
__device__ __forceinline__ void ph_final(const PAS Prm& p) {
    const int tid = TID, lane = tid & 63, wave = tid >> 6;
    const float* g = p.in[40];
    const float poison = (*(const volatile unsigned*)(p.ws + WS_CTL + 768 * 1024) != 0u) ? __builtin_nanf("") : 0.f;
    const int gw = BID * NWAVES + wave, NGW = NBLK * NWAVES;
    for (int r = gw; r < RL; r += NGW) {
        float* xr = p.out + (size_t)r * 1024;
        f32x4 v[4]; float s = 0.f;
#pragma unroll
        for (int j = 0; j < 4; ++j) { v[j] = *(const f32x4*)(xr + 4 * lane + 256 * j); s += (v[j].x * v[j].x + v[j].y * v[j].y) + (v[j].z * v[j].z + v[j].w * v[j].w); }
        const float rstd = rsqrtf(wave_sum(s) * (1.f / 1024.f) + 1e-6f);
#pragma unroll
        for (int j = 0; j < 4; ++j) { const int c0 = 4 * lane + 256 * j; const f32x4 gg = *(const f32x4*)(g + c0); *(f32x4*)(xr + c0) = v[j] * rstd * gg + poison; }
    }
}

struct RowInfo { int lat, b, t, T, base; };
__device__ __forceinline__ RowInfo row_info(int r) {
    RowInfo q;
    if (r < RC) { q.lat = 0; q.b = r / CTXL; q.t = r % CTXL; q.T = CTXL; q.base = q.b * CTXL; }
    else { const int x = r - RC; q.lat = 1; q.b = x / SEQ; q.t = x % SEQ; q.T = SEQ; q.base = RC + q.b * SEQ; }
    return q;
}
__device__ __forceinline__ int scan_row(int b, int d, int tau) {
    if (tau < CTXL) return b * CTXL + (d ? (CTXL - 1 - tau) : tau);
    const int t = tau - CTXL; return RC + b * SEQ + (d ? (SEQ - 1 - t) : t);
}

constexpr size_t RW_R = 0, RW_K = SZ17, RW_V = 2 * SZ17, RW_KK = 3 * SZ17, RW_OM = 4 * SZ17  , RW_A = 6 * SZ17  , RW_G = 8 * SZ17, RW_Y = 9 * SZ17  , RW_BON = 9 * SZ17 + 2 * SZ34;
static_assert(RW_BON + (size_t)RT * 16 <= 222 * MiB, "rwkv scratch");

__device__ __forceinline__ void ph_rw_prep(const PAS Prm& p, int l, LAS unsigned char* lds) {
    LAS float* xx = (LAS float*)lds;
    const int tid = TID, lane = tid & 63;
    const bf16* P = (const bf16*)(p.ws + WS_BIG + BG_P);
    unsigned char* S = p.ws + WS_BIG + BG_S;
    bf16* oR = (bf16*)(S + RW_R); bf16* oK = (bf16*)(S + RW_K); bf16* oV = (bf16*)(S + RW_V); bf16* oKK = (bf16*)(S + RW_KK);
    bf16* oOM = (bf16*)(S + RW_OM); bf16* oA = (bf16*)(S + RW_A); bf16* oG = (bf16*)(S + RW_G); float* oBon = (float*)(S + RW_BON);
    const float* mu = p.in[18] + l * 960;
    const float* w0 = p.in[19] + l * 512; const float* w2 = p.in[20] + (size_t)l * 2 * 64 * 256;
    const float* a0 = p.in[21] + l * 512; const float* a2 = p.in[22] + (size_t)l * 2 * 64 * 256;
    const float* g2 = p.in[23] + (size_t)l * 64 * 256;
    const float* k_k = p.in[24] + l * 256; const float* r_k = p.in[26] + l * 256;
    const int j = tid & 255, half = tid >> 8, h = j >> 6;
    for (int tile = BID; tile < RT / 16; tile += NBLK) {
        const int r0 = tile * 16;
        for (int i = tid; i < 16 * 960; i += NTHR) {
            const int rr = i / 960, c = i % 960, r = r0 + rr, q = c & 3;
            const RowInfo ri = row_info(r);
            int nb = -1;
            if (ri.lat) {
                const int gc = ri.t & 63, gr = ri.t >> 6;
                if (q == 0) { if (gc >= 1) nb = r - 1; } else if (q == 1) { if (gc <= 62) nb = r + 1; }
                else if (q == 2) { if (gr >= 1) nb = r - 64; } else { if (gr <= SEQ / 64 - 2) nb = r + 64; }
            } else {
                if ((q & 1) == 0) { if (ri.t >= 1) nb = r - 1; } else { if (ri.t <= CTXL - 2) nb = r + 1; }
            }
            const float pv = bf2f(P[(size_t)r * 1024 + c]);
            const float sv = nb >= 0 ? bf2f(P[(size_t)nb * 1024 + c]) : 0.f;
            float x = pv + (sv - pv) * mu[c];
            if (c >= 768 && c < 832) x = tanhf(x); else if (c >= 896) x = sigmoidf_(x);
            xx[rr * 960 + c] = x;
        }
        __syncthreads();
        float aw0[8], aw1[8], aa0[8], aa1[8], ag[8];
#pragma unroll
        for (int q = 0; q < 8; ++q) { aw0[q] = 0.f; aw1[q] = 0.f; aa0[q] = 0.f; aa1[q] = 0.f; ag[q] = 0.f; }
        for (int i = 0; i < 64; ++i) {
            const float w20 = w2[i * 256 + j], w21 = w2[64 * 256 + i * 256 + j], a20 = a2[i * 256 + j], a21 = a2[64 * 256 + i * 256 + j], g2v = g2[i * 256 + j];
#pragma unroll
            for (int q = 0; q < 8; ++q) { const LAS float* xr = xx + (half * 8 + q) * 960;
                const float cw = xr[768 + i], ca = xr[832 + i], cg = xr[896 + i];
                aw0[q] += cw * w20; aw1[q] += cw * w21; aa0[q] += ca * a20; aa1[q] += ca * a21; ag[q] += cg * g2v; }
        }
        const float kkj = k_k[j], rkj = r_k[j], w00 = w0[j], w01 = w0[256 + j], a00 = a0[j], a01 = a0[256 + j];
#pragma unroll
        for (int q = 0; q < 8; ++q) {
            const int rr = half * 8 + q; const size_t r = (size_t)(r0 + rr);
            const float rv = xx[rr * 960 + j], kv = xx[rr * 960 + 256 + j], vv = xx[rr * 960 + 512 + j];
            const float kkr = kv * kkj;
            const float ss = wave_sum(kkr * kkr);
            const float kkn = kkr * rsqrtf(ss + 1e-12f);
            const float bon = wave_sum(rv * kv * rkj);
            oR[r * 256 + j] = f2bf(rv); oK[r * 256 + j] = f2bf(kv); oV[r * 256 + j] = f2bf(vv); oKK[r * 256 + j] = f2bf(kkn);
            oG[r * 256 + j] = f2bf(ag[q]);
            if (lane == 0) oBon[r * 4 + h] = bon;
#pragma unroll
            for (int d = 0; d < 2; ++d) {
                const float wv = (d ? w01 : w00) + (d ? aw1[q] : aw0[q]);
                const float logw = -softplusf_(-wv) - 0.5f;
                const float om = -expm1f(-expf(logw));
                const float av = sigmoidf_((d ? a01 : a00) + (d ? aa1[q] : aa0[q]));
                oOM[(size_t)d * RT * 256 + r * 256 + j] = f2bf(om);
                oA[(size_t)d * RT * 256 + r * 256 + j] = f2bf(av);
            }
        }
        __syncthreads();
    }
}

template <int MODE>
__device__ __forceinline__ void scan_phase(const unsigned char* Sb  , const bf16* Pv  , float* Yout  ,
                                           const float* ka  , const float* gam  , LAS unsigned char* lds) {
    constexpr int NA = MODE == 0 ? 6 : 3, CH = 32, STEPB = NA * 128, BUFB = CH * STEPB, NPIECE = CH * NA * 8, NLD = (NPIECE + NTHR - 1) / NTHR;
    const int tid = TID, lane = tid & 63, wave = tid >> 6;
    if (BID >= 128) return;
    const int prob = BID >> 1, b = prob >> 3, h = (prob >> 1) & 3, d = prob & 1;
    const int rowv = 32 * (BID & 1) + 4 * wave + (lane >> 4);
    const int kl = lane & 15;
    float kav[4] = {0.f, 0.f, 0.f, 0.f};
    float gamma = 0.f;
    if (MODE == 0) {
#pragma unroll
        for (int i = 0; i < 4; ++i) kav[i] = ka[h * 64 + 4 * kl + i];
    } else gamma = sigmoidf_(gam[d * 4 + h]);
    float S[4] = {0.f, 0.f, 0.f, 0.f};
    v4u pre[NLD];
    const unsigned char* gsrc[NLD]; int gld[NLD]; int gs[NLD]; int ldso[NLD];
#pragma unroll
    for (int i = 0; i < NLD; ++i) { const int e = tid + NTHR * i; const int s = e / (NA * 8), rem = e % (NA * 8), a = rem >> 3, piece = rem & 7;
        gs[i] = s; ldso[i] = s * STEPB + a * 128 + piece * 16;
        if (MODE == 0) { const int slot = a == 0 ? 0 : a == 1 ? 1 : a == 2 ? 3 : a == 3 ? 4 + d : a == 4 ? 6 + d : 2;
            gsrc[i] = Sb + (size_t)slot * SZ17 + (size_t)(h * 64 + piece * 8) * 2; gld[i] = 512; }
        else { if (a < 2) { gsrc[i] = Sb + (size_t)a * SZ17 + (size_t)(h * 64 + piece * 8) * 2; gld[i] = 512; }
               else { gsrc[i] = (const unsigned char*)Pv + (size_t)(512 + h * 64 + piece * 8) * 2; gld[i] = 2048; } }
    }
#define SCAN_ISSUE(c) do { _Pragma("unroll") for (int i = 0; i < NLD; ++i) { if (tid + NTHR * i < NPIECE) { const int row = scan_row(b, d, (c) * CH + gs[i]); \
        pre[i] = *(const v4u*)(gsrc[i] + (size_t)row * gld[i]); } } } while (0)
#define SCAN_COMMIT(buf) do { _Pragma("unroll") for (int i = 0; i < NLD; ++i) { if (tid + NTHR * i < NPIECE) *(LAS v4u*)(lds + (buf) * BUFB + ldso[i]) = pre[i]; } } while (0)
    constexpr int NCH = (CTXL + SEQ) / CH;
    SCAN_ISSUE(0); SCAN_COMMIT(0); __syncthreads();
    for (int c = 0; c < NCH; ++c) {
        if (c + 1 < NCH) SCAN_ISSUE(c + 1);
        const LAS unsigned char* bufp = lds + (c & 1) * BUFB;
#pragma unroll 4
        for (int s = 0; s < CH; ++s) {
            const LAS unsigned char* sp = bufp + s * STEPB;
            float y;
            if (MODE == 0) {
                const v2u r2 = *(const LAS v2u*)(sp + 0 * 128 + kl * 8), k2 = *(const LAS v2u*)(sp + 1 * 128 + kl * 8), kk2 = *(const LAS v2u*)(sp + 2 * 128 + kl * 8),
                          om2 = *(const LAS v2u*)(sp + 3 * 128 + kl * 8), a2 = *(const LAS v2u*)(sp + 4 * 128 + kl * 8);
                const float vv = bf2f(*(const LAS bf16*)(sp + 5 * 128 + rowv * 2));
                const float rr[4] = {blo(r2.x), bhi(r2.x), blo(r2.y), bhi(r2.y)};
                const float kr[4] = {blo(k2.x), bhi(k2.x), blo(k2.y), bhi(k2.y)};
                const float kk[4] = {blo(kk2.x), bhi(kk2.x), blo(kk2.y), bhi(kk2.y)};
                const float om[4] = {blo(om2.x), bhi(om2.x), blo(om2.y), bhi(om2.y)};
                const float as[4] = {blo(a2.x), bhi(a2.x), blo(a2.y), bhi(a2.y)};
                float sap = 0.f;
#pragma unroll
                for (int i = 0; i < 4; ++i) sap -= S[i] * kk[i];
                const float sa = row16_sum(sap);
                float yp = 0.f;
#pragma unroll
                for (int i = 0; i < 4; ++i) {
                    const float kt = kr[i] * (1.f + (as[i] - 1.f) * kav[i]);
                    const float bb = kk[i] * as[i];
                    S[i] = S[i] * (1.f - om[i]) + (sa * bb + vv * kt);
                    yp += S[i] * rr[i];
                }
                y = row16_sum(yp);
            } else {
                const v2u q2 = *(const LAS v2u*)(sp + 0 * 128 + kl * 8), k2 = *(const LAS v2u*)(sp + 1 * 128 + kl * 8);
                const float vv = bf2f(*(const LAS bf16*)(sp + 2 * 128 + rowv * 2));
                const float qq[4] = {blo(q2.x), bhi(q2.x), blo(q2.y), bhi(q2.y)};
                const float kr[4] = {blo(k2.x), bhi(k2.x), blo(k2.y), bhi(k2.y)};
                float yp = 0.f;
#pragma unroll
                for (int i = 0; i < 4; ++i) { S[i] = S[i] * gamma + vv * kr[i]; yp += S[i] * qq[i]; }
                y = row16_sum(yp);
            }
            if (kl == 0) { const int row = scan_row(b, d, c * CH + s); Yout[((size_t)d * RT + row) * 256 + h * 64 + rowv] = y; }
        }
        if (c + 1 < NCH) SCAN_COMMIT((c + 1) & 1);
        __syncthreads();
    }
#undef SCAN_ISSUE
#undef SCAN_COMMIT
}

__device__ __forceinline__ void ph_rw_post(const PAS Prm& p, int l) {
    const int tid = TID, j = tid & 255, h = j >> 6;
    unsigned char* S = p.ws + WS_BIG + BG_S;
    const float* Y = (const float*)(S + RW_Y); const bf16* V = (const bf16*)(S + RW_V); const bf16* G = (const bf16*)(S + RW_G); const float* Bon = (const float*)(S + RW_BON);
    bf16* yrw = (bf16*)(p.ws + WS_Y + 1 * SZ17);
    const float lng = p.in[27][l * 256 + j];
    for (int r = BID * 2 + (tid >> 8); r < RT; r += NBLK * 2) {
        const size_t o = (size_t)r * 256 + j;
        const float y = Y[o] + Y[(size_t)RT * 256 + o];
        const float mean = wave_sum(y) * (1.f / 64.f); const float dv = y - mean;
        const float var = wave_sum(dv * dv) * (1.f / 64.f);
        float v = dv * rsqrtf(var + 64e-5f) * lng;
        v += Bon[(size_t)r * 4 + h] * bf2f(V[o]);
        v *= bf2f(G[o]);
        yrw[o] = f2bf(v);
    }
}

constexpr size_t RT_Q = 0, RT_K = SZ17, RT_Y = 2 * SZ17  ;
__device__ __forceinline__ void ph_ret_prep(const PAS Prm& p) {
    const int tid = TID, j = tid & 255;
    const bf16* P = (const bf16*)(p.ws + WS_BIG + BG_P);
    unsigned char* S = p.ws + WS_BIG + BG_S;
    bf16* oQ = (bf16*)(S + RT_Q); bf16* oK = (bf16*)(S + RT_K);
    const int hh = j & 63, i32 = hh & 31, idx = i32 & 15; const bool second = i32 >= 16, colhalf = hh >= 32;
    const float inv = exp2f(-(float)idx * (13.287712379549449f / 16.f));
    for (int r = BID * 2 + (tid >> 8); r < RT; r += NBLK * 2) {
        const size_t o = (size_t)r * 1024;
        float q = bf2f(P[o + j]), k = bf2f(P[o + 256 + j]);
        if (r >= RC) {
            const int t = (r - RC) & (SEQ - 1);
            const float coord = (float)(colhalf ? (t & 63) : (t >> 6));
            float sn, cs; sincosf(coord * inv, &sn, &cs);
            const int pj = second ? j - 16 : j + 16;
            const float qp = bf2f(P[o + pj]), kp = bf2f(P[o + 256 + pj]);
            q = second ? (qp * sn + q * cs) : (q * cs - qp * sn);
            k = second ? (kp * sn + k * cs) : (k * cs - kp * sn);
        }
        oQ[(size_t)r * 256 + j] = f2bf(q); oK[(size_t)r * 256 + j] = f2bf(k * 0.125f);
    }
}
__device__ __forceinline__ void ph_ret_post(const PAS Prm& p) {
    const int tid = TID, j = tid & 255;
    const bf16* P = (const bf16*)(p.ws + WS_BIG + BG_P);
    const float* Y = (const float*)(p.ws + WS_BIG + BG_S + RT_Y);
    bf16* yret = (bf16*)(p.ws + WS_Y + 3 * SZ17);
    for (int r = BID * 2 + (tid >> 8); r < RT; r += NBLK * 2) {
        const size_t o = (size_t)r * 256 + j;
        const float y = Y[o] + Y[(size_t)RT * 256 + o];
        const float mean = wave_sum(y) * (1.f / 64.f); const float dv = y - mean;
        const float var = wave_sum(dv * dv) * (1.f / 64.f);
        const float g = bf2f(P[(size_t)r * 1024 + 768 + j]);
        yret[o] = f2bf(dv * rsqrtf(var + 1e-5f) * (g * sigmoidf_(g)));
    }
}

constexpr size_t LR_A = 0  , LR_B = 2 * SZ34  ;
__device__ __forceinline__ void ph_lru_prep(const PAS Prm& p, int l, LAS unsigned char* lds) {
    LAS float* xc = (LAS float*)lds;
    const int tid = TID;
    const bf16* P = (const bf16*)(p.ws + WS_BIG + BG_P);
    float* A = (float*)(p.ws + WS_BIG + BG_S + LR_A); float* B = (float*)(p.ws + WS_BIG + BG_S + LR_B);
    const float* cw = p.in[28] + l * 4 * 256; const float* cb = p.in[29] + l * 256;
    const float* wa = p.in[30] + (size_t)l * 2 * 4 * 64 * 64; const float* ba = p.in[31] + l * 512;
    const float* wx = p.in[32] + (size_t)l * 2 * 4 * 64 * 64; const float* bx = p.in[33] + l * 512;
    const float* lam = p.in[34] + l * 512;
    const int j = tid & 255, half = tid >> 8, g = j >> 6, o = j & 63;
    const float sp0 = softplusf_(-lam[j]), sp1 = softplusf_(-lam[256 + j]);
    for (int tile = BID; tile < RT / 16; tile += NBLK) {
        const int r0 = tile * 16;
        for (int i = tid; i < 16 * 256; i += NTHR) {
            const int rr = i >> 8, jj = i & 255, r = r0 + rr; const RowInfo ri = row_info(r);
            float acc = cb[jj];
#pragma unroll
            for (int q = 0; q < 4; ++q) { const int tt = ri.t + q - 2; if (tt >= 0 && tt < ri.T) acc += cw[q * 256 + jj] * bf2f(P[(size_t)(ri.base + tt) * 512 + jj]); }
            xc[i] = acc;
        }
        __syncthreads();
        float ra0[8], ra1[8], rx0[8], rx1[8];
#pragma unroll
        for (int q = 0; q < 8; ++q) { ra0[q] = 0.f; ra1[q] = 0.f; rx0[q] = 0.f; rx1[q] = 0.f; }
        for (int i = 0; i < 64; ++i) {
            const float wa0 = wa[((0 * 4 + g) * 64 + i) * 64 + o], wa1 = wa[((1 * 4 + g) * 64 + i) * 64 + o], wx0 = wx[((0 * 4 + g) * 64 + i) * 64 + o], wx1 = wx[((1 * 4 + g) * 64 + i) * 64 + o];
#pragma unroll
            for (int q = 0; q < 8; ++q) { const float x = xc[(half * 8 + q) * 256 + g * 64 + i]; ra0[q] += x * wa0; ra1[q] += x * wa1; rx0[q] += x * wx0; rx1[q] += x * wx1; }
        }
#pragma unroll
        for (int q = 0; q < 8; ++q) {
            const int rr = half * 8 + q; const size_t r = (size_t)(r0 + rr); const float xcv = xc[rr * 256 + j];
#pragma unroll
            for (int d = 0; d < 2; ++d) {
                const float rg = sigmoidf_((d ? ra1[q] : ra0[q]) + ba[d * 256 + j]);
                const float ig = sigmoidf_((d ? rx1[q] : rx0[q]) + bx[d * 256 + j]);
                const float log_a = -8.f * rg * (d ? sp1 : sp0);
                const float a = expf(log_a);
                const float bv = sqrtf(-expm1f(2.f * log_a)) * (ig * xcv);
                A[((size_t)d * RT + r) * 256 + j] = a; B[((size_t)d * RT + r) * 256 + j] = bv;
            }
        }
        __syncthreads();
    }
}
__device__ __forceinline__ void ph_lru_scan(const PAS Prm& p) {
    const int gid = BID * NTHR + TID;
    if (gid >= 4096) return;
    const int d = gid >> 11, b = (gid >> 8) & 7, j = gid & 255;
    const float* A = (const float*)(p.ws + WS_BIG + BG_S + LR_A) + (size_t)d * RT * 256 + j;
    float* B = (float*)(p.ws + WS_BIG + BG_S + LR_B) + (size_t)d * RT * 256 + j;
    float h = 0.f;
    for (int tau = 0; tau < CTXL + SEQ; tau += 8) {
        float a[8], bb[8]; size_t ro[8];
#pragma unroll
        for (int q = 0; q < 8; ++q) { ro[q] = (size_t)scan_row(b, d, tau + q) * 256; a[q] = A[ro[q]]; bb[q] = B[ro[q]]; }
#pragma unroll
        for (int q = 0; q < 8; ++q) { h = a[q] * h + bb[q]; B[ro[q]] = h; }
    }
}
__device__ __forceinline__ void ph_lru_post(const PAS Prm& p) {
    const int tid = TID, j = tid & 255;
    const bf16* P = (const bf16*)(p.ws + WS_BIG + BG_P);
    const float* H = (const float*)(p.ws + WS_BIG + BG_S + LR_B);
    bf16* ylru = (bf16*)(p.ws + WS_Y + 2 * SZ17);
    for (int r = BID * 2 + (tid >> 8); r < RT; r += NBLK * 2) {
        const size_t o = (size_t)r * 256 + j;
        const float hsum = H[o] + H[(size_t)RT * 256 + o];
        const float x = bf2f(P[(size_t)r * 512 + 256 + j]);
        const float ge = 0.5f * x * (1.f + tanhf(0.7978845608028654f * (x + 0.044715f * x * x * x)));
        ylru[o] = f2bf(hsum * ge);
    }
}

constexpr size_t HY_VL = 0, HY_VC = 96 * MiB, HY_FL = 102 * MiB, HY_FC = 118 * MiB;
__device__ __forceinline__ void ph_hy_filter(const PAS Prm& p, int l, bool with_ctx, LAS unsigned char* lds) {
    LAS float* feat = (LAS float*)lds;
    LAS float* h1 = feat + 16 * 17;
    LAS float* h2 = h1 + 16 * 64;
    const int tid = TID;
    const float* w1 = p.in[11] + l * 17 * 64; const float* b1 = p.in[12] + l * 64; const float* w2 = p.in[13] + l * 64 * 64; const float* b2 = p.in[14] + l * 64;
    const float* w3 = p.in[15] + (size_t)l * 64 * 1024; const float* freq = p.in[16] + l * 128;
    float* FL = (float*)(p.ws + WS_BIG + BG_S + HY_FL); float* FC = (float*)(p.ws + WS_BIG + BG_S + HY_FC);
    const int ntile = with_ctx ? (SEQ + CTXL) / 16 : SEQ / 16;
    for (int tile = BID; tile < ntile; tile += NBLK) {
        const bool isctx = tile >= SEQ / 16; const int L = isctx ? CTXL : SEQ; const int pos0 = (isctx ? tile - SEQ / 16 : tile) * 16;
        float* F = isctx ? FC : FL;
        if (tid < 16 * 17) { const int pp = tid / 17, f = tid % 17; const float t = (float)(pos0 + pp) / (float)L;
            float v; if (f == 0) v = t; else if (f <= 8) v = sinf(6.283185307179586f * t * (float)f); else v = cosf(6.283185307179586f * t * (float)(f - 8));
            feat[tid] = v; }
        __syncthreads();
        for (int i = tid; i < 1024; i += NTHR) { const int pp = i >> 6, o = i & 63; float s = b1[o];
            for (int f = 0; f < 17; ++f) s += feat[pp * 17 + f] * w1[f * 64 + o];
            h1[i] = sinf(freq[o] * s); }
        __syncthreads();
        for (int i = tid; i < 1024; i += NTHR) { const int pp = i >> 6, o = i & 63; float s = b2[o];
            for (int q = 0; q < 64; ++q) s += h1[pp * 64 + q] * w2[q * 64 + o];
            h2[i] = sinf(freq[64 + o] * s); }
        __syncthreads();
        for (int cc = tid; cc < 1024; cc += NTHR) {
            float acc[16];
#pragma unroll
            for (int pp = 0; pp < 16; ++pp) acc[pp] = 0.f;
            for (int q = 0; q < 64; ++q) { const float w = w3[q * 1024 + cc];
#pragma unroll
                for (int pp = 0; pp < 16; ++pp) acc[pp] += h2[pp * 64 + q] * w; }
            const int o = cc >> 9, dd = (cc >> 8) & 1, c = cc & 255;
            const float rate = 3.0701134573253945f + (15.350567286626973f - 3.0701134573253945f) * (float)c * (1.f / 255.f);
            float* Fo = F + (size_t)(o * 256 + c) * (2 * L);
#pragma unroll
            for (int pp = 0; pp < 16; ++pp) { const int pos = pos0 + pp; const float t = (float)pos / (float)L;
                const float val = acc[pp] * expf(-t * rate);
                if (dd == 0) Fo[L + pos] = val; else if (pos >= 1) Fo[L - pos] = val; }
            if (pos0 == 0 && dd == 0) Fo[0] = 0.f;
        }
        __syncthreads();
    }
}
__device__ __forceinline__ void ph_hy_fnorm(const PAS Prm& p, bool with_ctx) {
    const int tid = TID, lane = tid & 63, wave = tid >> 6;
    float* FL = (float*)(p.ws + WS_BIG + BG_S + HY_FL); float* FC = (float*)(p.ws + WS_BIG + BG_S + HY_FC);
    const int gw = BID * NWAVES + wave, NGW = NBLK * NWAVES;
    for (int it = gw; it < (with_ctx ? 1024 : 512); it += NGW) {
        const bool isctx = it >= 512; const int L = isctx ? CTXL : SEQ; float* F = (isctx ? FC : FL) + (size_t)(it & 511) * (2 * L);
        float s = 0.f;
        for (int i = lane; i < 2 * L; i += 64) { const float v = F[i]; s += v * v; }
        const float sc = rsqrtf(wave_sum(s) + 1e-6f);
        for (int i = lane; i < 2 * L; i += 64) F[i] *= sc;
    }
}
__device__ __forceinline__ void ph_hy_prep(const PAS Prm& p, int l, bool with_ctx, LAS unsigned char* lds) {
    LAS float* tl = (LAS float*)lds;
    const int tid = TID;
    const bf16* P = (const bf16*)(p.ws + WS_BIG + BG_P);
    float* VL = (float*)(p.ws + WS_BIG + BG_S + HY_VL); float* VC = (float*)(p.ws + WS_BIG + BG_S + HY_VC);
    const float* cw = p.in[9] + l * 3 * 768; const float* cb = p.in[10] + l * 768;
    const int NTL = 8 * (SEQ / 64) * 12, NTC = with_ctx ? 8 * (CTXL / 64) * 12 : 0;
    for (int tile = BID; tile < NTL + NTC; tile += NBLK) {
        const bool isctx = tile >= NTL; const int tt = isctx ? tile - NTL : tile;
        const int T = isctx ? CTXL : SEQ, ntt = T / 64;
        const int ct = tt % 12, tb = (tt / 12) % ntt, b = tt / (12 * ntt);
        const int base = isctx ? b * CTXL : RC + b * SEQ, t0 = tb * 64, c0 = ct * 64;
        for (int i = tid; i < 66 * 64; i += NTHR) { const int rr = i >> 6, cc = i & 63, t = t0 - 1 + rr;
            tl[rr * 65 + cc] = (t >= 0 && t < T) ? bf2f(P[(size_t)(base + t) * 768 + c0 + cc]) : 0.f; }
        __syncthreads();
        const int part = c0 >> 8, cl0 = c0 & 255;
        float* dst = (isctx ? VC : VL) + ((size_t)(part * 8 + b) * 256 + cl0) * T + t0;
        for (int i = tid; i < 64 * 64; i += NTHR) { const int cc = i >> 6, ti = i & 63, col = c0 + cc;
            const float v = cb[col] + cw[col] * tl[ti * 65 + cc] + cw[768 + col] * tl[(ti + 1) * 65 + cc] + cw[1536 + col] * tl[(ti + 2) * 65 + cc];
            dst[(size_t)cc * T + ti] = v; }
        __syncthreads();
    }
}
template <int L>
__device__ __forceinline__ void hy_conv_item(const PAS Prm& p, int l, int c, int b0, LAS unsigned char* lds) {
    constexpr int NI = (L + NTHR - 1) / NTHR;
    LAS float* hh = (LAS float*)lds;
    LAS float* z = hh + 2 * L;
    const int tid = TID;
    const bool isctx = (L == CTXL);
    const float* F = (const float*)(p.ws + WS_BIG + BG_S + (isctx ? HY_FC : HY_FL));
    const float* HV = (const float*)(p.ws + WS_BIG + BG_S + (isctx ? HY_VC : HY_VL));
    const float* bias = p.in[17] + l * 512;
    for (int bb = 0; bb < 4; ++bb) for (int t = tid; t < L; t += NTHR) z[t * 4 + bb] = HV[((size_t)(0 * 8 + b0 + bb) * 256 + c) * L + t];
    for (int o = 0; o < 2; ++o) {
        for (int i = tid; i < 2 * L; i += NTHR) hh[i] = F[(size_t)(o * 256 + c) * (2 * L) + i];
        __syncthreads();
        float acc[NI][4];
#pragma unroll
        for (int i = 0; i < NI; ++i) { acc[i][0] = 0.f; acc[i][1] = 0.f; acc[i][2] = 0.f; acc[i][3] = 0.f; }
        if (tid < L) {
            for (int s = 0; s < L; ++s) {
                const f32x4 zs = *(const LAS f32x4*)(z + s * 4);
#pragma unroll
                for (int i = 0; i < NI; ++i) { const float hv = hh[L + tid + NTHR * i - s];
                    acc[i][0] += hv * zs.x; acc[i][1] += hv * zs.y; acc[i][2] += hv * zs.z; acc[i][3] += hv * zs.w; }
            }
        }
        __syncthreads();
        const float bo = bias[o * 256 + c];
        if (tid < L) {
#pragma unroll
            for (int i = 0; i < NI; ++i) { const int t = tid + NTHR * i;
#pragma unroll
                for (int bb = 0; bb < 4; ++bb) { const float gate = HV[((size_t)((1 + o) * 8 + b0 + bb) * 256 + c) * L + t];
                    z[t * 4 + bb] = gate * (acc[i][bb] + bo * z[t * 4 + bb]); } }
        }
        __syncthreads();
    }
    float* HVw = (float*)(p.ws + WS_BIG + BG_S + (isctx ? HY_VC : HY_VL));
    if (tid < L) {
#pragma unroll
        for (int i = 0; i < NI; ++i) { const int t = tid + NTHR * i;
#pragma unroll
            for (int bb = 0; bb < 4; ++bb) HVw[((size_t)(0 * 8 + b0 + bb) * 256 + c) * L + t] = z[t * 4 + bb]; }
    }
    __syncthreads();
}
__device__ __forceinline__ void ph_hy_post(const PAS Prm& p, bool with_ctx, LAS unsigned char* lds) {
    LAS float* tl = (LAS float*)lds;
    const int tid = TID;
    const float* VL = (const float*)(p.ws + WS_BIG + BG_S + HY_VL); const float* VC = (const float*)(p.ws + WS_BIG + BG_S + HY_VC);
    bf16* yhy = (bf16*)(p.ws + WS_Y);
    const int NTL = 8 * (SEQ / 64) * 4, NTC = with_ctx ? 8 * (CTXL / 64) * 4 : 0;
    for (int tile = BID; tile < NTL + NTC; tile += NBLK) {
        const bool isctx = tile >= NTL; const int tt = isctx ? tile - NTL : tile;
        const int T = isctx ? CTXL : SEQ, ntt = T / 64;
        const int ct = tt % 4, tb = (tt / 4) % ntt, b = tt / (4 * ntt);
        const int base = isctx ? b * CTXL : RC + b * SEQ, t0 = tb * 64, c0 = ct * 64;
        const float* src = (isctx ? VC : VL) + ((size_t)b * 256 + c0) * T + t0;
        for (int i = tid; i < 64 * 64; i += NTHR) { const int cc = i >> 6, ti = i & 63; tl[cc * 65 + ti] = src[(size_t)cc * T + ti]; }
        __syncthreads();
        for (int i = tid; i < 64 * 32; i += NTHR) { const int ti = i >> 5, cp = i & 31;
            *(unsigned*)(yhy + (size_t)(base + t0 + ti) * 256 + c0 + 2 * cp) = pk2(tl[(2 * cp) * 65 + ti], tl[(2 * cp + 1) * 65 + ti]); }
        __syncthreads();
    }
}
__device__ __forceinline__ void ph_hy_conv(const PAS Prm& p, int l, bool with_ctx, LAS unsigned char* lds) {
    for (int it = BID; it < 512; it += NBLK) hy_conv_item<SEQ>(p, l, it >> 1, (it & 1) * 4, lds);
    if (with_ctx) for (int it = BID; it < 512; it += NBLK) hy_conv_item<CTXL>(p, l, it >> 1, (it & 1) * 4, lds);
}

constexpr int PPL = 30;
constexpr int NPH = 1 + DEPTH * PPL + 1;

template <unsigned MASK> __global__ void __launch_bounds__(NTHR, 2) fwd(Prm pk) {
#ifdef HOST_EMU
    unsigned char* lds_raw = g_lds_emu;
#else
    extern __shared__ __attribute__((aligned(16))) unsigned char lds_raw[];
#endif
    LAS unsigned char* lds = (LAS unsigned char*)lds_raw;
    volatile LAS unsigned* misc = (volatile LAS unsigned*)(lds + LDS_BYTES - 256);
#ifndef HOST_EMU
    { const unsigned t0 = threadIdx.x;
      if (t0 < 64u) misc[t0] = 0u;
      if ((t0 & 63u) == 0u) ((volatile LAS unsigned*)(lds + TIDTAB_OFF))[hw_slot()] = t0 >> 6;
      __syncthreads();
      if ((unsigned)tid_opq() != t0) __hip_atomic_store((unsigned*)(pk.ws + WS_CTL + 768 * 1024), 1u, __ATOMIC_RELAXED, __HIP_MEMORY_SCOPE_AGENT); }
#else
    if (TID < 64) misc[TID] = 0u;
    __syncthreads();
#endif
    const int lo = pk.lo, hi = pk.hi;
    XcdBarrier bar; bar.bar = (unsigned*)(pk.ws + WS_CTL); bar.x = 0; bar.st = misc + 8;
    if (hi - lo > 1) bar = xcd_barrier_post((unsigned*)(pk.ws + WS_CTL), misc + 8);
    int ph = 0;
#ifdef HOST_EMU
#define PH_PRM() const Prm* pl_ = &pk
#else
#define PH_PRM() const PAS Prm* pl_ = (const PAS Prm*)__builtin_amdgcn_kernarg_segment_ptr(); asm volatile("" : "+s"(pl_))
#endif
#define PH_BEGIN(k) if (((MASK >> ((k) & 31)) & 1u) && ph >= lo && ph < hi) { PH_PRM(); const PAS Prm& p = *pl_; \
    bf16* const WB = (bf16*)(p.ws + WS_W); bf16* const U = (bf16*)(p.ws + WS_U); float* const XC = (float*)(p.ws + WS_XC); bf16* const PB = (bf16*)(p.ws + WS_BIG + BG_P); \
    unsigned char* const SB = p.ws + WS_BIG + BG_S; bf16* const GH = (bf16*)(p.ws + WS_BIG); bf16* const MG = (bf16*)(p.ws + WS_BIG + 136 * MiB); bf16* const ACT = (bf16*)(p.ws + WS_BIG); \
    const float* const MOD = (const float*)(p.ws + WS_MOD); const float* const modl = MOD + (size_t)l * 9 * 6144; \
    const float* xc_src = (l == 0) ? p.in[2] : XC; const float* xl_src = (l == 0) ? p.in[0] : p.out; \
    (void)WB; (void)U; (void)XC; (void)PB; (void)SB; (void)GH; (void)MG; (void)ACT; (void)MOD; (void)modl; (void)xc_src; (void)xl_src;
#define PH_END   if (ph + 1 < hi) xcd_barrier(bar); } ++ph;
    typedef pg8::StaticOrder SO;

    { const int l = 0; PH_BEGIN(1) ph_mod(p, lds); PH_END }

#pragma unroll 1
    for (int l0 = 0; l0 < DEPTH; ++l0) {
        int l = l0;
#ifndef HOST_EMU
        asm volatile("" : "+s"(l));
#endif
        const bool last = (l == DEPTH - 1), wctx = !last;
        const int ro = last ? RC : 0, Mpost = last ? RL : RT;

        PH_BEGIN(2) ph_cvt(p, l, lds); PH_END
        PH_BEGIN(3) ph_norm(p, l, 0, xc_src, xl_src, 0); PH_END
        PH_BEGIN(4) { pg8::Gemm g{U, WB + WO_WP + (size_t)768 * 1024, RT, 1024, 1024}; SO S; S.init(RT, 1024, NBLK, BID); pg8::EpiBf<0> E{PB, 1024};
                   pg8::gemm_phase<pg8::EpiBf<0>, SO, true, true>(lds, g, S, E); } PH_END
        PH_BEGIN(5) ph_rw_prep(p, l, lds); PH_END
        PH_BEGIN(6) scan_phase<0>(SB, PB, (float*)(SB + RW_Y), p.in[25] + l * 256, nullptr, lds); PH_END
        PH_BEGIN(7) ph_rw_post(p, l); PH_END
        PH_BEGIN(8) { pg8::Gemm g{U, WB + WO_WP + (size_t)2304 * 1024, RT, 1024, 1024}; SO S; S.init(RT, 1024, NBLK, BID); pg8::EpiBf<0> E{PB, 1024};
                   pg8::gemm_phase<pg8::EpiBf<0>, SO, true, true>(lds, g, S, E); } PH_END
        PH_BEGIN(9) ph_ret_prep(p); PH_END
        PH_BEGIN(10) scan_phase<1>(SB, PB, (float*)(SB + RT_Y), nullptr, p.in[35] + l * 8, lds); PH_END
        PH_BEGIN(11) ph_ret_post(p); PH_END
        PH_BEGIN(12) { pg8::Gemm g{U, WB + WO_WP + (size_t)1792 * 1024, RT, 512, 1024}; SO S; S.init(RT, 512, NBLK, BID); pg8::EpiBf<0> E{PB, 512};
                   pg8::gemm_phase<pg8::EpiBf<0>, SO, true, true>(lds, g, S, E); } PH_END
        PH_BEGIN(13) ph_lru_prep(p, l, lds); PH_END
        PH_BEGIN(14) ph_lru_scan(p); PH_END
        PH_BEGIN(15) ph_lru_post(p); PH_END
        PH_BEGIN(16) { pg8::Gemm g{U, WB + WO_WP, RT, 768, 1024}; SO S; S.init(RT, 768, NBLK, BID); pg8::EpiBf<0> E{PB, 768};
                   pg8::gemm_phase<pg8::EpiBf<0>, SO, true, true>(lds, g, S, E); } PH_END
        PH_BEGIN(17) ph_hy_filter(p, l, wctx, lds); PH_END
        PH_BEGIN(18) ph_hy_fnorm(p, wctx); PH_END
        PH_BEGIN(19) ph_hy_prep(p, l, wctx, lds); PH_END
        PH_BEGIN(20) ph_hy_conv(p, l, wctx, lds); PH_END
        PH_BEGIN(32) ph_hy_post(p, wctx, lds); PH_END
        PH_BEGIN(21) { pg8::Gemm g{U + (size_t)ro * 1024, WB + WO_WG, Mpost, 2048, 1024}; SO S; S.init(Mpost, 2048, NBLK, BID); pg8::EpiBf<1> E{GH + (size_t)ro * 2048, 2048};
                   pg8::gemm_phase<pg8::EpiBf<1>, SO, true, true>(lds, g, S, E); } PH_END
        PH_BEGIN(22) { pg8::Gemm g{(const bf16*)(p.ws + WS_Y + 0 * SZ17) + (size_t)ro * 256, WB + WO_BR + (size_t)0 * 1024 * 256, Mpost, 1024, 256}; SO S; S.init(Mpost, 1024, NBLK, BID);
                   pg8::EpiMerge E{GH + (size_t)ro * 2048, 2048, 0, MG + (size_t)ro * 1024, 1};
                   pg8::gemm_phase<pg8::EpiMerge, SO, true, true>(lds, g, S, E); } PH_END
        PH_BEGIN(23) { pg8::Gemm g{(const bf16*)(p.ws + WS_Y + 1 * SZ17) + (size_t)ro * 256, WB + WO_BR + (size_t)1 * 1024 * 256, Mpost, 1024, 256}; SO S; S.init(Mpost, 1024, NBLK, BID);
                   pg8::EpiMerge E{GH + (size_t)ro * 2048, 2048, 1024, MG + (size_t)ro * 1024, 0};
                   pg8::gemm_phase<pg8::EpiMerge, SO, true, true>(lds, g, S, E); } PH_END
        PH_BEGIN(24) { pg8::Gemm g{U + (size_t)ro * 1024, WB + WO_WG + (size_t)2048 * 1024, Mpost, 2048, 1024}; SO S; S.init(Mpost, 2048, NBLK, BID); pg8::EpiBf<1> E{GH + (size_t)ro * 2048, 2048};
                   pg8::gemm_phase<pg8::EpiBf<1>, SO, true, true>(lds, g, S, E); } PH_END
        PH_BEGIN(25) { pg8::Gemm g{(const bf16*)(p.ws + WS_Y + 2 * SZ17) + (size_t)ro * 256, WB + WO_BR + (size_t)2 * 1024 * 256, Mpost, 1024, 256}; SO S; S.init(Mpost, 1024, NBLK, BID);
                   pg8::EpiMerge E{GH + (size_t)ro * 2048, 2048, 0, MG + (size_t)ro * 1024, 0};
                   pg8::gemm_phase<pg8::EpiMerge, SO, true, true>(lds, g, S, E); } PH_END
        PH_BEGIN(26) { pg8::Gemm g{(const bf16*)(p.ws + WS_Y + 3 * SZ17) + (size_t)ro * 256, WB + WO_BR + (size_t)3 * 1024 * 256, Mpost, 1024, 256}; SO S; S.init(Mpost, 1024, NBLK, BID);
                   pg8::EpiMerge E{GH + (size_t)ro * 2048, 2048, 1024, MG + (size_t)ro * 1024, 0};
                   pg8::gemm_phase<pg8::EpiMerge, SO, true, true>(lds, g, S, E); } PH_END
        PH_BEGIN(27) { pg8::Gemm g{MG + (size_t)ro * 1024, WB + WO_WO, Mpost, 1024, 1024}; SO S; S.init(Mpost, 1024, NBLK, BID);
                   pg8::EpiResid E{xc_src, xl_src, XC, p.out, modl, 2 * 1024, ro};
                   pg8::gemm_phase<pg8::EpiResid, SO, true, true>(lds, g, S, E); } PH_END
        PH_BEGIN(28) ph_norm(p, l, 1, XC, p.out, ro); PH_END
        PH_BEGIN(29) { pg8::Gemm g{U + (size_t)ro * 1024, WB + WO_W1, Mpost, 5632, 1024}; SO S; S.init(Mpost, 5632, NBLK, BID); pg8::EpiSwiglu E{ACT + (size_t)ro * 2816, 2816};
                   pg8::gemm_phase<pg8::EpiSwiglu, SO, true, true>(lds, g, S, E); } PH_END
        PH_BEGIN(30) { pg8::Gemm g{ACT + (size_t)ro * 2816, WB + WO_W2, Mpost, 1024, 2816}; SO S; S.init(Mpost, 1024, NBLK, BID);
                   pg8::EpiResid E{XC, p.out, XC, p.out, modl, 5 * 1024, ro};
                   pg8::gemm_phase<pg8::EpiResid, SO, true, true>(lds, g, S, E); } PH_END
    }
    { const int l = 1; PH_BEGIN(31) ph_final(p); PH_END }
#undef PH_BEGIN
#undef PH_END
}

#ifndef HOST_EMU
#define SITE(k) (1u << (k))
#if MK_PER_PHASE
constexpr int NG = 19;
constexpr unsigned GM[NG] = {
    SITE(0) | SITE(1) | SITE(2) | SITE(3) | SITE(28) | SITE(31) | SITE(7) | SITE(11) | SITE(15) | SITE(9) | SITE(18) | SITE(19),
    SITE(5),
    SITE(6) | SITE(10),
    SITE(13) | SITE(14),
    SITE(17) | SITE(20),
    SITE(4), SITE(8), SITE(12), SITE(16), SITE(21), SITE(24), SITE(22), SITE(23), SITE(25), SITE(26), SITE(27), SITE(30), SITE(29), 0u };
#else
constexpr int NG = 1;
constexpr unsigned GM[NG] = {0xFFFFFFFFu};
#endif
template <int G> static bool prep_group() { return hipFuncSetAttribute((const void*)fwd<GM[G]>, hipFuncAttributeMaxDynamicSharedMemorySize, LDS_BYTES) == hipSuccess; }
template <int G> static void launch_group(int grid, hipStream_t stream, const Prm& p) { hipLaunchKernelGGL(fwd<GM[G]>, dim3(grid), dim3(NTHR), LDS_BYTES, stream, p); }

extern "C" void kernel_launch(void* const* d_in, const int* in_sizes, int n_in, void* d_out, int out_size, void* d_ws, size_t ws_size, hipStream_t stream) {
    static int grid = 0;
    if (grid == 0) {
        if (n_in != 41 || out_size != RL * D || ws_size < WS_END) { fprintf(stderr, "kernel_launch: unexpected shapes (n_in %d out %d ws %zu); nothing launched\n", n_in, out_size, ws_size); grid = -1; return; }
        int dev = 0, cus = 0;
        if (hipGetDevice(&dev) != hipSuccess || hipDeviceGetAttribute(&cus, hipDeviceAttributeMultiprocessorCount, dev) != hipSuccess) { grid = -1; return; }
        bool ok = true;
#if MK_PER_PHASE
        ok = ok && prep_group<0>() && prep_group<1>() && prep_group<2>() && prep_group<3>() && prep_group<4>() && prep_group<5>() && prep_group<6>() && prep_group<7>() && prep_group<8>() && prep_group<9>()
                && prep_group<10>() && prep_group<11>() && prep_group<12>() && prep_group<13>() && prep_group<14>() && prep_group<15>() && prep_group<16>() && prep_group<17>();
#else
        ok = prep_group<0>();
#endif
        if (!ok) { fprintf(stderr, "kernel_launch: hipFuncSetAttribute failed\n"); grid = -1; return; }
        (void)hipGetLastError();
        grid = cus > 0 ? cus : 256;
    }
    if (grid < 0) return;
    if (hipMemsetAsync((char*)d_ws + WS_CTL, 0, 1 * MiB, stream) != hipSuccess) return;
    Prm p{};
    for (int i = 0; i < 41; ++i) p.in[i] = (const float*)d_in[i];
    p.out = (float*)d_out; p.ws = (unsigned char*)d_ws;
#if MK_PER_PHASE
    for (int ph = 0; ph < NPH; ++ph) {
        p.lo = ph; p.hi = ph + 1;
        static const int layer_sites[PPL] = {2, 3, 4, 5, 6, 7, 8, 9, 10, 11, 12, 13, 14, 15, 16, 17, 18, 19, 20, 0  , 21, 22, 23, 24, 25, 26, 27, 28, 29, 30};
        const int k = (ph == 0) ? 1 : (ph == NPH - 1) ? 31 : layer_sites[(ph - 1) % PPL];
        int g = -1;
        for (int q = 0; q < NG; ++q) if ((GM[q] >> k) & 1u) g = q;
        switch (g) {
            case 0: launch_group<0>(grid, stream, p); break; case 1: launch_group<1>(grid, stream, p); break; case 2: launch_group<2>(grid, stream, p); break;
            case 3: launch_group<3>(grid, stream, p); break; case 4: launch_group<4>(grid, stream, p); break; case 5: launch_group<5>(grid, stream, p); break;
            case 6: launch_group<6>(grid, stream, p); break; case 7: launch_group<7>(grid, stream, p); break; case 8: launch_group<8>(grid, stream, p); break;
            case 9: launch_group<9>(grid, stream, p); break; case 10: launch_group<10>(grid, stream, p); break; case 11: launch_group<11>(grid, stream, p); break;
            case 12: launch_group<12>(grid, stream, p); break; case 13: launch_group<13>(grid, stream, p); break; case 14: launch_group<14>(grid, stream, p); break;
            case 15: launch_group<15>(grid, stream, p); break; case 16: launch_group<16>(grid, stream, p); break; case 17: launch_group<17>(grid, stream, p); break;
            default: break; }
#ifdef DIAG_BUILD
        { static const int dg[8][2] = {{0, 0}, {2, 1}, {10, 2}, {14, 3}, {20, 4}, {22, 5}, {26, 6}, {28, 7}};
          for (int q = 0; q < 8; ++q) if (ph == 1 + dg[q][0]) hipLaunchKernelGGL(diag_k, dim3(32), dim3(NTHR), 0, stream, p, dg[q][1]);
          if (ph == 1 + 19) hipLaunchKernelGGL(diag_k, dim3(32), dim3(NTHR), 0, stream, p, 8);
          if (ph == NPH - 1) hipLaunchKernelGGL(diag_out_k, dim3(grid), dim3(NTHR), 0, stream, p); }
#endif
    }
#else
    p.lo = 0; p.hi = NPH;
    launch_group<0>(grid, stream, p);
#endif
}
#endif
```

```cpp
#include <hip/hip_runtime.h>
#include <cstdio>
#include <cstdint>

#ifndef SEQ_
#define SEQ_ 4096
#define CTXL_ 256
#endif
#ifndef MK_PER_PHASE
#define MK_PER_PHASE 0
#endif

#ifndef HOST_EMU
extern __shared__ __attribute__((aligned(16))) unsigned char g_dyn_lds[];
constexpr int TIDTAB_OFF = 147456 - 2048;
__device__ __forceinline__ unsigned hw_slot() { return (unsigned)__builtin_amdgcn_s_getreg((7 << 11) | 4) & 0xFFu; }
__device__ __forceinline__ int tid_opq() {
    const unsigned w = ((const volatile __attribute__((address_space(3))) unsigned*)((__attribute__((address_space(3))) unsigned char*)g_dyn_lds + TIDTAB_OFF))[hw_slot()];
    unsigned lane; asm volatile("v_mbcnt_lo_u32_b32 %0, -1, 0\n\tv_mbcnt_hi_u32_b32 %0, -1, %0" : "=v"(lane));
    int t = (int)((unsigned)__builtin_amdgcn_readfirstlane((int)w) * 64u + lane); asm volatile("" : "+v"(t)); return t;
}
#endif

namespace pg8 {
#define PG8_LAS __attribute__((address_space(3)))
typedef unsigned short bf16_t;
typedef short bf16x8 __attribute__((ext_vector_type(8)));
typedef float f32x4 __attribute__((ext_vector_type(4)));
typedef unsigned u32x4 __attribute__((ext_vector_type(4)));
constexpr int BM = 256, BK = 64, HALF = 128, HTB = HALF * BK * 2  , STAGE_BYTES = 8 * HTB, NXCD = 8, WGM = 8;

__host__ __device__ __forceinline__ int lds_byte(int r, int c) { const int st = (r >> 4) * 2 + (c >> 5), rr = r & 15, cc = c & 31, ob = rr * 64 + cc * 2; return st * 1024 + (ob ^ (((ob >> 9) & 1) << 5)); }
__host__ __device__ __forceinline__ void stage_rc(int b, int& R, int& C) { const int st = b / 1024, sb = b % 1024, swz = sb ^ (((sb >> 9) & 1) << 5); R = (st >> 1) * 16 + swz / 64; C = (st & 1) * 32 + (swz % 64) / 2; }
__host__ __device__ __forceinline__ int perm32(int rho) { const int n = rho >> 4, i = rho & 15; return 8 * (i >> 2) + 4 * n + (i & 3); }

struct Unit { int pm, pn; };
struct Gemm { const bf16_t* A; const bf16_t* Bt; int M, N, K; };

struct StaticOrder {
    int nM, nN, nwg, G, c;
    __host__ __device__ void init(int M, int N, int G_, int c_) { nM = M / BM; nN = N / BM; nwg = nM * nN; G = G_; c = c_; }
    __host__ __device__ bool next(int i, Unit& u) const {
        const long L = (long)i * G + c; if (L >= nwg) return false;
        int wgid = (int)L; { const int q = nwg / NXCD, r = nwg % NXCD, xcd = wgid % NXCD, off = wgid / NXCD; wgid = (xcd < r ? xcd * (q + 1) : r * (q + 1) + (xcd - r) * q) + off; }
        const int nig = WGM * nN, gid = wgid / nig, fm = gid * WGM, gsz = (nM - fm) < WGM ? (nM - fm) : WGM;
        u.pm = fm + ((wgid % nig) % gsz); u.pn = (wgid % nig) / gsz; return true;
    }
    __device__ __forceinline__ void a_ready(const Unit&) const {}
    __device__ __forceinline__ void done(const Unit&) const {}
};

#ifdef HOST_EMU
__device__ __forceinline__ unsigned cvt_pk_bf16(float lo, float hi) { auto f = [](float x) { unsigned u; memcpy(&u, &x, 4); return (u + 0x7fffu + ((u >> 16) & 1u)) >> 16; }; return f(lo) | (f(hi) << 16); }
#else
typedef __bf16 pg8_bf16x2 __attribute__((ext_vector_type(2)));
typedef float pg8_f32x2 __attribute__((ext_vector_type(2)));
__device__ __forceinline__ unsigned cvt_pk_bf16(float lo, float hi) { pg8_f32x2 v = {lo, hi}; pg8_bf16x2 b = __builtin_convertvector(v, pg8_bf16x2); return __builtin_bit_cast(unsigned, b); }
#endif
typedef float f32x2 __attribute__((ext_vector_type(2)));
__device__ __forceinline__ float bflo(unsigned u) { return __uint_as_float(u << 16); }
__device__ __forceinline__ float bfhi(unsigned u) { return __uint_as_float(u & 0xffff0000u); }
#ifdef HOST_EMU
__device__ __forceinline__ float fsigmoid(float x) { return 1.f / (1.f + expf(-x)); }
#else
__device__ __forceinline__ float fsigmoid(float x) { return __builtin_amdgcn_rcpf(1.f + __expf(-x)); }
#endif

#ifdef HOST_EMU
#define EPI_PIN() do { } while (0)
#define EPI_LATE(fr, fq) do { } while (0)
#define EPI_Z(z) do { } while (0)
#else
#define EPI_Z(z) asm volatile("" : "+v"(z))
#define EPI_LATE(fr, fq) asm volatile("" : "+v"(fr), "+v"(fq))

#define EPI_PIN() asm volatile("" ::: "memory")
#endif
template <int ACT> struct EpiBf {
    static constexpr bool PERM = true, AFTER_DRAIN = false;
    bf16_t* O; int ldc;
    __device__ __forceinline__ void operator()(const f32x4 (&acc)[2][2][4][2], const Unit& u, int wr, int wc, int fr, int fq) const {
        EPI_LATE(fr, fq);
        const int row0 = u.pm * BM + wr * 64 + fr, col0 = u.pn * BM + wc * 32 + 8 * fq;
#pragma unroll
        for (int ai = 0; ai < 2; ++ai)
#pragma unroll
            for (int m = 0; m < 4; ++m) { bf16_t* rowp = O + (size_t)(row0 + ai * HALF + m * 16) * ldc + col0;
#pragma unroll
                for (int bj = 0; bj < 2; ++bj) { f32x4 v0 = acc[ai][bj][m][0], v1 = acc[ai][bj][m][1];
                    if (ACT == 1) {
#pragma unroll
                        for (int j = 0; j < 4; ++j) { v0[j] = fsigmoid(v0[j]); v1[j] = fsigmoid(v1[j]); } }
                    u32x4 w; w.x = cvt_pk_bf16(v0[0], v0[1]); w.y = cvt_pk_bf16(v0[2], v0[3]); w.z = cvt_pk_bf16(v1[0], v1[1]); w.w = cvt_pk_bf16(v1[2], v1[3]);
                    *(u32x4*)(rowp + bj * HALF) = w; } }
    }
};

struct EpiMerge {
    static constexpr bool PERM = true, AFTER_DRAIN = false;
    const bf16_t* G; int ldg; int gcol0; bf16_t* Mg; int first;
    __device__ __forceinline__ void operator()(const f32x4 (&acc)[2][2][4][2], const Unit& u, int wr, int wc, int fr, int fq) const {
        EPI_LATE(fr, fq);
        const int row0 = u.pm * BM + wr * 64 + fr, col0 = u.pn * BM + wc * 32 + 8 * fq;
#pragma unroll
        for (int ai = 0; ai < 2; ++ai)
#pragma unroll
            for (int m = 0; m < 4; ++m) { const size_t row = (size_t)(row0 + ai * HALF + m * 16);
#pragma unroll
                for (int bj = 0; bj < 2; ++bj) { const int col = col0 + bj * HALF;
                    const u32x4 gv = *(const u32x4*)(G + row * ldg + gcol0 + col);
                    bf16_t* mp = Mg + row * 1024 + col;
                    u32x4 pv; if (!first) pv = *(const u32x4*)mp; else { unsigned z0 = 0u; EPI_Z(z0); pv = (u32x4){z0, z0, z0, z0}; }
                    const f32x4 v0 = acc[ai][bj][m][0], v1 = acc[ai][bj][m][1];
                    float o[8];
                    o[0] = bflo(pv.x) + bflo(gv.x) * v0[0]; o[1] = bfhi(pv.x) + bfhi(gv.x) * v0[1];
                    o[2] = bflo(pv.y) + bflo(gv.y) * v0[2]; o[3] = bfhi(pv.y) + bfhi(gv.y) * v0[3];
                    o[4] = bflo(pv.z) + bflo(gv.z) * v1[0]; o[5] = bfhi(pv.z) + bfhi(gv.z) * v1[1];
                    o[6] = bflo(pv.w) + bflo(gv.w) * v1[2]; o[7] = bfhi(pv.w) + bfhi(gv.w) * v1[3];
                    u32x4 w; w.x = cvt_pk_bf16(o[0], o[1]); w.y = cvt_pk_bf16(o[2], o[3]); w.z = cvt_pk_bf16(o[4], o[5]); w.w = cvt_pk_bf16(o[6], o[7]);
                    *(u32x4*)mp = w; }
                EPI_PIN(); }
    }
};

struct EpiResid {
    static constexpr bool PERM = false, AFTER_DRAIN = false;
    const float* src_c; const float* src_l; float* dst_c; float* dst_l; const float* modl; int gate_off; int row_off;
    __device__ __forceinline__ void operator()(const f32x4 (&acc)[2][2][4][2], const Unit& u, int wr, int wc, int fr, int fq) const {
        EPI_LATE(fr, fq);
        const int grow0 = row_off + u.pm * BM;
        const bool isctx = grow0 < 8 * CTXL_;
        const int jb = isctx ? 8 : (grow0 - 8 * CTXL_) / SEQ_;
        const float* gate = modl + (size_t)jb * 6144 + gate_off;
        const float* src = isctx ? src_c + (size_t)grow0 * 1024 : src_l + (size_t)(grow0 - 8 * CTXL_) * 1024;
        float* dst = isctx ? dst_c + (size_t)grow0 * 1024 : dst_l + (size_t)(grow0 - 8 * CTXL_) * 1024;
        const int rr0 = wr * 64 + fr, col0 = u.pn * BM + wc * 32 + 4 * fq;
        f32x4 gv[2][2];
#pragma unroll
        for (int bj = 0; bj < 2; ++bj)
#pragma unroll
            for (int n = 0; n < 2; ++n) gv[bj][n] = *(const f32x4*)(gate + col0 + bj * HALF + n * 16);
#pragma unroll
        for (int ai = 0; ai < 2; ++ai)
#pragma unroll
            for (int m = 0; m < 4; ++m) { const size_t ro = (size_t)(rr0 + ai * HALF + m * 16) * 1024 + col0;
#pragma unroll
                for (int bj = 0; bj < 2; ++bj)
#pragma unroll
                    for (int n = 0; n < 2; ++n) { const f32x4 s = *(const f32x4*)(src + ro + bj * HALF + n * 16);
                        *(f32x4*)(dst + ro + bj * HALF + n * 16) = s + gv[bj][n] * acc[ai][bj][m][n]; }
                EPI_PIN(); }
    }
};

struct EpiSwiglu {
    static constexpr bool PERM = true, AFTER_DRAIN = false;
    bf16_t* O; int ldc;
    __device__ __forceinline__ void operator()(const f32x4 (&acc)[2][2][4][2], const Unit& u, int wr, int wc, int fr, int fq) const {
        EPI_LATE(fr, fq);
        const int row0 = u.pm * BM + wr * 64 + fr, col0 = u.pn * HALF + wc * 32 + 8 * fq;
#pragma unroll
        for (int ai = 0; ai < 2; ++ai)
#pragma unroll
            for (int m = 0; m < 4; ++m) { bf16_t* rowp = O + (size_t)(row0 + ai * HALF + m * 16) * ldc + col0;
                float o[8];
#pragma unroll
                for (int n = 0; n < 2; ++n)
#pragma unroll
                    for (int j = 0; j < 4; ++j) { const float g = acc[ai][0][m][n][j], up = acc[ai][1][m][n][j]; o[n * 4 + j] = g * fsigmoid(g) * up; }
                u32x4 w; w.x = cvt_pk_bf16(o[0], o[1]); w.y = cvt_pk_bf16(o[2], o[3]); w.z = cvt_pk_bf16(o[4], o[5]); w.w = cvt_pk_bf16(o[6], o[7]);
                *(u32x4*)rowp = w; }
    }
};

template <class Epi, class Sched, bool ALIGN_EPI = false, bool SP2 = false>
__device__ __forceinline__ void gemm_phase(PG8_LAS unsigned char* lds, const Gemm g, const Sched& S, const Epi& E) {
    const int tid = tid_opq();
    const int wid = __builtin_amdgcn_readfirstlane(tid >> 6), lane = tid & 63, wr = wid >> 2, wc = wid & 3, fr = lane & 15, fq = lane >> 4;
    const int K = g.K, nt = K / BK;
    unsigned voffA[2], voffB[2];
#pragma unroll
    for (int i = 0; i < 2; ++i) { int R, C; stage_rc(tid * 16 + i * 8192, R, C); const int Rb = Epi::PERM ? ((R & ~31) + perm32(R & 31)) : R;
        voffA[i] = (unsigned)(R * K + C) * 2u; voffB[i] = (unsigned)(Rb * K + C) * 2u; }
    const size_t kstep = (size_t)(BK * 2);
    const size_t hstep = (size_t)HALF * K * 2;
    const size_t tstep = 2 * hstep;
    const unsigned ldsw = (unsigned)wid * 1024u;
    const int aoff = lds_byte(wr * 64 + fr, fq * 8), boff = lds_byte(wc * 32 + fr, fq * 8);
#define PG8_SA(b, h) (((b) * 2 + (h)) * HTB)
#define PG8_SB(b, h) ((4 + (b) * 2 + (h)) * HTB)
#define PG8_STAGE(bufoff, gbase, voff) do { _Pragma("unroll") for (int _i = 0; _i < 2; ++_i) \
        __builtin_amdgcn_global_load_lds((const unsigned*)((const char*)(gbase) + (voff)[_i]), (PG8_LAS unsigned*)(lds + (bufoff) + ldsw + _i * 8192), 16, 0, 0); } while (0)
#define PG8_LDA(dst, b, h) do { _Pragma("unroll") for (int m = 0; m < 4; ++m) _Pragma("unroll") for (int k = 0; k < 2; ++k) dst[m][k] = *(const PG8_LAS bf16x8*)(lds + PG8_SA(b, h) + aoff + m * 2048 + k * 1024); } while (0)
#define PG8_LDB(dst, b, h) do { _Pragma("unroll") for (int n = 0; n < 2; ++n) _Pragma("unroll") for (int k = 0; k < 2; ++k) dst[n][k] = *(const PG8_LAS bf16x8*)(lds + PG8_SB(b, h) + boff + n * 2048 + k * 1024); } while (0)
#define PG8_MMA(ai, bj, At, Bt) do { __builtin_amdgcn_s_setprio(1); _Pragma("unroll") for (int m = 0; m < 4; ++m) _Pragma("unroll") for (int n = 0; n < 2; ++n) _Pragma("unroll") for (int k = 0; k < 2; ++k) \
        acc[ai][bj][m][n] = __builtin_amdgcn_mfma_f32_16x16x32_bf16(Bt[n][k], At[m][k], acc[ai][bj][m][n], 0, 0, 0); __builtin_amdgcn_s_setprio(0); } while (0)
#define PG8_WAIT_V(n) asm volatile("s_waitcnt vmcnt(" #n ")" ::: "memory")
#define PG8_WAIT_L(n) asm volatile("s_waitcnt lgkmcnt(" #n ")" ::: "memory")
#define PG8_BAR __builtin_amdgcn_s_barrier()
#define PG8_SCHED __builtin_amdgcn_sched_barrier(0)
    Unit cur, nxt; int ui = 0;
    if (!S.next(0, cur)) return;
    f32x4 acc[2][2][4][2];
    { float zf = 0.f; asm volatile("" : "+v"(zf));
#pragma unroll
    for (int a = 0; a < 2; ++a)
#pragma unroll
        for (int b = 0; b < 2; ++b)
#pragma unroll
            for (int m = 0; m < 4; ++m)
#pragma unroll
                for (int n = 0; n < 2; ++n) acc[a][b][m][n] = (f32x4){zf, zf, zf, zf}; }
    bf16x8 At[4][2], B0[2][2], B1[2][2];
    const char* cA = (const char*)g.A + (size_t)cur.pm * tstep; const char* cB = (const char*)g.Bt + (size_t)cur.pn * tstep;
    S.a_ready(cur);
    if constexpr (SP2) {
        PG8_STAGE(PG8_SB(0, 0), cB, voffB); PG8_STAGE(PG8_SB(0, 1), cB + hstep, voffB); PG8_STAGE(PG8_SA(0, 0), cA, voffA); PG8_STAGE(PG8_SA(0, 1), cA + hstep, voffA);
        if (wr == 1) PG8_BAR;
        PG8_WAIT_V(2); PG8_BAR;
        PG8_STAGE(PG8_SB(1, 0), cB + kstep, voffB); PG8_STAGE(PG8_SA(1, 0), cA + kstep, voffA); PG8_STAGE(PG8_SB(1, 1), cB + hstep + kstep, voffB);
        PG8_WAIT_V(6); PG8_BAR;
    } else {
        PG8_STAGE(PG8_SB(0, 0), cB, voffB); PG8_STAGE(PG8_SA(0, 0), cA, voffA); PG8_STAGE(PG8_SB(0, 1), cB + hstep, voffB); PG8_STAGE(PG8_SA(0, 1), cA + hstep, voffA);
        if (wr == 1) PG8_BAR;
        PG8_WAIT_V(4); PG8_BAR;
        PG8_STAGE(PG8_SB(1, 0), cB + kstep, voffB); PG8_STAGE(PG8_SA(1, 0), cA + kstep, voffA); PG8_STAGE(PG8_SB(1, 1), cB + hstep + kstep, voffB);
        PG8_WAIT_V(6); PG8_BAR;
    }
    for (;;) {
        const bool has_next = S.next(ui + 1, nxt);
        const char* nA = has_next ? (const char*)g.A + (size_t)nxt.pm * tstep : cA; const char* nB = has_next ? (const char*)g.Bt + (size_t)nxt.pn * tstep : cB;
        for (int t = 0; t < nt; t += 2) {
            const bool last = (t == nt - 2);
            const char* a1 = cA + (size_t)(t + 1) * kstep;
            const char* a2 = last ? nA : cA + (size_t)(t + 2) * kstep; const char* b2 = last ? nB : cB + (size_t)(t + 2) * kstep;
            const char* a3 = a2 + kstep; const char* b3 = b2 + kstep;
            if (last && has_next) S.a_ready(nxt);
            if constexpr (SP2) {
            PG8_LDB(B0, 0, 0); PG8_LDB(B1, 0, 1); PG8_SCHED; PG8_LDA(At, 0, 0); PG8_STAGE(PG8_SA(1, 1), a1 + hstep, voffA);
            PG8_WAIT_V(8); PG8_WAIT_L(0); PG8_BAR; PG8_MMA(0, 0, At, B0); PG8_MMA(0, 1, At, B1); PG8_BAR; PG8_SCHED;
            PG8_LDA(At, 0, 1); PG8_STAGE(PG8_SB(0, 0), b2, voffB); PG8_STAGE(PG8_SB(0, 1), b2 + hstep, voffB); PG8_STAGE(PG8_SA(0, 0), a2, voffA);
            PG8_WAIT_V(8); PG8_WAIT_L(0); PG8_BAR; PG8_MMA(1, 0, At, B0); PG8_MMA(1, 1, At, B1); PG8_BAR; PG8_SCHED;
            PG8_LDB(B0, 1, 0); PG8_LDB(B1, 1, 1); PG8_SCHED; PG8_LDA(At, 1, 0); PG8_STAGE(PG8_SA(0, 1), a2 + hstep, voffA);
            PG8_WAIT_V(8); PG8_WAIT_L(0); PG8_BAR; PG8_MMA(0, 0, At, B0); PG8_MMA(0, 1, At, B1); PG8_BAR; PG8_SCHED;
            PG8_LDA(At, 1, 1); PG8_STAGE(PG8_SB(1, 0), b3, voffB); PG8_STAGE(PG8_SB(1, 1), b3 + hstep, voffB); PG8_STAGE(PG8_SA(1, 0), a3, voffA);
            PG8_WAIT_V(8); PG8_WAIT_L(0); PG8_BAR; PG8_MMA(1, 0, At, B0); PG8_MMA(1, 1, At, B1); PG8_BAR; PG8_SCHED;
            } else {
            PG8_LDB(B0, 0, 0); PG8_SCHED; PG8_LDA(At, 0, 0); PG8_STAGE(PG8_SA(1, 1), a1 + hstep, voffA);
            PG8_WAIT_L(8); PG8_BAR; PG8_WAIT_L(0); PG8_MMA(0, 0, At, B0); PG8_BAR; PG8_SCHED;
            PG8_LDB(B1, 0, 1); PG8_STAGE(PG8_SB(0, 0), b2, voffB);
            PG8_BAR; PG8_WAIT_L(0); PG8_MMA(0, 1, At, B1); PG8_BAR;
            PG8_LDA(At, 0, 1); PG8_STAGE(PG8_SA(0, 0), a2, voffA);
            PG8_BAR; PG8_WAIT_L(0); PG8_MMA(1, 0, At, B0); PG8_BAR; PG8_SCHED;
            PG8_STAGE(PG8_SB(0, 1), b2 + hstep, voffB);
            PG8_WAIT_V(6); PG8_BAR; PG8_MMA(1, 1, At, B1); PG8_BAR;
            PG8_LDB(B0, 1, 0); PG8_SCHED; PG8_LDA(At, 1, 0); PG8_STAGE(PG8_SA(0, 1), a2 + hstep, voffA);
            PG8_WAIT_L(8); PG8_BAR; PG8_WAIT_L(0); PG8_MMA(0, 0, At, B0); PG8_BAR; PG8_SCHED;
            PG8_LDB(B1, 1, 1); PG8_STAGE(PG8_SB(1, 0), b3, voffB);
            PG8_BAR; PG8_WAIT_L(0); PG8_MMA(0, 1, At, B1); PG8_BAR;
            PG8_LDA(At, 1, 1); PG8_STAGE(PG8_SA(1, 0), a3, voffA);
            PG8_BAR; PG8_WAIT_L(0); PG8_MMA(1, 0, At, B0); PG8_BAR; PG8_SCHED;
            PG8_STAGE(PG8_SB(1, 1), b3 + hstep, voffB);
            PG8_WAIT_V(6); PG8_BAR; PG8_MMA(1, 1, At, B1); PG8_BAR;
            }
        }
        if constexpr (ALIGN_EPI) { if (wr == 0) PG8_BAR; }
        if constexpr (!Epi::AFTER_DRAIN) { E(acc, cur, wr, wc, fr, fq); S.done(cur); }
        if (!has_next) break;
{ float zf = 0.f; asm volatile("" : "+v"(zf));
#pragma unroll
        for (int a = 0; a < 2; ++a)
#pragma unroll
            for (int b = 0; b < 2; ++b)
#pragma unroll
                for (int m = 0; m < 4; ++m)
#pragma unroll
                    for (int n = 0; n < 2; ++n) acc[a][b][m][n] = (f32x4){zf, zf, zf, zf}; }
        cur = nxt; cA = nA; cB = nB; ++ui;
        if constexpr (ALIGN_EPI) { if (wr == 1) PG8_BAR; }
    }
    PG8_WAIT_V(0);
    if constexpr (!ALIGN_EPI) { if (wr == 0) PG8_BAR; }
    PG8_BAR;
    if constexpr (Epi::AFTER_DRAIN) { E.fused(acc, cur, wr, wc, fr, fq, lds, wid, lane); S.done(cur); }
#undef PG8_SA
#undef PG8_SB
#undef PG8_STAGE
#undef PG8_LDA
#undef PG8_LDB
#undef PG8_MMA
#undef PG8_WAIT_V
#undef PG8_WAIT_L
#undef PG8_BAR
#undef PG8_SCHED
}
}

#ifndef LAS
#define LAS __attribute__((address_space(3)))
#endif
#ifdef HOST_EMU
#define PAS
#else
#define PAS __attribute__((address_space(4)))
#endif
typedef unsigned short bf16;
typedef float f32x4 __attribute__((ext_vector_type(4)));
typedef unsigned v4u __attribute__((ext_vector_type(4)));
typedef unsigned v2u __attribute__((ext_vector_type(2)));

#ifndef SEQ_
#define SEQ_ 4096
#define CTXL_ 256
#endif
constexpr int D = 1024, NB = 8, SEQ = SEQ_, CTXL = CTXL_, DEPTH = 4;
constexpr int RC = NB * CTXL;
constexpr int RL = NB * SEQ;
constexpr int RT = RC + RL;
constexpr int NIN = 7360, DFF = 2816;
constexpr int NTHR = 512, NWAVES = 8;
constexpr int LDS_BYTES = 147456;

constexpr size_t MiB = (size_t)1 << 20;
constexpr size_t WS_CTL = 0;
constexpr size_t WS_MOD = 1 * MiB;
constexpr size_t WS_W   = 2 * MiB;
constexpr size_t WS_XC  = 37 * MiB;
constexpr size_t WS_U   = 45 * MiB;
constexpr size_t WS_Y   = 113 * MiB;
constexpr size_t WS_BIG = 181 * MiB;
constexpr size_t WS_END = 471 * MiB;
constexpr size_t SZ17 = (size_t)RT * 256 * 2;
constexpr size_t SZ34 = (size_t)RT * 256 * 4;
constexpr size_t WO_WP = 0;
constexpr size_t WO_WG = WO_WP + (size_t)3328 * 1024;
constexpr size_t WO_BR = WO_WG + (size_t)4096 * 1024;
constexpr size_t WO_WO = WO_BR + (size_t)4 * 1024 * 256;
constexpr size_t WO_W1 = WO_WO + (size_t)1024 * 1024;
constexpr size_t WO_W2 = WO_W1 + (size_t)5632 * 1024;
static_assert((WO_W2 + (size_t)1024 * 2816) * 2 <= 35 * MiB, "weights region");
constexpr size_t BG_P = 0;
constexpr size_t BG_S = 68 * MiB;

struct Prm { const float* in[41]; float* out; unsigned char* ws; int lo, hi; };

__device__ __forceinline__ float bf2f(bf16 b) { return __uint_as_float(((unsigned)b) << 16); }
__device__ __forceinline__ bf16 f2bf(float f) { unsigned u = __float_as_uint(f); return (bf16)((u + 0x7fffu + ((u >> 16) & 1u)) >> 16); }
__device__ __forceinline__ unsigned pk2(float lo, float hi) { return (unsigned)f2bf(lo) | ((unsigned)f2bf(hi) << 16); }
__device__ __forceinline__ float blo(unsigned u) { return __uint_as_float(u << 16); }
__device__ __forceinline__ float bhi(unsigned u) { return __uint_as_float(u & 0xffff0000u); }
__device__ __forceinline__ float sigmoidf_(float x) { return 1.f / (1.f + __expf(-x)); }
__device__ __forceinline__ float softplusf_(float x) { return x > 20.f ? x : log1pf(__expf(x)); }
template <int CTRL> __device__ __forceinline__ float dpp_mov(float v) { return __int_as_float(__builtin_amdgcn_update_dpp(0, __float_as_int(v), CTRL, 0xF, 0xF, true)); }
__device__ __forceinline__ float row16_sum(float v) {
    v += dpp_mov<0xB1>(v);
    v += dpp_mov<0x4E>(v);
    v += dpp_mov<0x141>(v);
    v += dpp_mov<0x140>(v);
    return v;
}
#ifdef HOST_EMU
__device__ __forceinline__ float wave_sum(float v) {
#pragma unroll
    for (int o = 1; o < 64; o <<= 1) v += __shfl_xor(v, o);
    return v;
}
#else
__device__ __forceinline__ float wave_sum(float v) {
    v = row16_sum(v);
    v += __int_as_float(__builtin_amdgcn_ds_swizzle(__float_as_int(v), 0x401F));
    return __int_as_float(__builtin_amdgcn_readlane(__float_as_int(v), 0)) + __int_as_float(__builtin_amdgcn_readlane(__float_as_int(v), 32));
}
#endif

#ifndef HOST_EMU
#define XB_TMO      128
#define XB_XCNT(j)  (256  + 64 * (j))
#define XB_XSUB(j)  (1280 + 64 * (j))
#define XB_XGEN(j)  (2304 + 64 * (j))
#define XB_TOP      3328
#define XB_TOPGEN   3392
#define XCD_BAR_WORDS 3456
#define XB_SPIN_CAP (1u << 18)
__device__ __forceinline__ unsigned xb_ld(unsigned* p)              { return __hip_atomic_load(p, __ATOMIC_RELAXED, __HIP_MEMORY_SCOPE_AGENT); }
__device__ __forceinline__ unsigned xb_add(unsigned* p, unsigned v) { return __hip_atomic_fetch_add(p, v, __ATOMIC_RELAXED, __HIP_MEMORY_SCOPE_AGENT); }
__device__ __forceinline__ unsigned xb_xcc_id() { return (unsigned)__builtin_amdgcn_s_getreg((3 << 11) | 20) & 0xFu; }
#define XB_SPIN(cond, bar) do { unsigned _sp = 0; while (cond) { __builtin_amdgcn_s_sleep(1); \
    if ((++_sp & 255u) == 0u) { if (xb_ld(&(bar)[XB_TMO])) break; if (_sp > XB_SPIN_CAP) { atomicAdd(&(bar)[XB_TMO], 1u); break; } } } } while (0)
struct XcdBarrier { unsigned* bar; unsigned x; volatile LAS unsigned* st; };
__device__ __forceinline__ XcdBarrier xcd_barrier_post(unsigned* bar, volatile LAS unsigned* st) {
    XcdBarrier b; b.bar = bar; b.x = xb_xcc_id(); b.st = st;
    if (threadIdx.x == 0) (void)xb_add(&bar[XB_XCNT(b.x)], 1u);
    return b;
}
__device__ __forceinline__ void xcd_barrier_complete(unsigned* bar, unsigned x, unsigned& nloc, unsigned& nx) {
    const unsigned G = gridDim.x * gridDim.y * gridDim.z;
    unsigned sum, cnt, mine, sp = 0u;
    for (;;) {
        sum = 0u; cnt = 0u; mine = 0u;
#pragma unroll
        for (unsigned j = 0; j < 16; ++j) { const unsigned c = xb_ld(&bar[XB_XCNT(j)]); sum += c; cnt += (c > 0u) ? 1u : 0u; mine = (j == x) ? c : mine; }
        if (sum == G) break;
        __builtin_amdgcn_s_sleep(1);
        if ((++sp & 255u) == 0u) { if (xb_ld(&bar[XB_TMO])) break; if (sp > XB_SPIN_CAP) { atomicAdd(&bar[XB_TMO], 1u); break; } }
    }
    nloc = mine > 0u ? mine : 1u; nx = cnt > 0u ? cnt : 1u;
}
__device__ __forceinline__ void xcd_barrier(const XcdBarrier& b) {
    asm volatile("s_waitcnt vmcnt(0)" ::: "memory");
    __syncthreads();
    if (tid_opq() == 0) {
        unsigned* bar = b.bar; asm volatile("" : "+v"(bar));
        __builtin_amdgcn_s_waitcnt(0);
        unsigned nloc = b.st[0], nx = b.st[1];
        if (nloc == 0u) { xcd_barrier_complete(bar, b.x, nloc, nx); b.st[0] = nloc; b.st[1] = nx; }
        const unsigned old = xb_add(&bar[XB_XSUB(b.x)], 1u);
        const unsigned gen = old / nloc;
        if (old + 1u == (gen + 1u) * nloc) {
            __builtin_amdgcn_fence(__ATOMIC_RELEASE, "agent");
            asm volatile("s_waitcnt vmcnt(0)" ::: "memory");
            const unsigned og = xb_add(&bar[XB_TOP], 1u);
            const unsigned tg = og / nx;
            if (og + 1u == (tg + 1u) * nx) xb_add(&bar[XB_TOPGEN], 1u);
            else XB_SPIN(xb_ld(&bar[XB_TOPGEN]) == tg, bar);
            __builtin_amdgcn_fence(__ATOMIC_ACQUIRE, "agent");
            xb_add(&bar[XB_XGEN(b.x)], 1u);
            asm volatile("s_waitcnt vmcnt(0)" ::: "memory");
        } else {
            XB_SPIN(xb_ld(&bar[XB_XGEN(b.x)]) == gen, bar);
            __builtin_amdgcn_fence(__ATOMIC_ACQUIRE, "agent");
            asm volatile("s_waitcnt vmcnt(0)" ::: "memory");
        }
    }
    __syncthreads();
}

#endif
#ifdef HOST_EMU
#define TID ((int)threadIdx.x)
#define BID ((int)blockIdx.x)
#define NBLK ((int)gridDim.x)
#else
#define TID tid_opq()
#define BID ((int)blockIdx.x)
#define NBLK ((int)gridDim.x)
#endif

__device__ __forceinline__ void ph_mod(const PAS Prm& p, LAS unsigned char* lds) {
    LAS float* sc = (LAS float*)lds;
    LAS float* red = sc + 9 * 1024;
    const float* c = p.in[1]; const float* cctx = p.in[3]; const float* w_mod = p.in[4]; const float* b_mod = p.in[5];
    float* mod = (float*)(p.ws + WS_MOD);
    const int tid = TID, lane = tid & 63, wave = tid >> 6;
    for (int i = tid; i < 9 * 1024; i += NTHR) { const int j = i >> 10, k = i & 1023; const float v = (j < 8) ? c[j * 1024 + k] : cctx[k]; sc[i] = v / (1.f + expf(-v)); }
    __syncthreads();
    for (int it = BID; it < 4 * 96; it += NBLK) {
        const int l = it / 96, cg = it % 96, col = cg * 64 + lane;
        float acc[9];
#pragma unroll
        for (int j = 0; j < 9; ++j) acc[j] = 0.f;
        const float* W = w_mod + (size_t)l * 1024 * 6144 + col;
        for (int k = wave * 128; k < wave * 128 + 128; ++k) { const float w = W[(size_t)k * 6144];
#pragma unroll
            for (int j = 0; j < 9; ++j) acc[j] += sc[j * 1024 + k] * w; }
#pragma unroll
        for (int j = 0; j < 9; ++j) red[(wave * 9 + j) * 64 + lane] = acc[j];
        __syncthreads();
        for (int i = tid; i < 9 * 64; i += NTHR) { const int j = i >> 6, ln = i & 63; float s = b_mod[l * 6144 + cg * 64 + ln];
#pragma unroll
            for (int w = 0; w < 8; ++w) s += red[(w * 9 + j) * 64 + ln];
            mod[((size_t)l * 9 + j) * 6144 + cg * 64 + ln] = s; }
        __syncthreads();
    }
}

#ifdef HOST_EMU
#define PH_ZOPQ(z) do { } while (0)
#else
#define PH_ZOPQ(z) asm volatile("" : "+v"(z))
#endif
#ifdef HOST_EMU
#define LGKM_WAIT() do { (void)emu_xchg(0, threadIdx.x & 63); } while (0)
#else
#define LGKM_WAIT() asm volatile("s_waitcnt lgkmcnt(0)" ::: "memory")
#endif
__device__ __forceinline__ void cvt_item(const float* W, size_t ldw, int k0, int n0, bf16* WT, int K, int drow0, LAS float* scr, int lane) {
#pragma unroll 8
    for (int i = 0; i < 32; ++i) { const int kk = 2 * i + (lane >> 5); scr[kk * 33 + (lane & 31)] = W[(size_t)(k0 + kk) * ldw + n0 + (lane & 31)]; }
    LGKM_WAIT();
    const int c = lane & 7;
#pragma unroll
    for (int j = 0; j < 4; ++j) { const int n = (lane >> 3) + 8 * j; const LAS float* s = scr + (8 * c) * 33 + n;
        v4u o; o.x = pk2(s[0 * 33], s[1 * 33]); o.y = pk2(s[2 * 33], s[3 * 33]); o.z = pk2(s[4 * 33], s[5 * 33]); o.w = pk2(s[6 * 33], s[7 * 33]);
        *(v4u*)(WT + (size_t)(drow0 + n) * K + k0 + 8 * c) = o; }
    LGKM_WAIT();
}
__device__ __forceinline__ void ph_cvt(const PAS Prm& p, int l, LAS unsigned char* lds) {
    const int tid = TID, lane = tid & 63, wave = tid >> 6;
    LAS float* scr = (LAS float*)(lds + wave * 16384);
    bf16* WB = (bf16*)(p.ws + WS_W);
    const float* w_in = p.in[8] + (size_t)l * 1024 * NIN;
    const float* brp = p.in[36] + (size_t)l * 4 * 256 * 1024;
    const float* wout = p.in[37] + (size_t)l * 1024 * 1024;
    const float* w1 = p.in[38] + (size_t)l * 1024 * 5632;
    const float* w2 = p.in[39] + (size_t)l * 2816 * 1024;
    constexpr int I_IN = 16 * 230, I_BR = 4 * 4 * 32, I_WO = 16 * 32, I_W1 = 16 * 176, I_W2 = 44 * 32, I_PAD = 16;
    constexpr int NITEMS = I_IN + I_BR + I_WO + I_W1 + I_W2 + I_PAD;
    const int gw = BID * NWAVES + wave, NGW = NBLK * NWAVES;
    for (int it = gw; it < NITEMS; it += NGW) {
        int r = it;
        if (r < I_IN) { const int kb = r / 230, nb = r % 230, n0 = nb * 32;
            if (n0 < 3264) { const int drow = n0 < 1728 ? n0 : n0 + 64; cvt_item(w_in, NIN, kb * 64, n0, WB + WO_WP, 1024, drow, scr, lane);
            } else { cvt_item(w_in, NIN, kb * 64, n0, WB + WO_WG, 1024, n0 - 3264, scr, lane); }
            continue; }
        r -= I_IN;
        if (r < I_BR) { const int n = r / 128, q = r % 128, kb = q / 32, nb = q % 32;
            cvt_item(brp + (size_t)n * 256 * 1024, 1024, kb * 64, nb * 32, WB + WO_BR + (size_t)n * 1024 * 256, 256, nb * 32, scr, lane); continue; }
        r -= I_BR;
        if (r < I_WO) { const int kb = r / 32, nb = r % 32; cvt_item(wout, 1024, kb * 64, nb * 32, WB + WO_WO, 1024, nb * 32, scr, lane); continue; }
        r -= I_WO;
        if (r < I_W1) { const int kb = r / 176, nb = r % 176, n0 = nb * 32; const int hh = n0 / 2816, jj = n0 % 2816, pn = jj / 128, j2 = jj % 128;
            cvt_item(w1, 5632, kb * 64, n0, WB + WO_W1, 1024, 256 * pn + 128 * hh + j2, scr, lane); continue; }
        r -= I_W1;
        if (r < I_W2) { const int kb = r / 32, nb = r % 32; cvt_item(w2, 1024, kb * 64, nb * 32, WB + WO_W2, 2816, nb * 32, scr, lane); continue; }
        r -= I_W2;
        {
            unsigned z0 = 0u; PH_ZOPQ(z0); v4u z = (v4u){z0, z0, z0, z0};
            for (int i = lane; i < 4 * 128; i += 64) { const int rr = 1728 + r * 4 + i / 128, cc = (i % 128) * 8; *(v4u*)(WB + WO_WP + (size_t)rr * 1024 + cc) = z; }
        }
    }
}

__device__ __forceinline__ void ph_norm(const PAS Prm& p, int l, int which, const float* xc_src, const float* xl_src, int r_begin) {
    const int tid = TID, lane = tid & 63, wave = tid >> 6;
    const float* mod = (const float*)(p.ws + WS_MOD) + (size_t)l * 9 * 6144;
    const float* g = (which ? p.in[7] : p.in[6]) + l * 1024;
    bf16* U = (bf16*)(p.ws + WS_U);
    const int gw = BID * NWAVES + wave, NGW = NBLK * NWAVES;
    for (int r = r_begin + gw; r < RT; r += NGW) {
        const float* xr = (r < RC) ? xc_src + (size_t)r * 1024 : xl_src + (size_t)(r - RC) * 1024;
        const int jb = (r < RC) ? 8 : (r - RC) / SEQ;
        const float* shift = mod + (size_t)jb * 6144 + (which ? 3 * 1024 : 0);
        const float* scale = shift + 1024;
        f32x4 v[4]; float s = 0.f;
#pragma unroll
        for (int j = 0; j < 4; ++j) { v[j] = *(const f32x4*)(xr + 4 * lane + 256 * j); s += (v[j].x * v[j].x + v[j].y * v[j].y) + (v[j].z * v[j].z + v[j].w * v[j].w); }
        const float rstd = rsqrtf(wave_sum(s) * (1.f / 1024.f) + 1e-6f);
#pragma unroll
        for (int j = 0; j < 4; ++j) { const int c0 = 4 * lane + 256 * j;
            const f32x4 gg = *(const f32x4*)(g + c0), sc = *(const f32x4*)(scale + c0), sh = *(const f32x4*)(shift + c0);
            const f32x4 o = v[j] * rstd * gg * (1.f + sc) + sh;
            v2u w; w.x = pk2(o.x, o.y); w.y = pk2(o.z, o.w);
            *(v2u*)(U + (size_t)r * 1024 + c0) = w; }
    }
}
__device__ __forceinline__ void ph_final(const PAS Prm& p) {
    const int tid = TID, lane = tid & 63, wave = tid >> 6;
    const float* g = p.in[40];
    const float poison = (*(const volatile unsigned*)(p.ws + WS_CTL + 768 * 1024) != 0u) ? __builtin_nanf("") : 0.f;
    const int gw = BID * NWAVES + wave, NGW = NBLK * NWAVES;
    for (int r = gw; r < RL; r += NGW) {
        float* xr = p.out + (size_t)r * 1024;
        f32x4 v[4]; float s = 0.f;
#pragma unroll
        for (int j = 0; j < 4; ++j) { v[j] = *(const f32x4*)(xr + 4 * lane + 256 * j); s += (v[j].x * v[j].x + v[j].y * v[j].y) + (v[j].z * v[j].z + v[j].w * v[j].w); }
        const float rstd = rsqrtf(wave_sum(s) * (1.f / 1024.f) + 1e-6f);
#pragma unroll
        for (int j = 0; j < 4; ++j) { const int c0 = 4 * lane + 256 * j; const f32x4 gg = *(const f32x4*)(g + c0); *(f32x4*)(xr + c0) = v[j] * rstd * gg + poison; }
    }
}

struct RowInfo { int lat, b, t, T, base; };
__device__ __forceinline__ RowInfo row_info(int r) {
    RowInfo q;
    if (r < RC) { q.lat = 0; q.b = r / CTXL; q.t = r % CTXL; q.T = CTXL; q.base = q.b * CTXL; }
    else { const int x = r - RC; q.lat = 1; q.b = x / SEQ; q.t = x % SEQ; q.T = SEQ; q.base = RC + q.b * SEQ; }
    return q;
}
__device__ __forceinline__ int scan_row(int b, int d, int tau) {
    if (tau < CTXL) return b * CTXL + (d ? (CTXL - 1 - tau) : tau);
    const int t = tau - CTXL; return RC + b * SEQ + (d ? (SEQ - 1 - t) : t);
}

constexpr size_t RW_R = 0, RW_K = SZ17, RW_V = 2 * SZ17, RW_KK = 3 * SZ17, RW_OM = 4 * SZ17  , RW_A = 6 * SZ17  , RW_G = 8 * SZ17, RW_Y = 9 * SZ17  , RW_BON = 9 * SZ17 + 2 * SZ34;
static_assert(RW_BON + (size_t)RT * 16 <= 222 * MiB, "rwkv scratch");

__device__ __forceinline__ void ph_rw_prep(const PAS Prm& p, int l, LAS unsigned char* lds) {
    LAS float* xx = (LAS float*)lds;
    const int tid = TID, lane = tid & 63;
    const bf16* P = (const bf16*)(p.ws + WS_BIG + BG_P);
    unsigned char* S = p.ws + WS_BIG + BG_S;
    bf16* oR = (bf16*)(S + RW_R); bf16* oK = (bf16*)(S + RW_K); bf16* oV = (bf16*)(S + RW_V); bf16* oKK = (bf16*)(S + RW_KK);
    bf16* oOM = (bf16*)(S + RW_OM); bf16* oA = (bf16*)(S + RW_A); bf16* oG = (bf16*)(S + RW_G); float* oBon = (float*)(S + RW_BON);
    const float* mu = p.in[18] + l * 960;
    const float* w0 = p.in[19] + l * 512; const float* w2 = p.in[20] + (size_t)l * 2 * 64 * 256;
    const float* a0 = p.in[21] + l * 512; const float* a2 = p.in[22] + (size_t)l * 2 * 64 * 256;
    const float* g2 = p.in[23] + (size_t)l * 64 * 256;
    const float* k_k = p.in[24] + l * 256; const float* r_k = p.in[26] + l * 256;
    const int j = tid & 255, half = tid >> 8, h = j >> 6;
    for (int tile = BID; tile < RT / 16; tile += NBLK) {
        const int r0 = tile * 16;
        for (int i = tid; i < 16 * 960; i += NTHR) {
            const int rr = i / 960, c = i % 960, r = r0 + rr, q = c & 3;
            const RowInfo ri = row_info(r);
            int nb = -1;
            if (ri.lat) {
                const int gc = ri.t & 63, gr = ri.t >> 6;
                if (q == 0) { if (gc >= 1) nb = r - 1; } else if (q == 1) { if (gc <= 62) nb = r + 1; }
                else if (q == 2) { if (gr >= 1) nb = r - 64; } else { if (gr <= SEQ / 64 - 2) nb = r + 64; }
            } else {
                if ((q & 1) == 0) { if (ri.t >= 1) nb = r - 1; } else { if (ri.t <= CTXL - 2) nb = r + 1; }
            }
            const float pv = bf2f(P[(size_t)r * 1024 + c]);
            const float sv = nb >= 0 ? bf2f(P[(size_t)nb * 1024 + c]) : 0.f;
            float x = pv + (sv - pv) * mu[c];
            if (c >= 768 && c < 832) x = tanhf(x); else if (c >= 896) x = sigmoidf_(x);
            xx[rr * 960 + c] = x;
        }
        __syncthreads();
        float aw0[8], aw1[8], aa0[8], aa1[8], ag[8];
#pragma unroll
        for (int q = 0; q < 8; ++q) { aw0[q] = 0.f; aw1[q] = 0.f; aa0[q] = 0.f; aa1[q] = 0.f; ag[q] = 0.f; }
        for (int i = 0; i < 64; ++i) {
            const float w20 = w2[i * 256 + j], w21 = w2[64 * 256 + i * 256 + j], a20 = a2[i * 256 + j], a21 = a2[64 * 256 + i * 256 + j], g2v = g2[i * 256 + j];
#pragma unroll
            for (int q = 0; q < 8; ++q) { const LAS float* xr = xx + (half * 8 + q) * 960;
                const float cw = xr[768 + i], ca = xr[832 + i], cg = xr[896 + i];
                aw0[q] += cw * w20; aw1[q] += cw * w21; aa0[q] += ca * a20; aa1[q] += ca * a21; ag[q] += cg * g2v; }
        }
        const float kkj = k_k[j], rkj = r_k[j], w00 = w0[j], w01 = w0[256 + j], a00 = a0[j], a01 = a0[256 + j];
#pragma unroll
        for (int q = 0; q < 8; ++q) {
            const int rr = half * 8 + q; const size_t r = (size_t)(r0 + rr);
            const float rv = xx[rr * 960 + j], kv = xx[rr * 960 + 256 + j], vv = xx[rr * 960 + 512 + j];
            const float kkr = kv * kkj;
            const float ss = wave_sum(kkr * kkr);
            const float kkn = kkr * rsqrtf(ss + 1e-12f);
            const float bon = wave_sum(rv * kv * rkj);
            oR[r * 256 + j] = f2bf(rv); oK[r * 256 + j] = f2bf(kv); oV[r * 256 + j] = f2bf(vv); oKK[r * 256 + j] = f2bf(kkn);
            oG[r * 256 + j] = f2bf(ag[q]);
            if (lane == 0) oBon[r * 4 + h] = bon;
#pragma unroll
            for (int d = 0; d < 2; ++d) {
                const float wv = (d ? w01 : w00) + (d ? aw1[q] : aw0[q]);
                const float logw = -softplusf_(-wv) - 0.5f;
                const float om = -expm1f(-expf(logw));
                const float av = sigmoidf_((d ? a01 : a00) + (d ? aa1[q] : aa0[q]));
                oOM[(size_t)d * RT * 256 + r * 256 + j] = f2bf(om);
                oA[(size_t)d * RT * 256 + r * 256 + j] = f2bf(av);
            }
        }
        __syncthreads();
    }
}

template <int MODE>
__device__ __forceinline__ void scan_phase(const unsigned char* Sb  , const bf16* Pv  , float* Yout  ,
                                           const float* ka  , const float* gam  , LAS unsigned char* lds) {
    constexpr int NA = MODE == 0 ? 6 : 3, CH = 32, STEPB = NA * 128, BUFB = CH * STEPB, NPIECE = CH * NA * 8, NLD = (NPIECE + NTHR - 1) / NTHR;
    const int tid = TID, lane = tid & 63, wave = tid >> 6;
    if (BID >= 128) return;
    const int prob = BID >> 1, b = prob >> 3, h = (prob >> 1) & 3, d = prob & 1;
    const int rowv = 32 * (BID & 1) + 4 * wave + (lane >> 4);
    const int kl = lane & 15;
    float kav[4] = {0.f, 0.f, 0.f, 0.f};
    float gamma = 0.f;
    if (MODE == 0) {
#pragma unroll
        for (int i = 0; i < 4; ++i) kav[i] = ka[h * 64 + 4 * kl + i];
    } else gamma = sigmoidf_(gam[d * 4 + h]);
    float S[4] = {0.f, 0.f, 0.f, 0.f};
    v4u pre[NLD];
    const unsigned char* gsrc[NLD]; int gld[NLD]; int gs[NLD]; int ldso[NLD];
#pragma unroll
    for (int i = 0; i < NLD; ++i) { const int e = tid + NTHR * i; const int s = e / (NA * 8), rem = e % (NA * 8), a = rem >> 3, piece = rem & 7;
        gs[i] = s; ldso[i] = s * STEPB + a * 128 + piece * 16;
        if (MODE == 0) { const int slot = a == 0 ? 0 : a == 1 ? 1 : a == 2 ? 3 : a == 3 ? 4 + d : a == 4 ? 6 + d : 2;
            gsrc[i] = Sb + (size_t)slot * SZ17 + (size_t)(h * 64 + piece * 8) * 2; gld[i] = 512; }
        else { if (a < 2) { gsrc[i] = Sb + (size_t)a * SZ17 + (size_t)(h * 64 + piece * 8) * 2; gld[i] = 512; }
               else { gsrc[i] = (const unsigned char*)Pv + (size_t)(512 + h * 64 + piece * 8) * 2; gld[i] = 2048; } }
    }
#define SCAN_ISSUE(c) do { _Pragma("unroll") for (int i = 0; i < NLD; ++i) { if (tid + NTHR * i < NPIECE) { const int row = scan_row(b, d, (c) * CH + gs[i]); \
        pre[i] = *(const v4u*)(gsrc[i] + (size_t)row * gld[i]); } } } while (0)
#define SCAN_COMMIT(buf) do { _Pragma("unroll") for (int i = 0; i < NLD; ++i) { if (tid + NTHR * i < NPIECE) *(LAS v4u*)(lds + (buf) * BUFB + ldso[i]) = pre[i]; } } while (0)
    constexpr int NCH = (CTXL + SEQ) / CH;
    SCAN_ISSUE(0); SCAN_COMMIT(0); __syncthreads();
    for (int c = 0; c < NCH; ++c) {
        if (c + 1 < NCH) SCAN_ISSUE(c + 1);
        const LAS unsigned char* bufp = lds + (c & 1) * BUFB;
#pragma unroll 4
        for (int s = 0; s < CH; ++s) {
            const LAS unsigned char* sp = bufp + s * STEPB;
            float y;
            if (MODE == 0) {
                const v2u r2 = *(const LAS v2u*)(sp + 0 * 128 + kl * 8), k2 = *(const LAS v2u*)(sp + 1 * 128 + kl * 8), kk2 = *(const LAS v2u*)(sp + 2 * 128 + kl * 8),
                          om2 = *(const LAS v2u*)(sp + 3 * 128 + kl * 8), a2 = *(const LAS v2u*)(sp + 4 * 128 + kl * 8);
                const float vv = bf2f(*(const LAS bf16*)(sp + 5 * 128 + rowv * 2));
                const float rr[4] = {blo(r2.x), bhi(r2.x), blo(r2.y), bhi(r2.y)};
                const float kr[4] = {blo(k2.x), bhi(k2.x), blo(k2.y), bhi(k2.y)};
                const float kk[4] = {blo(kk2.x), bhi(kk2.x), blo(kk2.y), bhi(kk2.y)};
                const float om[4] = {blo(om2.x), bhi(om2.x), blo(om2.y), bhi(om2.y)};
                const float as[4] = {blo(a2.x), bhi(a2.x), blo(a2.y), bhi(a2.y)};
                float sap = 0.f;
#pragma unroll
                for (int i = 0; i < 4; ++i) sap -= S[i] * kk[i];
                const float sa = row16_sum(sap);
                float yp = 0.f;
#pragma unroll
                for (int i = 0; i < 4; ++i) {
                    const float kt = kr[i] * (1.f + (as[i] - 1.f) * kav[i]);
                    const float bb = kk[i] * as[i];
                    S[i] = S[i] * (1.f - om[i]) + (sa * bb + vv * kt);
                    yp += S[i] * rr[i];
                }
                y = row16_sum(yp);
            } else {
                const v2u q2 = *(const LAS v2u*)(sp + 0 * 128 + kl * 8), k2 = *(const LAS v2u*)(sp + 1 * 128 + kl * 8);
                const float vv = bf2f(*(const LAS bf16*)(sp + 2 * 128 + rowv * 2));
                const float qq[4] = {blo(q2.x), bhi(q2.x), blo(q2.y), bhi(q2.y)};
                const float kr[4] = {blo(k2.x), bhi(k2.x), blo(k2.y), bhi(k2.y)};
                float yp = 0.f;
#pragma unroll
                for (int i = 0; i < 4; ++i) { S[i] = S[i] * gamma + vv * kr[i]; yp += S[i] * qq[i]; }
                y = row16_sum(yp);
            }
            if (kl == 0) { const int row = scan_row(b, d, c * CH + s); Yout[((size_t)d * RT + row) * 256 + h * 64 + rowv] = y; }
        }
        if (c + 1 < NCH) SCAN_COMMIT((c + 1) & 1);
        __syncthreads();
    }
#undef SCAN_ISSUE
#undef SCAN_COMMIT
}

__device__ __forceinline__ void ph_rw_post(const PAS Prm& p, int l) {
    const int tid = TID, j = tid & 255, h = j >> 6;
    unsigned char* S = p.ws + WS_BIG + BG_S;
    const float* Y = (const float*)(S + RW_Y); const bf16* V = (const bf16*)(S + RW_V); const bf16* G = (const bf16*)(S + RW_G); const float* Bon = (const float*)(S + RW_BON);
    bf16* yrw = (bf16*)(p.ws + WS_Y + 1 * SZ17);
    const float lng = p.in[27][l * 256 + j];
    for (int r = BID * 2 + (tid >> 8); r < RT; r += NBLK * 2) {
        const size_t o = (size_t)r * 256 + j;
        const float y = Y[o] + Y[(size_t)RT * 256 + o];
        const float mean = wave_sum(y) * (1.f / 64.f); const float dv = y - mean;
        const float var = wave_sum(dv * dv) * (1.f / 64.f);
        float v = dv * rsqrtf(var + 64e-5f) * lng;
        v += Bon[(size_t)r * 4 + h] * bf2f(V[o]);
        v *= bf2f(G[o]);
        yrw[o] = f2bf(v);
    }
}

constexpr size_t RT_Q = 0, RT_K = SZ17, RT_Y = 2 * SZ17  ;
__device__ __forceinline__ void ph_ret_prep(const PAS Prm& p) {
    const int tid = TID, j = tid & 255;
    const bf16* P = (const bf16*)(p.ws + WS_BIG + BG_P);
    unsigned char* S = p.ws + WS_BIG + BG_S;
    bf16* oQ = (bf16*)(S + RT_Q); bf16* oK = (bf16*)(S + RT_K);
    const int hh = j & 63, i32 = hh & 31, idx = i32 & 15; const bool second = i32 >= 16, colhalf = hh >= 32;
    const float inv = exp2f(-(float)idx * (13.287712379549449f / 16.f));
    for (int r = BID * 2 + (tid >> 8); r < RT; r += NBLK * 2) {
        const size_t o = (size_t)r * 1024;
        float q = bf2f(P[o + j]), k = bf2f(P[o + 256 + j]);
        if (r >= RC) {
            const int t = (r - RC) & (SEQ - 1);
            const float coord = (float)(colhalf ? (t & 63) : (t >> 6));
            float sn, cs; sincosf(coord * inv, &sn, &cs);
            const int pj = second ? j - 16 : j + 16;
            const float qp = bf2f(P[o + pj]), kp = bf2f(P[o + 256 + pj]);
            q = second ? (qp * sn + q * cs) : (q * cs - qp * sn);
            k = second ? (kp * sn + k * cs) : (k * cs - kp * sn);
        }
        oQ[(size_t)r * 256 + j] = f2bf(q); oK[(size_t)r * 256 + j] = f2bf(k * 0.125f);
    }
}
__device__ __forceinline__ void ph_ret_post(const PAS Prm& p) {
    const int tid = TID, j = tid & 255;
    const bf16* P = (const bf16*)(p.ws + WS_BIG + BG_P);
    const float* Y = (const float*)(p.ws + WS_BIG + BG_S + RT_Y);
    bf16* yret = (bf16*)(p.ws + WS_Y + 3 * SZ17);
    for (int r = BID * 2 + (tid >> 8); r < RT; r += NBLK * 2) {
        const size_t o = (size_t)r * 256 + j;
        const float y = Y[o] + Y[(size_t)RT * 256 + o];
        const float mean = wave_sum(y) * (1.f / 64.f); const float dv = y - mean;
        const float var = wave_sum(dv * dv) * (1.f / 64.f);
        const float g = bf2f(P[(size_t)r * 1024 + 768 + j]);
        yret[o] = f2bf(dv * rsqrtf(var + 1e-5f) * (g * sigmoidf_(g)));
    }
}

constexpr size_t LR_A = 0  , LR_B = 2 * SZ34  ;
__device__ __forceinline__ void ph_lru_prep(const PAS Prm& p, int l, LAS unsigned char* lds) {
    LAS float* xc = (LAS float*)lds;
    const int tid = TID;
    const bf16* P = (const bf16*)(p.ws + WS_BIG + BG_P);
    float* A = (float*)(p.ws + WS_BIG + BG_S + LR_A); float* B = (float*)(p.ws + WS_BIG + BG_S + LR_B);
    const float* cw = p.in[28] + l * 4 * 256; const float* cb = p.in[29] + l * 256;
    const float* wa = p.in[30] + (size_t)l * 2 * 4 * 64 * 64; const float* ba = p.in[31] + l * 512;
    const float* wx = p.in[32] + (size_t)l * 2 * 4 * 64 * 64; const float* bx = p.in[33] + l * 512;
    const float* lam = p.in[34] + l * 512;
    const int j = tid & 255, half = tid >> 8, g = j >> 6, o = j & 63;
    const float sp0 = softplusf_(-lam[j]), sp1 = softplusf_(-lam[256 + j]);
    for (int tile = BID; tile < RT / 16; tile += NBLK) {
        const int r0 = tile * 16;
        for (int i = tid; i < 16 * 256; i += NTHR) {
            const int rr = i >> 8, jj = i & 255, r = r0 + rr; const RowInfo ri = row_info(r);
            float acc = cb[jj];
#pragma unroll
            for (int q = 0; q < 4; ++q) { const int tt = ri.t + q - 2; if (tt >= 0 && tt < ri.T) acc += cw[q * 256 + jj] * bf2f(P[(size_t)(ri.base + tt) * 512 + jj]); }
            xc[i] = acc;
        }
        __syncthreads();
        float ra0[8], ra1[8], rx0[8], rx1[8];
#pragma unroll
        for (int q = 0; q < 8; ++q) { ra0[q] = 0.f; ra1[q] = 0.f; rx0[q] = 0.f; rx1[q] = 0.f; }
        for (int i = 0; i < 64; ++i) {
            const float wa0 = wa[((0 * 4 + g) * 64 + i) * 64 + o], wa1 = wa[((1 * 4 + g) * 64 + i) * 64 + o], wx0 = wx[((0 * 4 + g) * 64 + i) * 64 + o], wx1 = wx[((1 * 4 + g) * 64 + i) * 64 + o];
#pragma unroll
            for (int q = 0; q < 8; ++q) { const float x = xc[(half * 8 + q) * 256 + g * 64 + i]; ra0[q] += x * wa0; ra1[q] += x * wa1; rx0[q] += x * wx0; rx1[q] += x * wx1; }
        }
#pragma unroll
        for (int q = 0; q < 8; ++q) {
            const int rr = half * 8 + q; const size_t r = (size_t)(r0 + rr); const float xcv = xc[rr * 256 + j];
#pragma unroll
            for (int d = 0; d < 2; ++d) {
                const float rg = sigmoidf_((d ? ra1[q] : ra0[q]) + ba[d * 256 + j]);
                const float ig = sigmoidf_((d ? rx1[q] : rx0[q]) + bx[d * 256 + j]);
                const float log_a = -8.f * rg * (d ? sp1 : sp0);
                const float a = expf(log_a);
                const float bv = sqrtf(-expm1f(2.f * log_a)) * (ig * xcv);
                A[((size_t)d * RT + r) * 256 + j] = a; B[((size_t)d * RT + r) * 256 + j] = bv;
            }
        }
        __syncthreads();
    }
}
constexpr int LCH = 64, NVC = CTXL / LCH, NVL = SEQ / LCH, NV = NVC + NVL;
constexpr size_t LR_PA = 4 * SZ34  , LR_QB = LR_PA + (size_t)2 * 8 * NV * 256 * 4;
__device__ __forceinline__ int lru_chunk_row0(int b, int v) { return v < NVC ? b * CTXL + v * LCH : RC + b * SEQ + (v - NVC) * LCH; }
__device__ __forceinline__ void ph_lru_agg(const PAS Prm& p) {
    const int tid = TID, j = tid & 255, half = tid >> 8;
    const float* A = (const float*)(p.ws + WS_BIG + BG_S + LR_A); const float* B = (const float*)(p.ws + WS_BIG + BG_S + LR_B);
    float* PA = (float*)(p.ws + WS_BIG + BG_S + LR_PA); float* QB = (float*)(p.ws + WS_BIG + BG_S + LR_QB);
    for (int task = BID * 2 + half; task < 2 * 8 * NV; task += NBLK * 2) {
        const int d = task / (8 * NV), b = (task / NV) % 8, v = task % NV;
        const int row0 = lru_chunk_row0(b, v);
        const float* Ad = A + (size_t)d * RT * 256 + j; const float* Bd = B + (size_t)d * RT * 256 + j;
        float P = 1.f, Q = 0.f;
        for (int i0 = 0; i0 < LCH; i0 += 8) {
            float a[8], bb[8];
#pragma unroll
            for (int q = 0; q < 8; ++q) { const int i = i0 + q; const size_t ro = (size_t)(row0 + (d ? LCH - 1 - i : i)) * 256; a[q] = Ad[ro]; bb[q] = Bd[ro]; }
#pragma unroll
            for (int q = 0; q < 8; ++q) { Q = a[q] * Q + bb[q]; P = a[q] * P; }
        }
        PA[(size_t)task * 256 + j] = P; QB[(size_t)task * 256 + j] = Q;
    }
}
__device__ __forceinline__ void ph_lru_fin(const PAS Prm& p, LAS unsigned char* lds) {
    LAS float* hf = (LAS float*)lds;
    const int tid = TID, j = tid & 255, half = tid >> 8;
    const bf16* P = (const bf16*)(p.ws + WS_BIG + BG_P);
    const float* A = (const float*)(p.ws + WS_BIG + BG_S + LR_A); const float* B = (const float*)(p.ws + WS_BIG + BG_S + LR_B);
    const float* PA = (const float*)(p.ws + WS_BIG + BG_S + LR_PA); const float* QB = (const float*)(p.ws + WS_BIG + BG_S + LR_QB);
    bf16* ylru = (bf16*)(p.ws + WS_Y + 2 * SZ17);
    for (int task = BID * 2 + half; task < 8 * NV; task += NBLK * 2) {
        const int b = task / NV, v = task % NV;
        const int row0 = lru_chunk_row0(b, v);
        float h = 0.f;
        { const float* pa = PA + ((size_t)(0 * 8 + b) * NV) * 256 + j; const float* qb = QB + ((size_t)(0 * 8 + b) * NV) * 256 + j;
          for (int u = 0; u < v; ++u) h = pa[(size_t)u * 256] * h + qb[(size_t)u * 256]; }
        float g = 0.f;
        { const float* pa = PA + ((size_t)(1 * 8 + b) * NV) * 256 + j; const float* qb = QB + ((size_t)(1 * 8 + b) * NV) * 256 + j;
          if (v < NVC) { for (int u = NVC - 1; u > v; --u) g = pa[(size_t)u * 256] * g + qb[(size_t)u * 256]; }
          else { for (int u = NVC - 1; u >= 0; --u) g = pa[(size_t)u * 256] * g + qb[(size_t)u * 256];
                 for (int u = NV - 1; u > v; --u) g = pa[(size_t)u * 256] * g + qb[(size_t)u * 256]; } }
        const float* A0 = A + j; const float* B0 = B + j; const float* A1 = A + (size_t)RT * 256 + j; const float* B1 = B + (size_t)RT * 256 + j;
        for (int i0 = 0; i0 < LCH; i0 += 8) {
            float a[8], bb[8];
#pragma unroll
            for (int q = 0; q < 8; ++q) { const size_t ro = (size_t)(row0 + i0 + q) * 256; a[q] = A0[ro]; bb[q] = B0[ro]; }
#pragma unroll
            for (int q = 0; q < 8; ++q) { h = a[q] * h + bb[q]; hf[(i0 + q) * 512 + tid] = h; }
        }
        for (int i0 = LCH - 8; i0 >= 0; i0 -= 8) {
            float a[8], bb[8], gx[8];
#pragma unroll
            for (int q = 0; q < 8; ++q) { const size_t r = (size_t)(row0 + i0 + 7 - q); a[q] = A1[r * 256]; bb[q] = B1[r * 256]; gx[q] = bf2f(P[r * 512 + 256 + j]); }
#pragma unroll
            for (int q = 0; q < 8; ++q) { g = a[q] * g + bb[q]; const int i = i0 + 7 - q; const float x = gx[q];
                const float ge = 0.5f * x * (1.f + tanhf(0.7978845608028654f * (x + 0.044715f * x * x * x)));
                ylru[(size_t)(row0 + i) * 256 + j] = f2bf((hf[i * 512 + tid] + g) * ge); }
        }
    }
}

constexpr size_t HY_VL = 0, HY_VC = 96 * MiB, HY_FL = 102 * MiB, HY_FC = 118 * MiB;
__device__ __forceinline__ void ph_hy_filter(const PAS Prm& p, int l, bool with_ctx, LAS unsigned char* lds) {
    LAS float* feat = (LAS float*)lds;
    LAS float* h1 = feat + 16 * 17;
    LAS float* h2 = h1 + 16 * 64;
    const int tid = TID;
    const float* w1 = p.in[11] + l * 17 * 64; const float* b1 = p.in[12] + l * 64; const float* w2 = p.in[13] + l * 64 * 64; const float* b2 = p.in[14] + l * 64;
    const float* w3 = p.in[15] + (size_t)l * 64 * 1024; const float* freq = p.in[16] + l * 128;
    float* FL = (float*)(p.ws + WS_BIG + BG_S + HY_FL); float* FC = (float*)(p.ws + WS_BIG + BG_S + HY_FC);
    const int ntile = with_ctx ? (SEQ + CTXL) / 16 : SEQ / 16;
    for (int tile = BID; tile < ntile; tile += NBLK) {
        const bool isctx = tile >= SEQ / 16; const int L = isctx ? CTXL : SEQ; const int pos0 = (isctx ? tile - SEQ / 16 : tile) * 16;
        float* F = isctx ? FC : FL;
        if (tid < 16 * 17) { const int pp = tid / 17, f = tid % 17; const float t = (float)(pos0 + pp) / (float)L;
            float v; if (f == 0) v = t; else if (f <= 8) v = sinf(6.283185307179586f * t * (float)f); else v = cosf(6.283185307179586f * t * (float)(f - 8));
            feat[tid] = v; }
        __syncthreads();
        for (int i = tid; i < 1024; i += NTHR) { const int pp = i >> 6, o = i & 63; float s = b1[o];
            for (int f = 0; f < 17; ++f) s += feat[pp * 17 + f] * w1[f * 64 + o];
            h1[i] = sinf(freq[o] * s); }
        __syncthreads();
        for (int i = tid; i < 1024; i += NTHR) { const int pp = i >> 6, o = i & 63; float s = b2[o];
            for (int q = 0; q < 64; ++q) s += h1[pp * 64 + q] * w2[q * 64 + o];
            h2[i] = sinf(freq[64 + o] * s); }
        __syncthreads();
        for (int cc = tid; cc < 1024; cc += NTHR) {
            float acc[16];
#pragma unroll
            for (int pp = 0; pp < 16; ++pp) acc[pp] = 0.f;
            for (int q = 0; q < 64; ++q) { const float w = w3[q * 1024 + cc];
#pragma unroll
                for (int pp = 0; pp < 16; ++pp) acc[pp] += h2[pp * 64 + q] * w; }
            const int o = cc >> 9, dd = (cc >> 8) & 1, c = cc & 255;
            const float rate = 3.0701134573253945f + (15.350567286626973f - 3.0701134573253945f) * (float)c * (1.f / 255.f);
            float* Fo = F + (size_t)(o * 256 + c) * (2 * L);
#pragma unroll
            for (int pp = 0; pp < 16; ++pp) { const int pos = pos0 + pp; const float t = (float)pos / (float)L;
                const float val = acc[pp] * expf(-t * rate);
                if (dd == 0) Fo[L + pos] = val; else if (pos >= 1) Fo[L - pos] = val; }
            if (pos0 == 0 && dd == 0) Fo[0] = 0.f;
        }
        __syncthreads();
    }
}
__device__ __forceinline__ void ph_hy_fnorm(const PAS Prm& p, bool with_ctx) {
    const int tid = TID, lane = tid & 63, wave = tid >> 6;
    float* FL = (float*)(p.ws + WS_BIG + BG_S + HY_FL); float* FC = (float*)(p.ws + WS_BIG + BG_S + HY_FC);
    const int gw = BID * NWAVES + wave, NGW = NBLK * NWAVES;
    for (int it = gw; it < (with_ctx ? 1024 : 512); it += NGW) {
        const bool isctx = it >= 512; const int L = isctx ? CTXL : SEQ; float* F = (isctx ? FC : FL) + (size_t)(it & 511) * (2 * L);
        float s = 0.f;
        for (int i = lane; i < 2 * L; i += 64) { const float v = F[i]; s += v * v; }
        const float sc = rsqrtf(wave_sum(s) + 1e-6f);
        for (int i = lane; i < 2 * L; i += 64) F[i] *= sc;
    }
}
__device__ __forceinline__ void ph_hy_prep(const PAS Prm& p, int l, bool with_ctx, LAS unsigned char* lds) {
    LAS float* tl = (LAS float*)lds;
    const int tid = TID;
    const bf16* P = (const bf16*)(p.ws + WS_BIG + BG_P);
    float* VL = (float*)(p.ws + WS_BIG + BG_S + HY_VL); float* VC = (float*)(p.ws + WS_BIG + BG_S + HY_VC);
    const float* cw = p.in[9] + l * 3 * 768; const float* cb = p.in[10] + l * 768;
    const int NTL = 8 * (SEQ / 64) * 12, NTC = with_ctx ? 8 * (CTXL / 64) * 12 : 0;
    for (int tile = BID; tile < NTL + NTC; tile += NBLK) {
        const bool isctx = tile >= NTL; const int tt = isctx ? tile - NTL : tile;
        const int T = isctx ? CTXL : SEQ, ntt = T / 64;
        const int ct = tt % 12, tb = (tt / 12) % ntt, b = tt / (12 * ntt);
        const int base = isctx ? b * CTXL : RC + b * SEQ, t0 = tb * 64, c0 = ct * 64;
        for (int i = tid; i < 66 * 64; i += NTHR) { const int rr = i >> 6, cc = i & 63, t = t0 - 1 + rr;
            tl[rr * 65 + cc] = (t >= 0 && t < T) ? bf2f(P[(size_t)(base + t) * 768 + c0 + cc]) : 0.f; }
        __syncthreads();
        const int part = c0 >> 8, cl0 = c0 & 255;
        float* dst = (isctx ? VC : VL) + ((size_t)(part * 8 + b) * 256 + cl0) * T + t0;
        for (int i = tid; i < 64 * 64; i += NTHR) { const int cc = i >> 6, ti = i & 63, col = c0 + cc;
            const float v = cb[col] + cw[col] * tl[ti * 65 + cc] + cw[768 + col] * tl[(ti + 1) * 65 + cc] + cw[1536 + col] * tl[(ti + 2) * 65 + cc];
            dst[(size_t)cc * T + ti] = v; }
        __syncthreads();
    }
}
template <int L>
__device__ __forceinline__ void hy_conv_item(const PAS Prm& p, int l, int c, int b0, LAS unsigned char* lds) {
    constexpr int NI = (L + NTHR - 1) / NTHR;
    LAS float* hh = (LAS float*)lds;
    LAS float* z = hh + 2 * L;
    const int tid = TID;
    const bool isctx = (L == CTXL);
    const float* F = (const float*)(p.ws + WS_BIG + BG_S + (isctx ? HY_FC : HY_FL));
    const float* HV = (const float*)(p.ws + WS_BIG + BG_S + (isctx ? HY_VC : HY_VL));
    const float* bias = p.in[17] + l * 512;
    for (int bb = 0; bb < 4; ++bb) for (int t = tid; t < L; t += NTHR) z[t * 4 + bb] = HV[((size_t)(0 * 8 + b0 + bb) * 256 + c) * L + t];
    for (int o = 0; o < 2; ++o) {
        for (int i = tid; i < 2 * L; i += NTHR) hh[i] = F[(size_t)(o * 256 + c) * (2 * L) + i];
        __syncthreads();
        float acc[NI][4];
#pragma unroll
        for (int i = 0; i < NI; ++i) { acc[i][0] = 0.f; acc[i][1] = 0.f; acc[i][2] = 0.f; acc[i][3] = 0.f; }
        if (tid < L) {
            for (int s = 0; s < L; ++s) {
                const f32x4 zs = *(const LAS f32x4*)(z + s * 4);
#pragma unroll
                for (int i = 0; i < NI; ++i) { const float hv = hh[L + tid + NTHR * i - s];
                    acc[i][0] += hv * zs.x; acc[i][1] += hv * zs.y; acc[i][2] += hv * zs.z; acc[i][3] += hv * zs.w; }
            }
        }
        __syncthreads();
        const float bo = bias[o * 256 + c];
        if (tid < L) {
#pragma unroll
            for (int i = 0; i < NI; ++i) { const int t = tid + NTHR * i;
#pragma unroll
                for (int bb = 0; bb < 4; ++bb) { const float gate = HV[((size_t)((1 + o) * 8 + b0 + bb) * 256 + c) * L + t];
                    z[t * 4 + bb] = gate * (acc[i][bb] + bo * z[t * 4 + bb]); } }
        }
        __syncthreads();
    }
    float* HVw = (float*)(p.ws + WS_BIG + BG_S + (isctx ? HY_VC : HY_VL));
    if (tid < L) {
#pragma unroll
        for (int i = 0; i < NI; ++i) { const int t = tid + NTHR * i;
#pragma unroll
            for (int bb = 0; bb < 4; ++bb) HVw[((size_t)(0 * 8 + b0 + bb) * 256 + c) * L + t] = z[t * 4 + bb]; }
    }
    __syncthreads();
}
__device__ __forceinline__ void ph_hy_post(const PAS Prm& p, bool with_ctx, LAS unsigned char* lds) {
    LAS float* tl = (LAS float*)lds;
    const int tid = TID;
    const float* VL = (const float*)(p.ws + WS_BIG + BG_S + HY_VL); const float* VC = (const float*)(p.ws + WS_BIG + BG_S + HY_VC);
    bf16* yhy = (bf16*)(p.ws + WS_Y);
    const int NTL = 8 * (SEQ / 64) * 4, NTC = with_ctx ? 8 * (CTXL / 64) * 4 : 0;
    for (int tile = BID; tile < NTL + NTC; tile += NBLK) {
        const bool isctx = tile >= NTL; const int tt = isctx ? tile - NTL : tile;
        const int T = isctx ? CTXL : SEQ, ntt = T / 64;
        const int ct = tt % 4, tb = (tt / 4) % ntt, b = tt / (4 * ntt);
        const int base = isctx ? b * CTXL : RC + b * SEQ, t0 = tb * 64, c0 = ct * 64;
        const float* src = (isctx ? VC : VL) + ((size_t)b * 256 + c0) * T + t0;
        for (int i = tid; i < 64 * 64; i += NTHR) { const int cc = i >> 6, ti = i & 63; tl[cc * 65 + ti] = src[(size_t)cc * T + ti]; }
        __syncthreads();
        for (int i = tid; i < 64 * 32; i += NTHR) { const int ti = i >> 5, cp = i & 31;
            *(unsigned*)(yhy + (size_t)(base + t0 + ti) * 256 + c0 + 2 * cp) = pk2(tl[(2 * cp) * 65 + ti], tl[(2 * cp + 1) * 65 + ti]); }
        __syncthreads();
    }
}
typedef float cf2 __attribute__((ext_vector_type(2)));
__device__ __forceinline__ cf2 cmul(cf2 a, cf2 b) { return (cf2){a.x * b.x - a.y * b.y, a.x * b.y + a.y * b.x}; }
__device__ __forceinline__ cf2 cmulc(cf2 a, cf2 b) { return (cf2){a.x * b.x + a.y * b.y, a.y * b.x - a.x * b.y}; }
template <int LOGN, int M, bool INV>
__device__ __forceinline__ void fft_pass(LAS cf2* X, const LAS cf2* W, const int log_stride, const int tid) {
    constexpr int N = 1 << LOGN, R = 1 << M, NGRP = N / R;
    for (int g = tid; g < NGRP; g += NTHR) {
        const int q = g & ((1 << log_stride) - 1), blk = g >> log_stride;
        const int base = (blk << (log_stride + M)) + q;
        cf2 x[R];
#pragma unroll
        for (int j = 0; j < R; ++j) x[j] = X[base + (j << log_stride)];
#pragma unroll
        for (int s = 0; s < M; ++s) {
            const int half = INV ? (1 << s) : (R >> (s + 1));
            const int lsp = log_stride + (INV ? s : (M - 1 - s));
#pragma unroll
            for (int j = 0; j < R; ++j) {
                if (j & half) continue;
                const int pos = q + ((j & (half - 1)) << log_stride);
                const cf2 w = W[pos << (LOGN - 1 - lsp)];
                const cf2 a = x[j], bq = x[j + half];
                if (!INV) { x[j] = a + bq; x[j + half] = cmul(a - bq, w); }
                else { const cf2 t = cmulc(bq, w); x[j] = a + t; x[j + half] = a - t; }
            }
        }
#pragma unroll
        for (int j = 0; j < R; ++j) X[base + (j << log_stride)] = x[j];
    }
    __syncthreads();
}
template <int LOGN, bool INV> __device__ __forceinline__ void fft_lds(LAS cf2* X, const LAS cf2* W, const int tid) {
    static_assert(LOGN == 13 || LOGN == 9, "pass schedule");
    if (LOGN == 13) {
        if (!INV) { fft_pass<LOGN, 3, false>(X, W, 10, tid); fft_pass<LOGN, 3, false>(X, W, 7, tid); fft_pass<LOGN, 3, false>(X, W, 4, tid); fft_pass<LOGN, 2, false>(X, W, 2, tid); fft_pass<LOGN, 2, false>(X, W, 0, tid); }
        else { fft_pass<LOGN, 2, true>(X, W, 0, tid); fft_pass<LOGN, 2, true>(X, W, 2, tid); fft_pass<LOGN, 3, true>(X, W, 4, tid); fft_pass<LOGN, 3, true>(X, W, 7, tid); fft_pass<LOGN, 3, true>(X, W, 10, tid); }
    } else {
        if (!INV) { fft_pass<LOGN, 3, false>(X, W, 6, tid); fft_pass<LOGN, 3, false>(X, W, 3, tid); fft_pass<LOGN, 3, false>(X, W, 0, tid); }
        else { fft_pass<LOGN, 3, true>(X, W, 0, tid); fft_pass<LOGN, 3, true>(X, W, 3, tid); fft_pass<LOGN, 3, true>(X, W, 6, tid); }
    }
}
#ifdef HOST_EMU
static inline unsigned brev32(unsigned x) { unsigned r = 0; for (int i = 0; i < 32; ++i) if (x & (1u << i)) r |= 1u << (31 - i); return r; }
#else
__device__ __forceinline__ unsigned brev32(unsigned x) { return __builtin_bitreverse32(x); }
#endif
template <int LOGN>
__device__ __forceinline__ void hy_fft_channel(const PAS Prm& p, int l, int c, LAS unsigned char* lds) {
    constexpr int N = 1 << LOGN, L = N / 2;
    static_assert(L == SEQ, "transform length");
    LAS cf2* X = (LAS cf2*)lds;
    LAS cf2* Hh = X + N;
    LAS cf2* W = Hh + N / 2 + 8;
    const int tid = TID;
    const float* F = (const float*)(p.ws + WS_BIG + BG_S + HY_FL);
    float* HV = (float*)(p.ws + WS_BIG + BG_S + HY_VL);
    const float* bias = p.in[17] + l * 512;
    for (int k = tid; k < N / 2; k += NTHR) { float sn, cs; sincospif(-(float)k * (2.0f / (float)N), &sn, &cs); W[k] = (cf2){cs, sn}; }
    __syncthreads();
    const float inv_n = 1.0f / (float)N;
    for (int o = 0; o < 2; ++o) {
        const float* Fo = F + (size_t)(o * 256 + c) * N;
        for (int n = tid; n < N; n += NTHR) X[n] = (cf2){Fo[(n + L) & (N - 1)], 0.f};
        __syncthreads();
        fft_lds<LOGN, false>(X, W, tid);
        for (int pp = tid; pp < N; pp += NTHR) { const int k = (int)(brev32((unsigned)pp) >> (32 - LOGN)); if (k <= N / 2) Hh[k] = X[pp]; }
        __syncthreads();
        const float bo = bias[o * 256 + c];
        for (int pair = 0; pair < 4; ++pair) {
            float* z0 = HV + ((size_t)(0 * 8 + 2 * pair) * 256 + c) * L; float* z1 = z0 + (size_t)256 * L;
            const float* g0 = HV + ((size_t)((1 + o) * 8 + 2 * pair) * 256 + c) * L; const float* g1 = g0 + (size_t)256 * L;
            for (int t = tid; t < L; t += NTHR) { X[t] = (cf2){z0[t], z1[t]}; X[t + L] = (cf2){0.f, 0.f}; }
            __syncthreads();
            fft_lds<LOGN, false>(X, W, tid);
            for (int pp = tid; pp < N; pp += NTHR) { const int k = (int)(brev32((unsigned)pp) >> (32 - LOGN));
                cf2 h; if (k <= N / 2) h = Hh[k]; else { h = Hh[N - k]; h.y = -h.y; }
                X[pp] = cmul(X[pp], h); }
            __syncthreads();
            fft_lds<LOGN, true>(X, W, tid);
            for (int t = tid; t < L; t += NTHR) { const cf2 cv = X[t] * inv_n;
                const float a0 = z0[t], a1 = z1[t];
                z0[t] = g0[t] * (cv.x + bo * a0); z1[t] = g1[t] * (cv.y + bo * a1); }
            __syncthreads();
        }
    }
}
__device__ __forceinline__ void ph_hy_conv(const PAS Prm& p, int l, bool with_ctx, LAS unsigned char* lds) {
    constexpr int LOGN = (SEQ == 4096) ? 13 : 9;
    for (int c = BID; c < 256; c += NBLK) hy_fft_channel<LOGN>(p, l, c, lds);
    if (with_ctx) for (int it = BID; it < 512; it += NBLK) hy_conv_item<CTXL>(p, l, it >> 1, (it & 1) * 4, lds);
}

constexpr int PPL = 30;
constexpr int NPH = 1 + DEPTH * PPL + 1;

template <unsigned MASK> __global__ void __launch_bounds__(NTHR, 2) fwd(Prm pk) {
#ifdef HOST_EMU
    unsigned char* lds_raw = g_lds_emu;
#else
    extern __shared__ __attribute__((aligned(16))) unsigned char lds_raw[];
#endif
    LAS unsigned char* lds = (LAS unsigned char*)lds_raw;
    volatile LAS unsigned* misc = (volatile LAS unsigned*)(lds + LDS_BYTES - 256);
#ifndef HOST_EMU
    { const unsigned t0 = threadIdx.x;
      if (t0 < 64u) misc[t0] = 0u;
      if ((t0 & 63u) == 0u) ((volatile LAS unsigned*)(lds + TIDTAB_OFF))[hw_slot()] = t0 >> 6;
      __syncthreads();
      if ((unsigned)tid_opq() != t0) __hip_atomic_store((unsigned*)(pk.ws + WS_CTL + 768 * 1024), 1u, __ATOMIC_RELAXED, __HIP_MEMORY_SCOPE_AGENT); }
#else
    if (TID < 64) misc[TID] = 0u;
    __syncthreads();
#endif
    const int lo = pk.lo, hi = pk.hi;
    XcdBarrier bar; bar.bar = (unsigned*)(pk.ws + WS_CTL); bar.x = 0; bar.st = misc + 8;
    if (hi - lo > 1) bar = xcd_barrier_post((unsigned*)(pk.ws + WS_CTL), misc + 8);
    int ph = 0;
#ifdef HOST_EMU
#define PH_PRM() const Prm* pl_ = &pk
#else
#define PH_PRM() const PAS Prm* pl_ = (const PAS Prm*)__builtin_amdgcn_kernarg_segment_ptr(); asm volatile("" : "+s"(pl_))
#endif
#define PH_BEGIN(k) if (((MASK >> ((k) & 31)) & 1u) && ph >= lo && ph < hi) { PH_PRM(); const PAS Prm& p = *pl_; \
    bf16* const WB = (bf16*)(p.ws + WS_W); bf16* const U = (bf16*)(p.ws + WS_U); float* const XC = (float*)(p.ws + WS_XC); bf16* const PB = (bf16*)(p.ws + WS_BIG + BG_P); \
    unsigned char* const SB = p.ws + WS_BIG + BG_S; bf16* const GH = (bf16*)(p.ws + WS_BIG); bf16* const MG = (bf16*)(p.ws + WS_BIG + 136 * MiB); bf16* const ACT = (bf16*)(p.ws + WS_BIG); \
    const float* const MOD = (const float*)(p.ws + WS_MOD); const float* const modl = MOD + (size_t)l * 9 * 6144; \
    const float* xc_src = (l == 0) ? p.in[2] : XC; const float* xl_src = (l == 0) ? p.in[0] : p.out; \
    (void)WB; (void)U; (void)XC; (void)PB; (void)SB; (void)GH; (void)MG; (void)ACT; (void)MOD; (void)modl; (void)xc_src; (void)xl_src;
#define PH_END   if (ph + 1 < hi) xcd_barrier(bar); } ++ph;
    typedef pg8::StaticOrder SO;

    { const int l = 0; PH_BEGIN(1) ph_mod(p, lds); PH_END }

#pragma unroll 1
    for (int l0 = 0; l0 < DEPTH; ++l0) {
        int l = l0;
#ifndef HOST_EMU
        asm volatile("" : "+s"(l));
#endif
        const bool last = (l == DEPTH - 1), wctx = !last;
        const int ro = last ? RC : 0, Mpost = last ? RL : RT;

        PH_BEGIN(2) ph_cvt(p, l, lds); PH_END
        PH_BEGIN(3) ph_norm(p, l, 0, xc_src, xl_src, 0); PH_END
        PH_BEGIN(4) { pg8::Gemm g{U, WB + WO_WP + (size_t)768 * 1024, RT, 1024, 1024}; SO S; S.init(RT, 1024, NBLK, BID); pg8::EpiBf<0> E{PB, 1024};
                   pg8::gemm_phase<pg8::EpiBf<0>, SO, true, true>(lds, g, S, E); } PH_END
        PH_BEGIN(5) ph_rw_prep(p, l, lds); PH_END
        PH_BEGIN(6) scan_phase<0>(SB, PB, (float*)(SB + RW_Y), p.in[25] + l * 256, nullptr, lds); PH_END
        PH_BEGIN(7) ph_rw_post(p, l); PH_END
        PH_BEGIN(8) { pg8::Gemm g{U, WB + WO_WP + (size_t)2304 * 1024, RT, 1024, 1024}; SO S; S.init(RT, 1024, NBLK, BID); pg8::EpiBf<0> E{PB, 1024};
                   pg8::gemm_phase<pg8::EpiBf<0>, SO, true, true>(lds, g, S, E); } PH_END
        PH_BEGIN(9) ph_ret_prep(p); PH_END
        PH_BEGIN(10) scan_phase<1>(SB, PB, (float*)(SB + RT_Y), nullptr, p.in[35] + l * 8, lds); PH_END
        PH_BEGIN(11) ph_ret_post(p); PH_END
        PH_BEGIN(12) { pg8::Gemm g{U, WB + WO_WP + (size_t)1792 * 1024, RT, 512, 1024}; SO S; S.init(RT, 512, NBLK, BID); pg8::EpiBf<0> E{PB, 512};
                   pg8::gemm_phase<pg8::EpiBf<0>, SO, true, true>(lds, g, S, E); } PH_END
        PH_BEGIN(13) ph_lru_prep(p, l, lds); PH_END
        PH_BEGIN(14) ph_lru_agg(p); PH_END
        PH_BEGIN(15) ph_lru_fin(p, lds); PH_END
        PH_BEGIN(16) { pg8::Gemm g{U, WB + WO_WP, RT, 768, 1024}; SO S; S.init(RT, 768, NBLK, BID); pg8::EpiBf<0> E{PB, 768};
                   pg8::gemm_phase<pg8::EpiBf<0>, SO, true, true>(lds, g, S, E); } PH_END
        PH_BEGIN(17) ph_hy_filter(p, l, wctx, lds); PH_END
        PH_BEGIN(18) ph_hy_fnorm(p, wctx); PH_END
        PH_BEGIN(19) ph_hy_prep(p, l, wctx, lds); PH_END
        PH_BEGIN(20) ph_hy_conv(p, l, wctx, lds); PH_END
        PH_BEGIN(32) ph_hy_post(p, wctx, lds); PH_END
        PH_BEGIN(21) { pg8::Gemm g{U + (size_t)ro * 1024, WB + WO_WG, Mpost, 2048, 1024}; SO S; S.init(Mpost, 2048, NBLK, BID); pg8::EpiBf<1> E{GH + (size_t)ro * 2048, 2048};
                   pg8::gemm_phase<pg8::EpiBf<1>, SO, true, true>(lds, g, S, E); } PH_END
        PH_BEGIN(22) { pg8::Gemm g{(const bf16*)(p.ws + WS_Y + 0 * SZ17) + (size_t)ro * 256, WB + WO_BR + (size_t)0 * 1024 * 256, Mpost, 1024, 256}; SO S; S.init(Mpost, 1024, NBLK, BID);
                   pg8::EpiMerge E{GH + (size_t)ro * 2048, 2048, 0, MG + (size_t)ro * 1024, 1};
                   pg8::gemm_phase<pg8::EpiMerge, SO, true, true>(lds, g, S, E); } PH_END
        PH_BEGIN(23) { pg8::Gemm g{(const bf16*)(p.ws + WS_Y + 1 * SZ17) + (size_t)ro * 256, WB + WO_BR + (size_t)1 * 1024 * 256, Mpost, 1024, 256}; SO S; S.init(Mpost, 1024, NBLK, BID);
                   pg8::EpiMerge E{GH + (size_t)ro * 2048, 2048, 1024, MG + (size_t)ro * 1024, 0};
                   pg8::gemm_phase<pg8::EpiMerge, SO, true, true>(lds, g, S, E); } PH_END
        PH_BEGIN(24) { pg8::Gemm g{U + (size_t)ro * 1024, WB + WO_WG + (size_t)2048 * 1024, Mpost, 2048, 1024}; SO S; S.init(Mpost, 2048, NBLK, BID); pg8::EpiBf<1> E{GH + (size_t)ro * 2048, 2048};
                   pg8::gemm_phase<pg8::EpiBf<1>, SO, true, true>(lds, g, S, E); } PH_END
        PH_BEGIN(25) { pg8::Gemm g{(const bf16*)(p.ws + WS_Y + 2 * SZ17) + (size_t)ro * 256, WB + WO_BR + (size_t)2 * 1024 * 256, Mpost, 1024, 256}; SO S; S.init(Mpost, 1024, NBLK, BID);
                   pg8::EpiMerge E{GH + (size_t)ro * 2048, 2048, 0, MG + (size_t)ro * 1024, 0};
                   pg8::gemm_phase<pg8::EpiMerge, SO, true, true>(lds, g, S, E); } PH_END
        PH_BEGIN(26) { pg8::Gemm g{(const bf16*)(p.ws + WS_Y + 3 * SZ17) + (size_t)ro * 256, WB + WO_BR + (size_t)3 * 1024 * 256, Mpost, 1024, 256}; SO S; S.init(Mpost, 1024, NBLK, BID);
                   pg8::EpiMerge E{GH + (size_t)ro * 2048, 2048, 1024, MG + (size_t)ro * 1024, 0};
                   pg8::gemm_phase<pg8::EpiMerge, SO, true, true>(lds, g, S, E); } PH_END
        PH_BEGIN(27) { pg8::Gemm g{MG + (size_t)ro * 1024, WB + WO_WO, Mpost, 1024, 1024}; SO S; S.init(Mpost, 1024, NBLK, BID);
                   pg8::EpiResid E{xc_src, xl_src, XC, p.out, modl, 2 * 1024, ro};
                   pg8::gemm_phase<pg8::EpiResid, SO, true, true>(lds, g, S, E); } PH_END
        PH_BEGIN(28) ph_norm(p, l, 1, XC, p.out, ro); PH_END
        PH_BEGIN(29) { pg8::Gemm g{U + (size_t)ro * 1024, WB + WO_W1, Mpost, 5632, 1024}; SO S; S.init(Mpost, 5632, NBLK, BID); pg8::EpiSwiglu E{ACT + (size_t)ro * 2816, 2816};
                   pg8::gemm_phase<pg8::EpiSwiglu, SO, true, true>(lds, g, S, E); } PH_END
        PH_BEGIN(30) { pg8::Gemm g{ACT + (size_t)ro * 2816, WB + WO_W2, Mpost, 1024, 2816}; SO S; S.init(Mpost, 1024, NBLK, BID);
                   pg8::EpiResid E{XC, p.out, XC, p.out, modl, 5 * 1024, ro};
                   pg8::gemm_phase<pg8::EpiResid, SO, true, true>(lds, g, S, E); } PH_END
    }
    { const int l = 1; PH_BEGIN(31) ph_final(p); PH_END }
#undef PH_BEGIN
#undef PH_END
}

#ifndef HOST_EMU
#define SITE(k) (1u << (k))
#if MK_PER_PHASE
constexpr int NG = 19;
constexpr unsigned GM[NG] = {
    SITE(0) | SITE(1) | SITE(2) | SITE(3) | SITE(28) | SITE(31) | SITE(7) | SITE(11) | SITE(15) | SITE(9) | SITE(18) | SITE(19),
    SITE(5),
    SITE(6) | SITE(10),
    SITE(13) | SITE(14),
    SITE(17) | SITE(20),
    SITE(4), SITE(8), SITE(12), SITE(16), SITE(21), SITE(24), SITE(22), SITE(23), SITE(25), SITE(26), SITE(27), SITE(30), SITE(29), 0u };
#else
constexpr int NG = 1;
constexpr unsigned GM[NG] = {0xFFFFFFFFu};
#endif
template <int G> static bool prep_group() { return hipFuncSetAttribute((const void*)fwd<GM[G]>, hipFuncAttributeMaxDynamicSharedMemorySize, LDS_BYTES) == hipSuccess; }
template <int G> static void launch_group(int grid, hipStream_t stream, const Prm& p) { hipLaunchKernelGGL(fwd<GM[G]>, dim3(grid), dim3(NTHR), LDS_BYTES, stream, p); }

extern "C" void kernel_launch(void* const* d_in, const int* in_sizes, int n_in, void* d_out, int out_size, void* d_ws, size_t ws_size, hipStream_t stream) {
    static int grid = 0;
    if (grid == 0) {
        if (n_in != 41 || out_size != RL * D || ws_size < WS_END) { fprintf(stderr, "kernel_launch: unexpected shapes (n_in %d out %d ws %zu); nothing launched\n", n_in, out_size, ws_size); grid = -1; return; }
        int dev = 0, cus = 0;
        if (hipGetDevice(&dev) != hipSuccess || hipDeviceGetAttribute(&cus, hipDeviceAttributeMultiprocessorCount, dev) != hipSuccess) { grid = -1; return; }
        bool ok = true;
#if MK_PER_PHASE
        ok = ok && prep_group<0>() && prep_group<1>() && prep_group<2>() && prep_group<3>() && prep_group<4>() && prep_group<5>() && prep_group<6>() && prep_group<7>() && prep_group<8>() && prep_group<9>()
                && prep_group<10>() && prep_group<11>() && prep_group<12>() && prep_group<13>() && prep_group<14>() && prep_group<15>() && prep_group<16>() && prep_group<17>();
#else
        ok = prep_group<0>();
#endif
        if (!ok) { fprintf(stderr, "kernel_launch: hipFuncSetAttribute failed\n"); grid = -1; return; }
        (void)hipGetLastError();
        grid = cus > 0 ? cus : 256;
    }
    if (grid < 0) return;
    if (hipMemsetAsync((char*)d_ws + WS_CTL, 0, 1 * MiB, stream) != hipSuccess) return;
    Prm p{};
    for (int i = 0; i < 41; ++i) p.in[i] = (const float*)d_in[i];
    p.out = (float*)d_out; p.ws = (unsigned char*)d_ws;
#if MK_PER_PHASE
    for (int ph = 0; ph < NPH; ++ph) {
        p.lo = ph; p.hi = ph + 1;
        static const int layer_sites[PPL] = {2, 3, 4, 5, 6, 7, 8, 9, 10, 11, 12, 13, 14, 15, 16, 17, 18, 19, 20, 0  , 21, 22, 23, 24, 25, 26, 27, 28, 29, 30};
        const int k = (ph == 0) ? 1 : (ph == NPH - 1) ? 31 : layer_sites[(ph - 1) % PPL];
        int g = -1;
        for (int q = 0; q < NG; ++q) if ((GM[q] >> k) & 1u) g = q;
        switch (g) {
            case 0: launch_group<0>(grid, stream, p); break; case 1: launch_group<1>(grid, stream, p); break; case 2: launch_group<2>(grid, stream, p); break;
            case 3: launch_group<3>(grid, stream, p); break; case 4: launch_group<4>(grid, stream, p); break; case 5: launch_group<5>(grid, stream, p); break;
            case 6: launch_group<6>(grid, stream, p); break; case 7: launch_group<7>(grid, stream, p); break; case 8: launch_group<8>(grid, stream, p); break;
            case 9: launch_group<9>(grid, stream, p); break; case 10: launch_group<10>(grid, stream, p); break; case 11: launch_group<11>(grid, stream, p); break;
            case 12: launch_group<12>(grid, stream, p); break; case 13: launch_group<13>(grid, stream, p); break; case 14: launch_group<14>(grid, stream, p); break;
            case 15: launch_group<15>(grid, stream, p); break; case 16: launch_group<16>(grid, stream, p); break; case 17: launch_group<17>(grid, stream, p); break;
            default: break; }
#ifdef DIAG_BUILD
        { static const int dg[8][2] = {{0, 0}, {2, 1}, {10, 2}, {14, 3}, {20, 4}, {22, 5}, {26, 6}, {28, 7}};
          for (int q = 0; q < 8; ++q) if (ph == 1 + dg[q][0]) hipLaunchKernelGGL(diag_k, dim3(32), dim3(NTHR), 0, stream, p, dg[q][1]);
          if (ph == 1 + 19) hipLaunchKernelGGL(diag_k, dim3(32), dim3(NTHR), 0, stream, p, 8);
          if (ph == NPH - 1) hipLaunchKernelGGL(diag_out_k, dim3(grid), dim3(NTHR), 0, stream, p); }
#endif
    }
#else
    p.lo = 0; p.hi = NPH;
    launch_group<0>(grid, stream, p);
#endif
}
#endif
```

```cpp
#include <hip/hip_runtime.h>
#include <cstdio>
#include <cstdint>

#ifndef SEQ_
#define SEQ_ 4096
#define CTXL_ 256
#endif
#ifndef MK_PER_PHASE
#define MK_PER_PHASE 0
#endif

#ifndef HOST_EMU
extern __shared__ __attribute__((aligned(16))) unsigned char g_dyn_lds[];
constexpr int TIDTAB_OFF = 147456 - 2048;
__device__ __forceinline__ unsigned hw_slot() { return (unsigned)__builtin_amdgcn_s_getreg((7 << 11) | 4) & 0xFFu; }
__device__ __forceinline__ int tid_opq() {
    const unsigned w = ((const volatile __attribute__((address_space(3))) unsigned*)((__attribute__((address_space(3))) unsigned char*)g_dyn_lds + TIDTAB_OFF))[hw_slot()];
    unsigned lane; asm volatile("v_mbcnt_lo_u32_b32 %0, -1, 0\n\tv_mbcnt_hi_u32_b32 %0, -1, %0" : "=v"(lane));
    int t = (int)((unsigned)__builtin_amdgcn_readfirstlane((int)w) * 64u + lane); asm volatile("" : "+v"(t)); return t;
}
#endif

namespace pg8 {
#define PG8_LAS __attribute__((address_space(3)))
typedef unsigned short bf16_t;
typedef short bf16x8 __attribute__((ext_vector_type(8)));
typedef float f32x4 __attribute__((ext_vector_type(4)));
typedef unsigned u32x4 __attribute__((ext_vector_type(4)));
constexpr int BM = 256, BK = 64, HALF = 128, HTB = HALF * BK * 2  , STAGE_BYTES = 8 * HTB, NXCD = 8, WGM = 8;

__host__ __device__ __forceinline__ int lds_byte(int r, int c) { const int st = (r >> 4) * 2 + (c >> 5), rr = r & 15, cc = c & 31, ob = rr * 64 + cc * 2; return st * 1024 + (ob ^ (((ob >> 9) & 1) << 5)); }
__host__ __device__ __forceinline__ void stage_rc(int b, int& R, int& C) { const int st = b / 1024, sb = b % 1024, swz = sb ^ (((sb >> 9) & 1) << 5); R = (st >> 1) * 16 + swz / 64; C = (st & 1) * 32 + (swz % 64) / 2; }
__host__ __device__ __forceinline__ int perm32(int rho) { const int n = rho >> 4, i = rho & 15; return 8 * (i >> 2) + 4 * n + (i & 3); }

struct Unit { int pm, pn; };
struct Gemm { const bf16_t* A; const bf16_t* Bt; int M, N, K; };

struct StaticOrder {
    int nM, nN, nwg, G, c;
    __host__ __device__ void init(int M, int N, int G_, int c_) { nM = M / BM; nN = N / BM; nwg = nM * nN; G = G_; c = c_; }
    __host__ __device__ bool next(int i, Unit& u) const {
        const long L = (long)i * G + c; if (L >= nwg) return false;
        int wgid = (int)L; { const int q = nwg / NXCD, r = nwg % NXCD, xcd = wgid % NXCD, off = wgid / NXCD; wgid = (xcd < r ? xcd * (q + 1) : r * (q + 1) + (xcd - r) * q) + off; }
        const int nig = WGM * nN, gid = wgid / nig, fm = gid * WGM, gsz = (nM - fm) < WGM ? (nM - fm) : WGM;
        u.pm = fm + ((wgid % nig) % gsz); u.pn = (wgid % nig) / gsz; return true;
    }
    __device__ __forceinline__ void a_ready(const Unit&) const {}
    __device__ __forceinline__ void done(const Unit&) const {}
};

#ifdef HOST_EMU
__device__ __forceinline__ unsigned cvt_pk_bf16(float lo, float hi) { auto f = [](float x) { unsigned u; memcpy(&u, &x, 4); return (u + 0x7fffu + ((u >> 16) & 1u)) >> 16; }; return f(lo) | (f(hi) << 16); }
#else
typedef __bf16 pg8_bf16x2 __attribute__((ext_vector_type(2)));
typedef float pg8_f32x2 __attribute__((ext_vector_type(2)));
__device__ __forceinline__ unsigned cvt_pk_bf16(float lo, float hi) { pg8_f32x2 v = {lo, hi}; pg8_bf16x2 b = __builtin_convertvector(v, pg8_bf16x2); return __builtin_bit_cast(unsigned, b); }
#endif
typedef float f32x2 __attribute__((ext_vector_type(2)));
__device__ __forceinline__ float bflo(unsigned u) { return __uint_as_float(u << 16); }
__device__ __forceinline__ float bfhi(unsigned u) { return __uint_as_float(u & 0xffff0000u); }
#ifdef HOST_EMU
__device__ __forceinline__ float fsigmoid(float x) { return 1.f / (1.f + expf(-x)); }
#else
__device__ __forceinline__ float fsigmoid(float x) { return __builtin_amdgcn_rcpf(1.f + __expf(-x)); }
#endif

#ifdef HOST_EMU
#define EPI_PIN() do { } while (0)
#define EPI_LATE(fr, fq) do { } while (0)
#define EPI_Z(z) do { } while (0)
#else
#define EPI_Z(z) asm volatile("" : "+v"(z))
#define EPI_LATE(fr, fq) asm volatile("" : "+v"(fr), "+v"(fq))

#define EPI_PIN() asm volatile("" ::: "memory")
#endif
template <int ACT> struct EpiBf {
    static constexpr bool PERM = true, AFTER_DRAIN = false;
    bf16_t* O; int ldc;
    __device__ __forceinline__ void operator()(const f32x4 (&acc)[2][2][4][2], const Unit& u, int wr, int wc, int fr, int fq) const {
        EPI_LATE(fr, fq);
        const int row0 = u.pm * BM + wr * 64 + fr, col0 = u.pn * BM + wc * 32 + 8 * fq;
#pragma unroll
        for (int ai = 0; ai < 2; ++ai)
#pragma unroll
            for (int m = 0; m < 4; ++m) { bf16_t* rowp = O + (size_t)(row0 + ai * HALF + m * 16) * ldc + col0;
#pragma unroll
                for (int bj = 0; bj < 2; ++bj) { f32x4 v0 = acc[ai][bj][m][0], v1 = acc[ai][bj][m][1];
                    if (ACT == 1) {
#pragma unroll
                        for (int j = 0; j < 4; ++j) { v0[j] = fsigmoid(v0[j]); v1[j] = fsigmoid(v1[j]); } }
                    u32x4 w; w.x = cvt_pk_bf16(v0[0], v0[1]); w.y = cvt_pk_bf16(v0[2], v0[3]); w.z = cvt_pk_bf16(v1[0], v1[1]); w.w = cvt_pk_bf16(v1[2], v1[3]);
                    *(u32x4*)(rowp + bj * HALF) = w; } }
    }
};

struct EpiMerge {
    static constexpr bool PERM = true, AFTER_DRAIN = false;
    const bf16_t* G; int ldg; int gcol0; bf16_t* Mg; int first;
    __device__ __forceinline__ void operator()(const f32x4 (&acc)[2][2][4][2], const Unit& u, int wr, int wc, int fr, int fq) const {
        EPI_LATE(fr, fq);
        const int row0 = u.pm * BM + wr * 64 + fr, col0 = u.pn * BM + wc * 32 + 8 * fq;
#pragma unroll
        for (int ai = 0; ai < 2; ++ai)
#pragma unroll
            for (int m = 0; m < 4; ++m) { const size_t row = (size_t)(row0 + ai * HALF + m * 16);
#pragma unroll
                for (int bj = 0; bj < 2; ++bj) { const int col = col0 + bj * HALF;
                    const u32x4 gv = *(const u32x4*)(G + row * ldg + gcol0 + col);
                    bf16_t* mp = Mg + row * 1024 + col;
                    u32x4 pv; if (!first) pv = *(const u32x4*)mp; else { unsigned z0 = 0u; EPI_Z(z0); pv = (u32x4){z0, z0, z0, z0}; }
                    const f32x4 v0 = acc[ai][bj][m][0], v1 = acc[ai][bj][m][1];
                    float o[8];
                    o[0] = bflo(pv.x) + bflo(gv.x) * v0[0]; o[1] = bfhi(pv.x) + bfhi(gv.x) * v0[1];
                    o[2] = bflo(pv.y) + bflo(gv.y) * v0[2]; o[3] = bfhi(pv.y) + bfhi(gv.y) * v0[3];
                    o[4] = bflo(pv.z) + bflo(gv.z) * v1[0]; o[5] = bfhi(pv.z) + bfhi(gv.z) * v1[1];
                    o[6] = bflo(pv.w) + bflo(gv.w) * v1[2]; o[7] = bfhi(pv.w) + bfhi(gv.w) * v1[3];
                    u32x4 w; w.x = cvt_pk_bf16(o[0], o[1]); w.y = cvt_pk_bf16(o[2], o[3]); w.z = cvt_pk_bf16(o[4], o[5]); w.w = cvt_pk_bf16(o[6], o[7]);
                    *(u32x4*)mp = w; }
                EPI_PIN(); }
    }
};

struct EpiResid {
    static constexpr bool PERM = false, AFTER_DRAIN = false;
    const float* src_c; const float* src_l; float* dst_c; float* dst_l; const float* modl; int gate_off; int row_off;
    __device__ __forceinline__ void operator()(const f32x4 (&acc)[2][2][4][2], const Unit& u, int wr, int wc, int fr, int fq) const {
        EPI_LATE(fr, fq);
        const int grow0 = row_off + u.pm * BM;
        const bool isctx = grow0 < 8 * CTXL_;
        const int jb = isctx ? 8 : (grow0 - 8 * CTXL_) / SEQ_;
        const float* gate = modl + (size_t)jb * 6144 + gate_off;
        const float* src = isctx ? src_c + (size_t)grow0 * 1024 : src_l + (size_t)(grow0 - 8 * CTXL_) * 1024;
        float* dst = isctx ? dst_c + (size_t)grow0 * 1024 : dst_l + (size_t)(grow0 - 8 * CTXL_) * 1024;
        const int rr0 = wr * 64 + fr, col0 = u.pn * BM + wc * 32 + 4 * fq;
        f32x4 gv[2][2];
#pragma unroll
        for (int bj = 0; bj < 2; ++bj)
#pragma unroll
            for (int n = 0; n < 2; ++n) gv[bj][n] = *(const f32x4*)(gate + col0 + bj * HALF + n * 16);
#pragma unroll
        for (int ai = 0; ai < 2; ++ai)
#pragma unroll
            for (int m = 0; m < 4; ++m) { const size_t ro = (size_t)(rr0 + ai * HALF + m * 16) * 1024 + col0;
#pragma unroll
                for (int bj = 0; bj < 2; ++bj)
#pragma unroll
                    for (int n = 0; n < 2; ++n) { const f32x4 s = *(const f32x4*)(src + ro + bj * HALF + n * 16);
                        *(f32x4*)(dst + ro + bj * HALF + n * 16) = s + gv[bj][n] * acc[ai][bj][m][n]; }
                EPI_PIN(); }
    }
};

struct EpiSwiglu {
    static constexpr bool PERM = true, AFTER_DRAIN = false;
    bf16_t* O; int ldc;
    __device__ __forceinline__ void operator()(const f32x4 (&acc)[2][2][4][2], const Unit& u, int wr, int wc, int fr, int fq) const {
        EPI_LATE(fr, fq);
        const int row0 = u.pm * BM + wr * 64 + fr, col0 = u.pn * HALF + wc * 32 + 8 * fq;
#pragma unroll
        for (int ai = 0; ai < 2; ++ai)
#pragma unroll
            for (int m = 0; m < 4; ++m) { bf16_t* rowp = O + (size_t)(row0 + ai * HALF + m * 16) * ldc + col0;
                float o[8];
#pragma unroll
                for (int n = 0; n < 2; ++n)
#pragma unroll
                    for (int j = 0; j < 4; ++j) { const float g = acc[ai][0][m][n][j], up = acc[ai][1][m][n][j]; o[n * 4 + j] = g * fsigmoid(g) * up; }
                u32x4 w; w.x = cvt_pk_bf16(o[0], o[1]); w.y = cvt_pk_bf16(o[2], o[3]); w.z = cvt_pk_bf16(o[4], o[5]); w.w = cvt_pk_bf16(o[6], o[7]);
                *(u32x4*)rowp = w; }
    }
};

template <class Epi, class Sched, bool ALIGN_EPI = false, bool SP2 = false>
__device__ __forceinline__ void gemm_phase(PG8_LAS unsigned char* lds, const Gemm g, const Sched& S, const Epi& E) {
    const int tid = tid_opq();
    const int wid = __builtin_amdgcn_readfirstlane(tid >> 6), lane = tid & 63, wr = wid >> 2, wc = wid & 3, fr = lane & 15, fq = lane >> 4;
    const int K = g.K, nt = K / BK;
    unsigned voffA, voffB;
    { int R, C; stage_rc(tid * 16, R, C); const int Rb = Epi::PERM ? ((R & ~31) + perm32(R & 31)) : R;
      voffA = (unsigned)(R * K + C) * 2u; voffB = (unsigned)(Rb * K + C) * 2u; }
    const size_t r64 = (size_t)64 * K * 2;
    const size_t kstep = (size_t)(BK * 2);
    const size_t hstep = (size_t)HALF * K * 2;
    const size_t tstep = 2 * hstep;
    const unsigned ldsw = (unsigned)wid * 1024u;
    const int aoff = lds_byte(wr * 64 + fr, fq * 8), boff = lds_byte(wc * 32 + fr, fq * 8);
#define PG8_SA(b, h) (((b) * 2 + (h)) * HTB)
#define PG8_SB(b, h) ((4 + (b) * 2 + (h)) * HTB)
#define PG8_STAGE(bufoff, gbase, voff) do { _Pragma("unroll") for (int _i = 0; _i < 2; ++_i) \
        __builtin_amdgcn_global_load_lds((const unsigned*)((const char*)(gbase) + (size_t)_i * r64 + (voff)), (PG8_LAS unsigned*)(lds + (bufoff) + ldsw + _i * 8192), 16, 0, 0); } while (0)
#define PG8_LDA(dst, b, h) do { _Pragma("unroll") for (int m = 0; m < 4; ++m) _Pragma("unroll") for (int k = 0; k < 2; ++k) dst[m][k] = *(const PG8_LAS bf16x8*)(lds + PG8_SA(b, h) + aoff + m * 2048 + k * 1024); } while (0)
#define PG8_LDB(dst, b, h) do { _Pragma("unroll") for (int n = 0; n < 2; ++n) _Pragma("unroll") for (int k = 0; k < 2; ++k) dst[n][k] = *(const PG8_LAS bf16x8*)(lds + PG8_SB(b, h) + boff + n * 2048 + k * 1024); } while (0)
#define PG8_MMA(ai, bj, At, Bt) do { __builtin_amdgcn_s_setprio(1); _Pragma("unroll") for (int m = 0; m < 4; ++m) _Pragma("unroll") for (int n = 0; n < 2; ++n) _Pragma("unroll") for (int k = 0; k < 2; ++k) \
        acc[ai][bj][m][n] = __builtin_amdgcn_mfma_f32_16x16x32_bf16(Bt[n][k], At[m][k], acc[ai][bj][m][n], 0, 0, 0); __builtin_amdgcn_s_setprio(0); } while (0)
#define PG8_WAIT_V(n) asm volatile("s_waitcnt vmcnt(" #n ")" ::: "memory")
#define PG8_WAIT_L(n) asm volatile("s_waitcnt lgkmcnt(" #n ")" ::: "memory")
#define PG8_BAR __builtin_amdgcn_s_barrier()
#define PG8_SCHED __builtin_amdgcn_sched_barrier(0)
    Unit cur, nxt; int ui = 0;
    if (!S.next(0, cur)) return;
    f32x4 acc[2][2][4][2];
    { float zf = 0.f; asm volatile("" : "+v"(zf));
#pragma unroll
    for (int a = 0; a < 2; ++a)
#pragma unroll
        for (int b = 0; b < 2; ++b)
#pragma unroll
            for (int m = 0; m < 4; ++m)
#pragma unroll
                for (int n = 0; n < 2; ++n) acc[a][b][m][n] = (f32x4){zf, zf, zf, zf}; }
    bf16x8 At[4][2], B0[2][2], B1[2][2];
    const char* cA = (const char*)g.A + (size_t)cur.pm * tstep; const char* cB = (const char*)g.Bt + (size_t)cur.pn * tstep;
    S.a_ready(cur);
    if constexpr (SP2) {
        PG8_STAGE(PG8_SB(0, 0), cB, voffB); PG8_STAGE(PG8_SB(0, 1), cB + hstep, voffB); PG8_STAGE(PG8_SA(0, 0), cA, voffA); PG8_STAGE(PG8_SA(0, 1), cA + hstep, voffA);
        if (wr == 1) PG8_BAR;
        PG8_WAIT_V(2); PG8_BAR;
        PG8_STAGE(PG8_SB(1, 0), cB + kstep, voffB); PG8_STAGE(PG8_SA(1, 0), cA + kstep, voffA); PG8_STAGE(PG8_SB(1, 1), cB + hstep + kstep, voffB);
        PG8_WAIT_V(6); PG8_BAR;
    } else {
        PG8_STAGE(PG8_SB(0, 0), cB, voffB); PG8_STAGE(PG8_SA(0, 0), cA, voffA); PG8_STAGE(PG8_SB(0, 1), cB + hstep, voffB); PG8_STAGE(PG8_SA(0, 1), cA + hstep, voffA);
        if (wr == 1) PG8_BAR;
        PG8_WAIT_V(4); PG8_BAR;
        PG8_STAGE(PG8_SB(1, 0), cB + kstep, voffB); PG8_STAGE(PG8_SA(1, 0), cA + kstep, voffA); PG8_STAGE(PG8_SB(1, 1), cB + hstep + kstep, voffB);
        PG8_WAIT_V(6); PG8_BAR;
    }
    for (;;) {
        const bool has_next = S.next(ui + 1, nxt);
        const char* nA = has_next ? (const char*)g.A + (size_t)nxt.pm * tstep : cA; const char* nB = has_next ? (const char*)g.Bt + (size_t)nxt.pn * tstep : cB;
        for (int t = 0; t < nt; t += 2) {
            const bool last = (t == nt - 2);
            const char* a1 = cA + (size_t)(t + 1) * kstep;
            const char* a2 = last ? nA : cA + (size_t)(t + 2) * kstep; const char* b2 = last ? nB : cB + (size_t)(t + 2) * kstep;
            const char* a3 = a2 + kstep; const char* b3 = b2 + kstep;
            if (last && has_next) S.a_ready(nxt);
            if constexpr (SP2) {
            PG8_LDB(B0, 0, 0); PG8_LDB(B1, 0, 1); PG8_SCHED; PG8_LDA(At, 0, 0); PG8_STAGE(PG8_SA(1, 1), a1 + hstep, voffA);
            PG8_WAIT_V(8); PG8_WAIT_L(0); PG8_BAR; PG8_MMA(0, 0, At, B0); PG8_MMA(0, 1, At, B1); PG8_BAR; PG8_SCHED;
            PG8_LDA(At, 0, 1); PG8_STAGE(PG8_SB(0, 0), b2, voffB); PG8_STAGE(PG8_SB(0, 1), b2 + hstep, voffB); PG8_STAGE(PG8_SA(0, 0), a2, voffA);
            PG8_WAIT_V(8); PG8_WAIT_L(0); PG8_BAR; PG8_MMA(1, 0, At, B0); PG8_MMA(1, 1, At, B1); PG8_BAR; PG8_SCHED;
            PG8_LDB(B0, 1, 0); PG8_LDB(B1, 1, 1); PG8_SCHED; PG8_LDA(At, 1, 0); PG8_STAGE(PG8_SA(0, 1), a2 + hstep, voffA);
            PG8_WAIT_V(8); PG8_WAIT_L(0); PG8_BAR; PG8_MMA(0, 0, At, B0); PG8_MMA(0, 1, At, B1); PG8_BAR; PG8_SCHED;
            PG8_LDA(At, 1, 1); PG8_STAGE(PG8_SB(1, 0), b3, voffB); PG8_STAGE(PG8_SB(1, 1), b3 + hstep, voffB); PG8_STAGE(PG8_SA(1, 0), a3, voffA);
            PG8_WAIT_V(8); PG8_WAIT_L(0); PG8_BAR; PG8_MMA(1, 0, At, B0); PG8_MMA(1, 1, At, B1); PG8_BAR; PG8_SCHED;
            } else {
            PG8_LDB(B0, 0, 0); PG8_SCHED; PG8_LDA(At, 0, 0); PG8_STAGE(PG8_SA(1, 1), a1 + hstep, voffA);
            PG8_WAIT_L(8); PG8_BAR; PG8_WAIT_L(0); PG8_MMA(0, 0, At, B0); PG8_BAR; PG8_SCHED;
            PG8_LDB(B1, 0, 1); PG8_STAGE(PG8_SB(0, 0), b2, voffB);
            PG8_BAR; PG8_WAIT_L(0); PG8_MMA(0, 1, At, B1); PG8_BAR;
            PG8_LDA(At, 0, 1); PG8_STAGE(PG8_SA(0, 0), a2, voffA);
            PG8_BAR; PG8_WAIT_L(0); PG8_MMA(1, 0, At, B0); PG8_BAR; PG8_SCHED;
            PG8_STAGE(PG8_SB(0, 1), b2 + hstep, voffB);
            PG8_WAIT_V(6); PG8_BAR; PG8_MMA(1, 1, At, B1); PG8_BAR;
            PG8_LDB(B0, 1, 0); PG8_SCHED; PG8_LDA(At, 1, 0); PG8_STAGE(PG8_SA(0, 1), a2 + hstep, voffA);
            PG8_WAIT_L(8); PG8_BAR; PG8_WAIT_L(0); PG8_MMA(0, 0, At, B0); PG8_BAR; PG8_SCHED;
            PG8_LDB(B1, 1, 1); PG8_STAGE(PG8_SB(1, 0), b3, voffB);
            PG8_BAR; PG8_WAIT_L(0); PG8_MMA(0, 1, At, B1); PG8_BAR;
            PG8_LDA(At, 1, 1); PG8_STAGE(PG8_SA(1, 0), a3, voffA);
            PG8_BAR; PG8_WAIT_L(0); PG8_MMA(1, 0, At, B0); PG8_BAR; PG8_SCHED;
            PG8_STAGE(PG8_SB(1, 1), b3 + hstep, voffB);
            PG8_WAIT_V(6); PG8_BAR; PG8_MMA(1, 1, At, B1); PG8_BAR;
            }
        }
        if constexpr (ALIGN_EPI) { if (wr == 0) PG8_BAR; }
        if constexpr (!Epi::AFTER_DRAIN) { E(acc, cur, wr, wc, fr, fq); S.done(cur); }
        if (!has_next) break;
{ float zf = 0.f; asm volatile("" : "+v"(zf));
#pragma unroll
        for (int a = 0; a < 2; ++a)
#pragma unroll
            for (int b = 0; b < 2; ++b)
#pragma unroll
                for (int m = 0; m < 4; ++m)
#pragma unroll
                    for (int n = 0; n < 2; ++n) acc[a][b][m][n] = (f32x4){zf, zf, zf, zf}; }
        cur = nxt; cA = nA; cB = nB; ++ui;
        if constexpr (ALIGN_EPI) { if (wr == 1) PG8_BAR; }
    }
    PG8_WAIT_V(0);
    if constexpr (!ALIGN_EPI) { if (wr == 0) PG8_BAR; }
    PG8_BAR;
    if constexpr (Epi::AFTER_DRAIN) { E.fused(acc, cur, wr, wc, fr, fq, lds, wid, lane); S.done(cur); }
#undef PG8_SA
#undef PG8_SB
#undef PG8_STAGE
#undef PG8_LDA
#undef PG8_LDB
#undef PG8_MMA
#undef PG8_WAIT_V
#undef PG8_WAIT_L
#undef PG8_BAR
#undef PG8_SCHED
}
}

#ifndef LAS
#define LAS __attribute__((address_space(3)))
#endif
#ifdef HOST_EMU
#define PAS
#else
#define PAS __attribute__((address_space(4)))
#endif
typedef unsigned short bf16;
typedef float f32x4 __attribute__((ext_vector_type(4)));
typedef unsigned v4u __attribute__((ext_vector_type(4)));
typedef unsigned v2u __attribute__((ext_vector_type(2)));

#ifndef SEQ_
#define SEQ_ 4096
#define CTXL_ 256
#endif
constexpr int D = 1024, NB = 8, SEQ = SEQ_, CTXL = CTXL_, DEPTH = 4;
constexpr int RC = NB * CTXL;
constexpr int RL = NB * SEQ;
constexpr int RT = RC + RL;
constexpr int NIN = 7360, DFF = 2816;
constexpr int NTHR = 512, NWAVES = 8;
constexpr int LDS_BYTES = 147456;

constexpr size_t MiB = (size_t)1 << 20;
constexpr size_t WS_CTL = 0;
constexpr size_t WS_MOD = 1 * MiB;
constexpr size_t WS_W   = 2 * MiB;
constexpr size_t WS_XC  = 37 * MiB;
constexpr size_t WS_U   = 45 * MiB;
constexpr size_t WS_Y   = 113 * MiB;
constexpr size_t WS_BIG = 181 * MiB;
constexpr size_t WS_END = 471 * MiB;
constexpr size_t SZ17 = (size_t)RT * 256 * 2;
constexpr size_t SZ34 = (size_t)RT * 256 * 4;
constexpr size_t WO_WP = 0;
constexpr size_t WO_WG = WO_WP + (size_t)3328 * 1024;
constexpr size_t WO_BR = WO_WG + (size_t)4096 * 1024;
constexpr size_t WO_WO = WO_BR + (size_t)4 * 1024 * 256;
constexpr size_t WO_W1 = WO_WO + (size_t)1024 * 1024;
constexpr size_t WO_W2 = WO_W1 + (size_t)5632 * 1024;
static_assert((WO_W2 + (size_t)1024 * 2816) * 2 <= 35 * MiB, "weights region");
constexpr size_t BG_P = 0;
constexpr size_t BG_S = 68 * MiB;

struct Prm { const float* in[41]; float* out; unsigned char* ws; int lo, hi; };

__device__ __forceinline__ float bf2f(bf16 b) { return __uint_as_float(((unsigned)b) << 16); }
__device__ __forceinline__ bf16 f2bf(float f) { unsigned u = __float_as_uint(f); return (bf16)((u + 0x7fffu + ((u >> 16) & 1u)) >> 16); }
__device__ __forceinline__ unsigned pk2(float lo, float hi) { return (unsigned)f2bf(lo) | ((unsigned)f2bf(hi) << 16); }
__device__ __forceinline__ float blo(unsigned u) { return __uint_as_float(u << 16); }
__device__ __forceinline__ float bhi(unsigned u) { return __uint_as_float(u & 0xffff0000u); }
__device__ __forceinline__ float sigmoidf_(float x) { return 1.f / (1.f + __expf(-x)); }
__device__ __forceinline__ float softplusf_(float x) { return x > 20.f ? x : log1pf(__expf(x)); }
template <int CTRL> __device__ __forceinline__ float dpp_mov(float v) { return __int_as_float(__builtin_amdgcn_update_dpp(0, __float_as_int(v), CTRL, 0xF, 0xF, true)); }
__device__ __forceinline__ float row16_sum(float v) {
    v += dpp_mov<0xB1>(v);
    v += dpp_mov<0x4E>(v);
    v += dpp_mov<0x141>(v);
    v += dpp_mov<0x140>(v);
    return v;
}
#ifdef HOST_EMU
__device__ __forceinline__ float wave_sum(float v) {
#pragma unroll
    for (int o = 1; o < 64; o <<= 1) v += __shfl_xor(v, o);
    return v;
}
#else
__device__ __forceinline__ float wave_sum(float v) {
    v = row16_sum(v);
    v += __int_as_float(__builtin_amdgcn_ds_swizzle(__float_as_int(v), 0x401F));
    return __int_as_float(__builtin_amdgcn_readlane(__float_as_int(v), 0)) + __int_as_float(__builtin_amdgcn_readlane(__float_as_int(v), 32));
}
#endif

#ifndef HOST_EMU
#define XB_TMO      128
#define XB_XCNT(j)  (256  + 64 * (j))
#define XB_XSUB(j)  (1280 + 64 * (j))
#define XB_XGEN(j)  (2304 + 64 * (j))
#define XB_TOP      3328
#define XB_TOPGEN   3392
#define XCD_BAR_WORDS 3456
#define XB_SPIN_CAP (1u << 18)
__device__ __forceinline__ unsigned xb_ld(unsigned* p)              { return __hip_atomic_load(p, __ATOMIC_RELAXED, __HIP_MEMORY_SCOPE_AGENT); }
__device__ __forceinline__ unsigned xb_add(unsigned* p, unsigned v) { return __hip_atomic_fetch_add(p, v, __ATOMIC_RELAXED, __HIP_MEMORY_SCOPE_AGENT); }
__device__ __forceinline__ unsigned xb_xcc_id() { return (unsigned)__builtin_amdgcn_s_getreg((3 << 11) | 20) & 0xFu; }
#define XB_SPIN(cond, bar) do { unsigned _sp = 0; while (cond) { __builtin_amdgcn_s_sleep(1); \
    if ((++_sp & 255u) == 0u) { if (xb_ld(&(bar)[XB_TMO])) break; if (_sp > XB_SPIN_CAP) { atomicAdd(&(bar)[XB_TMO], 1u); break; } } } } while (0)
struct XcdBarrier { unsigned* bar; unsigned x; volatile LAS unsigned* st; };
__device__ __forceinline__ XcdBarrier xcd_barrier_post(unsigned* bar, volatile LAS unsigned* st) {
    XcdBarrier b; b.bar = bar; b.x = xb_xcc_id(); b.st = st;
    if (threadIdx.x == 0) (void)xb_add(&bar[XB_XCNT(b.x)], 1u);
    return b;
}
__device__ __forceinline__ void xcd_barrier_complete(unsigned* bar, unsigned x, unsigned& nloc, unsigned& nx) {
    const unsigned G = gridDim.x * gridDim.y * gridDim.z;
    unsigned sum, cnt, mine, sp = 0u;
    for (;;) {
        sum = 0u; cnt = 0u; mine = 0u;
#pragma unroll
        for (unsigned j = 0; j < 16; ++j) { const unsigned c = xb_ld(&bar[XB_XCNT(j)]); sum += c; cnt += (c > 0u) ? 1u : 0u; mine = (j == x) ? c : mine; }
        if (sum == G) break;
        __builtin_amdgcn_s_sleep(1);
        if ((++sp & 255u) == 0u) { if (xb_ld(&bar[XB_TMO])) break; if (sp > XB_SPIN_CAP) { atomicAdd(&bar[XB_TMO], 1u); break; } }
    }
    nloc = mine > 0u ? mine : 1u; nx = cnt > 0u ? cnt : 1u;
}
__device__ __forceinline__ void xcd_barrier(const XcdBarrier& b) {
    asm volatile("s_waitcnt vmcnt(0)" ::: "memory");
    __syncthreads();
    if (tid_opq() == 0) {
        unsigned* bar = b.bar; asm volatile("" : "+v"(bar));
        __builtin_amdgcn_s_waitcnt(0);
        unsigned nloc = b.st[0], nx = b.st[1];
        if (nloc == 0u) { xcd_barrier_complete(bar, b.x, nloc, nx); b.st[0] = nloc; b.st[1] = nx; }
        const unsigned old = xb_add(&bar[XB_XSUB(b.x)], 1u);
        const unsigned gen = old / nloc;
        if (old + 1u == (gen + 1u) * nloc) {
            __builtin_amdgcn_fence(__ATOMIC_RELEASE, "agent");
            asm volatile("s_waitcnt vmcnt(0)" ::: "memory");
            const unsigned og = xb_add(&bar[XB_TOP], 1u);
            const unsigned tg = og / nx;
            if (og + 1u == (tg + 1u) * nx) xb_add(&bar[XB_TOPGEN], 1u);
            else XB_SPIN(xb_ld(&bar[XB_TOPGEN]) == tg, bar);
            __builtin_amdgcn_fence(__ATOMIC_ACQUIRE, "agent");
            xb_add(&bar[XB_XGEN(b.x)], 1u);
            asm volatile("s_waitcnt vmcnt(0)" ::: "memory");
        } else {
            XB_SPIN(xb_ld(&bar[XB_XGEN(b.x)]) == gen, bar);
            __builtin_amdgcn_fence(__ATOMIC_ACQUIRE, "agent");
            asm volatile("s_waitcnt vmcnt(0)" ::: "memory");
        }
    }
    __syncthreads();
}

#endif
#ifdef HOST_EMU
#define TID ((int)threadIdx.x)
#define BID ((int)blockIdx.x)
#define NBLK ((int)gridDim.x)
#else
#define TID tid_opq()
#define BID ((int)blockIdx.x)
#define NBLK ((int)gridDim.x)
#endif

__device__ __forceinline__ void ph_mod(const PAS Prm& p, LAS unsigned char* lds) {
    LAS float* sc = (LAS float*)lds;
    LAS float* red = sc + 9 * 1024;
    const float* c = p.in[1]; const float* cctx = p.in[3]; const float* w_mod = p.in[4]; const float* b_mod = p.in[5];
    float* mod = (float*)(p.ws + WS_MOD);
    const int tid = TID, lane = tid & 63, wave = tid >> 6;
    for (int i = tid; i < 9 * 1024; i += NTHR) { const int j = i >> 10, k = i & 1023; const float v = (j < 8) ? c[j * 1024 + k] : cctx[k]; sc[i] = v / (1.f + expf(-v)); }
    __syncthreads();
    for (int it = BID; it < 4 * 96; it += NBLK) {
        const int l = it / 96, cg = it % 96, col = cg * 64 + lane;
        float acc[9];
#pragma unroll
        for (int j = 0; j < 9; ++j) acc[j] = 0.f;
        const float* W = w_mod + (size_t)l * 1024 * 6144 + col;
        for (int k = wave * 128; k < wave * 128 + 128; ++k) { const float w = W[(size_t)k * 6144];
#pragma unroll
            for (int j = 0; j < 9; ++j) acc[j] += sc[j * 1024 + k] * w; }
#pragma unroll
        for (int j = 0; j < 9; ++j) red[(wave * 9 + j) * 64 + lane] = acc[j];
        __syncthreads();
        for (int i = tid; i < 9 * 64; i += NTHR) { const int j = i >> 6, ln = i & 63; float s = b_mod[l * 6144 + cg * 64 + ln];
#pragma unroll
            for (int w = 0; w < 8; ++w) s += red[(w * 9 + j) * 64 + ln];
            mod[((size_t)l * 9 + j) * 6144 + cg * 64 + ln] = s; }
        __syncthreads();
    }
}

#ifdef HOST_EMU
#define PH_ZOPQ(z) do { } while (0)
#else
#define PH_ZOPQ(z) asm volatile("" : "+v"(z))
#endif
#ifdef HOST_EMU
#define LGKM_WAIT() do { (void)emu_xchg(0, threadIdx.x & 63); } while (0)
#else
#define LGKM_WAIT() asm volatile("s_waitcnt lgkmcnt(0)" ::: "memory")
#endif
__device__ __forceinline__ void cvt_item(const float* W, size_t ldw, int k0, int n0, bf16* WT, int K, int drow0, LAS float* scr, int lane) {
#pragma unroll 8
    for (int i = 0; i < 32; ++i) { const int kk = 2 * i + (lane >> 5); scr[kk * 33 + (lane & 31)] = W[(size_t)(k0 + kk) * ldw + n0 + (lane & 31)]; }
    LGKM_WAIT();
    const int c = lane & 7;
#pragma unroll
    for (int j = 0; j < 4; ++j) { const int n = (lane >> 3) + 8 * j; const LAS float* s = scr + (8 * c) * 33 + n;
        v4u o; o.x = pk2(s[0 * 33], s[1 * 33]); o.y = pk2(s[2 * 33], s[3 * 33]); o.z = pk2(s[4 * 33], s[5 * 33]); o.w = pk2(s[6 * 33], s[7 * 33]);
        *(v4u*)(WT + (size_t)(drow0 + n) * K + k0 + 8 * c) = o; }
    LGKM_WAIT();
}
__device__ __forceinline__ void ph_cvt(const PAS Prm& p, int l, LAS unsigned char* lds) {
    const int tid = TID, lane = tid & 63, wave = tid >> 6;
    LAS float* scr = (LAS float*)(lds + wave * 16384);
    bf16* WB = (bf16*)(p.ws + WS_W);
    const float* w_in = p.in[8] + (size_t)l * 1024 * NIN;
    const float* brp = p.in[36] + (size_t)l * 4 * 256 * 1024;
    const float* wout = p.in[37] + (size_t)l * 1024 * 1024;
    const float* w1 = p.in[38] + (size_t)l * 1024 * 5632;
    const float* w2 = p.in[39] + (size_t)l * 2816 * 1024;
    constexpr int I_IN = 16 * 230, I_BR = 4 * 4 * 32, I_WO = 16 * 32, I_W1 = 16 * 176, I_W2 = 44 * 32, I_PAD = 16;
    constexpr int NITEMS = I_IN + I_BR + I_WO + I_W1 + I_W2 + I_PAD;
    const int gw = BID * NWAVES + wave, NGW = NBLK * NWAVES;
    for (int it = gw; it < NITEMS; it += NGW) {
        int r = it;
        if (r < I_IN) { const int kb = r / 230, nb = r % 230, n0 = nb * 32;
            if (n0 < 3264) { const int drow = n0 < 1728 ? n0 : n0 + 64; cvt_item(w_in, NIN, kb * 64, n0, WB + WO_WP, 1024, drow, scr, lane);
            } else { cvt_item(w_in, NIN, kb * 64, n0, WB + WO_WG, 1024, n0 - 3264, scr, lane); }
            continue; }
        r -= I_IN;
        if (r < I_BR) { const int n = r / 128, q = r % 128, kb = q / 32, nb = q % 32;
            cvt_item(brp + (size_t)n * 256 * 1024, 1024, kb * 64, nb * 32, WB + WO_BR + (size_t)n * 1024 * 256, 256, nb * 32, scr, lane); continue; }
        r -= I_BR;
        if (r < I_WO) { const int kb = r / 32, nb = r % 32; cvt_item(wout, 1024, kb * 64, nb * 32, WB + WO_WO, 1024, nb * 32, scr, lane); continue; }
        r -= I_WO;
        if (r < I_W1) { const int kb = r / 176, nb = r % 176, n0 = nb * 32; const int hh = n0 / 2816, jj = n0 % 2816, pn = jj / 128, j2 = jj % 128;
            cvt_item(w1, 5632, kb * 64, n0, WB + WO_W1, 1024, 256 * pn + 128 * hh + j2, scr, lane); continue; }
        r -= I_W1;
        if (r < I_W2) { const int kb = r / 32, nb = r % 32; cvt_item(w2, 1024, kb * 64, nb * 32, WB + WO_W2, 2816, nb * 32, scr, lane); continue; }
        r -= I_W2;
        {
            unsigned z0 = 0u; PH_ZOPQ(z0); v4u z = (v4u){z0, z0, z0, z0};
            for (int i = lane; i < 4 * 128; i += 64) { const int rr = 1728 + r * 4 + i / 128, cc = (i % 128) * 8; *(v4u*)(WB + WO_WP + (size_t)rr * 1024 + cc) = z; }
        }
    }
}

__device__ __forceinline__ void ph_norm(const PAS Prm& p, int l, int which, const float* xc_src, const float* xl_src, int r_begin) {
    const int tid = TID, lane = tid & 63, wave = tid >> 6;
    const float* mod = (const float*)(p.ws + WS_MOD) + (size_t)l * 9 * 6144;
    const float* g = (which ? p.in[7] : p.in[6]) + l * 1024;
    bf16* U = (bf16*)(p.ws + WS_U);
    const int gw = BID * NWAVES + wave, NGW = NBLK * NWAVES;
    for (int r = r_begin + gw; r < RT; r += NGW) {
        const float* xr = (r < RC) ? xc_src + (size_t)r * 1024 : xl_src + (size_t)(r - RC) * 1024;
        const int jb = (r < RC) ? 8 : (r - RC) / SEQ;
        const float* shift = mod + (size_t)jb * 6144 + (which ? 3 * 1024 : 0);
        const float* scale = shift + 1024;
        f32x4 v[4]; float s = 0.f;
#pragma unroll
        for (int j = 0; j < 4; ++j) { v[j] = *(const f32x4*)(xr + 4 * lane + 256 * j); s += (v[j].x * v[j].x + v[j].y * v[j].y) + (v[j].z * v[j].z + v[j].w * v[j].w); }
        const float rstd = rsqrtf(wave_sum(s) * (1.f / 1024.f) + 1e-6f);
#pragma unroll
        for (int j = 0; j < 4; ++j) { const int c0 = 4 * lane + 256 * j;
            const f32x4 gg = *(const f32x4*)(g + c0), sc = *(const f32x4*)(scale + c0), sh = *(const f32x4*)(shift + c0);
            const f32x4 o = v[j] * rstd * gg * (1.f + sc) + sh;
            v2u w; w.x = pk2(o.x, o.y); w.y = pk2(o.z, o.w);
            *(v2u*)(U + (size_t)r * 1024 + c0) = w; }
    }
}
__device__ __forceinline__ void ph_final(const PAS Prm& p) {
    const int tid = TID, lane = tid & 63, wave = tid >> 6;
    const float* g = p.in[40];
    const float poison = (*(const volatile unsigned*)(p.ws + WS_CTL + 768 * 1024) != 0u) ? __builtin_nanf("") : 0.f;
    const int gw = BID * NWAVES + wave, NGW = NBLK * NWAVES;
    for (int r = gw; r < RL; r += NGW) {
        float* xr = p.out + (size_t)r * 1024;
        f32x4 v[4]; float s = 0.f;
#pragma unroll
        for (int j = 0; j < 4; ++j) { v[j] = *(const f32x4*)(xr + 4 * lane + 256 * j); s += (v[j].x * v[j].x + v[j].y * v[j].y) + (v[j].z * v[j].z + v[j].w * v[j].w); }
        const float rstd = rsqrtf(wave_sum(s) * (1.f / 1024.f) + 1e-6f);
#pragma unroll
        for (int j = 0; j < 4; ++j) { const int c0 = 4 * lane + 256 * j; const f32x4 gg = *(const f32x4*)(g + c0); *(f32x4*)(xr + c0) = v[j] * rstd * gg + poison; }
    }
}

struct RowInfo { int lat, b, t, T, base; };
__device__ __forceinline__ RowInfo row_info(int r) {
    RowInfo q;
    if (r < RC) { q.lat = 0; q.b = r / CTXL; q.t = r % CTXL; q.T = CTXL; q.base = q.b * CTXL; }
    else { const int x = r - RC; q.lat = 1; q.b = x / SEQ; q.t = x % SEQ; q.T = SEQ; q.base = RC + q.b * SEQ; }
    return q;
}
__device__ __forceinline__ int scan_row(int b, int d, int tau) {
    if (tau < CTXL) return b * CTXL + (d ? (CTXL - 1 - tau) : tau);
    const int t = tau - CTXL; return RC + b * SEQ + (d ? (SEQ - 1 - t) : t);
}

constexpr size_t RW_R = 0, RW_K = SZ17, RW_V = 2 * SZ17, RW_KK = 3 * SZ17, RW_OM = 4 * SZ17  , RW_A = 6 * SZ17  , RW_G = 8 * SZ17, RW_Y = 9 * SZ17  , RW_BON = 9 * SZ17 + 2 * SZ34;
static_assert(RW_BON + (size_t)RT * 16 <= 222 * MiB, "rwkv scratch");

__device__ __forceinline__ void ph_rw_prep(const PAS Prm& p, int l, LAS unsigned char* lds) {
    LAS float* xx = (LAS float*)lds;
    const int tid = TID, lane = tid & 63;
    const bf16* P = (const bf16*)(p.ws + WS_BIG + BG_P);
    unsigned char* S = p.ws + WS_BIG + BG_S;
    bf16* oR = (bf16*)(S + RW_R); bf16* oK = (bf16*)(S + RW_K); bf16* oV = (bf16*)(S + RW_V); bf16* oKK = (bf16*)(S + RW_KK);
    bf16* oOM = (bf16*)(S + RW_OM); bf16* oA = (bf16*)(S + RW_A); bf16* oG = (bf16*)(S + RW_G); float* oBon = (float*)(S + RW_BON);
    const float* mu = p.in[18] + l * 960;
    const float* w0 = p.in[19] + l * 512; const float* w2 = p.in[20] + (size_t)l * 2 * 64 * 256;
    const float* a0 = p.in[21] + l * 512; const float* a2 = p.in[22] + (size_t)l * 2 * 64 * 256;
    const float* g2 = p.in[23] + (size_t)l * 64 * 256;
    const float* k_k = p.in[24] + l * 256; const float* r_k = p.in[26] + l * 256;
    const int j = tid & 255, half = tid >> 8, h = j >> 6;
    for (int tile = BID; tile < RT / 16; tile += NBLK) {
        const int r0 = tile * 16;
        for (int i = tid; i < 16 * 960; i += NTHR) {
            const int rr = i / 960, c = i % 960, r = r0 + rr, q = c & 3;
            const RowInfo ri = row_info(r);
            int nb = -1;
            if (ri.lat) {
                const int gc = ri.t & 63, gr = ri.t >> 6;
                if (q == 0) { if (gc >= 1) nb = r - 1; } else if (q == 1) { if (gc <= 62) nb = r + 1; }
                else if (q == 2) { if (gr >= 1) nb = r - 64; } else { if (gr <= SEQ / 64 - 2) nb = r + 64; }
            } else {
                if ((q & 1) == 0) { if (ri.t >= 1) nb = r - 1; } else { if (ri.t <= CTXL - 2) nb = r + 1; }
            }
            const float pv = bf2f(P[(size_t)r * 1024 + c]);
            const float sv = nb >= 0 ? bf2f(P[(size_t)nb * 1024 + c]) : 0.f;
            float x = pv + (sv - pv) * mu[c];
            if (c >= 768 && c < 832) x = tanhf(x); else if (c >= 896) x = sigmoidf_(x);
            xx[rr * 960 + c] = x;
        }
        __syncthreads();
        float aw0[8], aw1[8], aa0[8], aa1[8], ag[8];
#pragma unroll
        for (int q = 0; q < 8; ++q) { aw0[q] = 0.f; aw1[q] = 0.f; aa0[q] = 0.f; aa1[q] = 0.f; ag[q] = 0.f; }
        for (int i = 0; i < 64; ++i) {
            const float w20 = w2[i * 256 + j], w21 = w2[64 * 256 + i * 256 + j], a20 = a2[i * 256 + j], a21 = a2[64 * 256 + i * 256 + j], g2v = g2[i * 256 + j];
#pragma unroll
            for (int q = 0; q < 8; ++q) { const LAS float* xr = xx + (half * 8 + q) * 960;
                const float cw = xr[768 + i], ca = xr[832 + i], cg = xr[896 + i];
                aw0[q] += cw * w20; aw1[q] += cw * w21; aa0[q] += ca * a20; aa1[q] += ca * a21; ag[q] += cg * g2v; }
        }
        const float kkj = k_k[j], rkj = r_k[j], w00 = w0[j], w01 = w0[256 + j], a00 = a0[j], a01 = a0[256 + j];
#pragma unroll
        for (int q = 0; q < 8; ++q) {
            const int rr = half * 8 + q; const size_t r = (size_t)(r0 + rr);
            const float rv = xx[rr * 960 + j], kv = xx[rr * 960 + 256 + j], vv = xx[rr * 960 + 512 + j];
            const float kkr = kv * kkj;
            const float ss = wave_sum(kkr * kkr);
            const float kkn = kkr * rsqrtf(ss + 1e-12f);
            const float bon = wave_sum(rv * kv * rkj);
            oR[r * 256 + j] = f2bf(rv); oK[r * 256 + j] = f2bf(kv); oV[r * 256 + j] = f2bf(vv); oKK[r * 256 + j] = f2bf(kkn);
            oG[r * 256 + j] = f2bf(ag[q]);
            if (lane == 0) oBon[r * 4 + h] = bon;
#pragma unroll
            for (int d = 0; d < 2; ++d) {
                const float wv = (d ? w01 : w00) + (d ? aw1[q] : aw0[q]);
                const float logw = -softplusf_(-wv) - 0.5f;
                const float om = -expm1f(-expf(logw));
                const float av = sigmoidf_((d ? a01 : a00) + (d ? aa1[q] : aa0[q]));
                oOM[(size_t)d * RT * 256 + r * 256 + j] = f2bf(om);
                oA[(size_t)d * RT * 256 + r * 256 + j] = f2bf(av);
            }
        }
        __syncthreads();
    }
}

template <int MODE>
__device__ __forceinline__ void scan_phase(const unsigned char* Sb  , const bf16* Pv  , float* Yout  ,
                                           const float* ka  , const float* gam  , LAS unsigned char* lds) {
    constexpr int NF = MODE == 0 ? 5 : 2;
    constexpr int CH = 32, ARRB = CH * 256, VOFF = NF * ARRB, BUFB = VOFF + CH * 128, NCH = (CTXL + SEQ) / CH;
    const int tid = TID, lane = tid & 63, wave = tid >> 6;
    if (BID >= 128) return;
    const int prob = BID >> 1, b = prob >> 3, h = (prob >> 1) & 3, d = prob & 1;
    const int rowv = 32 * (BID & 1) + 4 * wave + (lane >> 4);
    const int kl = lane & 15;
    const int st_s = (tid & 255) >> 3, st_g = tid & 7;
    const bool st_v = tid >= 256;
    float kav[8];
    float gamma = 0.f;
#pragma unroll
    for (int i = 0; i < 8; ++i) kav[i] = (MODE == 0) ? ka[h * 64 + 8 * st_g + i] : 0.f;
    if (MODE == 1) gamma = sigmoidf_(gam[d * 4 + h]);
    const size_t colb = (size_t)(h * 64 + st_g * 8) * 2;
    const unsigned char* src0 = Sb + colb;
    const unsigned char* srcv = (MODE == 0) ? Sb + 2 * SZ17 + colb : (const unsigned char*)Pv + (size_t)(512 + h * 64 + st_g * 8) * 2;
    const size_t ldv = (MODE == 0) ? 512 : 2048;
    float S[4] = {0.f, 0.f, 0.f, 0.f};
    v4u pre[NF];
#define SCAN_ISSUE(c) do { const size_t row = (size_t)scan_row(b, d, (c) * CH + st_s); \
        if (st_v) pre[0] = *(const v4u*)(srcv + row * ldv); \
        else if (MODE == 0) { pre[0] = *(const v4u*)(src0 + row * 512); pre[1] = *(const v4u*)(src0 + 1 * SZ17 + row * 512); pre[2] = *(const v4u*)(src0 + 3 * SZ17 + row * 512); \
                              pre[3] = *(const v4u*)(src0 + (size_t)(4 + d) * SZ17 + row * 512); pre[4] = *(const v4u*)(src0 + (size_t)(6 + d) * SZ17 + row * 512); } \
        else { pre[0] = *(const v4u*)(src0 + row * 512); pre[1] = *(const v4u*)(src0 + 1 * SZ17 + row * 512); } } while (0)
#define SCAN_COMMIT(buf) do { LAS unsigned char* bp = lds + (buf) * BUFB; \
        if (st_v) *(LAS v4u*)(bp + VOFF + st_s * 128 + st_g * 16) = pre[0]; \
        else { LAS float* o = (LAS float*)(bp + st_s * 256 + st_g * 32); \
            if (MODE == 0) { _Pragma("unroll") for (int i = 0; i < 4; ++i) { \
                const unsigned ur = ((const unsigned*)&pre[0])[i], uk = ((const unsigned*)&pre[1])[i], ukk = ((const unsigned*)&pre[2])[i], uom = ((const unsigned*)&pre[3])[i], ua = ((const unsigned*)&pre[4])[i]; \
                const float a0 = blo(ua), a1 = bhi(ua), kk0 = blo(ukk), kk1 = bhi(ukk); \
                o[0 * (ARRB / 4) + 2 * i] = blo(ur); o[0 * (ARRB / 4) + 2 * i + 1] = bhi(ur); \
                o[1 * (ARRB / 4) + 2 * i] = 1.f - blo(uom); o[1 * (ARRB / 4) + 2 * i + 1] = 1.f - bhi(uom); \
                o[2 * (ARRB / 4) + 2 * i] = blo(uk) * (1.f + (a0 - 1.f) * kav[2 * i]); o[2 * (ARRB / 4) + 2 * i + 1] = bhi(uk) * (1.f + (a1 - 1.f) * kav[2 * i + 1]); \
                o[3 * (ARRB / 4) + 2 * i] = kk0 * a0; o[3 * (ARRB / 4) + 2 * i + 1] = kk1 * a1; \
                o[4 * (ARRB / 4) + 2 * i] = kk0; o[4 * (ARRB / 4) + 2 * i + 1] = kk1; } } \
            else { _Pragma("unroll") for (int i = 0; i < 4; ++i) { const unsigned uq = ((const unsigned*)&pre[0])[i], uk = ((const unsigned*)&pre[1])[i]; \
                o[0 * (ARRB / 4) + 2 * i] = blo(uq); o[0 * (ARRB / 4) + 2 * i + 1] = bhi(uq); o[1 * (ARRB / 4) + 2 * i] = blo(uk); o[1 * (ARRB / 4) + 2 * i + 1] = bhi(uk); } } } } while (0)
    SCAN_ISSUE(0); SCAN_COMMIT(0); __syncthreads();
    for (int c = 0; c < NCH; ++c) {
        if (c + 1 < NCH) SCAN_ISSUE(c + 1);
        const LAS unsigned char* bufp = lds + (c & 1) * BUFB;
        const int row_first = scan_row(b, d, c * CH);
        float* yp = Yout + ((size_t)d * RT + row_first) * 256 + h * 64 + rowv;
        const int ystep = d ? -256 : 256;
#pragma unroll 4
        for (int s = 0; s < CH; ++s) {
            const LAS unsigned char* sp = bufp + s * 256 + kl * 16;
            const float vv = bf2f(*(const LAS bf16*)(bufp + VOFF + s * 128 + rowv * 2));
            float y;
            if (MODE == 0) {
                const f32x4 rr = *(const LAS f32x4*)(sp), ww = *(const LAS f32x4*)(sp + ARRB), kt = *(const LAS f32x4*)(sp + 2 * ARRB), bb = *(const LAS f32x4*)(sp + 3 * ARRB), kk = *(const LAS f32x4*)(sp + 4 * ARRB);
                const float sap = (S[0] * kk.x + S[1] * kk.y) + (S[2] * kk.z + S[3] * kk.w);
                const float sa = -row16_sum(sap);
                S[0] = S[0] * ww.x + (sa * bb.x + vv * kt.x); S[1] = S[1] * ww.y + (sa * bb.y + vv * kt.y);
                S[2] = S[2] * ww.z + (sa * bb.z + vv * kt.z); S[3] = S[3] * ww.w + (sa * bb.w + vv * kt.w);
                y = row16_sum((S[0] * rr.x + S[1] * rr.y) + (S[2] * rr.z + S[3] * rr.w));
            } else {
                const f32x4 qq = *(const LAS f32x4*)(sp), kr = *(const LAS f32x4*)(sp + ARRB);
                S[0] = S[0] * gamma + vv * kr.x; S[1] = S[1] * gamma + vv * kr.y; S[2] = S[2] * gamma + vv * kr.z; S[3] = S[3] * gamma + vv * kr.w;
                y = row16_sum((S[0] * qq.x + S[1] * qq.y) + (S[2] * qq.z + S[3] * qq.w));
            }
            if (kl == 0) yp[(ptrdiff_t)s * ystep] = y;
        }
        if (c + 1 < NCH) SCAN_COMMIT((c + 1) & 1);
        __syncthreads();
    }
#undef SCAN_ISSUE
#undef SCAN_COMMIT
}

__device__ __forceinline__ void ph_rw_post(const PAS Prm& p, int l) {
    const int tid = TID, j = tid & 255, h = j >> 6;
    unsigned char* S = p.ws + WS_BIG + BG_S;
    const float* Y = (const float*)(S + RW_Y); const bf16* V = (const bf16*)(S + RW_V); const bf16* G = (const bf16*)(S + RW_G); const float* Bon = (const float*)(S + RW_BON);
    bf16* yrw = (bf16*)(p.ws + WS_Y + 1 * SZ17);
    const float lng = p.in[27][l * 256 + j];
    for (int r = BID * 2 + (tid >> 8); r < RT; r += NBLK * 2) {
        const size_t o = (size_t)r * 256 + j;
        const float y = Y[o] + Y[(size_t)RT * 256 + o];
        const float mean = wave_sum(y) * (1.f / 64.f); const float dv = y - mean;
        const float var = wave_sum(dv * dv) * (1.f / 64.f);
        float v = dv * rsqrtf(var + 64e-5f) * lng;
        v += Bon[(size_t)r * 4 + h] * bf2f(V[o]);
        v *= bf2f(G[o]);
        yrw[o] = f2bf(v);
    }
}

constexpr size_t RT_Q = 0, RT_K = SZ17, RT_Y = 2 * SZ17  ;
__device__ __forceinline__ void ph_ret_prep(const PAS Prm& p) {
    const int tid = TID, j = tid & 255;
    const bf16* P = (const bf16*)(p.ws + WS_BIG + BG_P);
    unsigned char* S = p.ws + WS_BIG + BG_S;
    bf16* oQ = (bf16*)(S + RT_Q); bf16* oK = (bf16*)(S + RT_K);
    const int hh = j & 63, i32 = hh & 31, idx = i32 & 15; const bool second = i32 >= 16, colhalf = hh >= 32;
    const float inv = exp2f(-(float)idx * (13.287712379549449f / 16.f));
    for (int r = BID * 2 + (tid >> 8); r < RT; r += NBLK * 2) {
        const size_t o = (size_t)r * 1024;
        float q = bf2f(P[o + j]), k = bf2f(P[o + 256 + j]);
        if (r >= RC) {
            const int t = (r - RC) & (SEQ - 1);
            const float coord = (float)(colhalf ? (t & 63) : (t >> 6));
            float sn, cs; sincosf(coord * inv, &sn, &cs);
            const int pj = second ? j - 16 : j + 16;
            const float qp = bf2f(P[o + pj]), kp = bf2f(P[o + 256 + pj]);
            q = second ? (qp * sn + q * cs) : (q * cs - qp * sn);
            k = second ? (kp * sn + k * cs) : (k * cs - kp * sn);
        }
        oQ[(size_t)r * 256 + j] = f2bf(q); oK[(size_t)r * 256 + j] = f2bf(k * 0.125f);
    }
}
__device__ __forceinline__ void ph_ret_post(const PAS Prm& p) {
    const int tid = TID, j = tid & 255;
    const bf16* P = (const bf16*)(p.ws + WS_BIG + BG_P);
    const float* Y = (const float*)(p.ws + WS_BIG + BG_S + RT_Y);
    bf16* yret = (bf16*)(p.ws + WS_Y + 3 * SZ17);
    for (int r = BID * 2 + (tid >> 8); r < RT; r += NBLK * 2) {
        const size_t o = (size_t)r * 256 + j;
        const float y = Y[o] + Y[(size_t)RT * 256 + o];
        const float mean = wave_sum(y) * (1.f / 64.f); const float dv = y - mean;
        const float var = wave_sum(dv * dv) * (1.f / 64.f);
        const float g = bf2f(P[(size_t)r * 1024 + 768 + j]);
        yret[o] = f2bf(dv * rsqrtf(var + 1e-5f) * (g * sigmoidf_(g)));
    }
}

constexpr size_t LR_A = 0  , LR_B = 2 * SZ34  ;
__device__ __forceinline__ void ph_lru_prep(const PAS Prm& p, int l, LAS unsigned char* lds) {
    LAS float* xc = (LAS float*)lds;
    const int tid = TID;
    const bf16* P = (const bf16*)(p.ws + WS_BIG + BG_P);
    float* A = (float*)(p.ws + WS_BIG + BG_S + LR_A); float* B = (float*)(p.ws + WS_BIG + BG_S + LR_B);
    const float* cw = p.in[28] + l * 4 * 256; const float* cb = p.in[29] + l * 256;
    const float* wa = p.in[30] + (size_t)l * 2 * 4 * 64 * 64; const float* ba = p.in[31] + l * 512;
    const float* wx = p.in[32] + (size_t)l * 2 * 4 * 64 * 64; const float* bx = p.in[33] + l * 512;
    const float* lam = p.in[34] + l * 512;
    const int j = tid & 255, half = tid >> 8, g = j >> 6, o = j & 63;
    const float sp0 = softplusf_(-lam[j]), sp1 = softplusf_(-lam[256 + j]);
    for (int tile = BID; tile < RT / 16; tile += NBLK) {
        const int r0 = tile * 16;
        for (int i = tid; i < 16 * 256; i += NTHR) {
            const int rr = i >> 8, jj = i & 255, r = r0 + rr; const RowInfo ri = row_info(r);
            float acc = cb[jj];
#pragma unroll
            for (int q = 0; q < 4; ++q) { const int tt = ri.t + q - 2; if (tt >= 0 && tt < ri.T) acc += cw[q * 256 + jj] * bf2f(P[(size_t)(ri.base + tt) * 512 + jj]); }
            xc[i] = acc;
        }
        __syncthreads();
        float ra0[8], ra1[8], rx0[8], rx1[8];
#pragma unroll
        for (int q = 0; q < 8; ++q) { ra0[q] = 0.f; ra1[q] = 0.f; rx0[q] = 0.f; rx1[q] = 0.f; }
        for (int i = 0; i < 64; ++i) {
            const float wa0 = wa[((0 * 4 + g) * 64 + i) * 64 + o], wa1 = wa[((1 * 4 + g) * 64 + i) * 64 + o], wx0 = wx[((0 * 4 + g) * 64 + i) * 64 + o], wx1 = wx[((1 * 4 + g) * 64 + i) * 64 + o];
#pragma unroll
            for (int q = 0; q < 8; ++q) { const float x = xc[(half * 8 + q) * 256 + g * 64 + i]; ra0[q] += x * wa0; ra1[q] += x * wa1; rx0[q] += x * wx0; rx1[q] += x * wx1; }
        }
#pragma unroll
        for (int q = 0; q < 8; ++q) {
            const int rr = half * 8 + q; const size_t r = (size_t)(r0 + rr); const float xcv = xc[rr * 256 + j];
#pragma unroll
            for (int d = 0; d < 2; ++d) {
                const float rg = sigmoidf_((d ? ra1[q] : ra0[q]) + ba[d * 256 + j]);
                const float ig = sigmoidf_((d ? rx1[q] : rx0[q]) + bx[d * 256 + j]);
                const float log_a = -8.f * rg * (d ? sp1 : sp0);
                const float a = expf(log_a);
                const float bv = sqrtf(-expm1f(2.f * log_a)) * (ig * xcv);
                A[((size_t)d * RT + r) * 256 + j] = a; B[((size_t)d * RT + r) * 256 + j] = bv;
            }
        }
        __syncthreads();
    }
}
constexpr int LCH = 64, NVC = CTXL / LCH, NVL = SEQ / LCH, NV = NVC + NVL;
constexpr size_t LR_PA = 4 * SZ34  , LR_QB = LR_PA + (size_t)2 * 8 * NV * 256 * 4;
__device__ __forceinline__ int lru_chunk_row0(int b, int v) { return v < NVC ? b * CTXL + v * LCH : RC + b * SEQ + (v - NVC) * LCH; }
__device__ __forceinline__ void ph_lru_agg(const PAS Prm& p) {
    const int tid = TID, j = tid & 255, half = tid >> 8;
    const float* A = (const float*)(p.ws + WS_BIG + BG_S + LR_A); const float* B = (const float*)(p.ws + WS_BIG + BG_S + LR_B);
    float* PA = (float*)(p.ws + WS_BIG + BG_S + LR_PA); float* QB = (float*)(p.ws + WS_BIG + BG_S + LR_QB);
    for (int task = BID * 2 + half; task < 2 * 8 * NV; task += NBLK * 2) {
        const int d = task / (8 * NV), b = (task / NV) % 8, v = task % NV;
        const int row0 = lru_chunk_row0(b, v);
        const float* Ad = A + (size_t)d * RT * 256 + j; const float* Bd = B + (size_t)d * RT * 256 + j;
        float P = 1.f, Q = 0.f;
        for (int i0 = 0; i0 < LCH; i0 += 8) {
            float a[8], bb[8];
#pragma unroll
            for (int q = 0; q < 8; ++q) { const int i = i0 + q; const size_t ro = (size_t)(row0 + (d ? LCH - 1 - i : i)) * 256; a[q] = Ad[ro]; bb[q] = Bd[ro]; }
#pragma unroll
            for (int q = 0; q < 8; ++q) { Q = a[q] * Q + bb[q]; P = a[q] * P; }
        }
        PA[(size_t)task * 256 + j] = P; QB[(size_t)task * 256 + j] = Q;
    }
}
__device__ __forceinline__ void ph_lru_fin(const PAS Prm& p, LAS unsigned char* lds) {
    LAS float* hf = (LAS float*)lds;
    const int tid = TID, j = tid & 255, half = tid >> 8;
    const bf16* P = (const bf16*)(p.ws + WS_BIG + BG_P);
    const float* A = (const float*)(p.ws + WS_BIG + BG_S + LR_A); const float* B = (const float*)(p.ws + WS_BIG + BG_S + LR_B);
    const float* PA = (const float*)(p.ws + WS_BIG + BG_S + LR_PA); const float* QB = (const float*)(p.ws + WS_BIG + BG_S + LR_QB);
    bf16* ylru = (bf16*)(p.ws + WS_Y + 2 * SZ17);
    for (int task = BID * 2 + half; task < 8 * NV; task += NBLK * 2) {
        const int b = task / NV, v = task % NV;
        const int row0 = lru_chunk_row0(b, v);
        float h = 0.f;
        { const float* pa = PA + ((size_t)(0 * 8 + b) * NV) * 256 + j; const float* qb = QB + ((size_t)(0 * 8 + b) * NV) * 256 + j;
          for (int u = 0; u < v; ++u) h = pa[(size_t)u * 256] * h + qb[(size_t)u * 256]; }
        float g = 0.f;
        { const float* pa = PA + ((size_t)(1 * 8 + b) * NV) * 256 + j; const float* qb = QB + ((size_t)(1 * 8 + b) * NV) * 256 + j;
          if (v < NVC) { for (int u = NVC - 1; u > v; --u) g = pa[(size_t)u * 256] * g + qb[(size_t)u * 256]; }
          else { for (int u = NVC - 1; u >= 0; --u) g = pa[(size_t)u * 256] * g + qb[(size_t)u * 256];
                 for (int u = NV - 1; u > v; --u) g = pa[(size_t)u * 256] * g + qb[(size_t)u * 256]; } }
        const float* A0 = A + j; const float* B0 = B + j; const float* A1 = A + (size_t)RT * 256 + j; const float* B1 = B + (size_t)RT * 256 + j;
        for (int i0 = 0; i0 < LCH; i0 += 8) {
            float a[8], bb[8];
#pragma unroll
            for (int q = 0; q < 8; ++q) { const size_t ro = (size_t)(row0 + i0 + q) * 256; a[q] = A0[ro]; bb[q] = B0[ro]; }
#pragma unroll
            for (int q = 0; q < 8; ++q) { h = a[q] * h + bb[q]; hf[(i0 + q) * 512 + tid] = h; }
        }
        for (int i0 = LCH - 8; i0 >= 0; i0 -= 8) {
            float a[8], bb[8], gx[8];
#pragma unroll
            for (int q = 0; q < 8; ++q) { const size_t r = (size_t)(row0 + i0 + 7 - q); a[q] = A1[r * 256]; bb[q] = B1[r * 256]; gx[q] = bf2f(P[r * 512 + 256 + j]); }
#pragma unroll
            for (int q = 0; q < 8; ++q) { g = a[q] * g + bb[q]; const int i = i0 + 7 - q; const float x = gx[q];
                const float ge = 0.5f * x * (1.f + tanhf(0.7978845608028654f * (x + 0.044715f * x * x * x)));
                ylru[(size_t)(row0 + i) * 256 + j] = f2bf((hf[i * 512 + tid] + g) * ge); }
        }
    }
}

constexpr size_t HY_VL = 0, HY_VC = 96 * MiB, HY_FL = 102 * MiB, HY_FC = 118 * MiB;
__device__ __forceinline__ void ph_hy_filter(const PAS Prm& p, int l, bool with_ctx, LAS unsigned char* lds) {
    LAS float* feat = (LAS float*)lds;
    LAS float* h1 = feat + 16 * 17;
    LAS float* h2 = h1 + 16 * 64;
    const int tid = TID;
    const float* w1 = p.in[11] + l * 17 * 64; const float* b1 = p.in[12] + l * 64; const float* w2 = p.in[13] + l * 64 * 64; const float* b2 = p.in[14] + l * 64;
    const float* w3 = p.in[15] + (size_t)l * 64 * 1024; const float* freq = p.in[16] + l * 128;
    float* FL = (float*)(p.ws + WS_BIG + BG_S + HY_FL); float* FC = (float*)(p.ws + WS_BIG + BG_S + HY_FC);
    const int ntile = with_ctx ? (SEQ + CTXL) / 16 : SEQ / 16;
    for (int tile = BID; tile < ntile; tile += NBLK) {
        const bool isctx = tile >= SEQ / 16; const int L = isctx ? CTXL : SEQ; const int pos0 = (isctx ? tile - SEQ / 16 : tile) * 16;
        float* F = isctx ? FC : FL;
        if (tid < 16 * 17) { const int pp = tid / 17, f = tid % 17; const float t = (float)(pos0 + pp) / (float)L;
            float v; if (f == 0) v = t; else if (f <= 8) v = sinf(6.283185307179586f * t * (float)f); else v = cosf(6.283185307179586f * t * (float)(f - 8));
            feat[tid] = v; }
        __syncthreads();
        for (int i = tid; i < 1024; i += NTHR) { const int pp = i >> 6, o = i & 63; float s = b1[o];
            for (int f = 0; f < 17; ++f) s += feat[pp * 17 + f] * w1[f * 64 + o];
            h1[i] = sinf(freq[o] * s); }
        __syncthreads();
        for (int i = tid; i < 1024; i += NTHR) { const int pp = i >> 6, o = i & 63; float s = b2[o];
            for (int q = 0; q < 64; ++q) s += h1[pp * 64 + q] * w2[q * 64 + o];
            h2[i] = sinf(freq[64 + o] * s); }
        __syncthreads();
        for (int cc = tid; cc < 1024; cc += NTHR) {
            float acc[16];
#pragma unroll
            for (int pp = 0; pp < 16; ++pp) acc[pp] = 0.f;
            for (int q = 0; q < 64; ++q) { const float w = w3[q * 1024 + cc];
#pragma unroll
                for (int pp = 0; pp < 16; ++pp) acc[pp] += h2[pp * 64 + q] * w; }
            const int o = cc >> 9, dd = (cc >> 8) & 1, c = cc & 255;
            const float rate = 3.0701134573253945f + (15.350567286626973f - 3.0701134573253945f) * (float)c * (1.f / 255.f);
            float* Fo = F + (size_t)(o * 256 + c) * (2 * L);
#pragma unroll
            for (int pp = 0; pp < 16; ++pp) { const int pos = pos0 + pp; const float t = (float)pos / (float)L;
                const float val = acc[pp] * expf(-t * rate);
                if (dd == 0) Fo[L + pos] = val; else if (pos >= 1) Fo[L - pos] = val; }
            if (pos0 == 0 && dd == 0) Fo[0] = 0.f;
        }
        __syncthreads();
    }
}
__device__ __forceinline__ void ph_hy_fnorm(const PAS Prm& p, bool with_ctx) {
    const int tid = TID, lane = tid & 63, wave = tid >> 6;
    float* FL = (float*)(p.ws + WS_BIG + BG_S + HY_FL); float* FC = (float*)(p.ws + WS_BIG + BG_S + HY_FC);
    const int gw = BID * NWAVES + wave, NGW = NBLK * NWAVES;
    for (int it = gw; it < (with_ctx ? 1024 : 512); it += NGW) {
        const bool isctx = it >= 512; const int L = isctx ? CTXL : SEQ; float* F = (isctx ? FC : FL) + (size_t)(it & 511) * (2 * L);
        float s = 0.f;
        for (int i = lane; i < 2 * L; i += 64) { const float v = F[i]; s += v * v; }
        const float sc = rsqrtf(wave_sum(s) + 1e-6f);
        for (int i = lane; i < 2 * L; i += 64) F[i] *= sc;
    }
}
__device__ __forceinline__ void ph_hy_prep(const PAS Prm& p, int l, bool with_ctx, LAS unsigned char* lds) {
    LAS float* tl = (LAS float*)lds;
    const int tid = TID;
    const bf16* P = (const bf16*)(p.ws + WS_BIG + BG_P);
    float* VL = (float*)(p.ws + WS_BIG + BG_S + HY_VL); float* VC = (float*)(p.ws + WS_BIG + BG_S + HY_VC);
    const float* cw = p.in[9] + l * 3 * 768; const float* cb = p.in[10] + l * 768;
    const int NTL = 8 * (SEQ / 64) * 12, NTC = with_ctx ? 8 * (CTXL / 64) * 12 : 0;
    for (int tile = BID; tile < NTL + NTC; tile += NBLK) {
        const bool isctx = tile >= NTL; const int tt = isctx ? tile - NTL : tile;
        const int T = isctx ? CTXL : SEQ, ntt = T / 64;
        const int ct = tt % 12, tb = (tt / 12) % ntt, b = tt / (12 * ntt);
        const int base = isctx ? b * CTXL : RC + b * SEQ, t0 = tb * 64, c0 = ct * 64;
        for (int i = tid; i < 66 * 64; i += NTHR) { const int rr = i >> 6, cc = i & 63, t = t0 - 1 + rr;
            tl[rr * 65 + cc] = (t >= 0 && t < T) ? bf2f(P[(size_t)(base + t) * 768 + c0 + cc]) : 0.f; }
        __syncthreads();
        const int part = c0 >> 8, cl0 = c0 & 255;
        float* dst = (isctx ? VC : VL) + ((size_t)(part * 8 + b) * 256 + cl0) * T + t0;
        for (int i = tid; i < 64 * 64; i += NTHR) { const int cc = i >> 6, ti = i & 63, col = c0 + cc;
            const float v = cb[col] + cw[col] * tl[ti * 65 + cc] + cw[768 + col] * tl[(ti + 1) * 65 + cc] + cw[1536 + col] * tl[(ti + 2) * 65 + cc];
            dst[(size_t)cc * T + ti] = v; }
        __syncthreads();
    }
}
template <int L>
__device__ __forceinline__ void hy_conv_item(const PAS Prm& p, int l, int c, int b0, LAS unsigned char* lds) {
    constexpr int NI = (L + NTHR - 1) / NTHR;
    LAS float* hh = (LAS float*)lds;
    LAS float* z = hh + 2 * L;
    const int tid = TID;
    const bool isctx = (L == CTXL);
    const float* F = (const float*)(p.ws + WS_BIG + BG_S + (isctx ? HY_FC : HY_FL));
    const float* HV = (const float*)(p.ws + WS_BIG + BG_S + (isctx ? HY_VC : HY_VL));
    const float* bias = p.in[17] + l * 512;
    for (int bb = 0; bb < 4; ++bb) for (int t = tid; t < L; t += NTHR) z[t * 4 + bb] = HV[((size_t)(0 * 8 + b0 + bb) * 256 + c) * L + t];
    for (int o = 0; o < 2; ++o) {
        for (int i = tid; i < 2 * L; i += NTHR) hh[i] = F[(size_t)(o * 256 + c) * (2 * L) + i];
        __syncthreads();
        float acc[NI][4];
#pragma unroll
        for (int i = 0; i < NI; ++i) { acc[i][0] = 0.f; acc[i][1] = 0.f; acc[i][2] = 0.f; acc[i][3] = 0.f; }
        if (tid < L) {
            for (int s = 0; s < L; ++s) {
                const f32x4 zs = *(const LAS f32x4*)(z + s * 4);
#pragma unroll
                for (int i = 0; i < NI; ++i) { const float hv = hh[L + tid + NTHR * i - s];
                    acc[i][0] += hv * zs.x; acc[i][1] += hv * zs.y; acc[i][2] += hv * zs.z; acc[i][3] += hv * zs.w; }
            }
        }
        __syncthreads();
        const float bo = bias[o * 256 + c];
        if (tid < L) {
#pragma unroll
            for (int i = 0; i < NI; ++i) { const int t = tid + NTHR * i;
#pragma unroll
                for (int bb = 0; bb < 4; ++bb) { const float gate = HV[((size_t)((1 + o) * 8 + b0 + bb) * 256 + c) * L + t];
                    z[t * 4 + bb] = gate * (acc[i][bb] + bo * z[t * 4 + bb]); } }
        }
        __syncthreads();
    }
    float* HVw = (float*)(p.ws + WS_BIG + BG_S + (isctx ? HY_VC : HY_VL));
    if (tid < L) {
#pragma unroll
        for (int i = 0; i < NI; ++i) { const int t = tid + NTHR * i;
#pragma unroll
            for (int bb = 0; bb < 4; ++bb) HVw[((size_t)(0 * 8 + b0 + bb) * 256 + c) * L + t] = z[t * 4 + bb]; }
    }
    __syncthreads();
}
__device__ __forceinline__ void ph_hy_post(const PAS Prm& p, bool with_ctx, LAS unsigned char* lds) {
    LAS float* tl = (LAS float*)lds;
    const int tid = TID;
    const float* VL = (const float*)(p.ws + WS_BIG + BG_S + HY_VL); const float* VC = (const float*)(p.ws + WS_BIG + BG_S + HY_VC);
    bf16* yhy = (bf16*)(p.ws + WS_Y);
    const int NTL = 8 * (SEQ / 64) * 4, NTC = with_ctx ? 8 * (CTXL / 64) * 4 : 0;
    for (int tile = BID; tile < NTL + NTC; tile += NBLK) {
        const bool isctx = tile >= NTL; const int tt = isctx ? tile - NTL : tile;
        const int T = isctx ? CTXL : SEQ, ntt = T / 64;
        const int ct = tt % 4, tb = (tt / 4) % ntt, b = tt / (4 * ntt);
        const int base = isctx ? b * CTXL : RC + b * SEQ, t0 = tb * 64, c0 = ct * 64;
        const float* src = (isctx ? VC : VL) + ((size_t)b * 256 + c0) * T + t0;
        for (int i = tid; i < 64 * 64; i += NTHR) { const int cc = i >> 6, ti = i & 63; tl[cc * 65 + ti] = src[(size_t)cc * T + ti]; }
        __syncthreads();
        for (int i = tid; i < 64 * 32; i += NTHR) { const int ti = i >> 5, cp = i & 31;
            *(unsigned*)(yhy + (size_t)(base + t0 + ti) * 256 + c0 + 2 * cp) = pk2(tl[(2 * cp) * 65 + ti], tl[(2 * cp + 1) * 65 + ti]); }
        __syncthreads();
    }
}
typedef float cf2 __attribute__((ext_vector_type(2)));
__device__ __forceinline__ cf2 cmul(cf2 a, cf2 b) { return (cf2){a.x * b.x - a.y * b.y, a.x * b.y + a.y * b.x}; }
__device__ __forceinline__ cf2 cmulc(cf2 a, cf2 b) { return (cf2){a.x * b.x + a.y * b.y, a.y * b.x - a.x * b.y}; }
template <int LOGN, int M, bool INV>
__device__ __forceinline__ void fft_pass(LAS cf2* X, const LAS cf2* W, const int log_stride, const int tid) {
    constexpr int N = 1 << LOGN, R = 1 << M, NGRP = N / R;
    for (int g = tid; g < NGRP; g += NTHR) {
        const int q = g & ((1 << log_stride) - 1), blk = g >> log_stride;
        const int base = (blk << (log_stride + M)) + q;
        cf2 x[R];
#pragma unroll
        for (int j = 0; j < R; ++j) x[j] = X[base + (j << log_stride)];
#pragma unroll
        for (int s = 0; s < M; ++s) {
            const int half = INV ? (1 << s) : (R >> (s + 1));
            const int lsp = log_stride + (INV ? s : (M - 1 - s));
#pragma unroll
            for (int j = 0; j < R; ++j) {
                if (j & half) continue;
                const int pos = q + ((j & (half - 1)) << log_stride);
                const cf2 w = W[pos << (LOGN - 1 - lsp)];
                const cf2 a = x[j], bq = x[j + half];
                if (!INV) { x[j] = a + bq; x[j + half] = cmul(a - bq, w); }
                else { const cf2 t = cmulc(bq, w); x[j] = a + t; x[j + half] = a - t; }
            }
        }
#pragma unroll
        for (int j = 0; j < R; ++j) X[base + (j << log_stride)] = x[j];
    }
    __syncthreads();
}
template <int LOGN, bool INV> __device__ __forceinline__ void fft_lds(LAS cf2* X, const LAS cf2* W, const int tid) {
    static_assert(LOGN == 13 || LOGN == 9, "pass schedule");
    if (LOGN == 13) {
        if (!INV) { fft_pass<LOGN, 3, false>(X, W, 10, tid); fft_pass<LOGN, 3, false>(X, W, 7, tid); fft_pass<LOGN, 3, false>(X, W, 4, tid); fft_pass<LOGN, 2, false>(X, W, 2, tid); fft_pass<LOGN, 2, false>(X, W, 0, tid); }
        else { fft_pass<LOGN, 2, true>(X, W, 0, tid); fft_pass<LOGN, 2, true>(X, W, 2, tid); fft_pass<LOGN, 3, true>(X, W, 4, tid); fft_pass<LOGN, 3, true>(X, W, 7, tid); fft_pass<LOGN, 3, true>(X, W, 10, tid); }
    } else {
        if (!INV) { fft_pass<LOGN, 3, false>(X, W, 6, tid); fft_pass<LOGN, 3, false>(X, W, 3, tid); fft_pass<LOGN, 3, false>(X, W, 0, tid); }
        else { fft_pass<LOGN, 3, true>(X, W, 0, tid); fft_pass<LOGN, 3, true>(X, W, 3, tid); fft_pass<LOGN, 3, true>(X, W, 6, tid); }
    }
}
#ifdef HOST_EMU
static inline unsigned brev32(unsigned x) { unsigned r = 0; for (int i = 0; i < 32; ++i) if (x & (1u << i)) r |= 1u << (31 - i); return r; }
#else
__device__ __forceinline__ unsigned brev32(unsigned x) { return __builtin_bitreverse32(x); }
#endif
template <int LOGN>
__device__ __forceinline__ void hy_fft_channel(const PAS Prm& p, int l, int c, LAS unsigned char* lds) {
    constexpr int N = 1 << LOGN, L = N / 2;
    static_assert(L == SEQ, "transform length");
    LAS cf2* X = (LAS cf2*)lds;
    LAS cf2* Hh = X + N;
    LAS cf2* W = Hh + N / 2 + 8;
    const int tid = TID;
    const float* F = (const float*)(p.ws + WS_BIG + BG_S + HY_FL);
    float* HV = (float*)(p.ws + WS_BIG + BG_S + HY_VL);
    const float* bias = p.in[17] + l * 512;
    for (int k = tid; k < N / 2; k += NTHR) { float sn, cs; sincospif(-(float)k * (2.0f / (float)N), &sn, &cs); W[k] = (cf2){cs, sn}; }
    __syncthreads();
    const float inv_n = 1.0f / (float)N;
    for (int o = 0; o < 2; ++o) {
        const float* Fo = F + (size_t)(o * 256 + c) * N;
        for (int n = tid; n < N; n += NTHR) X[n] = (cf2){Fo[(n + L) & (N - 1)], 0.f};
        __syncthreads();
        fft_lds<LOGN, false>(X, W, tid);
        for (int pp = tid; pp < N; pp += NTHR) { const int k = (int)(brev32((unsigned)pp) >> (32 - LOGN)); if (k <= N / 2) Hh[k] = X[pp]; }
        __syncthreads();
        const float bo = bias[o * 256 + c];
        for (int pair = 0; pair < 4; ++pair) {
            float* z0 = HV + ((size_t)(0 * 8 + 2 * pair) * 256 + c) * L; float* z1 = z0 + (size_t)256 * L;
            const float* g0 = HV + ((size_t)((1 + o) * 8 + 2 * pair) * 256 + c) * L; const float* g1 = g0 + (size_t)256 * L;
            for (int t = tid; t < L; t += NTHR) { X[t] = (cf2){z0[t], z1[t]}; X[t + L] = (cf2){0.f, 0.f}; }
            __syncthreads();
            fft_lds<LOGN, false>(X, W, tid);
            for (int pp = tid; pp < N; pp += NTHR) { const int k = (int)(brev32((unsigned)pp) >> (32 - LOGN));
                cf2 h; if (k <= N / 2) h = Hh[k]; else { h = Hh[N - k]; h.y = -h.y; }
                X[pp] = cmul(X[pp], h); }
            __syncthreads();
            fft_lds<LOGN, true>(X, W, tid);
            for (int t = tid; t < L; t += NTHR) { const cf2 cv = X[t] * inv_n;
                const float a0 = z0[t], a1 = z1[t];
                z0[t] = g0[t] * (cv.x + bo * a0); z1[t] = g1[t] * (cv.y + bo * a1); }
            __syncthreads();
        }
    }
}
__device__ __forceinline__ void ph_hy_conv(const PAS Prm& p, int l, bool with_ctx, LAS unsigned char* lds) {
    constexpr int LOGN = (SEQ == 4096) ? 13 : 9;
    for (int c = BID; c < 256; c += NBLK) hy_fft_channel<LOGN>(p, l, c, lds);
    if (with_ctx) for (int it = BID; it < 512; it += NBLK) hy_conv_item<CTXL>(p, l, it >> 1, (it & 1) * 4, lds);
}

constexpr int PPL = 30;
constexpr int NPH = 1 + DEPTH * PPL + 1;

template <unsigned MASK> __global__ void __launch_bounds__(NTHR, 2) fwd(Prm pk) {
#ifdef HOST_EMU
    unsigned char* lds_raw = g_lds_emu;
#else
    extern __shared__ __attribute__((aligned(16))) unsigned char lds_raw[];
#endif
    LAS unsigned char* lds = (LAS unsigned char*)lds_raw;
    volatile LAS unsigned* misc = (volatile LAS unsigned*)(lds + LDS_BYTES - 256);
#ifndef HOST_EMU
    { const unsigned t0 = threadIdx.x;
      if (t0 < 64u) misc[t0] = 0u;
      if ((t0 & 63u) == 0u) ((volatile LAS unsigned*)(lds + TIDTAB_OFF))[hw_slot()] = t0 >> 6;
      __syncthreads();
      if ((unsigned)tid_opq() != t0) __hip_atomic_store((unsigned*)(pk.ws + WS_CTL + 768 * 1024), 1u, __ATOMIC_RELAXED, __HIP_MEMORY_SCOPE_AGENT); }
#else
    if (TID < 64) misc[TID] = 0u;
    __syncthreads();
#endif
    const int lo = pk.lo, hi = pk.hi;
    XcdBarrier bar; bar.bar = (unsigned*)(pk.ws + WS_CTL); bar.x = 0; bar.st = misc + 8;
    if (hi - lo > 1) bar = xcd_barrier_post((unsigned*)(pk.ws + WS_CTL), misc + 8);
    int ph = 0;
#ifdef HOST_EMU
#define PH_PRM() const Prm* pl_ = &pk
#else
#define PH_PRM() const PAS Prm* pl_ = (const PAS Prm*)__builtin_amdgcn_kernarg_segment_ptr(); asm volatile("" : "+s"(pl_))
#endif
#define PH_BEGIN(k) if (((MASK >> ((k) & 31)) & 1u) && ph >= lo && ph < hi) { PH_PRM(); const PAS Prm& p = *pl_; \
    bf16* const WB = (bf16*)(p.ws + WS_W); bf16* const U = (bf16*)(p.ws + WS_U); float* const XC = (float*)(p.ws + WS_XC); bf16* const PB = (bf16*)(p.ws + WS_BIG + BG_P); \
    unsigned char* const SB = p.ws + WS_BIG + BG_S; bf16* const GH = (bf16*)(p.ws + WS_BIG); bf16* const MG = (bf16*)(p.ws + WS_BIG + 136 * MiB); bf16* const ACT = (bf16*)(p.ws + WS_BIG); \
    const float* const MOD = (const float*)(p.ws + WS_MOD); const float* const modl = MOD + (size_t)l * 9 * 6144; \
    const float* xc_src = (l == 0) ? p.in[2] : XC; const float* xl_src = (l == 0) ? p.in[0] : p.out; \
    (void)WB; (void)U; (void)XC; (void)PB; (void)SB; (void)GH; (void)MG; (void)ACT; (void)MOD; (void)modl; (void)xc_src; (void)xl_src;
#define PH_END   if (ph + 1 < hi) xcd_barrier(bar); } ++ph;
    typedef pg8::StaticOrder SO;

    { const int l = 0; PH_BEGIN(1) ph_mod(p, lds); PH_END }

    {
        constexpr int l = 0;
        const bool last = (l == DEPTH - 1), wctx = !last;
        const int ro = last ? RC : 0, Mpost = last ? RL : RT;

        PH_BEGIN(2) ph_cvt(p, l, lds); PH_END
        PH_BEGIN(3) ph_norm(p, l, 0, xc_src, xl_src, 0); PH_END
        PH_BEGIN(4) { pg8::Gemm g{U, WB + WO_WP + (size_t)768 * 1024, RT, 1024, 1024}; SO S; S.init(RT, 1024, NBLK, BID); pg8::EpiBf<0> E{PB, 1024};
                   pg8::gemm_phase<pg8::EpiBf<0>, SO, true, true>(lds, g, S, E); } PH_END
        PH_BEGIN(5) ph_rw_prep(p, l, lds); PH_END
        PH_BEGIN(6) scan_phase<0>(SB, PB, (float*)(SB + RW_Y), p.in[25] + l * 256, nullptr, lds); PH_END
        PH_BEGIN(7) ph_rw_post(p, l); PH_END
        PH_BEGIN(8) { pg8::Gemm g{U, WB + WO_WP + (size_t)2304 * 1024, RT, 1024, 1024}; SO S; S.init(RT, 1024, NBLK, BID); pg8::EpiBf<0> E{PB, 1024};
                   pg8::gemm_phase<pg8::EpiBf<0>, SO, true, true>(lds, g, S, E); } PH_END
        PH_BEGIN(9) ph_ret_prep(p); PH_END
        PH_BEGIN(10) scan_phase<1>(SB, PB, (float*)(SB + RT_Y), nullptr, p.in[35] + l * 8, lds); PH_END
        PH_BEGIN(11) ph_ret_post(p); PH_END
        PH_BEGIN(12) { pg8::Gemm g{U, WB + WO_WP + (size_t)1792 * 1024, RT, 512, 1024}; SO S; S.init(RT, 512, NBLK, BID); pg8::EpiBf<0> E{PB, 512};
                   pg8::gemm_phase<pg8::EpiBf<0>, SO, true, true>(lds, g, S, E); } PH_END
        PH_BEGIN(13) ph_lru_prep(p, l, lds); PH_END
        PH_BEGIN(14) ph_lru_agg(p); PH_END
        PH_BEGIN(15) ph_lru_fin(p, lds); PH_END
        PH_BEGIN(16) { pg8::Gemm g{U, WB + WO_WP, RT, 768, 1024}; SO S; S.init(RT, 768, NBLK, BID); pg8::EpiBf<0> E{PB, 768};
                   pg8::gemm_phase<pg8::EpiBf<0>, SO, true, true>(lds, g, S, E); } PH_END
        PH_BEGIN(17) ph_hy_filter(p, l, wctx, lds); PH_END
        PH_BEGIN(18) ph_hy_fnorm(p, wctx); PH_END
        PH_BEGIN(19) ph_hy_prep(p, l, wctx, lds); PH_END
        PH_BEGIN(20) ph_hy_conv(p, l, wctx, lds); PH_END
        PH_BEGIN(32) ph_hy_post(p, wctx, lds); PH_END
        PH_BEGIN(21) { pg8::Gemm g{U + (size_t)ro * 1024, WB + WO_WG, Mpost, 2048, 1024}; SO S; S.init(Mpost, 2048, NBLK, BID); pg8::EpiBf<1> E{GH + (size_t)ro * 2048, 2048};
                   pg8::gemm_phase<pg8::EpiBf<1>, SO, true, true>(lds, g, S, E); } PH_END
        PH_BEGIN(22) { pg8::Gemm g{(const bf16*)(p.ws + WS_Y + 0 * SZ17) + (size_t)ro * 256, WB + WO_BR + (size_t)0 * 1024 * 256, Mpost, 1024, 256}; SO S; S.init(Mpost, 1024, NBLK, BID);
                   pg8::EpiMerge E{GH + (size_t)ro * 2048, 2048, 0, MG + (size_t)ro * 1024, 1};
                   pg8::gemm_phase<pg8::EpiMerge, SO, true, true>(lds, g, S, E); } PH_END
        PH_BEGIN(23) { pg8::Gemm g{(const bf16*)(p.ws + WS_Y + 1 * SZ17) + (size_t)ro * 256, WB + WO_BR + (size_t)1 * 1024 * 256, Mpost, 1024, 256}; SO S; S.init(Mpost, 1024, NBLK, BID);
                   pg8::EpiMerge E{GH + (size_t)ro * 2048, 2048, 1024, MG + (size_t)ro * 1024, 0};
                   pg8::gemm_phase<pg8::EpiMerge, SO, true, true>(lds, g, S, E); } PH_END
        PH_BEGIN(24) { pg8::Gemm g{U + (size_t)ro * 1024, WB + WO_WG + (size_t)2048 * 1024, Mpost, 2048, 1024}; SO S; S.init(Mpost, 2048, NBLK, BID); pg8::EpiBf<1> E{GH + (size_t)ro * 2048, 2048};
                   pg8::gemm_phase<pg8::EpiBf<1>, SO, true, true>(lds, g, S, E); } PH_END
        PH_BEGIN(25) { pg8::Gemm g{(const bf16*)(p.ws + WS_Y + 2 * SZ17) + (size_t)ro * 256, WB + WO_BR + (size_t)2 * 1024 * 256, Mpost, 1024, 256}; SO S; S.init(Mpost, 1024, NBLK, BID);
                   pg8::EpiMerge E{GH + (size_t)ro * 2048, 2048, 0, MG + (size_t)ro * 1024, 0};
                   pg8::gemm_phase<pg8::EpiMerge, SO, true, true>(lds, g, S, E); } PH_END
        PH_BEGIN(26) { pg8::Gemm g{(const bf16*)(p.ws + WS_Y + 3 * SZ17) + (size_t)ro * 256, WB + WO_BR + (size_t)3 * 1024 * 256, Mpost, 1024, 256}; SO S; S.init(Mpost, 1024, NBLK, BID);
                   pg8::EpiMerge E{GH + (size_t)ro * 2048, 2048, 1024, MG + (size_t)ro * 1024, 0};
                   pg8::gemm_phase<pg8::EpiMerge, SO, true, true>(lds, g, S, E); } PH_END
        PH_BEGIN(27) { pg8::Gemm g{MG + (size_t)ro * 1024, WB + WO_WO, Mpost, 1024, 1024}; SO S; S.init(Mpost, 1024, NBLK, BID);
                   pg8::EpiResid E{xc_src, xl_src, XC, p.out, modl, 2 * 1024, ro};
                   pg8::gemm_phase<pg8::EpiResid, SO, true, true>(lds, g, S, E); } PH_END
        PH_BEGIN(28) ph_norm(p, l, 1, XC, p.out, ro); PH_END
        PH_BEGIN(29) { pg8::Gemm g{U + (size_t)ro * 1024, WB + WO_W1, Mpost, 5632, 1024}; SO S; S.init(Mpost, 5632, NBLK, BID); pg8::EpiSwiglu E{ACT + (size_t)ro * 2816, 2816};
                   pg8::gemm_phase<pg8::EpiSwiglu, SO, true, true>(lds, g, S, E); } PH_END
        PH_BEGIN(30) { pg8::Gemm g{ACT + (size_t)ro * 2816, WB + WO_W2, Mpost, 1024, 2816}; SO S; S.init(Mpost, 1024, NBLK, BID);
                   pg8::EpiResid E{XC, p.out, XC, p.out, modl, 5 * 1024, ro};
                   pg8::gemm_phase<pg8::EpiResid, SO, true, true>(lds, g, S, E); } PH_END
    }
    {
        constexpr int l = 1;
        const bool last = (l == DEPTH - 1), wctx = !last;
        const int ro = last ? RC : 0, Mpost = last ? RL : RT;

        PH_BEGIN(2) ph_cvt(p, l, lds); PH_END
        PH_BEGIN(3) ph_norm(p, l, 0, xc_src, xl_src, 0); PH_END
        PH_BEGIN(4) { pg8::Gemm g{U, WB + WO_WP + (size_t)768 * 1024, RT, 1024, 1024}; SO S; S.init(RT, 1024, NBLK, BID); pg8::EpiBf<0> E{PB, 1024};
                   pg8::gemm_phase<pg8::EpiBf<0>, SO, true, true>(lds, g, S, E); } PH_END
        PH_BEGIN(5) ph_rw_prep(p, l, lds); PH_END
        PH_BEGIN(6) scan_phase<0>(SB, PB, (float*)(SB + RW_Y), p.in[25] + l * 256, nullptr, lds); PH_END
        PH_BEGIN(7) ph_rw_post(p, l); PH_END
        PH_BEGIN(8) { pg8::Gemm g{U, WB + WO_WP + (size_t)2304 * 1024, RT, 1024, 1024}; SO S; S.init(RT, 1024, NBLK, BID); pg8::EpiBf<0> E{PB, 1024};
                   pg8::gemm_phase<pg8::EpiBf<0>, SO, true, true>(lds, g, S, E); } PH_END
        PH_BEGIN(9) ph_ret_prep(p); PH_END
        PH_BEGIN(10) scan_phase<1>(SB, PB, (float*)(SB + RT_Y), nullptr, p.in[35] + l * 8, lds); PH_END
        PH_BEGIN(11) ph_ret_post(p); PH_END
        PH_BEGIN(12) { pg8::Gemm g{U, WB + WO_WP + (size_t)1792 * 1024, RT, 512, 1024}; SO S; S.init(RT, 512, NBLK, BID); pg8::EpiBf<0> E{PB, 512};
                   pg8::gemm_phase<pg8::EpiBf<0>, SO, true, true>(lds, g, S, E); } PH_END
        PH_BEGIN(13) ph_lru_prep(p, l, lds); PH_END
        PH_BEGIN(14) ph_lru_agg(p); PH_END
        PH_BEGIN(15) ph_lru_fin(p, lds); PH_END
        PH_BEGIN(16) { pg8::Gemm g{U, WB + WO_WP, RT, 768, 1024}; SO S; S.init(RT, 768, NBLK, BID); pg8::EpiBf<0> E{PB, 768};
                   pg8::gemm_phase<pg8::EpiBf<0>, SO, true, true>(lds, g, S, E); } PH_END
        PH_BEGIN(17) ph_hy_filter(p, l, wctx, lds); PH_END
        PH_BEGIN(18) ph_hy_fnorm(p, wctx); PH_END
        PH_BEGIN(19) ph_hy_prep(p, l, wctx, lds); PH_END
        PH_BEGIN(20) ph_hy_conv(p, l, wctx, lds); PH_END
        PH_BEGIN(32) ph_hy_post(p, wctx, lds); PH_END
        PH_BEGIN(21) { pg8::Gemm g{U + (size_t)ro * 1024, WB + WO_WG, Mpost, 2048, 1024}; SO S; S.init(Mpost, 2048, NBLK, BID); pg8::EpiBf<1> E{GH + (size_t)ro * 2048, 2048};
                   pg8::gemm_phase<pg8::EpiBf<1>, SO, true, true>(lds, g, S, E); } PH_END
        PH_BEGIN(22) { pg8::Gemm g{(const bf16*)(p.ws + WS_Y + 0 * SZ17) + (size_t)ro * 256, WB + WO_BR + (size_t)0 * 1024 * 256, Mpost, 1024, 256}; SO S; S.init(Mpost, 1024, NBLK, BID);
                   pg8::EpiMerge E{GH + (size_t)ro * 2048, 2048, 0, MG + (size_t)ro * 1024, 1};
                   pg8::gemm_phase<pg8::EpiMerge, SO, true, true>(lds, g, S, E); } PH_END
        PH_BEGIN(23) { pg8::Gemm g{(const bf16*)(p.ws + WS_Y + 1 * SZ17) + (size_t)ro * 256, WB + WO_BR + (size_t)1 * 1024 * 256, Mpost, 1024, 256}; SO S; S.init(Mpost, 1024, NBLK, BID);
                   pg8::EpiMerge E{GH + (size_t)ro * 2048, 2048, 1024, MG + (size_t)ro * 1024, 0};
                   pg8::gemm_phase<pg8::EpiMerge, SO, true, true>(lds, g, S, E); } PH_END
        PH_BEGIN(24) { pg8::Gemm g{U + (size_t)ro * 1024, WB + WO_WG + (size_t)2048 * 1024, Mpost, 2048, 1024}; SO S; S.init(Mpost, 2048, NBLK, BID); pg8::EpiBf<1> E{GH + (size_t)ro * 2048, 2048};
                   pg8::gemm_phase<pg8::EpiBf<1>, SO, true, true>(lds, g, S, E); } PH_END
        PH_BEGIN(25) { pg8::Gemm g{(const bf16*)(p.ws + WS_Y + 2 * SZ17) + (size_t)ro * 256, WB + WO_BR + (size_t)2 * 1024 * 256, Mpost, 1024, 256}; SO S; S.init(Mpost, 1024, NBLK, BID);
                   pg8::EpiMerge E{GH + (size_t)ro * 2048, 2048, 0, MG + (size_t)ro * 1024, 0};
                   pg8::gemm_phase<pg8::EpiMerge, SO, true, true>(lds, g, S, E); } PH_END
        PH_BEGIN(26) { pg8::Gemm g{(const bf16*)(p.ws + WS_Y + 3 * SZ17) + (size_t)ro * 256, WB + WO_BR + (size_t)3 * 1024 * 256, Mpost, 1024, 256}; SO S; S.init(Mpost, 1024, NBLK, BID);
                   pg8::EpiMerge E{GH + (size_t)ro * 2048, 2048, 1024, MG + (size_t)ro * 1024, 0};
                   pg8::gemm_phase<pg8::EpiMerge, SO, true, true>(lds, g, S, E); } PH_END
        PH_BEGIN(27) { pg8::Gemm g{MG + (size_t)ro * 1024, WB + WO_WO, Mpost, 1024, 1024}; SO S; S.init(Mpost, 1024, NBLK, BID);
                   pg8::EpiResid E{xc_src, xl_src, XC, p.out, modl, 2 * 1024, ro};
                   pg8::gemm_phase<pg8::EpiResid, SO, true, true>(lds, g, S, E); } PH_END
        PH_BEGIN(28) ph_norm(p, l, 1, XC, p.out, ro); PH_END
        PH_BEGIN(29) { pg8::Gemm g{U + (size_t)ro * 1024, WB + WO_W1, Mpost, 5632, 1024}; SO S; S.init(Mpost, 5632, NBLK, BID); pg8::EpiSwiglu E{ACT + (size_t)ro * 2816, 2816};
                   pg8::gemm_phase<pg8::EpiSwiglu, SO, true, true>(lds, g, S, E); } PH_END
        PH_BEGIN(30) { pg8::Gemm g{ACT + (size_t)ro * 2816, WB + WO_W2, Mpost, 1024, 2816}; SO S; S.init(Mpost, 1024, NBLK, BID);
                   pg8::EpiResid E{XC, p.out, XC, p.out, modl, 5 * 1024, ro};
                   pg8::gemm_phase<pg8::EpiResid, SO, true, true>(lds, g, S, E); } PH_END
    }
    {
        constexpr int l = 2;
        const bool last = (l == DEPTH - 1), wctx = !last;
        const int ro = last ? RC : 0, Mpost = last ? RL : RT;

        PH_BEGIN(2) ph_cvt(p, l, lds); PH_END
        PH_BEGIN(3) ph_norm(p, l, 0, xc_src, xl_src, 0); PH_END
        PH_BEGIN(4) { pg8::Gemm g{U, WB + WO_WP + (size_t)768 * 1024, RT, 1024, 1024}; SO S; S.init(RT, 1024, NBLK, BID); pg8::EpiBf<0> E{PB, 1024};
                   pg8::gemm_phase<pg8::EpiBf<0>, SO, true, true>(lds, g, S, E); } PH_END
        PH_BEGIN(5) ph_rw_prep(p, l, lds); PH_END
        PH_BEGIN(6) scan_phase<0>(SB, PB, (float*)(SB + RW_Y), p.in[25] + l * 256, nullptr, lds); PH_END
        PH_BEGIN(7) ph_rw_post(p, l); PH_END
        PH_BEGIN(8) { pg8::Gemm g{U, WB + WO_WP + (size_t)2304 * 1024, RT, 1024, 1024}; SO S; S.init(RT, 1024, NBLK, BID); pg8::EpiBf<0> E{PB, 1024};
                   pg8::gemm_phase<pg8::EpiBf<0>, SO, true, true>(lds, g, S, E); } PH_END
        PH_BEGIN(9) ph_ret_prep(p); PH_END
        PH_BEGIN(10) scan_phase<1>(SB, PB, (float*)(SB + RT_Y), nullptr, p.in[35] + l * 8, lds); PH_END
        PH_BEGIN(11) ph_ret_post(p); PH_END
        PH_BEGIN(12) { pg8::Gemm g{U, WB + WO_WP + (size_t)1792 * 1024, RT, 512, 1024}; SO S; S.init(RT, 512, NBLK, BID); pg8::EpiBf<0> E{PB, 512};
                   pg8::gemm_phase<pg8::EpiBf<0>, SO, true, true>(lds, g, S, E); } PH_END
        PH_BEGIN(13) ph_lru_prep(p, l, lds); PH_END
        PH_BEGIN(14) ph_lru_agg(p); PH_END
        PH_BEGIN(15) ph_lru_fin(p, lds); PH_END
        PH_BEGIN(16) { pg8::Gemm g{U, WB + WO_WP, RT, 768, 1024}; SO S; S.init(RT, 768, NBLK, BID); pg8::EpiBf<0> E{PB, 768};
                   pg8::gemm_phase<pg8::EpiBf<0>, SO, true, true>(lds, g, S, E); } PH_END
        PH_BEGIN(17) ph_hy_filter(p, l, wctx, lds); PH_END
        PH_BEGIN(18) ph_hy_fnorm(p, wctx); PH_END
        PH_BEGIN(19) ph_hy_prep(p, l, wctx, lds); PH_END
        PH_BEGIN(20) ph_hy_conv(p, l, wctx, lds); PH_END
        PH_BEGIN(32) ph_hy_post(p, wctx, lds); PH_END
        PH_BEGIN(21) { pg8::Gemm g{U + (size_t)ro * 1024, WB + WO_WG, Mpost, 2048, 1024}; SO S; S.init(Mpost, 2048, NBLK, BID); pg8::EpiBf<1> E{GH + (size_t)ro * 2048, 2048};
                   pg8::gemm_phase<pg8::EpiBf<1>, SO, true, true>(lds, g, S, E); } PH_END
        PH_BEGIN(22) { pg8::Gemm g{(const bf16*)(p.ws + WS_Y + 0 * SZ17) + (size_t)ro * 256, WB + WO_BR + (size_t)0 * 1024 * 256, Mpost, 1024, 256}; SO S; S.init(Mpost, 1024, NBLK, BID);
                   pg8::EpiMerge E{GH + (size_t)ro * 2048, 2048, 0, MG + (size_t)ro * 1024, 1};
                   pg8::gemm_phase<pg8::EpiMerge, SO, true, true>(lds, g, S, E); } PH_END
        PH_BEGIN(23) { pg8::Gemm g{(const bf16*)(p.ws + WS_Y + 1 * SZ17) + (size_t)ro * 256, WB + WO_BR + (size_t)1 * 1024 * 256, Mpost, 1024, 256}; SO S; S.init(Mpost, 1024, NBLK, BID);
                   pg8::EpiMerge E{GH + (size_t)ro * 2048, 2048, 1024, MG + (size_t)ro * 1024, 0};
                   pg8::gemm_phase<pg8::EpiMerge, SO, true, true>(lds, g, S, E); } PH_END
        PH_BEGIN(24) { pg8::Gemm g{U + (size_t)ro * 1024, WB + WO_WG + (size_t)2048 * 1024, Mpost, 2048, 1024}; SO S; S.init(Mpost, 2048, NBLK, BID); pg8::EpiBf<1> E{GH + (size_t)ro * 2048, 2048};
                   pg8::gemm_phase<pg8::EpiBf<1>, SO, true, true>(lds, g, S, E); } PH_END
        PH_BEGIN(25) { pg8::Gemm g{(const bf16*)(p.ws + WS_Y + 2 * SZ17) + (size_t)ro * 256, WB + WO_BR + (size_t)2 * 1024 * 256, Mpost, 1024, 256}; SO S; S.init(Mpost, 1024, NBLK, BID);
                   pg8::EpiMerge E{GH + (size_t)ro * 2048, 2048, 0, MG + (size_t)ro * 1024, 0};
                   pg8::gemm_phase<pg8::EpiMerge, SO, true, true>(lds, g, S, E); } PH_END
        PH_BEGIN(26) { pg8::Gemm g{(const bf16*)(p.ws + WS_Y + 3 * SZ17) + (size_t)ro * 256, WB + WO_BR + (size_t)3 * 1024 * 256, Mpost, 1024, 256}; SO S; S.init(Mpost, 1024, NBLK, BID);
                   pg8::EpiMerge E{GH + (size_t)ro * 2048, 2048, 1024, MG + (size_t)ro * 1024, 0};
                   pg8::gemm_phase<pg8::EpiMerge, SO, true, true>(lds, g, S, E); } PH_END
        PH_BEGIN(27) { pg8::Gemm g{MG + (size_t)ro * 1024, WB + WO_WO, Mpost, 1024, 1024}; SO S; S.init(Mpost, 1024, NBLK, BID);
                   pg8::EpiResid E{xc_src, xl_src, XC, p.out, modl, 2 * 1024, ro};
                   pg8::gemm_phase<pg8::EpiResid, SO, true, true>(lds, g, S, E); } PH_END
        PH_BEGIN(28) ph_norm(p, l, 1, XC, p.out, ro); PH_END
        PH_BEGIN(29) { pg8::Gemm g{U + (size_t)ro * 1024, WB + WO_W1, Mpost, 5632, 1024}; SO S; S.init(Mpost, 5632, NBLK, BID); pg8::EpiSwiglu E{ACT + (size_t)ro * 2816, 2816};
                   pg8::gemm_phase<pg8::EpiSwiglu, SO, true, true>(lds, g, S, E); } PH_END
        PH_BEGIN(30) { pg8::Gemm g{ACT + (size_t)ro * 2816, WB + WO_W2, Mpost, 1024, 2816}; SO S; S.init(Mpost, 1024, NBLK, BID);
                   pg8::EpiResid E{XC, p.out, XC, p.out, modl, 5 * 1024, ro};
                   pg8::gemm_phase<pg8::EpiResid, SO, true, true>(lds, g, S, E); } PH_END
    }
    {
        constexpr int l = 3;
        const bool last = (l == DEPTH - 1), wctx = !last;
        const int ro = last ? RC : 0, Mpost = last ? RL : RT;

        PH_BEGIN(2) ph_cvt(p, l, lds); PH_END
        PH_BEGIN(3) ph_norm(p, l, 0, xc_src, xl_src, 0); PH_END
        PH_BEGIN(4) { pg8::Gemm g{U, WB + WO_WP + (size_t)768 * 1024, RT, 1024, 1024}; SO S; S.init(RT, 1024, NBLK, BID); pg8::EpiBf<0> E{PB, 1024};
                   pg8::gemm_phase<pg8::EpiBf<0>, SO, true, true>(lds, g, S, E); } PH_END
        PH_BEGIN(5) ph_rw_prep(p, l, lds); PH_END
        PH_BEGIN(6) scan_phase<0>(SB, PB, (float*)(SB + RW_Y), p.in[25] + l * 256, nullptr, lds); PH_END
        PH_BEGIN(7) ph_rw_post(p, l); PH_END
        PH_BEGIN(8) { pg8::Gemm g{U, WB + WO_WP + (size_t)2304 * 1024, RT, 1024, 1024}; SO S; S.init(RT, 1024, NBLK, BID); pg8::EpiBf<0> E{PB, 1024};
                   pg8::gemm_phase<pg8::EpiBf<0>, SO, true, true>(lds, g, S, E); } PH_END
        PH_BEGIN(9) ph_ret_prep(p); PH_END
        PH_BEGIN(10) scan_phase<1>(SB, PB, (float*)(SB + RT_Y), nullptr, p.in[35] + l * 8, lds); PH_END
        PH_BEGIN(11) ph_ret_post(p); PH_END
        PH_BEGIN(12) { pg8::Gemm g{U, WB + WO_WP + (size_t)1792 * 1024, RT, 512, 1024}; SO S; S.init(RT, 512, NBLK, BID); pg8::EpiBf<0> E{PB, 512};
                   pg8::gemm_phase<pg8::EpiBf<0>, SO, true, true>(lds, g, S, E); } PH_END
        PH_BEGIN(13) ph_lru_prep(p, l, lds); PH_END
        PH_BEGIN(14) ph_lru_agg(p); PH_END
        PH_BEGIN(15) ph_lru_fin(p, lds); PH_END
        PH_BEGIN(16) { pg8::Gemm g{U, WB + WO_WP, RT, 768, 1024}; SO S; S.init(RT, 768, NBLK, BID); pg8::EpiBf<0> E{PB, 768};
                   pg8::gemm_phase<pg8::EpiBf<0>, SO, true, true>(lds, g, S, E); } PH_END
        PH_BEGIN(17) ph_hy_filter(p, l, wctx, lds); PH_END
        PH_BEGIN(18) ph_hy_fnorm(p, wctx); PH_END
        PH_BEGIN(19) ph_hy_prep(p, l, wctx, lds); PH_END
        PH_BEGIN(20) ph_hy_conv(p, l, wctx, lds); PH_END
        PH_BEGIN(32) ph_hy_post(p, wctx, lds); PH_END
        PH_BEGIN(21) { pg8::Gemm g{U + (size_t)ro * 1024, WB + WO_WG, Mpost, 2048, 1024}; SO S; S.init(Mpost, 2048, NBLK, BID); pg8::EpiBf<1> E{GH + (size_t)ro * 2048, 2048};
                   pg8::gemm_phase<pg8::EpiBf<1>, SO, true, true>(lds, g, S, E); } PH_END
        PH_BEGIN(22) { pg8::Gemm g{(const bf16*)(p.ws + WS_Y + 0 * SZ17) + (size_t)ro * 256, WB + WO_BR + (size_t)0 * 1024 * 256, Mpost, 1024, 256}; SO S; S.init(Mpost, 1024, NBLK, BID);
                   pg8::EpiMerge E{GH + (size_t)ro * 2048, 2048, 0, MG + (size_t)ro * 1024, 1};
                   pg8::gemm_phase<pg8::EpiMerge, SO, true, true>(lds, g, S, E); } PH_END
        PH_BEGIN(23) { pg8::Gemm g{(const bf16*)(p.ws + WS_Y + 1 * SZ17) + (size_t)ro * 256, WB + WO_BR + (size_t)1 * 1024 * 256, Mpost, 1024, 256}; SO S; S.init(Mpost, 1024, NBLK, BID);
                   pg8::EpiMerge E{GH + (size_t)ro * 2048, 2048, 1024, MG + (size_t)ro * 1024, 0};
                   pg8::gemm_phase<pg8::EpiMerge, SO, true, true>(lds, g, S, E); } PH_END
        PH_BEGIN(24) { pg8::Gemm g{U + (size_t)ro * 1024, WB + WO_WG + (size_t)2048 * 1024, Mpost, 2048, 1024}; SO S; S.init(Mpost, 2048, NBLK, BID); pg8::EpiBf<1> E{GH + (size_t)ro * 2048, 2048};
                   pg8::gemm_phase<pg8::EpiBf<1>, SO, true, true>(lds, g, S, E); } PH_END
        PH_BEGIN(25) { pg8::Gemm g{(const bf16*)(p.ws + WS_Y + 2 * SZ17) + (size_t)ro * 256, WB + WO_BR + (size_t)2 * 1024 * 256, Mpost, 1024, 256}; SO S; S.init(Mpost, 1024, NBLK, BID);
                   pg8::EpiMerge E{GH + (size_t)ro * 2048, 2048, 0, MG + (size_t)ro * 1024, 0};
                   pg8::gemm_phase<pg8::EpiMerge, SO, true, true>(lds, g, S, E); } PH_END
        PH_BEGIN(26) { pg8::Gemm g{(const bf16*)(p.ws + WS_Y + 3 * SZ17) + (size_t)ro * 256, WB + WO_BR + (size_t)3 * 1024 * 256, Mpost, 1024, 256}; SO S; S.init(Mpost, 1024, NBLK, BID);
                   pg8::EpiMerge E{GH + (size_t)ro * 2048, 2048, 1024, MG + (size_t)ro * 1024, 0};
                   pg8::gemm_phase<pg8::EpiMerge, SO, true, true>(lds, g, S, E); } PH_END
        PH_BEGIN(27) { pg8::Gemm g{MG + (size_t)ro * 1024, WB + WO_WO, Mpost, 1024, 1024}; SO S; S.init(Mpost, 1024, NBLK, BID);
                   pg8::EpiResid E{xc_src, xl_src, XC, p.out, modl, 2 * 1024, ro};
                   pg8::gemm_phase<pg8::EpiResid, SO, true, true>(lds, g, S, E); } PH_END
        PH_BEGIN(28) ph_norm(p, l, 1, XC, p.out, ro); PH_END
        PH_BEGIN(29) { pg8::Gemm g{U + (size_t)ro * 1024, WB + WO_W1, Mpost, 5632, 1024}; SO S; S.init(Mpost, 5632, NBLK, BID); pg8::EpiSwiglu E{ACT + (size_t)ro * 2816, 2816};
                   pg8::gemm_phase<pg8::EpiSwiglu, SO, true, true>(lds, g, S, E); } PH_END
        PH_BEGIN(30) { pg8::Gemm g{ACT + (size_t)ro * 2816, WB + WO_W2, Mpost, 1024, 2816}; SO S; S.init(Mpost, 1024, NBLK, BID);
                   pg8::EpiResid E{XC, p.out, XC, p.out, modl, 5 * 1024, ro};
                   pg8::gemm_phase<pg8::EpiResid, SO, true, true>(lds, g, S, E); } PH_END
    }
    { const int l = 1; PH_BEGIN(31) ph_final(p); PH_END }
#undef PH_BEGIN
#undef PH_END
}

#ifndef HOST_EMU
#define SITE(k) (1u << (k))
#if MK_PER_PHASE
constexpr int NG = 19;
constexpr unsigned GM[NG] = {
    SITE(0) | SITE(1) | SITE(2) | SITE(3) | SITE(28) | SITE(31) | SITE(7) | SITE(11) | SITE(15) | SITE(9) | SITE(18) | SITE(19),
    SITE(5),
    SITE(6) | SITE(10),
    SITE(13) | SITE(14),
    SITE(17) | SITE(20),
    SITE(4), SITE(8), SITE(12), SITE(16), SITE(21), SITE(24), SITE(22), SITE(23), SITE(25), SITE(26), SITE(27), SITE(30), SITE(29), 0u };
#else
constexpr int NG = 1;
constexpr unsigned GM[NG] = {0xFFFFFFFFu};
#endif
template <int G> static bool prep_group() { return hipFuncSetAttribute((const void*)fwd<GM[G]>, hipFuncAttributeMaxDynamicSharedMemorySize, LDS_BYTES) == hipSuccess; }
template <int G> static void launch_group(int grid, hipStream_t stream, const Prm& p) { hipLaunchKernelGGL(fwd<GM[G]>, dim3(grid), dim3(NTHR), LDS_BYTES, stream, p); }

extern "C" void kernel_launch(void* const* d_in, const int* in_sizes, int n_in, void* d_out, int out_size, void* d_ws, size_t ws_size, hipStream_t stream) {
    static int grid = 0;
    if (grid == 0) {
        if (n_in != 41 || out_size != RL * D || ws_size < WS_END) { fprintf(stderr, "kernel_launch: unexpected shapes (n_in %d out %d ws %zu); nothing launched\n", n_in, out_size, ws_size); grid = -1; return; }
        int dev = 0, cus = 0;
        if (hipGetDevice(&dev) != hipSuccess || hipDeviceGetAttribute(&cus, hipDeviceAttributeMultiprocessorCount, dev) != hipSuccess) { grid = -1; return; }
        bool ok = true;
#if MK_PER_PHASE
        ok = ok && prep_group<0>() && prep_group<1>() && prep_group<2>() && prep_group<3>() && prep_group<4>() && prep_group<5>() && prep_group<6>() && prep_group<7>() && prep_group<8>() && prep_group<9>()
                && prep_group<10>() && prep_group<11>() && prep_group<12>() && prep_group<13>() && prep_group<14>() && prep_group<15>() && prep_group<16>() && prep_group<17>();
#else
        ok = prep_group<0>();
#endif
        if (!ok) { fprintf(stderr, "kernel_launch: hipFuncSetAttribute failed\n"); grid = -1; return; }
        (void)hipGetLastError();
        grid = cus > 0 ? cus : 256;
    }
    if (grid < 0) return;
    if (hipMemsetAsync((char*)d_ws + WS_CTL, 0, 1 * MiB, stream) != hipSuccess) return;
    Prm p{};
    for (int i = 0; i < 41; ++i) p.in[i] = (const float*)d_in[i];
    p.out = (float*)d_out; p.ws = (unsigned char*)d_ws;
#if MK_PER_PHASE
    for (int ph = 0; ph < NPH; ++ph) {
        p.lo = ph; p.hi = ph + 1;
        static const int layer_sites[PPL] = {2, 3, 4, 5, 6, 7, 8, 9, 10, 11, 12, 13, 14, 15, 16, 17, 18, 19, 20, 0  , 21, 22, 23, 24, 25, 26, 27, 28, 29, 30};
        const int k = (ph == 0) ? 1 : (ph == NPH - 1) ? 31 : layer_sites[(ph - 1) % PPL];
        int g = -1;
        for (int q = 0; q < NG; ++q) if ((GM[q] >> k) & 1u) g = q;
        switch (g) {
            case 0: launch_group<0>(grid, stream, p); break; case 1: launch_group<1>(grid, stream, p); break; case 2: launch_group<2>(grid, stream, p); break;
            case 3: launch_group<3>(grid, stream, p); break; case 4: launch_group<4>(grid, stream, p); break; case 5: launch_group<5>(grid, stream, p); break;
            case 6: launch_group<6>(grid, stream, p); break; case 7: launch_group<7>(grid, stream, p); break; case 8: launch_group<8>(grid, stream, p); break;
            case 9: launch_group<9>(grid, stream, p); break; case 10: launch_group<10>(grid, stream, p); break; case 11: launch_group<11>(grid, stream, p); break;
            case 12: launch_group<12>(grid, stream, p); break; case 13: launch_group<13>(grid, stream, p); break; case 14: launch_group<14>(grid, stream, p); break;
            case 15: launch_group<15>(grid, stream, p); break; case 16: launch_group<16>(grid, stream, p); break; case 17: launch_group<17>(grid, stream, p); break;
            default: break; }
#ifdef DIAG_BUILD
        { static const int dg[8][2] = {{0, 0}, {2, 1}, {10, 2}, {14, 3}, {20, 4}, {22, 5}, {26, 6}, {28, 7}};
          for (int q = 0; q < 8; ++q) if (ph == 1 + dg[q][0]) hipLaunchKernelGGL(diag_k, dim3(32), dim3(NTHR), 0, stream, p, dg[q][1]);
          if (ph == 1 + 19) hipLaunchKernelGGL(diag_k, dim3(32), dim3(NTHR), 0, stream, p, 8);
          if (ph == NPH - 1) hipLaunchKernelGGL(diag_out_k, dim3(grid), dim3(NTHR), 0, stream, p); }
#endif
    }
#else
    p.lo = 0; p.hi = NPH;
    launch_group<0>(grid, stream, p);
#endif
}
#endif
```

```cpp
#include <hip/hip_runtime.h>
#include <cstdio>
#include <cstdint>

#ifndef SEQ_
#define SEQ_ 4096
#define CTXL_ 256
#endif
#ifndef MK_PER_PHASE
#define MK_PER_PHASE 0
#endif

#ifndef HOST_EMU
extern __shared__ __attribute__((aligned(16))) unsigned char g_dyn_lds[];
constexpr int TIDTAB_OFF = 147456 - 2048;
__device__ __forceinline__ unsigned hw_slot() { return (unsigned)__builtin_amdgcn_s_getreg((7 << 11) | 4) & 0xFFu; }
__device__ __forceinline__ int tid_opq() {
    const unsigned w = ((const volatile __attribute__((address_space(3))) unsigned*)((__attribute__((address_space(3))) unsigned char*)g_dyn_lds + TIDTAB_OFF))[hw_slot()];
    unsigned lane; asm volatile("v_mbcnt_lo_u32_b32 %0, -1, 0\n\tv_mbcnt_hi_u32_b32 %0, -1, %0" : "=v"(lane));
    int t = (int)((unsigned)__builtin_amdgcn_readfirstlane((int)w) * 64u + lane); asm volatile("" : "+v"(t)); return t;
}
#endif

namespace pg8 {
#define PG8_LAS __attribute__((address_space(3)))
typedef unsigned short bf16_t;
typedef short bf16x8 __attribute__((ext_vector_type(8)));
typedef float f32x4 __attribute__((ext_vector_type(4)));
typedef unsigned u32x4 __attribute__((ext_vector_type(4)));
constexpr int BM = 256, BK = 64, HALF = 128, HTB = HALF * BK * 2  , STAGE_BYTES = 8 * HTB, NXCD = 8, WGM = 8;

__host__ __device__ __forceinline__ int lds_byte(int r, int c) { const int st = (r >> 4) * 2 + (c >> 5), rr = r & 15, cc = c & 31, ob = rr * 64 + cc * 2; return st * 1024 + (ob ^ (((ob >> 9) & 1) << 5)); }
__host__ __device__ __forceinline__ void stage_rc(int b, int& R, int& C) { const int st = b / 1024, sb = b % 1024, swz = sb ^ (((sb >> 9) & 1) << 5); R = (st >> 1) * 16 + swz / 64; C = (st & 1) * 32 + (swz % 64) / 2; }
__host__ __device__ __forceinline__ int perm32(int rho) { const int n = rho >> 4, i = rho & 15; return 8 * (i >> 2) + 4 * n + (i & 3); }

struct Unit { int pm, pn; };
struct Gemm { const bf16_t* A; const bf16_t* Bt; int M, N, K; };

struct StaticOrder {
    int nM, nN, nwg, G, c;
    __host__ __device__ void init(int M, int N, int G_, int c_) { nM = M / BM; nN = N / BM; nwg = nM * nN; G = G_; c = c_; }
    __host__ __device__ bool next(int i, Unit& u) const {
        const long L = (long)i * G + c; if (L >= nwg) return false;
        int wgid = (int)L; { const int q = nwg / NXCD, r = nwg % NXCD, xcd = wgid % NXCD, off = wgid / NXCD; wgid = (xcd < r ? xcd * (q + 1) : r * (q + 1) + (xcd - r) * q) + off; }
        const int nig = WGM * nN, gid = wgid / nig, fm = gid * WGM, gsz = (nM - fm) < WGM ? (nM - fm) : WGM;
        u.pm = fm + ((wgid % nig) % gsz); u.pn = (wgid % nig) / gsz; return true;
    }
    __device__ __forceinline__ void a_ready(const Unit&) const {}
    __device__ __forceinline__ void done(const Unit&) const {}
};

#ifdef HOST_EMU
__device__ __forceinline__ unsigned cvt_pk_bf16(float lo, float hi) { auto f = [](float x) { unsigned u; memcpy(&u, &x, 4); return (u + 0x7fffu + ((u >> 16) & 1u)) >> 16; }; return f(lo) | (f(hi) << 16); }
#else
typedef __bf16 pg8_bf16x2 __attribute__((ext_vector_type(2)));
typedef float pg8_f32x2 __attribute__((ext_vector_type(2)));
__device__ __forceinline__ unsigned cvt_pk_bf16(float lo, float hi) { pg8_f32x2 v = {lo, hi}; pg8_bf16x2 b = __builtin_convertvector(v, pg8_bf16x2); return __builtin_bit_cast(unsigned, b); }
#endif
typedef float f32x2 __attribute__((ext_vector_type(2)));
__device__ __forceinline__ float bflo(unsigned u) { return __uint_as_float(u << 16); }
__device__ __forceinline__ float bfhi(unsigned u) { return __uint_as_float(u & 0xffff0000u); }
#ifdef HOST_EMU
__device__ __forceinline__ float fsigmoid(float x) { return 1.f / (1.f + expf(-x)); }
#else
__device__ __forceinline__ float fsigmoid(float x) { return __builtin_amdgcn_rcpf(1.f + __expf(-x)); }
#endif

#ifdef HOST_EMU
#define EPI_PIN() do { } while (0)
#define EPI_LATE(fr, fq) do { } while (0)
#define EPI_Z(z) do { } while (0)
#else
#define EPI_Z(z) asm volatile("" : "+v"(z))
#define EPI_LATE(fr, fq) asm volatile("" : "+v"(fr), "+v"(fq))

#define EPI_PIN() asm volatile("" ::: "memory")
#endif
template <int ACT> struct EpiBf {
    static constexpr bool PERM = true, AFTER_DRAIN = false;
    bf16_t* O; int ldc;
    __device__ __forceinline__ void operator()(const f32x4 (&acc)[2][2][4][2], const Unit& u, int wr, int wc, int fr, int fq) const {
        EPI_LATE(fr, fq);
        const int row0 = u.pm * BM + wr * 64 + fr, col0 = u.pn * BM + wc * 32 + 8 * fq;
#pragma unroll
        for (int ai = 0; ai < 2; ++ai)
#pragma unroll
            for (int m = 0; m < 4; ++m) { bf16_t* rowp = O + (size_t)(row0 + ai * HALF + m * 16) * ldc + col0;
#pragma unroll
                for (int bj = 0; bj < 2; ++bj) { f32x4 v0 = acc[ai][bj][m][0], v1 = acc[ai][bj][m][1];
                    if (ACT == 1) {
#pragma unroll
                        for (int j = 0; j < 4; ++j) { v0[j] = fsigmoid(v0[j]); v1[j] = fsigmoid(v1[j]); } }
                    u32x4 w; w.x = cvt_pk_bf16(v0[0], v0[1]); w.y = cvt_pk_bf16(v0[2], v0[3]); w.z = cvt_pk_bf16(v1[0], v1[1]); w.w = cvt_pk_bf16(v1[2], v1[3]);
                    *(u32x4*)(rowp + bj * HALF) = w; } }
    }
};

struct EpiBf2 {
    static constexpr bool PERM = true, AFTER_DRAIN = false;
    bf16_t* O1; int ld1; bf16_t* O2; int ld2; int split;
    __device__ __forceinline__ void operator()(const f32x4 (&acc)[2][2][4][2], const Unit& u, int wr, int wc, int fr, int fq) const {
        EPI_LATE(fr, fq);
        const bool first = u.pn < split;
        bf16_t* O = first ? O1 : O2; const int ldc = first ? ld1 : ld2;
        const int row0 = u.pm * BM + wr * 64 + fr, col0 = (first ? u.pn : u.pn - split) * BM + wc * 32 + 8 * fq;
#pragma unroll
        for (int ai = 0; ai < 2; ++ai)
#pragma unroll
            for (int m = 0; m < 4; ++m) { bf16_t* rowp = O + (size_t)(row0 + ai * HALF + m * 16) * ldc + col0;
#pragma unroll
                for (int bj = 0; bj < 2; ++bj) { const f32x4 v0 = acc[ai][bj][m][0], v1 = acc[ai][bj][m][1];
                    u32x4 w; w.x = cvt_pk_bf16(v0[0], v0[1]); w.y = cvt_pk_bf16(v0[2], v0[3]); w.z = cvt_pk_bf16(v1[0], v1[1]); w.w = cvt_pk_bf16(v1[2], v1[3]);
                    *(u32x4*)(rowp + bj * HALF) = w; } }
    }
};

struct EpiMerge {
    static constexpr bool PERM = true, AFTER_DRAIN = false;
    const bf16_t* G; int ldg; int gcol0; bf16_t* Mg; int first;
    __device__ __forceinline__ void operator()(const f32x4 (&acc)[2][2][4][2], const Unit& u, int wr, int wc, int fr, int fq) const {
        EPI_LATE(fr, fq);
        const int row0 = u.pm * BM + wr * 64 + fr, col0 = u.pn * BM + wc * 32 + 8 * fq;
#pragma unroll
        for (int ai = 0; ai < 2; ++ai)
#pragma unroll
            for (int m = 0; m < 4; ++m) { const size_t row = (size_t)(row0 + ai * HALF + m * 16);
#pragma unroll
                for (int bj = 0; bj < 2; ++bj) { const int col = col0 + bj * HALF;
                    const u32x4 gv = *(const u32x4*)(G + row * ldg + gcol0 + col);
                    bf16_t* mp = Mg + row * 1024 + col;
                    u32x4 pv; if (!first) pv = *(const u32x4*)mp; else { unsigned z0 = 0u; EPI_Z(z0); pv = (u32x4){z0, z0, z0, z0}; }
                    const f32x4 v0 = acc[ai][bj][m][0], v1 = acc[ai][bj][m][1];
                    float o[8];
                    o[0] = bflo(pv.x) + bflo(gv.x) * v0[0]; o[1] = bfhi(pv.x) + bfhi(gv.x) * v0[1];
                    o[2] = bflo(pv.y) + bflo(gv.y) * v0[2]; o[3] = bfhi(pv.y) + bfhi(gv.y) * v0[3];
                    o[4] = bflo(pv.z) + bflo(gv.z) * v1[0]; o[5] = bfhi(pv.z) + bfhi(gv.z) * v1[1];
                    o[6] = bflo(pv.w) + bflo(gv.w) * v1[2]; o[7] = bfhi(pv.w) + bfhi(gv.w) * v1[3];
                    u32x4 w; w.x = cvt_pk_bf16(o[0], o[1]); w.y = cvt_pk_bf16(o[2], o[3]); w.z = cvt_pk_bf16(o[4], o[5]); w.w = cvt_pk_bf16(o[6], o[7]);
                    *(u32x4*)mp = w; }
                EPI_PIN(); }
    }
};

struct EpiResid {
    static constexpr bool PERM = false, AFTER_DRAIN = false;
    const float* src_c; const float* src_l; float* dst_c; float* dst_l; const float* modl; int gate_off; int row_off;
    __device__ __forceinline__ void operator()(const f32x4 (&acc)[2][2][4][2], const Unit& u, int wr, int wc, int fr, int fq) const {
        EPI_LATE(fr, fq);
        const int grow0 = row_off + u.pm * BM;
        const bool isctx = grow0 < 8 * CTXL_;
        const int jb = isctx ? 8 : (grow0 - 8 * CTXL_) / SEQ_;
        const float* gate = modl + (size_t)jb * 6144 + gate_off;
        const float* src = isctx ? src_c + (size_t)grow0 * 1024 : src_l + (size_t)(grow0 - 8 * CTXL_) * 1024;
        float* dst = isctx ? dst_c + (size_t)grow0 * 1024 : dst_l + (size_t)(grow0 - 8 * CTXL_) * 1024;
        const int rr0 = wr * 64 + fr, col0 = u.pn * BM + wc * 32 + 4 * fq;
        f32x4 gv[2][2];
#pragma unroll
        for (int bj = 0; bj < 2; ++bj)
#pragma unroll
            for (int n = 0; n < 2; ++n) gv[bj][n] = *(const f32x4*)(gate + col0 + bj * HALF + n * 16);
#pragma unroll
        for (int ai = 0; ai < 2; ++ai)
#pragma unroll
            for (int m = 0; m < 4; ++m) { const size_t ro = (size_t)(rr0 + ai * HALF + m * 16) * 1024 + col0;
#pragma unroll
                for (int bj = 0; bj < 2; ++bj)
#pragma unroll
                    for (int n = 0; n < 2; ++n) { const f32x4 s = *(const f32x4*)(src + ro + bj * HALF + n * 16);
                        *(f32x4*)(dst + ro + bj * HALF + n * 16) = s + gv[bj][n] * acc[ai][bj][m][n]; }
                EPI_PIN(); }
    }
};

struct EpiSwiglu {
    static constexpr bool PERM = true, AFTER_DRAIN = false;
    bf16_t* O; int ldc;
    __device__ __forceinline__ void operator()(const f32x4 (&acc)[2][2][4][2], const Unit& u, int wr, int wc, int fr, int fq) const {
        EPI_LATE(fr, fq);
        const int row0 = u.pm * BM + wr * 64 + fr, col0 = u.pn * HALF + wc * 32 + 8 * fq;
#pragma unroll
        for (int ai = 0; ai < 2; ++ai)
#pragma unroll
            for (int m = 0; m < 4; ++m) { bf16_t* rowp = O + (size_t)(row0 + ai * HALF + m * 16) * ldc + col0;
                float o[8];
#pragma unroll
                for (int n = 0; n < 2; ++n)
#pragma unroll
                    for (int j = 0; j < 4; ++j) { const float g = acc[ai][0][m][n][j], up = acc[ai][1][m][n][j]; o[n * 4 + j] = g * fsigmoid(g) * up; }
                u32x4 w; w.x = cvt_pk_bf16(o[0], o[1]); w.y = cvt_pk_bf16(o[2], o[3]); w.z = cvt_pk_bf16(o[4], o[5]); w.w = cvt_pk_bf16(o[6], o[7]);
                *(u32x4*)rowp = w; }
    }
};

template <class Epi, class Sched, bool ALIGN_EPI = false, bool SP2 = false>
__device__ __forceinline__ void gemm_phase(PG8_LAS unsigned char* lds, const Gemm g, const Sched& S, const Epi& E) {
    const int tid = tid_opq();
    const int wid = __builtin_amdgcn_readfirstlane(tid >> 6), lane = tid & 63, wr = wid >> 2, wc = wid & 3, fr = lane & 15, fq = lane >> 4;
    const int K = g.K, nt = K / BK;
    unsigned voffA, voffB;
    { int R, C; stage_rc(tid * 16, R, C); const int Rb = Epi::PERM ? ((R & ~31) + perm32(R & 31)) : R;
      voffA = (unsigned)(R * K + C) * 2u; voffB = (unsigned)(Rb * K + C) * 2u; }
    const size_t r64 = (size_t)64 * K * 2;
    const size_t kstep = (size_t)(BK * 2);
    const size_t hstep = (size_t)HALF * K * 2;
    const size_t tstep = 2 * hstep;
    const unsigned ldsw = (unsigned)wid * 1024u;
    const int aoff = lds_byte(wr * 64 + fr, fq * 8), boff = lds_byte(wc * 32 + fr, fq * 8);
#define PG8_SA(b, h) (((b) * 2 + (h)) * HTB)
#define PG8_SB(b, h) ((4 + (b) * 2 + (h)) * HTB)
#define PG8_STAGE(bufoff, gbase, voff) do { _Pragma("unroll") for (int _i = 0; _i < 2; ++_i) \
        __builtin_amdgcn_global_load_lds((const unsigned*)((const char*)(gbase) + (size_t)_i * r64 + (voff)), (PG8_LAS unsigned*)(lds + (bufoff) + ldsw + _i * 8192), 16, 0, 0); } while (0)
#define PG8_LDA(dst, b, h) do { _Pragma("unroll") for (int m = 0; m < 4; ++m) _Pragma("unroll") for (int k = 0; k < 2; ++k) dst[m][k] = *(const PG8_LAS bf16x8*)(lds + PG8_SA(b, h) + aoff + m * 2048 + k * 1024); } while (0)
#define PG8_LDB(dst, b, h) do { _Pragma("unroll") for (int n = 0; n < 2; ++n) _Pragma("unroll") for (int k = 0; k < 2; ++k) dst[n][k] = *(const PG8_LAS bf16x8*)(lds + PG8_SB(b, h) + boff + n * 2048 + k * 1024); } while (0)
#define PG8_MMA(ai, bj, At, Bt) do { __builtin_amdgcn_s_setprio(1); _Pragma("unroll") for (int m = 0; m < 4; ++m) _Pragma("unroll") for (int n = 0; n < 2; ++n) _Pragma("unroll") for (int k = 0; k < 2; ++k) \
        acc[ai][bj][m][n] = __builtin_amdgcn_mfma_f32_16x16x32_bf16(Bt[n][k], At[m][k], acc[ai][bj][m][n], 0, 0, 0); __builtin_amdgcn_s_setprio(0); } while (0)
#define PG8_WAIT_V(n) asm volatile("s_waitcnt vmcnt(" #n ")" ::: "memory")
#define PG8_WAIT_L(n) asm volatile("s_waitcnt lgkmcnt(" #n ")" ::: "memory")
#define PG8_BAR __builtin_amdgcn_s_barrier()
#define PG8_SCHED __builtin_amdgcn_sched_barrier(0)
    Unit cur, nxt; int ui = 0;
    if (!S.next(0, cur)) return;
    f32x4 acc[2][2][4][2];
    { float zf = 0.f; asm volatile("" : "+v"(zf));
#pragma unroll
    for (int a = 0; a < 2; ++a)
#pragma unroll
        for (int b = 0; b < 2; ++b)
#pragma unroll
            for (int m = 0; m < 4; ++m)
#pragma unroll
                for (int n = 0; n < 2; ++n) acc[a][b][m][n] = (f32x4){zf, zf, zf, zf}; }
    bf16x8 At[4][2], B0[2][2], B1[2][2];
    const char* cA = (const char*)g.A + (size_t)cur.pm * tstep; const char* cB = (const char*)g.Bt + (size_t)cur.pn * tstep;
    S.a_ready(cur);
    if constexpr (SP2) {
        PG8_STAGE(PG8_SB(0, 0), cB, voffB); PG8_STAGE(PG8_SB(0, 1), cB + hstep, voffB); PG8_STAGE(PG8_SA(0, 0), cA, voffA); PG8_STAGE(PG8_SA(0, 1), cA + hstep, voffA);
        if (wr == 1) PG8_BAR;
        PG8_WAIT_V(2); PG8_BAR;
        PG8_STAGE(PG8_SB(1, 0), cB + kstep, voffB); PG8_STAGE(PG8_SA(1, 0), cA + kstep, voffA); PG8_STAGE(PG8_SB(1, 1), cB + hstep + kstep, voffB);
        PG8_WAIT_V(6); PG8_BAR;
    } else {
        PG8_STAGE(PG8_SB(0, 0), cB, voffB); PG8_STAGE(PG8_SA(0, 0), cA, voffA); PG8_STAGE(PG8_SB(0, 1), cB + hstep, voffB); PG8_STAGE(PG8_SA(0, 1), cA + hstep, voffA);
        if (wr == 1) PG8_BAR;
        PG8_WAIT_V(4); PG8_BAR;
        PG8_STAGE(PG8_SB(1, 0), cB + kstep, voffB); PG8_STAGE(PG8_SA(1, 0), cA + kstep, voffA); PG8_STAGE(PG8_SB(1, 1), cB + hstep + kstep, voffB);
        PG8_WAIT_V(6); PG8_BAR;
    }
    for (;;) {
        const bool has_next = S.next(ui + 1, nxt);
        const char* nA = has_next ? (const char*)g.A + (size_t)nxt.pm * tstep : cA; const char* nB = has_next ? (const char*)g.Bt + (size_t)nxt.pn * tstep : cB;
        for (int t = 0; t < nt; t += 2) {
            const bool last = (t == nt - 2);
            const char* a1 = cA + (size_t)(t + 1) * kstep;
            const char* a2 = last ? nA : cA + (size_t)(t + 2) * kstep; const char* b2 = last ? nB : cB + (size_t)(t + 2) * kstep;
            const char* a3 = a2 + kstep; const char* b3 = b2 + kstep;
            if (last && has_next) S.a_ready(nxt);
            if constexpr (SP2) {
            PG8_LDB(B0, 0, 0); PG8_LDB(B1, 0, 1); PG8_SCHED; PG8_LDA(At, 0, 0); PG8_STAGE(PG8_SA(1, 1), a1 + hstep, voffA);
            PG8_WAIT_V(8); PG8_WAIT_L(0); PG8_BAR; PG8_MMA(0, 0, At, B0); PG8_MMA(0, 1, At, B1); PG8_BAR; PG8_SCHED;
            PG8_LDA(At, 0, 1); PG8_STAGE(PG8_SB(0, 0), b2, voffB); PG8_STAGE(PG8_SB(0, 1), b2 + hstep, voffB); PG8_STAGE(PG8_SA(0, 0), a2, voffA);
            PG8_WAIT_V(8); PG8_WAIT_L(0); PG8_BAR; PG8_MMA(1, 0, At, B0); PG8_MMA(1, 1, At, B1); PG8_BAR; PG8_SCHED;
            PG8_LDB(B0, 1, 0); PG8_LDB(B1, 1, 1); PG8_SCHED; PG8_LDA(At, 1, 0); PG8_STAGE(PG8_SA(0, 1), a2 + hstep, voffA);
            PG8_WAIT_V(8); PG8_WAIT_L(0); PG8_BAR; PG8_MMA(0, 0, At, B0); PG8_MMA(0, 1, At, B1); PG8_BAR; PG8_SCHED;
            PG8_LDA(At, 1, 1); PG8_STAGE(PG8_SB(1, 0), b3, voffB); PG8_STAGE(PG8_SB(1, 1), b3 + hstep, voffB); PG8_STAGE(PG8_SA(1, 0), a3, voffA);
            PG8_WAIT_V(8); PG8_WAIT_L(0); PG8_BAR; PG8_MMA(1, 0, At, B0); PG8_MMA(1, 1, At, B1); PG8_BAR; PG8_SCHED;
            } else {
            PG8_LDB(B0, 0, 0); PG8_SCHED; PG8_LDA(At, 0, 0); PG8_STAGE(PG8_SA(1, 1), a1 + hstep, voffA);
            PG8_WAIT_L(8); PG8_BAR; PG8_WAIT_L(0); PG8_MMA(0, 0, At, B0); PG8_BAR; PG8_SCHED;
            PG8_LDB(B1, 0, 1); PG8_STAGE(PG8_SB(0, 0), b2, voffB);
            PG8_BAR; PG8_WAIT_L(0); PG8_MMA(0, 1, At, B1); PG8_BAR;
            PG8_LDA(At, 0, 1); PG8_STAGE(PG8_SA(0, 0), a2, voffA);
            PG8_BAR; PG8_WAIT_L(0); PG8_MMA(1, 0, At, B0); PG8_BAR; PG8_SCHED;
            PG8_STAGE(PG8_SB(0, 1), b2 + hstep, voffB);
            PG8_WAIT_V(6); PG8_BAR; PG8_MMA(1, 1, At, B1); PG8_BAR;
            PG8_LDB(B0, 1, 0); PG8_SCHED; PG8_LDA(At, 1, 0); PG8_STAGE(PG8_SA(0, 1), a2 + hstep, voffA);
            PG8_WAIT_L(8); PG8_BAR; PG8_WAIT_L(0); PG8_MMA(0, 0, At, B0); PG8_BAR; PG8_SCHED;
            PG8_LDB(B1, 1, 1); PG8_STAGE(PG8_SB(1, 0), b3, voffB);
            PG8_BAR; PG8_WAIT_L(0); PG8_MMA(0, 1, At, B1); PG8_BAR;
            PG8_LDA(At, 1, 1); PG8_STAGE(PG8_SA(1, 0), a3, voffA);
            PG8_BAR; PG8_WAIT_L(0); PG8_MMA(1, 0, At, B0); PG8_BAR; PG8_SCHED;
            PG8_STAGE(PG8_SB(1, 1), b3 + hstep, voffB);
            PG8_WAIT_V(6); PG8_BAR; PG8_MMA(1, 1, At, B1); PG8_BAR;
            }
        }
        if constexpr (ALIGN_EPI) { if (wr == 0) PG8_BAR; }
        if constexpr (!Epi::AFTER_DRAIN) { E(acc, cur, wr, wc, fr, fq); S.done(cur); }
        if (!has_next) break;
{ float zf = 0.f; asm volatile("" : "+v"(zf));
#pragma unroll
        for (int a = 0; a < 2; ++a)
#pragma unroll
            for (int b = 0; b < 2; ++b)
#pragma unroll
                for (int m = 0; m < 4; ++m)
#pragma unroll
                    for (int n = 0; n < 2; ++n) acc[a][b][m][n] = (f32x4){zf, zf, zf, zf}; }
        cur = nxt; cA = nA; cB = nB; ++ui;
        if constexpr (ALIGN_EPI) { if (wr == 1) PG8_BAR; }
    }
    PG8_WAIT_V(0);
    if constexpr (!ALIGN_EPI) { if (wr == 0) PG8_BAR; }
    PG8_BAR;
    if constexpr (Epi::AFTER_DRAIN) { E.fused(acc, cur, wr, wc, fr, fq, lds, wid, lane); S.done(cur); }
#undef PG8_SA
#undef PG8_SB
#undef PG8_STAGE
#undef PG8_LDA
#undef PG8_LDB
#undef PG8_MMA
#undef PG8_WAIT_V
#undef PG8_WAIT_L
#undef PG8_BAR
#undef PG8_SCHED
}
}

#ifndef LAS
#define LAS __attribute__((address_space(3)))
#endif
#ifdef HOST_EMU
#define PAS
#else
#define PAS __attribute__((address_space(4)))
#endif
typedef unsigned short bf16;
typedef float f32x4 __attribute__((ext_vector_type(4)));
typedef unsigned v4u __attribute__((ext_vector_type(4)));
typedef unsigned v2u __attribute__((ext_vector_type(2)));
typedef float cf2 __attribute__((ext_vector_type(2)));

#ifndef SEQ_
#define SEQ_ 4096
#define CTXL_ 256
#endif
constexpr int D = 1024, NB = 8, SEQ = SEQ_, CTXL = CTXL_, DEPTH = 4;
constexpr int RC = NB * CTXL;
constexpr int RL = NB * SEQ;
constexpr int RT = RC + RL;
constexpr int NIN = 7360, DFF = 2816;
constexpr int NTHR = 512, NWAVES = 8;
constexpr int LDS_BYTES = 147456;

constexpr size_t MiB = (size_t)1 << 20;
constexpr size_t WS_CTL = 0;
constexpr size_t WS_MOD = 1 * MiB;
constexpr size_t WS_W   = 2 * MiB;
constexpr size_t WS_XC  = 37 * MiB;
constexpr size_t WS_U   = 45 * MiB;
constexpr size_t WS_Y   = 113 * MiB;
constexpr size_t WS_BIG = 181 * MiB;
constexpr size_t WS_END = 505 * MiB;
constexpr size_t SZ17 = (size_t)RT * 256 * 2;
constexpr size_t SZ34 = (size_t)RT * 256 * 4;
constexpr size_t WO_WP = 0;
constexpr size_t WO_WG = WO_WP + (size_t)3328 * 1024;
constexpr size_t WO_BR = WO_WG + (size_t)4096 * 1024;
constexpr size_t WO_WO = WO_BR + (size_t)4 * 1024 * 256;
constexpr size_t WO_W1 = WO_WO + (size_t)1024 * 1024;
constexpr size_t WO_W2 = WO_W1 + (size_t)5632 * 1024;
static_assert((WO_W2 + (size_t)1024 * 2816) * 2 <= 35 * MiB, "weights region");
constexpr size_t BG_P = 0;
constexpr size_t BG_S = 68 * MiB;

struct Prm { const float* in[41]; float* out; unsigned char* ws; int lo, hi; };

__device__ __forceinline__ float bf2f(bf16 b) { return __uint_as_float(((unsigned)b) << 16); }
__device__ __forceinline__ bf16 f2bf(float f) { unsigned u = __float_as_uint(f); return (bf16)((u + 0x7fffu + ((u >> 16) & 1u)) >> 16); }
__device__ __forceinline__ unsigned pk2(float lo, float hi) { return (unsigned)f2bf(lo) | ((unsigned)f2bf(hi) << 16); }
__device__ __forceinline__ float blo(unsigned u) { return __uint_as_float(u << 16); }
__device__ __forceinline__ float bhi(unsigned u) { return __uint_as_float(u & 0xffff0000u); }
__device__ __forceinline__ float sigmoidf_(float x) { return 1.f / (1.f + __expf(-x)); }
__device__ __forceinline__ float softplusf_(float x) { return x > 20.f ? x : log1pf(__expf(x)); }
template <int CTRL> __device__ __forceinline__ float dpp_mov(float v) { return __int_as_float(__builtin_amdgcn_update_dpp(0, __float_as_int(v), CTRL, 0xF, 0xF, true)); }
__device__ __forceinline__ float row16_sum(float v) {
    v += dpp_mov<0xB1>(v);
    v += dpp_mov<0x4E>(v);
    v += dpp_mov<0x141>(v);
    v += dpp_mov<0x140>(v);
    return v;
}
#ifdef HOST_EMU
__device__ __forceinline__ float wave_sum(float v) {
#pragma unroll
    for (int o = 1; o < 64; o <<= 1) v += __shfl_xor(v, o);
    return v;
}
#else
__device__ __forceinline__ float wave_sum(float v) {
    v = row16_sum(v);
    v += __int_as_float(__builtin_amdgcn_ds_swizzle(__float_as_int(v), 0x401F));
    return __int_as_float(__builtin_amdgcn_readlane(__float_as_int(v), 0)) + __int_as_float(__builtin_amdgcn_readlane(__float_as_int(v), 32));
}
#endif

#ifdef HOST_EMU
static inline float sfma(float a, float b, float c) { return a * b + c; }
static inline float smul(float a, float b) { return a * b; }
static inline float sadd(float a, float b) { return a + b; }
static inline float ssub(float a, float b) { return a - b; }
#else
__device__ __forceinline__ float sfma(float a, float b, float c) { float d; asm("v_fma_f32 %0, %1, %2, %3" : "=v"(d) : "v"(a), "v"(b), "v"(c)); return d; }
__device__ __forceinline__ float smul(float a, float b) { float d; asm("v_mul_f32_e32 %0, %1, %2" : "=v"(d) : "v"(a), "v"(b)); return d; }
__device__ __forceinline__ float sadd(float a, float b) { float d; asm("v_add_f32_e32 %0, %1, %2" : "=v"(d) : "v"(a), "v"(b)); return d; }
__device__ __forceinline__ float ssub(float a, float b) { float d; asm("v_sub_f32_e32 %0, %1, %2" : "=v"(d) : "v"(a), "v"(b)); return d; }
#endif
#ifdef HOST_EMU
__device__ __forceinline__ float half32_sum(float v) { for (int o = 1; o < 32; o <<= 1) v += __shfl_xor(v, o); return v; }
#else
__device__ __forceinline__ float half32_sum(float v) { v = row16_sum(v); return v + __int_as_float(__builtin_amdgcn_ds_swizzle(__float_as_int(v), 0x401F)); }
#endif
__device__ __forceinline__ float block_sum(float v, LAS float* sc, int tid) {
    v = wave_sum(v);
    if ((tid & 63) == 0) sc[tid >> 6] = v;
    __syncthreads();
    const float r = ((sc[0] + sc[1]) + (sc[2] + sc[3])) + ((sc[4] + sc[5]) + (sc[6] + sc[7]));
    __syncthreads();
    return r;
}
#ifndef HOST_EMU
#define XB_TMO      128
#define XB_XCNT(j)  (256  + 64 * (j))
#define XB_XSUB(j)  (1280 + 64 * (j))
#define XB_XGEN(j)  (2304 + 64 * (j))
#define XB_TOP      3328
#define XB_TOPGEN   3392
#define XCD_BAR_WORDS 3456
#define XB_SPIN_CAP (1u << 18)
__device__ __forceinline__ unsigned xb_ld(unsigned* p)              { return __hip_atomic_load(p, __ATOMIC_RELAXED, __HIP_MEMORY_SCOPE_AGENT); }
__device__ __forceinline__ unsigned xb_add(unsigned* p, unsigned v) { return __hip_atomic_fetch_add(p, v, __ATOMIC_RELAXED, __HIP_MEMORY_SCOPE_AGENT); }
__device__ __forceinline__ unsigned xb_xcc_id() { return (unsigned)__builtin_amdgcn_s_getreg((3 << 11) | 20) & 0xFu; }
#define XB_SPIN(cond, bar) do { unsigned _sp = 0; while (cond) { __builtin_amdgcn_s_sleep(1); \
    if ((++_sp & 255u) == 0u) { if (xb_ld(&(bar)[XB_TMO])) break; if (_sp > XB_SPIN_CAP) { atomicAdd(&(bar)[XB_TMO], 1u); break; } } } } while (0)
struct XcdBarrier { unsigned* bar; unsigned x; volatile LAS unsigned* st; };
__device__ __forceinline__ XcdBarrier xcd_barrier_post(unsigned* bar, volatile LAS unsigned* st) {
    XcdBarrier b; b.bar = bar; b.x = xb_xcc_id(); b.st = st;
    if (threadIdx.x == 0) (void)xb_add(&bar[XB_XCNT(b.x)], 1u);
    return b;
}
__device__ __forceinline__ void xcd_barrier_complete(unsigned* bar, unsigned x, unsigned& nloc, unsigned& nx) {
    const unsigned G = gridDim.x * gridDim.y * gridDim.z;
    unsigned sum, cnt, mine, sp = 0u;
    for (;;) {
        sum = 0u; cnt = 0u; mine = 0u;
#pragma unroll
        for (unsigned j = 0; j < 16; ++j) { const unsigned c = xb_ld(&bar[XB_XCNT(j)]); sum += c; cnt += (c > 0u) ? 1u : 0u; mine = (j == x) ? c : mine; }
        if (sum == G) break;
        __builtin_amdgcn_s_sleep(1);
        if ((++sp & 255u) == 0u) { if (xb_ld(&bar[XB_TMO])) break; if (sp > XB_SPIN_CAP) { atomicAdd(&bar[XB_TMO], 1u); break; } }
    }
    nloc = mine > 0u ? mine : 1u; nx = cnt > 0u ? cnt : 1u;
}
__device__ __forceinline__ void xcd_barrier(const XcdBarrier& b) {
    asm volatile("s_waitcnt vmcnt(0)" ::: "memory");
    __syncthreads();
    if (tid_opq() == 0) {
        unsigned* bar = b.bar; asm volatile("" : "+v"(bar));
        __builtin_amdgcn_s_waitcnt(0);
        unsigned nloc = b.st[0], nx = b.st[1];
        if (nloc == 0u) { xcd_barrier_complete(bar, b.x, nloc, nx); b.st[0] = nloc; b.st[1] = nx; }
        const unsigned old = xb_add(&bar[XB_XSUB(b.x)], 1u);
        const unsigned gen = old / nloc;
        if (old + 1u == (gen + 1u) * nloc) {
            __builtin_amdgcn_fence(__ATOMIC_RELEASE, "agent");
            asm volatile("s_waitcnt vmcnt(0)" ::: "memory");
            const unsigned og = xb_add(&bar[XB_TOP], 1u);
            const unsigned tg = og / nx;
            if (og + 1u == (tg + 1u) * nx) xb_add(&bar[XB_TOPGEN], 1u);
            else XB_SPIN(xb_ld(&bar[XB_TOPGEN]) == tg, bar);
            __builtin_amdgcn_fence(__ATOMIC_ACQUIRE, "agent");
            xb_add(&bar[XB_XGEN(b.x)], 1u);
            asm volatile("s_waitcnt vmcnt(0)" ::: "memory");
        } else {
            XB_SPIN(xb_ld(&bar[XB_XGEN(b.x)]) == gen, bar);
            __builtin_amdgcn_fence(__ATOMIC_ACQUIRE, "agent");
            asm volatile("s_waitcnt vmcnt(0)" ::: "memory");
        }
    }
    __syncthreads();
}

#endif
#ifdef HOST_EMU
#define TID ((int)threadIdx.x)
#define BID ((int)blockIdx.x)
#define NBLK ((int)gridDim.x)
#else
#define TID tid_opq()
#define BID ((int)blockIdx.x)
#define NBLK ((int)gridDim.x)
#endif

__device__ __forceinline__ void ph_mod(const PAS Prm& p, LAS unsigned char* lds) {
    LAS float* sc = (LAS float*)lds;
    LAS float* red = sc + 9 * 1024;
    const float* c = p.in[1]; const float* cctx = p.in[3]; const float* w_mod = p.in[4]; const float* b_mod = p.in[5];
    float* mod = (float*)(p.ws + WS_MOD);
    const int tid = TID, lane = tid & 63, wave = tid >> 6;
    for (int i = tid; i < 9 * 1024; i += NTHR) { const int j = i >> 10, k = i & 1023; const float v = (j < 8) ? c[j * 1024 + k] : cctx[k]; sc[i] = v / (1.f + expf(-v)); }
    __syncthreads();
    for (int it = BID; it < 4 * 96; it += NBLK) {
        const int l = it / 96, cg = it % 96, col = cg * 64 + lane;
        float acc[9];
#pragma unroll
        for (int j = 0; j < 9; ++j) acc[j] = 0.f;
        const float* W = w_mod + (size_t)l * 1024 * 6144 + col;
        for (int k = wave * 128; k < wave * 128 + 128; ++k) { const float w = W[(size_t)k * 6144];
#pragma unroll
            for (int j = 0; j < 9; ++j) acc[j] += sc[j * 1024 + k] * w; }
#pragma unroll
        for (int j = 0; j < 9; ++j) red[(wave * 9 + j) * 64 + lane] = acc[j];
        __syncthreads();
        for (int i = tid; i < 9 * 64; i += NTHR) { const int j = i >> 6, ln = i & 63; float s = b_mod[l * 6144 + cg * 64 + ln];
#pragma unroll
            for (int w = 0; w < 8; ++w) s += red[(w * 9 + j) * 64 + ln];
            mod[((size_t)l * 9 + j) * 6144 + cg * 64 + ln] = s; }
        __syncthreads();
    }
}

#ifdef HOST_EMU
#define PH_ZOPQ(z) do { } while (0)
#else
#define PH_ZOPQ(z) asm volatile("" : "+v"(z))
#endif
#ifdef HOST_EMU
#define LGKM_WAIT() do { (void)emu_xchg(0, threadIdx.x & 63); } while (0)
#else
#define LGKM_WAIT() asm volatile("s_waitcnt lgkmcnt(0)" ::: "memory")
#endif
__device__ __forceinline__ void cvt_item(const float* W, size_t ldw, int k0, int n0, bf16* WT, int K, int drow0, LAS float* scr, int lane) {
#pragma unroll 8
    for (int i = 0; i < 32; ++i) { const int kk = 2 * i + (lane >> 5); scr[kk * 33 + (lane & 31)] = W[(size_t)(k0 + kk) * ldw + n0 + (lane & 31)]; }
    LGKM_WAIT();
    const int c = lane & 7;
#pragma unroll
    for (int j = 0; j < 4; ++j) { const int n = (lane >> 3) + 8 * j; const LAS float* s = scr + (8 * c) * 33 + n;
        v4u o; o.x = pk2(s[0 * 33], s[1 * 33]); o.y = pk2(s[2 * 33], s[3 * 33]); o.z = pk2(s[4 * 33], s[5 * 33]); o.w = pk2(s[6 * 33], s[7 * 33]);
        *(v4u*)(WT + (size_t)(drow0 + n) * K + k0 + 8 * c) = o; }
    LGKM_WAIT();
}
__device__ __forceinline__ void ph_cvt(const PAS Prm& p, int l, LAS unsigned char* lds, const int part = 0, const int blk0 = 0) {
    const int tid = TID, lane = tid & 63, wave = tid >> 6;
    LAS float* scr = (LAS float*)(lds + wave * 16384);
    bf16* WB = (bf16*)(p.ws + WS_W);
    const float* w_in = p.in[8] + (size_t)l * 1024 * NIN;
    const float* brp = p.in[36] + (size_t)l * 4 * 256 * 1024;
    const float* wout = p.in[37] + (size_t)l * 1024 * 1024;
    const float* w1 = p.in[38] + (size_t)l * 1024 * 5632;
    const float* w2 = p.in[39] + (size_t)l * 2816 * 1024;
    constexpr int I_IN = 16 * 230, I_BR = 4 * 4 * 32, I_WO = 16 * 32, I_W1 = 16 * 176, I_W2 = 44 * 32, I_PAD = 16;
    constexpr int NITEMS = I_IN + I_BR + I_WO + I_W1 + I_W2 + I_PAD;
    const int gw = (BID - blk0) * NWAVES + wave, NGW = (NBLK - blk0) * NWAVES;
    constexpr int I_PRE = I_IN + I_BR + I_WO + I_W1;
    const int nit = part == 0 ? NITEMS : part == 1 ? NITEMS - I_W2 : I_W2;
    for (int it = gw; it < nit; it += NGW) {
        int r = part == 0 ? it : part == 1 ? (it < I_PRE ? it : it + I_W2) : it + I_PRE;
        if (r < I_IN) { const int kb = r / 230, nb = r % 230, n0 = nb * 32;
            if (n0 < 3264) { const int drow = n0 < 768 ? n0 + 512 : n0 < 1728 ? n0 + 512 : n0 < 2240 ? n0 - 1728 : n0 + 64;
                cvt_item(w_in, NIN, kb * 64, n0, WB + WO_WP, 1024, drow, scr, lane);
            } else { cvt_item(w_in, NIN, kb * 64, n0, WB + WO_WG, 1024, n0 - 3264, scr, lane); }
            continue; }
        r -= I_IN;
        if (r < I_BR) { const int n = r / 128, q = r % 128, kb = q / 32, nb = q % 32;
            cvt_item(brp + (size_t)n * 256 * 1024, 1024, kb * 64, nb * 32, WB + WO_BR + (size_t)n * 1024 * 256, 256, nb * 32, scr, lane); continue; }
        r -= I_BR;
        if (r < I_WO) { const int kb = r / 32, nb = r % 32; cvt_item(wout, 1024, kb * 64, nb * 32, WB + WO_WO, 1024, nb * 32, scr, lane); continue; }
        r -= I_WO;
        if (r < I_W1) { const int kb = r / 176, nb = r % 176, n0 = nb * 32; const int hh = n0 / 2816, jj = n0 % 2816, pn = jj / 128, j2 = jj % 128;
            cvt_item(w1, 5632, kb * 64, n0, WB + WO_W1, 1024, 256 * pn + 128 * hh + j2, scr, lane); continue; }
        r -= I_W1;
        if (r < I_W2) { const int kb = r / 32, nb = r % 32; cvt_item(w2, 1024, kb * 64, nb * 32, WB + WO_W2, 2816, nb * 32, scr, lane); continue; }
        r -= I_W2;
        {
            unsigned z0 = 0u; PH_ZOPQ(z0); v4u z = (v4u){z0, z0, z0, z0};
            for (int i = lane; i < 4 * 128; i += 64) { const int rr = 2240 + r * 4 + i / 128, cc = (i % 128) * 8; *(v4u*)(WB + WO_WP + (size_t)rr * 1024 + cc) = z; }
        }
    }
}

__device__ __forceinline__ void ph_norm(const PAS Prm& p, int l, int which, const float* xc_src, const float* xl_src, int r_begin) {
    const int tid = TID, lane = tid & 63, wave = tid >> 6;
    const float* mod = (const float*)(p.ws + WS_MOD) + (size_t)l * 9 * 6144;
    const float* g = (which ? p.in[7] : p.in[6]) + l * 1024;
    bf16* U = (bf16*)(p.ws + WS_U);
    const int gw = BID * NWAVES + wave, NGW = NBLK * NWAVES;
    constexpr int NR = 2;
    f32x4 gg[4];
#pragma unroll
    for (int j = 0; j < 4; ++j) gg[j] = *(const f32x4*)(g + 4 * lane + 256 * j);
    for (int r0 = r_begin + gw * NR; r0 < RT; r0 += NGW * NR) {
        f32x4 v[NR][4], sc[NR][4], sh[NR][4]; float s[NR];
#pragma unroll
        for (int q = 0; q < NR; ++q) { const int r = r0 + q;
            const float* xr = (r < RC) ? xc_src + (size_t)r * 1024 : xl_src + (size_t)(r - RC) * 1024; s[q] = 0.f;
#pragma unroll
            for (int j = 0; j < 4; ++j) v[q][j] = *(const f32x4*)(xr + 4 * lane + 256 * j); }
#pragma unroll
        for (int q = 0; q < NR; ++q) { const int r = r0 + q;
            const int jb = (r < RC) ? 8 : (r - RC) / SEQ;
            const float* shift = mod + (size_t)jb * 6144 + (which ? 3 * 1024 : 0);
#pragma unroll
            for (int j = 0; j < 4; ++j) { sh[q][j] = *(const f32x4*)(shift + 4 * lane + 256 * j); sc[q][j] = *(const f32x4*)(shift + 1024 + 4 * lane + 256 * j); } }
#pragma unroll
        for (int q = 0; q < NR; ++q) {
#pragma unroll
            for (int j = 0; j < 4; ++j) s[q] += (v[q][j].x * v[q][j].x + v[q][j].y * v[q][j].y) + (v[q][j].z * v[q][j].z + v[q][j].w * v[q][j].w); }
#pragma unroll
        for (int q = 0; q < NR; ++q) { const int r = r0 + q;
            const float rstd = rsqrtf(wave_sum(s[q]) * (1.f / 1024.f) + 1e-6f);
#pragma unroll
            for (int j = 0; j < 4; ++j) { const int c0 = 4 * lane + 256 * j;
                const f32x4 o = v[q][j] * rstd * gg[j] * (1.f + sc[q][j]) + sh[q][j];
                v2u w; w.x = pk2(o.x, o.y); w.y = pk2(o.z, o.w);
                *(v2u*)(U + (size_t)r * 1024 + c0) = w; } }
    }
}
__device__ __forceinline__ void ph_final(const PAS Prm& p) {
    const int tid = TID, lane = tid & 63, wave = tid >> 6;
    const float* g = p.in[40];
    const float poison = (*(const volatile unsigned*)(p.ws + WS_CTL + 768 * 1024) != 0u) ? __builtin_nanf("") : 0.f;
    const int gw = BID * NWAVES + wave, NGW = NBLK * NWAVES;
    for (int r = gw; r < RL; r += NGW) {
        float* xr = p.out + (size_t)r * 1024;
        f32x4 v[4]; float s = 0.f;
#pragma unroll
        for (int j = 0; j < 4; ++j) { v[j] = *(const f32x4*)(xr + 4 * lane + 256 * j); s += (v[j].x * v[j].x + v[j].y * v[j].y) + (v[j].z * v[j].z + v[j].w * v[j].w); }
        const float rstd = rsqrtf(wave_sum(s) * (1.f / 1024.f) + 1e-6f);
#pragma unroll
        for (int j = 0; j < 4; ++j) { const int c0 = 4 * lane + 256 * j; const f32x4 gg = *(const f32x4*)(g + c0); *(f32x4*)(xr + c0) = v[j] * rstd * gg + poison; }
    }
}

struct RowInfo { int lat, b, t, T, base; };
__device__ __forceinline__ RowInfo row_info(int r) {
    RowInfo q;
    if (r < RC) { q.lat = 0; q.b = r / CTXL; q.t = r % CTXL; q.T = CTXL; q.base = q.b * CTXL; }
    else { const int x = r - RC; q.lat = 1; q.b = x / SEQ; q.t = x % SEQ; q.T = SEQ; q.base = RC + q.b * SEQ; }
    return q;
}
__device__ __forceinline__ int scan_row(int b, int d, int tau) {
    if (tau < CTXL) return b * CTXL + (d ? (CTXL - 1 - tau) : tau);
    const int t = tau - CTXL; return RC + b * SEQ + (d ? (SEQ - 1 - t) : t);
}

constexpr size_t RW_R = 0, RW_K = SZ17, RW_V = 2 * SZ17, RW_KK = 3 * SZ17, RW_OM = 4 * SZ17  , RW_A = 6 * SZ17  , RW_G = 8 * SZ17, RW_Y = 9 * SZ17  , RW_BON = 9 * SZ17 + 2 * SZ34;
static_assert(RW_BON + (size_t)RT * 16 <= 222 * MiB, "rwkv scratch");

typedef short bfx8 __attribute__((ext_vector_type(8)));
__device__ __forceinline__ bfx8 pack8(const float (&v)[8]) { bfx8 r;
#pragma unroll
    for (int i = 0; i < 8; ++i) r[i] = (short)f2bf(v[i]);
    return r; }
__device__ __forceinline__ void ph_rw_prep(const PAS Prm& p, int l, LAS unsigned char* lds) {
    LAS float* xx = (LAS float*)lds;
    LAS float* res = xx + 16 * 960;
    const int tid = TID, lane = tid & 63, wave = tid >> 6;
    const bf16* P = (const bf16*)(p.ws + WS_Y);
    unsigned char* S = p.ws + WS_BIG + BG_S;
    bf16* oR = (bf16*)(S + RW_R); bf16* oK = (bf16*)(S + RW_K); bf16* oV = (bf16*)(S + RW_V); bf16* oKK = (bf16*)(S + RW_KK);
    bf16* oOM = (bf16*)(S + RW_OM); bf16* oA = (bf16*)(S + RW_A); bf16* oG = (bf16*)(S + RW_G); float* oBon = (float*)(S + RW_BON);
    const float* mu = p.in[18] + l * 960;
    const float* w0 = p.in[19] + l * 512; const float* w2 = p.in[20] + (size_t)l * 2 * 64 * 256;
    const float* a0 = p.in[21] + l * 512; const float* a2 = p.in[22] + (size_t)l * 2 * 64 * 256;
    const float* g2 = p.in[23] + (size_t)l * 64 * 256;
    const float* k_k = p.in[24] + l * 256; const float* r_k = p.in[26] + l * 256;
    const int j = tid & 255, half = tid >> 8, h = j >> 6;
    bfx8 Bf[5][2][2];
#pragma unroll
    for (int m = 0; m < 5; ++m) { const float* W = m == 0 ? w2 : m == 1 ? w2 + 64 * 256 : m == 2 ? a2 : m == 3 ? a2 + 64 * 256 : g2;
#pragma unroll
        for (int ct = 0; ct < 2; ++ct)
#pragma unroll
            for (int ks = 0; ks < 2; ++ks) { float v[8];
#pragma unroll
                for (int q = 0; q < 8; ++q) v[q] = W[(size_t)(32 * ks + (lane >> 4) * 8 + q) * 256 + 32 * wave + 16 * ct + (lane & 15)];
                Bf[m][ct][ks] = pack8(v); } }
    const int cpair = 2 * (tid & 127);
    const cf2 kkp = {k_k[cpair], k_k[cpair + 1]}, rkp = {r_k[cpair], r_k[cpair + 1]}, w0p0 = {w0[cpair], w0[cpair + 1]}, w0p1 = {w0[256 + cpair], w0[256 + cpair + 1]}, a0p0 = {a0[cpair], a0[cpair + 1]}, a0p1 = {a0[256 + cpair], a0[256 + cpair + 1]};
    for (int tile = BID; tile < RT / 16; tile += NBLK) {
        const int r0 = tile * 16;
        for (int t = tid; t < 16 * 120; t += NTHR) {
            const int rr = t / 120, c0 = (t % 120) * 8, r = r0 + rr;
            const RowInfo ri = row_info(r);
            int nb[4];
            if (ri.lat) { const int gc = ri.t & 63, gr = ri.t >> 6;
                nb[0] = gc >= 1 ? r - 1 : -1; nb[1] = gc <= 62 ? r + 1 : -1; nb[2] = gr >= 1 ? r - 64 : -1; nb[3] = gr <= SEQ / 64 - 2 ? r + 64 : -1; }
            else { nb[0] = ri.t >= 1 ? r - 1 : -1; nb[1] = ri.t <= CTXL - 2 ? r + 1 : -1; nb[2] = nb[0]; nb[3] = nb[1]; }
            const v4u pv = *(const v4u*)(P + (size_t)r * 1024 + c0);
            v4u nv[4];
#pragma unroll
            for (int q = 0; q < 4; ++q) nv[q] = nb[q] >= 0 ? *(const v4u*)(P + (size_t)nb[q] * 1024 + c0) : (v4u){0u, 0u, 0u, 0u};
            const f32x4 m0 = *(const f32x4*)(mu + c0), m1 = *(const f32x4*)(mu + c0 + 4);
            float o[8];
#pragma unroll
            for (int i = 0; i < 8; ++i) { const unsigned pw = ((const unsigned*)&pv)[i >> 1], sw = ((const unsigned*)&nv[i & 3])[i >> 1];
                const float pf = (i & 1) ? bhi(pw) : blo(pw), sf = (i & 1) ? bhi(sw) : blo(sw), mm = i < 4 ? m0[i] : m1[i - 4];
                float x = pf + (sf - pf) * mm;
                if (c0 >= 768 && c0 < 832) x = tanhf(x); else if (c0 >= 896) x = sigmoidf_(x);
                o[i] = x; }
            *(LAS f32x4*)(xx + rr * 960 + c0) = (f32x4){o[0], o[1], o[2], o[3]}; *(LAS f32x4*)(xx + rr * 960 + c0 + 4) = (f32x4){o[4], o[5], o[6], o[7]};
        }
        __syncthreads();
        {
            f32x4 acc[5][2];
#pragma unroll
            for (int m = 0; m < 5; ++m) { acc[m][0] = (f32x4){0.f, 0.f, 0.f, 0.f}; acc[m][1] = (f32x4){0.f, 0.f, 0.f, 0.f}; }
#pragma unroll
            for (int inp = 0; inp < 3; ++inp)
#pragma unroll
                for (int ks = 0; ks < 2; ++ks) {
                    const LAS float* ap = xx + (lane & 15) * 960 + 768 + 64 * inp + 32 * ks + (lane >> 4) * 8;
                    const f32x4 x0 = *(const LAS f32x4*)ap, x1 = *(const LAS f32x4*)(ap + 4);
                    const float av[8] = {x0.x, x0.y, x0.z, x0.w, x1.x, x1.y, x1.z, x1.w};
                    const bfx8 Af = pack8(av);
#pragma unroll
                    for (int ct = 0; ct < 2; ++ct) {
                        if (inp == 0) { acc[0][ct] = __builtin_amdgcn_mfma_f32_16x16x32_bf16(Af, Bf[0][ct][ks], acc[0][ct], 0, 0, 0); acc[1][ct] = __builtin_amdgcn_mfma_f32_16x16x32_bf16(Af, Bf[1][ct][ks], acc[1][ct], 0, 0, 0); }
                        else if (inp == 1) { acc[2][ct] = __builtin_amdgcn_mfma_f32_16x16x32_bf16(Af, Bf[2][ct][ks], acc[2][ct], 0, 0, 0); acc[3][ct] = __builtin_amdgcn_mfma_f32_16x16x32_bf16(Af, Bf[3][ct][ks], acc[3][ct], 0, 0, 0); }
                        else acc[4][ct] = __builtin_amdgcn_mfma_f32_16x16x32_bf16(Af, Bf[4][ct][ks], acc[4][ct], 0, 0, 0);
                    }
                }
#pragma unroll
            for (int m = 0; m < 5; ++m)
#pragma unroll
                for (int ct = 0; ct < 2; ++ct)
#pragma unroll
                    for (int q = 0; q < 4; ++q) res[((lane >> 4) * 4 + q) * 1280 + m * 256 + 32 * wave + 16 * ct + (lane & 15)] = acc[m][ct][q];
        }
        __syncthreads();
        {
            const int j2 = tid & 127, rq = tid >> 7, c = 2 * j2, hh2 = c >> 6;
#pragma unroll
            for (int q = 0; q < 4; ++q) {
                const int rr = rq * 4 + q; const size_t r = (size_t)(r0 + rr);
                const LAS float* xr = xx + rr * 960; const LAS float* rs = res + rr * 1280;
                const float rv0 = xr[c], rv1 = xr[c + 1], kv0 = xr[256 + c], kv1 = xr[256 + c + 1], vv0 = xr[512 + c], vv1 = xr[512 + c + 1];
                const float kr0 = kv0 * kkp.x, kr1 = kv1 * kkp.y;
                const float ss = half32_sum(kr0 * kr0 + kr1 * kr1);
                const float nrm = rsqrtf(ss + 1e-12f);
                const float bon = half32_sum(rv0 * kv0 * rkp.x + rv1 * kv1 * rkp.y);
                *(unsigned*)(oR + r * 256 + c) = pk2(rv0, rv1); *(unsigned*)(oK + r * 256 + c) = pk2(kv0, kv1); *(unsigned*)(oV + r * 256 + c) = pk2(vv0, vv1);
                *(unsigned*)(oKK + r * 256 + c) = pk2(kr0 * nrm, kr1 * nrm);
                *(unsigned*)(oG + r * 256 + c) = pk2(rs[4 * 256 + c], rs[4 * 256 + c + 1]);
                if ((lane & 31) == 0) oBon[r * 4 + hh2] = bon;
#pragma unroll
                for (int d = 0; d < 2; ++d) {
                    const float wv0 = (d ? w0p1.x : w0p0.x) + rs[d * 256 + c], wv1 = (d ? w0p1.y : w0p0.y) + rs[d * 256 + c + 1];
                    const float om0 = 1.f - __expf(-0.6065306597126334f * sigmoidf_(wv0)), om1 = 1.f - __expf(-0.6065306597126334f * sigmoidf_(wv1));
                    const float av0 = sigmoidf_((d ? a0p1.x : a0p0.x) + rs[(2 + d) * 256 + c]), av1 = sigmoidf_((d ? a0p1.y : a0p0.y) + rs[(2 + d) * 256 + c + 1]);
                    *(unsigned*)(oOM + (size_t)d * RT * 256 + r * 256 + c) = pk2(om0, om1);
                    *(unsigned*)(oA + (size_t)d * RT * 256 + r * 256 + c) = pk2(av0, av1);
                }
            }
        }
        __syncthreads();
    }
}

#ifdef HOST_EMU
#define SC_PIN(x) do { } while (0)
#else
#define SC_PIN(x) asm("" : "+v"(x))
#endif
template <int MODE, int SPREAD = 1>
__device__ __forceinline__ void scan_phase(const int bid  , const unsigned char* Sb  , const bf16* Pv  ,
                                           void* Yout_  , const float* ka  , const float* gam  , LAS unsigned char* lds) {
    constexpr int NF = MODE == 0 ? 5 : 2;
    constexpr int CH = 32, ARRB = CH * 256, VOFF = NF * ARRB, BUFB = VOFF + CH * 128, NCH = (CTXL + SEQ) / CH;
    const int tid = TID, lane = tid & 63, wave = tid >> 6;
    if (bid < 0 || bid >= 128 * SPREAD) return;
    const int prob = bid / (2 * SPREAD), b = prob >> 3, h = (prob >> 1) & 3, d = prob & 1;
    const int rowv = (32 / SPREAD) * (bid & (2 * SPREAD - 1)) + 4 * (wave & (8 / SPREAD - 1)) + (lane >> 4);
    const bool computes = SPREAD == 1 || wave < 4;
    const int stt = SPREAD == 1 ? tid : (tid ^ 256);
    const int kl = lane & 15;
    const int st_s = (stt & 255) >> 3, st_g = stt & 7;
    const bool st_v = stt >= 256;
    float kav[8];
    float gamma = 0.f;
#pragma unroll
    for (int i = 0; i < 8; ++i) kav[i] = (MODE == 0) ? ka[h * 64 + 8 * st_g + i] : 0.f;
    if (MODE == 1) gamma = sigmoidf_(gam[d * 4 + h]);
    const size_t colb = (size_t)(h * 64 + st_g * 8) * 2;
    const unsigned char* src0 = (MODE == 0) ? Sb + colb : (const unsigned char*)Pv + colb;
    const unsigned char* srcp = (const unsigned char*)Pv + (size_t)(h * 64 + (st_g ^ 2) * 8) * 2;
    const unsigned char* srcv = (MODE == 0) ? Sb + 2 * SZ17 + colb : (const unsigned char*)Pv + (size_t)(512 + h * 64 + st_g * 8) * 2;
    const size_t ldv = (MODE == 0) ? 512 : 2048;
    LAS cf2* rtab = (LAS cf2*)(lds + 2 * BUFB);
    if (MODE == 1) { for (int i = tid; i < 64 * 16; i += NTHR) { float sn, cs; sincosf((float)(i >> 4) * exp2f(-(float)(i & 15) * (13.287712379549449f / 16.f)), &sn, &cs); rtab[i] = (cf2){cs, sn}; } __syncthreads(); }
    const bool rsecond = ((8 * st_g) & 31) >= 16, rcolhalf = (8 * st_g) >= 32;
    float S[4] = {0.f, 0.f, 0.f, 0.f};
    v4u pre[2][MODE == 0 ? 5 : 4];
    int st_tq[2] = {-1, -1};
#define SCAN_ISSUE(c, Q) do { const size_t row = (size_t)scan_row(b, d, (c) * CH + st_s); \
        if (st_v) pre[Q][0] = *(const v4u*)(srcv + row * ldv); \
        else if (MODE == 0) { pre[Q][0] = *(const v4u*)(src0 + row * 512); pre[Q][1] = *(const v4u*)(src0 + 1 * SZ17 + row * 512); pre[Q][2] = *(const v4u*)(src0 + 3 * SZ17 + row * 512); \
                              pre[Q][3] = *(const v4u*)(src0 + (size_t)(4 + d) * SZ17 + row * 512); pre[Q][4] = *(const v4u*)(src0 + (size_t)(6 + d) * SZ17 + row * 512); } \
        else { pre[Q][0] = *(const v4u*)(src0 + row * 2048); pre[Q][1] = *(const v4u*)(src0 + 512 + row * 2048); pre[Q][2] = *(const v4u*)(srcp + row * 2048); pre[Q][3] = *(const v4u*)(srcp + 512 + row * 2048); \
               st_tq[Q] = row >= (size_t)RC ? (int)((row - RC) & (SEQ - 1)) : -1; } } while (0)
#define SCAN_COMMIT(buf, Q) do { const int st_t = st_tq[Q]; (void)st_t; LAS unsigned char* bp = lds + (buf) * BUFB; \
        if (st_v) *(LAS v4u*)(bp + VOFF + st_s * 128 + st_g * 16) = pre[Q][0]; \
        else { LAS float* o = (LAS float*)(bp + st_s * 256 + st_g * 32); \
            if (MODE == 0) { _Pragma("unroll") for (int i = 0; i < 4; ++i) { \
                const unsigned ur = ((const unsigned*)&pre[Q][0])[i], uk = ((const unsigned*)&pre[Q][1])[i], ukk = ((const unsigned*)&pre[Q][2])[i], uom = ((const unsigned*)&pre[Q][3])[i], ua = ((const unsigned*)&pre[Q][4])[i]; \
                const float a0 = blo(ua), a1 = bhi(ua), kk0 = blo(ukk), kk1 = bhi(ukk); \
                o[0 * (ARRB / 4) + 2 * i] = blo(ur); o[0 * (ARRB / 4) + 2 * i + 1] = bhi(ur); \
                o[1 * (ARRB / 4) + 2 * i] = 1.f - blo(uom); o[1 * (ARRB / 4) + 2 * i + 1] = 1.f - bhi(uom); \
                o[2 * (ARRB / 4) + 2 * i] = blo(uk) * (1.f + (a0 - 1.f) * kav[2 * i]); o[2 * (ARRB / 4) + 2 * i + 1] = bhi(uk) * (1.f + (a1 - 1.f) * kav[2 * i + 1]); \
                o[3 * (ARRB / 4) + 2 * i] = kk0 * a0; o[3 * (ARRB / 4) + 2 * i + 1] = kk1 * a1; \
                o[4 * (ARRB / 4) + 2 * i] = -kk0; o[4 * (ARRB / 4) + 2 * i + 1] = -kk1; } } \
            else { const int icoord = st_t < 0 ? 0 : (rcolhalf ? (st_t & 63) : (st_t >> 6)); \
                _Pragma("unroll") for (int i = 0; i < 8; ++i) { const unsigned uq = ((const unsigned*)&pre[Q][0])[i >> 1], uk = ((const unsigned*)&pre[Q][1])[i >> 1], pq = ((const unsigned*)&pre[Q][2])[i >> 1], pk = ((const unsigned*)&pre[Q][3])[i >> 1]; \
                    const float q = (i & 1) ? bhi(uq) : blo(uq), k = (i & 1) ? bhi(uk) : blo(uk), qp = (i & 1) ? bhi(pq) : blo(pq), kp = (i & 1) ? bhi(pk) : blo(pk); \
                    float sn = 0.f, cs = 1.f; if (st_t >= 0) { const cf2 t2 = rtab[icoord * 16 + ((8 * st_g + i) & 15)]; cs = t2.x; sn = t2.y; } \
                    o[0 * (ARRB / 4) + i] = rsecond ? (qp * sn + q * cs) : (q * cs - qp * sn); \
                    o[1 * (ARRB / 4) + i] = 0.125f * (rsecond ? (kp * sn + k * cs) : (k * cs - kp * sn)); } } } } while (0)
    static_assert(NCH % 2 == 0, "chunk pairs");
    SCAN_ISSUE(0, 0); SCAN_COMMIT(0, 0); __syncthreads();
    SCAN_ISSUE(1, 1);
    float ycar = 0.f; ptrdiff_t ycar_i = 0; (void)ycar; (void)ycar_i;
    for (int c0 = 0; c0 < NCH; c0 += 2) {
#pragma unroll
    for (int hf = 0; hf < 2; ++hf) {
        const int c = c0 + hf;
        if (c + 2 < NCH) SCAN_ISSUE(c + 2, hf);
        const LAS unsigned char* bufp = lds + hf * BUFB;
        const int row_first = scan_row(b, d, c * CH);
        const size_t yoff = ((size_t)d * RT + row_first) * 256 + h * 64 + rowv;
        const int ystep = d ? -256 : 256;
        float ykeep = 0.f;
#ifndef HOST_EMU
#define DPQ1 " quad_perm:[1,0,3,2] row_mask:0xf bank_mask:0xf\n\t"
#define DPQ2 " quad_perm:[2,3,0,1] row_mask:0xf bank_mask:0xf\n\t"
#define DPHM " row_half_mirror row_mask:0xf bank_mask:0xf\n\t"
#define DPRM " row_mirror row_mask:0xf bank_mask:0xf\n\t"
#define SC_YRED(y) asm volatile("s_nop 1\n\tv_add_f32_dpp %0, %0, %0" DPQ1 "s_nop 1\n\tv_add_f32_dpp %0, %0, %0" DPQ2 "s_nop 1\n\tv_add_f32_dpp %0, %0, %0" DPHM "s_nop 1\n\tv_add_f32_dpp %0, %0, %0" DPRM "s_nop 1" : "+v"(y))
        const unsigned aop = (unsigned)(uintptr_t)(bufp + kl * 16), av = (unsigned)(uintptr_t)(bufp + rowv * 2);
        if (!computes) { }
        else if (MODE == 0) {
#define RWA_READ(KN, KT, BB, WW, RR, VV, s) asm volatile("ds_read_b128 %[kn], %[a] offset:%[o4]\n\tds_read_u16_d16_hi %[vv], %[av] offset:%[ov]\n\tds_read_b128 %[kt], %[a] offset:%[o2]\n\t" \
                "ds_read_b128 %[bb], %[a] offset:%[o3]\n\tds_read_b128 %[ww], %[a] offset:%[o1]\n\tds_read_b128 %[rr], %[a] offset:%[o0]" \
                : [kn] "=&v"(KN), [kt] "=&v"(KT), [bb] "=&v"(BB), [ww] "=&v"(WW), [rr] "=&v"(RR), [vv] "+v"(VV) \
                : [a] "v"(aop), [av] "v"(av), [o0] "i"((s) * 256), [o1] "i"((s) * 256 + ARRB), [o2] "i"((s) * 256 + 2 * ARRB), [o3] "i"((s) * 256 + 3 * ARRB), [o4] "i"((s) * 256 + 4 * ARRB), [ov] "i"(VOFF + (s) * 128) : "memory")
#define RWA_STEP(KN, KT, BB, WW, RR, VV) do { float sa_, m0_, m1_, m2_, m3_, yp_; \
            asm volatile("v_mul_f32 %[sa], %[s0], %[k0]\n\tv_fmac_f32 %[sa], %[s1], %[k1]\n\tv_fmac_f32 %[sa], %[s2], %[k2]\n\tv_fmac_f32 %[sa], %[s3], %[k3]\n\t" \
                "v_mul_f32 %[m0], %[vv], %[t0]\n\t" \
                "v_add_f32_dpp %[yq], %[yq], %[yq]" DPQ1 "v_add_f32_dpp %[sa], %[sa], %[sa]" DPQ1 "v_mul_f32 %[m1], %[vv], %[t1]\n\t" \
                "v_add_f32_dpp %[yq], %[yq], %[yq]" DPQ2 "v_add_f32_dpp %[sa], %[sa], %[sa]" DPQ2 "v_mul_f32 %[m2], %[vv], %[t2]\n\t" \
                "v_add_f32_dpp %[yq], %[yq], %[yq]" DPHM "v_add_f32_dpp %[sa], %[sa], %[sa]" DPHM "v_mul_f32 %[m3], %[vv], %[t3]\n\t" \
                "v_add_f32_dpp %[yq], %[yq], %[yq]" DPRM "v_add_f32_dpp %[sa], %[sa], %[sa] row_mirror row_mask:0xf bank_mask:0xf" \
                : [sa] "=&v"(sa_), [m0] "=&v"(m0_), [m1] "=&v"(m1_), [m2] "=&v"(m2_), [m3] "=&v"(m3_), [yq] "+v"(yq) \
                : [s0] "v"(S[0]), [s1] "v"(S[1]), [s2] "v"(S[2]), [s3] "v"(S[3]), [k0] "v"(KN.x), [k1] "v"(KN.y), [k2] "v"(KN.z), [k3] "v"(KN.w), [vv] "v"(VV), \
                  [t0] "v"(KT.x), [t1] "v"(KT.y), [t2] "v"(KT.z), [t3] "v"(KT.w)); \
            yfull = yq; \
            asm volatile("v_fmac_f32 %[m0], %[sa], %[b0]\n\tv_fmac_f32 %[m1], %[sa], %[b1]\n\tv_fmac_f32 %[m2], %[sa], %[b2]\n\tv_fmac_f32 %[m3], %[sa], %[b3]\n\t" \
                "v_fma_f32 %[s0], %[s0], %[w0], %[m0]\n\tv_fma_f32 %[s1], %[s1], %[w1], %[m1]\n\tv_fma_f32 %[s2], %[s2], %[w2], %[m2]\n\tv_fma_f32 %[s3], %[s3], %[w3], %[m3]\n\t" \
                "v_mul_f32 %[yp], %[s0], %[r0]\n\tv_fmac_f32 %[yp], %[s1], %[r1]\n\tv_fmac_f32 %[yp], %[s2], %[r2]\n\tv_fmac_f32 %[yp], %[s3], %[r3]" \
                : [m0] "+v"(m0_), [m1] "+v"(m1_), [m2] "+v"(m2_), [m3] "+v"(m3_), [s0] "+v"(S[0]), [s1] "+v"(S[1]), [s2] "+v"(S[2]), [s3] "+v"(S[3]), [yp] "=&v"(yp_) \
                : [sa] "v"(sa_), [b0] "v"(BB.x), [b1] "v"(BB.y), [b2] "v"(BB.z), [b3] "v"(BB.w), [w0] "v"(WW.x), [w1] "v"(WW.y), [w2] "v"(WW.z), [w3] "v"(WW.w), \
                  [r0] "v"(RR.x), [r1] "v"(RR.y), [r2] "v"(RR.z), [r3] "v"(RR.w)); \
            yq = yp_; } while (0)
#define RWA_YOUT(sprev) do { ykeep = (((sprev) & 15) == kl) ? yfull : ykeep; \
            if ((sprev) == CH - 1) { ycar = ykeep; ycar_i = (ptrdiff_t)yoff + (ptrdiff_t)(((sprev) & ~15) + kl) * ystep; } \
            else if (((sprev) & 15) == 15) ((bf16*)Yout_)[(ptrdiff_t)yoff + (ptrdiff_t)(((sprev) & ~15) + kl) * ystep] = f2bf(ykeep); } while (0)
            f32x4 knA, ktA, bbA, wwA, rrA, knB, ktB, bbB, wwB, rrB; float vvA = 0.f, vvB = 0.f, yq = 0.f, yfull = 0.f;
            RWA_READ(knA, ktA, bbA, wwA, rrA, vvA, 0);
            if (c > 0) ((bf16*)Yout_)[ycar_i] = f2bf(ycar);
#pragma unroll
            for (int s = 0; s < CH; s += 2) {
                RWA_READ(knB, ktB, bbB, wwB, rrB, vvB, s + 1); asm volatile("s_waitcnt lgkmcnt(6)" ::: "memory");
                RWA_STEP(knA, ktA, bbA, wwA, rrA, vvA);
                if (s > 0) RWA_YOUT(s - 1);
                if (s + 2 < CH) { RWA_READ(knA, ktA, bbA, wwA, rrA, vvA, (s + 2 < CH ? s + 2 : 0)); asm volatile("s_waitcnt lgkmcnt(6)" ::: "memory"); }
                else asm volatile("s_waitcnt lgkmcnt(0)" ::: "memory");
                RWA_STEP(knB, ktB, bbB, wwB, rrB, vvB);
                RWA_YOUT(s);
            }
            SC_YRED(yq); yfull = yq; RWA_YOUT(CH - 1);
#undef RWA_READ
#undef RWA_STEP
#undef RWA_YOUT
        } else {
#define RTA_READ(QQ, KR, VV, s) asm volatile("ds_read_b128 %[kr], %[a] offset:%[o1]\n\tds_read_u16_d16_hi %[vv], %[av] offset:%[ov]\n\tds_read_b128 %[qq], %[a] offset:%[o0]" \
                : [kr] "=&v"(KR), [qq] "=&v"(QQ), [vv] "+v"(VV) : [a] "v"(aop), [av] "v"(av), [o0] "i"((s) * 256), [o1] "i"((s) * 256 + ARRB), [ov] "i"(VOFF + (s) * 128) : "memory")
#define RTA_STEP(QQ, KR, VV) do { float m0_, m1_, m2_, m3_, yp_; \
            asm volatile("v_mul_f32 %[m0], %[vv], %[k0]\n\tv_mul_f32 %[m1], %[vv], %[k1]\n\t" \
                "v_add_f32_dpp %[yq], %[yq], %[yq]" DPQ1 "v_mul_f32 %[m2], %[vv], %[k2]\n\tv_mul_f32 %[m3], %[vv], %[k3]\n\t" \
                "v_add_f32_dpp %[yq], %[yq], %[yq]" DPQ2 "v_fma_f32 %[s0], %[s0], %[g], %[m0]\n\tv_fma_f32 %[s1], %[s1], %[g], %[m1]\n\t" \
                "v_add_f32_dpp %[yq], %[yq], %[yq]" DPHM "v_fma_f32 %[s2], %[s2], %[g], %[m2]\n\tv_fma_f32 %[s3], %[s3], %[g], %[m3]\n\t" \
                "v_add_f32_dpp %[yq], %[yq], %[yq]" DPRM \
                "v_mul_f32 %[yp], %[s0], %[q0]\n\tv_fmac_f32 %[yp], %[s1], %[q1]\n\tv_fmac_f32 %[yp], %[s2], %[q2]\n\tv_fmac_f32 %[yp], %[s3], %[q3]" \
                : [m0] "=&v"(m0_), [m1] "=&v"(m1_), [m2] "=&v"(m2_), [m3] "=&v"(m3_), [yq] "+v"(yq), [s0] "+v"(S[0]), [s1] "+v"(S[1]), [s2] "+v"(S[2]), [s3] "+v"(S[3]), [yp] "=&v"(yp_) \
                : [vv] "v"(VV), [k0] "v"(KR.x), [k1] "v"(KR.y), [k2] "v"(KR.z), [k3] "v"(KR.w), [g] "v"(gamma), [q0] "v"(QQ.x), [q1] "v"(QQ.y), [q2] "v"(QQ.z), [q3] "v"(QQ.w)); \
            yfull = yq; yq = yp_; } while (0)
#define RTA_YOUT(sprev) do { ykeep = (((sprev) & 15) == kl) ? yfull : ykeep; \
            if ((sprev) == CH - 1) { ycar = ykeep; ycar_i = (ptrdiff_t)yoff + (ptrdiff_t)(((sprev) & ~15) + kl) * ystep; } \
            else if (((sprev) & 15) == 15) ((bf16*)Yout_)[(ptrdiff_t)yoff + (ptrdiff_t)(((sprev) & ~15) + kl) * ystep] = f2bf(ykeep); } while (0)
            f32x4 qqA, krA, qqB, krB; float vvA = 0.f, vvB = 0.f, yq = 0.f, yfull = 0.f;
            RTA_READ(qqA, krA, vvA, 0);
            if (c > 0) ((bf16*)Yout_)[ycar_i] = f2bf(ycar);
#pragma unroll
            for (int s = 0; s < CH; s += 2) {
                RTA_READ(qqB, krB, vvB, s + 1); asm volatile("s_waitcnt lgkmcnt(3)" ::: "memory");
                RTA_STEP(qqA, krA, vvA);
                if (s > 0) RTA_YOUT(s - 1);
                if (s + 2 < CH) { RTA_READ(qqA, krA, vvA, (s + 2 < CH ? s + 2 : 0)); asm volatile("s_waitcnt lgkmcnt(3)" ::: "memory"); }
                else asm volatile("s_waitcnt lgkmcnt(0)" ::: "memory");
                RTA_STEP(qqB, krB, vvB);
                RTA_YOUT(s);
            }
            SC_YRED(yq); yfull = yq; RTA_YOUT(CH - 1);
#undef RTA_READ
#undef RTA_STEP
#undef RTA_YOUT
        }
#undef DPQ1
#undef DPQ2
#undef DPHM
#undef DPRM
#undef SC_YRED
#else
        if (!computes) { }
        else if (MODE == 0) {
            const LAS unsigned char* sp0 = bufp + kl * 16;
            f32x4 rrA = *(const LAS f32x4*)(sp0), wwA = *(const LAS f32x4*)(sp0 + ARRB), ktA = *(const LAS f32x4*)(sp0 + 2 * ARRB), bbA = *(const LAS f32x4*)(sp0 + 3 * ARRB), knA = *(const LAS f32x4*)(sp0 + 4 * ARRB);
            float vvA = bf2f(*(const LAS bf16*)(bufp + VOFF + rowv * 2));
            f32x4 rrB, wwB, ktB, bbB, knB; float vvB;
            float ypend = 0.f;
#define RW_STEP(s, rr, ww, kt, bb, kn, vv, rrN, wwN, ktN, bbN, knN, vvN) do { \
                const int sn_ = ((s) + 1 < CH) ? (s) + 1 : (s); const LAS unsigned char* sp = bufp + sn_ * 256 + kl * 16; \
                rrN = *(const LAS f32x4*)(sp); wwN = *(const LAS f32x4*)(sp + ARRB); ktN = *(const LAS f32x4*)(sp + 2 * ARRB); bbN = *(const LAS f32x4*)(sp + 3 * ARRB); knN = *(const LAS f32x4*)(sp + 4 * ARRB); \
                vvN = bf2f(*(const LAS bf16*)(bufp + VOFF + sn_ * 128 + rowv * 2)); \
                float sa = sfma(S[1], kn.y, smul(S[0], kn.x)) + sfma(S[3], kn.w, smul(S[2], kn.z)); \
                float yq = ypend; \
                sa += dpp_mov<0xB1>(sa); yq += dpp_mov<0xB1>(yq); \
                sa += dpp_mov<0x4E>(sa); yq += dpp_mov<0x4E>(yq); \
                sa += dpp_mov<0x141>(sa); yq += dpp_mov<0x141>(yq); \
                sa += dpp_mov<0x140>(sa); yq += dpp_mov<0x140>(yq); \
                if ((s) > 0) { ykeep = ((((s) - 1) & 15) == kl) ? yq : ykeep; \
                    if ((((s) - 1) & 15) == 15) ((bf16*)Yout_)[(ptrdiff_t)yoff + (ptrdiff_t)((((s) - 1) & ~15) + kl) * ystep] = f2bf(ykeep); } \
                S[0] = sfma(S[0], ww.x, sfma(sa, bb.x, smul(vv, kt.x))); S[1] = sfma(S[1], ww.y, sfma(sa, bb.y, smul(vv, kt.y))); \
                S[2] = sfma(S[2], ww.z, sfma(sa, bb.z, smul(vv, kt.z))); S[3] = sfma(S[3], ww.w, sfma(sa, bb.w, smul(vv, kt.w))); \
                ypend = sfma(S[1], rr.y, smul(S[0], rr.x)) + sfma(S[3], rr.w, smul(S[2], rr.z)); } while (0)
#pragma unroll 8
            for (int s = 0; s < CH; s += 2) {
                RW_STEP(s, rrA, wwA, ktA, bbA, knA, vvA, rrB, wwB, ktB, bbB, knB, vvB);
                RW_STEP(s + 1, rrB, wwB, ktB, bbB, knB, vvB, rrA, wwA, ktA, bbA, knA, vvA);
            }
#undef RW_STEP
            { const float yq = row16_sum(ypend); ykeep = (((CH - 1) & 15) == kl) ? yq : ykeep;
              ((bf16*)Yout_)[(ptrdiff_t)yoff + (ptrdiff_t)(((CH - 1) & ~15) + kl) * ystep] = f2bf(ykeep); }
        } else {
#pragma unroll 16
        for (int s = 0; s < CH; ++s) {
            const LAS unsigned char* sp = bufp + s * 256 + kl * 16;
            const float vv = bf2f(*(const LAS bf16*)(bufp + VOFF + s * 128 + rowv * 2));
            const f32x4 qq = *(const LAS f32x4*)(sp), kr = *(const LAS f32x4*)(sp + ARRB);
            S[0] = sfma(S[0], gamma, smul(vv, kr.x)); S[1] = sfma(S[1], gamma, smul(vv, kr.y)); S[2] = sfma(S[2], gamma, smul(vv, kr.z)); S[3] = sfma(S[3], gamma, smul(vv, kr.w));
            const float y = row16_sum(sfma(S[1], qq.y, smul(S[0], qq.x)) + sfma(S[3], qq.w, smul(S[2], qq.z)));
            ykeep = ((s & 15) == kl) ? y : ykeep;
            if ((s & 15) == 15) ((bf16*)Yout_)[(ptrdiff_t)yoff + (ptrdiff_t)((s & ~15) + kl) * ystep] = f2bf(ykeep);
        }
        }
#endif
        if (c + 1 < NCH) SCAN_COMMIT(hf ^ 1, hf ^ 1);
        __syncthreads();
    }
    }
#ifndef HOST_EMU
    if (computes) ((bf16*)Yout_)[ycar_i] = f2bf(ycar);
#endif
#undef SCAN_ISSUE
#undef SCAN_COMMIT
}

__device__ __forceinline__ void ph_rw_post(const PAS Prm& p, int l) {
    const int tid = TID, j2 = tid & 127, c = 2 * j2, h = c >> 6;
    unsigned char* S = p.ws + WS_BIG + BG_S;
    const bf16* Y = (const bf16*)(S + RW_Y); const bf16* V = (const bf16*)(S + RW_V); const bf16* G = (const bf16*)(S + RW_G); const float* Bon = (const float*)(S + RW_BON);
    bf16* yrw = (bf16*)(p.ws + WS_Y + 1 * SZ17);
    const float lng0 = p.in[27][l * 256 + c], lng1 = p.in[27][l * 256 + c + 1];
    constexpr int NR = 4;
    for (int r0 = (BID * 4 + (tid >> 7)) * NR; r0 < RT; r0 += NBLK * 4 * NR) {
        unsigned y0[NR], y1[NR], vv[NR], gg[NR]; float bo[NR];
#pragma unroll
        for (int q = 0; q < NR; ++q) { const size_t o = (size_t)(r0 + q) * 256 + c; y0[q] = *(const unsigned*)(Y + o); y1[q] = *(const unsigned*)(Y + (size_t)RT * 256 + o); vv[q] = *(const unsigned*)(V + o); gg[q] = *(const unsigned*)(G + o); bo[q] = Bon[(size_t)(r0 + q) * 4 + h]; }
#pragma unroll
        for (int q = 0; q < NR; ++q) { const size_t o = (size_t)(r0 + q) * 256 + c;
            const float ya = blo(y0[q]) + blo(y1[q]), yb = bhi(y0[q]) + bhi(y1[q]);
            const float mean = half32_sum(ya + yb) * (1.f / 64.f); const float da = ya - mean, db = yb - mean;
            const float rs = rsqrtf(half32_sum(da * da + db * db) * (1.f / 64.f) + 64e-5f);
            const float va = (da * rs * lng0 + bo[q] * blo(vv[q])) * blo(gg[q]), vb = (db * rs * lng1 + bo[q] * bhi(vv[q])) * bhi(gg[q]);
            *(unsigned*)(yrw + o) = pk2(va, vb); }
    }
}

constexpr size_t RT_Y = 222 * MiB  ;
__device__ __forceinline__ void ph_ret_post(const PAS Prm& p) {
    const int tid = TID, j2 = tid & 127, c = 2 * j2;
    const bf16* P = (const bf16*)(p.ws + WS_BIG + BG_P);
    const bf16* Y = (const bf16*)(p.ws + WS_BIG + BG_S + RT_Y);
    bf16* yret = (bf16*)(p.ws + WS_Y + 3 * SZ17);
    constexpr int NR = 4;
    for (int r0 = (BID * 4 + (tid >> 7)) * NR; r0 < RT; r0 += NBLK * 4 * NR) {
        unsigned y0[NR], y1[NR], gg[NR];
#pragma unroll
        for (int q = 0; q < NR; ++q) { const size_t o = (size_t)(r0 + q) * 256 + c; y0[q] = *(const unsigned*)(Y + o); y1[q] = *(const unsigned*)(Y + (size_t)RT * 256 + o); gg[q] = *(const unsigned*)(P + (size_t)(r0 + q) * 1024 + 768 + c); }
#pragma unroll
        for (int q = 0; q < NR; ++q) { const size_t o = (size_t)(r0 + q) * 256 + c;
            const float ya = blo(y0[q]) + blo(y1[q]), yb = bhi(y0[q]) + bhi(y1[q]);
            const float mean = half32_sum(ya + yb) * (1.f / 64.f); const float da = ya - mean, db = yb - mean;
            const float rs = rsqrtf(half32_sum(da * da + db * db) * (1.f / 64.f) + 1e-5f);
            const float ga = blo(gg[q]), gb = bhi(gg[q]);
            *(unsigned*)(yret + o) = pk2(da * rs * (ga * sigmoidf_(ga)), db * rs * (gb * sigmoidf_(gb))); }
    }
}

constexpr size_t LR_A = 0  , LR_B = 2 * SZ34  ;
__device__ __forceinline__ void ph_lru_prep(const PAS Prm& p, int l, LAS unsigned char* lds) {
    LAS float* xc = (LAS float*)lds;
    LAS float* res = xc + 16 * 256;
    const int tid = TID, lane = tid & 63, wave = tid >> 6;
    const bf16* P = (const bf16*)(p.ws + WS_BIG + BG_P);
    bf16* A = (bf16*)(p.ws + WS_BIG + BG_S + LR_A); bf16* B = (bf16*)(p.ws + WS_BIG + BG_S + LR_B);
    const float* cw = p.in[28] + l * 4 * 256; const float* cb = p.in[29] + l * 256;
    const float* wa = p.in[30] + (size_t)l * 2 * 4 * 64 * 64; const float* ba = p.in[31] + l * 512;
    const float* wx = p.in[32] + (size_t)l * 2 * 4 * 64 * 64; const float* bx = p.in[33] + l * 512;
    const float* lam = p.in[34] + l * 512;
    const int j = tid & 255, half = tid >> 8;
    const float sp0 = softplusf_(-lam[j]), sp1 = softplusf_(-lam[256 + j]);
    const float ba0 = ba[j], ba1 = ba[256 + j], bx0 = bx[j], bx1 = bx[256 + j];
    const int g = wave >> 1;
    bfx8 Bf[4][2][2];
#pragma unroll
    for (int m = 0; m < 4; ++m) { const float* W = (m < 2 ? wa : wx) + (size_t)(((m & 1) * 4 + g) * 64) * 64;
#pragma unroll
        for (int ct = 0; ct < 2; ++ct)
#pragma unroll
            for (int ks = 0; ks < 2; ++ks) { float v[8];
#pragma unroll
                for (int q = 0; q < 8; ++q) v[q] = W[(size_t)(32 * ks + (lane >> 4) * 8 + q) * 64 + ((32 * wave + 16 * ct + (lane & 15)) & 63)];
                Bf[m][ct][ks] = pack8(v); } }
    for (int tile = BID; tile < RT / 16; tile += NBLK) {
        const int r0 = tile * 16;
        {
            const int rr = tid >> 5, c8 = (tid & 31) * 8, r = r0 + rr; const RowInfo ri = row_info(r);
            v4u tv[4];
#pragma unroll
            for (int q = 0; q < 4; ++q) { const int tt = ri.t + q - 2; tv[q] = (tt >= 0 && tt < ri.T) ? *(const v4u*)(P + (size_t)(ri.base + tt) * 512 + c8) : (v4u){0u, 0u, 0u, 0u}; }
            float acc[8];
#pragma unroll
            for (int e = 0; e < 8; ++e) acc[e] = cb[c8 + e];
#pragma unroll
            for (int q = 0; q < 4; ++q)
#pragma unroll
                for (int e = 0; e < 8; ++e) { const unsigned w = ((const unsigned*)&tv[q])[e >> 1]; acc[e] += cw[q * 256 + c8 + e] * ((e & 1) ? bhi(w) : blo(w)); }
#pragma unroll
            for (int e = 0; e < 8; ++e) xc[rr * 256 + c8 + e] = acc[e];
        }
        __syncthreads();
        {
            f32x4 acc[4][2];
#pragma unroll
            for (int m = 0; m < 4; ++m) { acc[m][0] = (f32x4){0.f, 0.f, 0.f, 0.f}; acc[m][1] = (f32x4){0.f, 0.f, 0.f, 0.f}; }
#pragma unroll
            for (int ks = 0; ks < 2; ++ks) {
                const LAS float* ap = xc + (lane & 15) * 256 + g * 64 + 32 * ks + (lane >> 4) * 8;
                const f32x4 x0 = *(const LAS f32x4*)ap, x1 = *(const LAS f32x4*)(ap + 4);
                const float av[8] = {x0.x, x0.y, x0.z, x0.w, x1.x, x1.y, x1.z, x1.w};
                const bfx8 Af = pack8(av);
#pragma unroll
                for (int m = 0; m < 4; ++m)
#pragma unroll
                    for (int ct = 0; ct < 2; ++ct) acc[m][ct] = __builtin_amdgcn_mfma_f32_16x16x32_bf16(Af, Bf[m][ct][ks], acc[m][ct], 0, 0, 0);
            }
#pragma unroll
            for (int m = 0; m < 4; ++m)
#pragma unroll
                for (int ct = 0; ct < 2; ++ct)
#pragma unroll
                    for (int q = 0; q < 4; ++q) res[((lane >> 4) * 4 + q) * 1024 + m * 256 + 32 * wave + 16 * ct + (lane & 15)] = acc[m][ct][q];
        }
        __syncthreads();
#pragma unroll
        for (int q = 0; q < 8; ++q) {
            const int rr = half * 8 + q; const size_t r = (size_t)(r0 + rr); const float xcv = xc[rr * 256 + j];
#pragma unroll
            for (int d = 0; d < 2; ++d) {
                const float rg = sigmoidf_(res[rr * 1024 + d * 256 + j] + (d ? ba1 : ba0));
                const float ig = sigmoidf_(res[rr * 1024 + (2 + d) * 256 + j] + (d ? bx1 : bx0));
                const float a = __expf(-8.f * rg * (d ? sp1 : sp0));
                const float bv = sqrtf(fmaxf(1.f - a * a, 0.f)) * (ig * xcv);
                A[((size_t)d * RT + r) * 256 + j] = f2bf(1.f - a); B[((size_t)d * RT + r) * 256 + j] = f2bf(bv);
            }
        }
        __syncthreads();
    }
}
constexpr int LCH = 64, NVC = CTXL / LCH, NVL = SEQ / LCH, NV = NVC + NVL;
constexpr size_t LR_PA = 4 * SZ34  , LR_QB = LR_PA + (size_t)2 * 8 * NV * 256 * 4;
__device__ __forceinline__ int lru_chunk_row0(int b, int v) { return v < NVC ? b * CTXL + v * LCH : RC + b * SEQ + (v - NVC) * LCH; }
__device__ __forceinline__ void ph_lru_agg(const PAS Prm& p) {
    const int tid = TID, j4 = tid & 63, qt = tid >> 6;
    const bf16* A = (const bf16*)(p.ws + WS_BIG + BG_S + LR_A); const bf16* B = (const bf16*)(p.ws + WS_BIG + BG_S + LR_B);
    float* PA = (float*)(p.ws + WS_BIG + BG_S + LR_PA); float* QB = (float*)(p.ws + WS_BIG + BG_S + LR_QB);
    for (int task = BID * 8 + qt; task < 2 * 8 * NV; task += NBLK * 8) {
        const int d = task / (8 * NV), b = (task / NV) % 8, v = task % NV;
        const int row0 = lru_chunk_row0(b, v);
        const bf16* Ad = A + (size_t)d * RT * 256 + 4 * j4; const bf16* Bd = B + (size_t)d * RT * 256 + 4 * j4;
        f32x4 P = {1.f, 1.f, 1.f, 1.f}, Q = {0.f, 0.f, 0.f, 0.f};
        for (int i0 = 0; i0 < LCH; i0 += 16) {
            v2u a[16], bb[16];
#pragma unroll
            for (int q = 0; q < 16; ++q) { const int i = i0 + q; const size_t ro = (size_t)(row0 + (d ? LCH - 1 - i : i)) * 256; a[q] = *(const v2u*)(Ad + ro); bb[q] = *(const v2u*)(Bd + ro); }
#pragma unroll
            for (int q = 0; q < 16; ++q) { const f32x4 av = {1.f - blo(a[q].x), 1.f - bhi(a[q].x), 1.f - blo(a[q].y), 1.f - bhi(a[q].y)}, bv = {blo(bb[q].x), bhi(bb[q].x), blo(bb[q].y), bhi(bb[q].y)};
                Q = av * Q + bv; P = av * P; }
        }
        *(f32x4*)(PA + (size_t)task * 256 + 4 * j4) = P; *(f32x4*)(QB + (size_t)task * 256 + 4 * j4) = Q;
    }
}
__device__ __forceinline__ float gelu_tanh_(float x) { return 0.5f * x * (1.f + tanhf(0.7978845608028654f * (x + 0.044715f * x * x * x))); }
__device__ __forceinline__ void ph_lru_fin(const PAS Prm& p, LAS unsigned char* lds) {
    LAS unsigned* hf = (LAS unsigned*)lds;
    const int tid = TID, j2 = tid & 127, qt = tid >> 7;
    const bf16* P = (const bf16*)(p.ws + WS_BIG + BG_P);
    const bf16* A = (const bf16*)(p.ws + WS_BIG + BG_S + LR_A); const bf16* B = (const bf16*)(p.ws + WS_BIG + BG_S + LR_B);
    const float* PA = (const float*)(p.ws + WS_BIG + BG_S + LR_PA); const float* QB = (const float*)(p.ws + WS_BIG + BG_S + LR_QB);
    bf16* ylru = (bf16*)(p.ws + WS_Y + 2 * SZ17);
    for (int task = BID * 4 + qt; task < 8 * NV; task += NBLK * 4) {
        const int b = task / NV, v = task % NV;
        const int row0 = lru_chunk_row0(b, v);
        float h0 = 0.f, h1 = 0.f;
        { const float* pa = PA + ((size_t)(0 * 8 + b) * NV) * 256 + 2 * j2; const float* qb = QB + ((size_t)(0 * 8 + b) * NV) * 256 + 2 * j2;
          for (int u0 = 0; u0 < v; u0 += 8) { cf2 pp[8], qq[8];
#pragma unroll
              for (int q = 0; q < 8; ++q) { const int u = u0 + q < v ? u0 + q : v - 1; pp[q] = *(const cf2*)(pa + (size_t)u * 256); qq[q] = *(const cf2*)(qb + (size_t)u * 256); }
#pragma unroll
              for (int q = 0; q < 8; ++q) if (u0 + q < v) { h0 = pp[q].x * h0 + qq[q].x; h1 = pp[q].y * h1 + qq[q].y; } } }
        float g0 = 0.f, g1 = 0.f;
        { const float* pa = PA + ((size_t)(1 * 8 + b) * NV) * 256 + 2 * j2; const float* qb = QB + ((size_t)(1 * 8 + b) * NV) * 256 + 2 * j2;
          const int n1 = v < NVC ? NVC - 1 - v : NVC, n2 = v < NVC ? 0 : NV - 1 - v, nt = n1 + n2;
          for (int i0 = 0; i0 < nt; i0 += 8) { cf2 pp[8], qq[8];
#pragma unroll
              for (int q = 0; q < 8; ++q) { const int i = i0 + q < nt ? i0 + q : nt - 1; const int u = i < n1 ? NVC - 1 - i : NV - 1 - (i - n1); pp[q] = *(const cf2*)(pa + (size_t)u * 256); qq[q] = *(const cf2*)(qb + (size_t)u * 256); }
#pragma unroll
              for (int q = 0; q < 8; ++q) if (i0 + q < nt) { g0 = pp[q].x * g0 + qq[q].x; g1 = pp[q].y * g1 + qq[q].y; } } }
        const bf16* A0 = A + 2 * j2; const bf16* B0 = B + 2 * j2; const bf16* A1 = A + (size_t)RT * 256 + 2 * j2; const bf16* B1 = B + (size_t)RT * 256 + 2 * j2;
        for (int i0 = 0; i0 < LCH; i0 += 16) {
            unsigned a[16], bb[16];
#pragma unroll
            for (int q = 0; q < 16; ++q) { const size_t ro = (size_t)(row0 + i0 + q) * 256; a[q] = *(const unsigned*)(A0 + ro); bb[q] = *(const unsigned*)(B0 + ro); }
#pragma unroll
            for (int q = 0; q < 16; ++q) { h0 = (1.f - blo(a[q])) * h0 + blo(bb[q]); h1 = (1.f - bhi(a[q])) * h1 + bhi(bb[q]); hf[(i0 + q) * 512 + tid] = pk2(h0, h1); }
        }
        for (int i0 = LCH - 16; i0 >= 0; i0 -= 16) {
            unsigned a[16], bb[16], gx[16];
#pragma unroll
            for (int q = 0; q < 16; ++q) { const size_t r = (size_t)(row0 + i0 + 15 - q); a[q] = *(const unsigned*)(A1 + r * 256); bb[q] = *(const unsigned*)(B1 + r * 256); gx[q] = *(const unsigned*)(P + r * 512 + 256 + 2 * j2); }
#pragma unroll
            for (int q = 0; q < 16; ++q) { g0 = (1.f - blo(a[q])) * g0 + blo(bb[q]); g1 = (1.f - bhi(a[q])) * g1 + bhi(bb[q]); const int i = i0 + 15 - q;
                const unsigned hp = hf[i * 512 + tid];
                *(unsigned*)(ylru + (size_t)(row0 + i) * 256 + 2 * j2) = pk2((blo(hp) + g0) * gelu_tanh_(blo(gx[q])), (bhi(hp) + g1) * gelu_tanh_(bhi(gx[q]))); }
        }
    }
}

constexpr size_t HY_VL = 0, HY_VC = 96 * MiB, HY_P = 140 * MiB  , HY_FL = 200 * MiB, HY_FC = 216 * MiB;
__device__ __forceinline__ void ph_hy_filter(const PAS Prm& p, int l, bool with_ctx, LAS unsigned char* lds) {
    LAS float* feat = (LAS float*)lds;
    LAS float* h1 = feat + 16 * 17;
    LAS float* h2 = h1 + 16 * 64;
    const int tid = TID;
    const float* w1 = p.in[11] + l * 17 * 64; const float* b1 = p.in[12] + l * 64; const float* w2 = p.in[13] + l * 64 * 64; const float* b2 = p.in[14] + l * 64;
    const float* w3 = p.in[15] + (size_t)l * 64 * 1024; const float* freq = p.in[16] + l * 128;
    float* FL = (float*)(p.ws + WS_BIG + BG_S + HY_FL); float* FC = (float*)(p.ws + WS_BIG + BG_S + HY_FC);
    const int ntile = with_ctx ? (SEQ + CTXL) / 16 : SEQ / 16;
    for (int tile = (BID + NBLK / 2) % NBLK; tile < ntile; tile += NBLK) {
        const bool isctx = tile >= SEQ / 16; const int L = isctx ? CTXL : SEQ; const int pos0 = (isctx ? tile - SEQ / 16 : tile) * 16;
        float* F = isctx ? FC : FL;
        if (tid < 16 * 17) { const int pp = tid / 17, f = tid % 17; const float t = (float)(pos0 + pp) / (float)L;
            float v; if (f == 0) v = t; else if (f <= 8) v = sinf(6.283185307179586f * t * (float)f); else v = cosf(6.283185307179586f * t * (float)(f - 8));
            feat[tid] = v; }
        __syncthreads();
        for (int i = tid; i < 1024; i += NTHR) { const int pp = i >> 6, o = i & 63; float s = b1[o];
            for (int f = 0; f < 17; ++f) s += feat[pp * 17 + f] * w1[f * 64 + o];
            h1[i] = sinf(freq[o] * s); }
        __syncthreads();
        for (int i = tid; i < 1024; i += NTHR) { const int pp = i >> 6, o = i & 63; float s = b2[o];
            for (int q = 0; q < 64; ++q) s += h1[pp * 64 + q] * w2[q * 64 + o];
            h2[i] = sinf(freq[64 + o] * s); }
        __syncthreads();
        for (int cc = tid; cc < 1024; cc += NTHR) {
            float acc[16];
#pragma unroll
            for (int pp = 0; pp < 16; ++pp) acc[pp] = 0.f;
            for (int q = 0; q < 64; ++q) { const float w = w3[q * 1024 + cc];
#pragma unroll
                for (int pp = 0; pp < 16; ++pp) acc[pp] += h2[pp * 64 + q] * w; }
            const int o = cc >> 9, dd = (cc >> 8) & 1, c = cc & 255;
            const float rate = 3.0701134573253945f + (15.350567286626973f - 3.0701134573253945f) * (float)c * (1.f / 255.f);
            float* Fo = F + (size_t)(o * 256 + c) * (2 * L);
#pragma unroll
            for (int pp = 0; pp < 16; ++pp) { const int pos = pos0 + pp; const float t = (float)pos / (float)L;
                const float val = acc[pp] * expf(-t * rate);
                if (dd == 0) Fo[L + pos] = val; else if (pos >= 1) Fo[L - pos] = val; }
            if (pos0 == 0 && dd == 0) Fo[0] = 0.f;
        }
        __syncthreads();
    }
}
__device__ __forceinline__ void ph_hy_fnorm(const PAS Prm& p, bool with_ctx) {
    const int tid = TID, lane = tid & 63, wave = tid >> 6;
    float* FL = (float*)(p.ws + WS_BIG + BG_S + HY_FL); float* FC = (float*)(p.ws + WS_BIG + BG_S + HY_FC);
    const int gw = BID * NWAVES + wave, NGW = NBLK * NWAVES;
    for (int it = gw; it < (with_ctx ? 1024 : 512); it += NGW) {
        const bool isctx = it >= 512; const int L = isctx ? CTXL : SEQ; float* F = (isctx ? FC : FL) + (size_t)(it & 511) * (2 * L);
        float s = 0.f;
        for (int i = lane; i < 2 * L; i += 64) { const float v = F[i]; s += v * v; }
        const float sc = rsqrtf(wave_sum(s) + 1e-6f);
        for (int i = lane; i < 2 * L; i += 64) F[i] *= sc;
    }
}
__device__ __forceinline__ void ph_hy_prep(const PAS Prm& p, int l, bool with_ctx, LAS unsigned char* lds) {
    LAS float* tl = (LAS float*)lds;
    const int tid = TID;
    const bf16* P = (const bf16*)(p.ws + WS_BIG + BG_S + HY_P);
    float* VL = (float*)(p.ws + WS_BIG + BG_S + HY_VL); float* VC = (float*)(p.ws + WS_BIG + BG_S + HY_VC);
    const float* cw = p.in[9] + l * 3 * 768; const float* cb = p.in[10] + l * 768;
    const int NTL = 8 * (SEQ / 64) * 12, NTC = with_ctx ? 8 * (CTXL / 64) * 12 : 0, NT = NTL + NTC;
    v4u pv[2]; const int rr2[2] = {tid >> 3, (tid + NTHR) >> 3}, cg = tid & 7;
#define HYP_DECODE(tile_, isctx_, T_, b_, t0_, c0_, base_) const bool isctx_ = (tile_) >= NTL; const int tt_ = isctx_ ? (tile_) - NTL : (tile_); const int T_ = isctx_ ? CTXL : SEQ, ntt_ = T_ / 64; \
        const int ct_ = tt_ % 12, tb_ = (tt_ / 12) % ntt_, b_ = tt_ / (12 * ntt_); const int base_ = isctx_ ? b_ * CTXL : RC + b_ * SEQ, t0_ = tb_ * 64, c0_ = ct_ * 64; (void)ct_; (void)tb_;
#define HYP_LOAD(tile_) do { if ((tile_) < NT) { HYP_DECODE(tile_, ic_, T_, b_, t0_, c0_, base_) (void)b_; \
        _Pragma("unroll") for (int q = 0; q < 2; ++q) { const int t = t0_ - 1 + rr2[q]; \
            pv[q] = (rr2[q] < 66 && t >= 0 && t < T_) ? *(const v4u*)(P + (size_t)(base_ + t) * 768 + c0_ + cg * 8) : (v4u){0u, 0u, 0u, 0u}; } } } while (0)
    HYP_LOAD(BID);
    for (int tile = BID; tile < NT; tile += NBLK) {
        HYP_DECODE(tile, isctx, T, b, t0, c0, base) (void)base;
#pragma unroll
        for (int q = 0; q < 2; ++q) if (rr2[q] < 66) {
#pragma unroll
            for (int e = 0; e < 4; ++e) { const unsigned w = ((const unsigned*)&pv[q])[e]; tl[rr2[q] * 65 + cg * 8 + 2 * e] = blo(w); tl[rr2[q] * 65 + cg * 8 + 2 * e + 1] = bhi(w); } }
        __syncthreads();
        HYP_LOAD(tile + NBLK);
        const int part = c0 >> 8, cl0 = c0 & 255;
        float* dst = (isctx ? VC : VL) + ((size_t)(part * 8 + b) * 256 + cl0) * T + t0;
        for (int i = tid; i < 64 * 64; i += NTHR) { const int cc = i >> 6, ti = i & 63, col = c0 + cc;
            const float v = cb[col] + cw[col] * tl[ti * 65 + cc] + cw[768 + col] * tl[(ti + 1) * 65 + cc] + cw[1536 + col] * tl[(ti + 2) * 65 + cc];
            dst[(size_t)cc * T + ti] = v; }
        __syncthreads();
    }
#undef HYP_LOAD
#undef HYP_DECODE
}
template <int L>
__device__ __forceinline__ void hy_conv_item(const PAS Prm& p, int l, int c, int b0, LAS unsigned char* lds) {
    constexpr int NI = (L + NTHR - 1) / NTHR;
    LAS float* hh = (LAS float*)lds;
    LAS float* z = hh + 2 * L;
    const int tid = TID;
    const bool isctx = (L == CTXL);
    const float* F = (const float*)(p.ws + WS_BIG + BG_S + (isctx ? HY_FC : HY_FL));
    const float* HV = (const float*)(p.ws + WS_BIG + BG_S + (isctx ? HY_VC : HY_VL));
    const float* bias = p.in[17] + l * 512;
    for (int bb = 0; bb < 4; ++bb) for (int t = tid; t < L; t += NTHR) z[t * 4 + bb] = HV[((size_t)(0 * 8 + b0 + bb) * 256 + c) * L + t];
    for (int o = 0; o < 2; ++o) {
        float ssq = 0.f;
        for (int i = tid; i < 2 * L; i += NTHR) { const float fv = F[(size_t)(o * 256 + c) * (2 * L) + i]; ssq += fv * fv; hh[i] = fv; }
        const float fscale = rsqrtf(block_sum(ssq, z + 4 * L, tid) + 1e-6f);
        float acc[NI][4];
#pragma unroll
        for (int i = 0; i < NI; ++i) { acc[i][0] = 0.f; acc[i][1] = 0.f; acc[i][2] = 0.f; acc[i][3] = 0.f; }
        if (tid < L) {
            for (int s = 0; s < L; ++s) {
                const f32x4 zs = *(const LAS f32x4*)(z + s * 4);
#pragma unroll
                for (int i = 0; i < NI; ++i) { const float hv = hh[L + tid + NTHR * i - s];
                    acc[i][0] += hv * zs.x; acc[i][1] += hv * zs.y; acc[i][2] += hv * zs.z; acc[i][3] += hv * zs.w; }
            }
        }
        __syncthreads();
        const float bo = bias[o * 256 + c];
        if (tid < L) {
#pragma unroll
            for (int i = 0; i < NI; ++i) { const int t = tid + NTHR * i;
#pragma unroll
                for (int bb = 0; bb < 4; ++bb) { const float gate = HV[((size_t)((1 + o) * 8 + b0 + bb) * 256 + c) * L + t];
                    z[t * 4 + bb] = gate * (acc[i][bb] * fscale + bo * z[t * 4 + bb]); } }
        }
        __syncthreads();
    }
    float* HVw = (float*)(p.ws + WS_BIG + BG_S + (isctx ? HY_VC : HY_VL));
    if (tid < L) {
#pragma unroll
        for (int i = 0; i < NI; ++i) { const int t = tid + NTHR * i;
#pragma unroll
            for (int bb = 0; bb < 4; ++bb) HVw[((size_t)(0 * 8 + b0 + bb) * 256 + c) * L + t] = z[t * 4 + bb]; }
    }
    __syncthreads();
}
__device__ __forceinline__ void ph_hy_post(const PAS Prm& p, bool with_ctx, LAS unsigned char* lds) {
    LAS float* tl = (LAS float*)lds;
    const int tid = TID;
    const float* VL = (const float*)(p.ws + WS_BIG + BG_S + HY_VL); const float* VC = (const float*)(p.ws + WS_BIG + BG_S + HY_VC);
    bf16* yhy = (bf16*)(p.ws + WS_Y);
    const int NTL = 8 * (SEQ / 64) * 4, NTC = with_ctx ? 8 * (CTXL / 64) * 4 : 0;
    for (int tile = BID; tile < NTL + NTC; tile += NBLK) {
        const bool isctx = tile >= NTL; const int tt = isctx ? tile - NTL : tile;
        const int T = isctx ? CTXL : SEQ, ntt = T / 64;
        const int ct = tt % 4, tb = (tt / 4) % ntt, b = tt / (4 * ntt);
        const int base = isctx ? b * CTXL : RC + b * SEQ, t0 = tb * 64, c0 = ct * 64;
        const float* src = (isctx ? VC : VL) + ((size_t)b * 256 + c0) * T + t0;
        for (int i = tid; i < 64 * 64; i += NTHR) { const int cc = i >> 6, ti = i & 63; tl[cc * 65 + ti] = src[(size_t)cc * T + ti]; }
        __syncthreads();
        for (int i = tid; i < 64 * 32; i += NTHR) { const int ti = i >> 5, cp = i & 31;
            *(unsigned*)(yhy + (size_t)(base + t0 + ti) * 256 + c0 + 2 * cp) = pk2(tl[(2 * cp) * 65 + ti], tl[(2 * cp + 1) * 65 + ti]); }
        __syncthreads();
    }
}
__device__ __forceinline__ cf2 cmul(cf2 a, cf2 b) { return (cf2){sfma(a.x, b.x, -smul(a.y, b.y)), sfma(a.x, b.y, smul(a.y, b.x))}; }
__device__ __forceinline__ cf2 cmulc(cf2 a, cf2 b) { return (cf2){sfma(a.x, b.x, smul(a.y, b.y)), sfma(a.y, b.x, -smul(a.x, b.y))}; }
__device__ __forceinline__ cf2 cadd(cf2 a, cf2 b) { return (cf2){sadd(a.x, b.x), sadd(a.y, b.y)}; }
__device__ __forceinline__ cf2 csub(cf2 a, cf2 b) { return (cf2){ssub(a.x, b.x), ssub(a.y, b.y)}; }
#define XP(i) ((i) + ((i) >> 5))
#ifdef HOST_EMU
static inline unsigned brev32(unsigned x) { unsigned r = 0; for (int i = 0; i < 32; ++i) if (x & (1u << i)) r |= 1u << (31 - i); return r; }
#else
__device__ __forceinline__ unsigned brev32(unsigned x) { return __builtin_bitreverse32(x); }
#endif
template <int LOGN, int M, bool INV, int GMAP, bool PM = false, int RIO = 0>
__device__ __forceinline__ void fft_pass(LAS cf2* X, const LAS cf2* W, const int log_stride, const int tid, const LAS cf2* Hh = nullptr, cf2* xr = nullptr) {
    static_assert(RIO == 0 || ((1 << LOGN) >> M) == NTHR, "register hand-over needs one group per thread");
    constexpr int N = 1 << LOGN, R = 1 << M, NGRP = N / R, LG = LOGN - M;
#pragma unroll
    for (int t = tid; t < NGRP; t += NTHR) {
        int g = t;
        if (GMAP == 1) g = ((t << 1) | (t >> (LG - 1))) & (NGRP - 1);
        if (GMAP == 2) { const int bl = t >> 4, nb = LG - 4; g = (t & 15) | ((((bl << 1) | (bl >> (nb - 1))) & ((1 << nb) - 1)) << 4); }
        const int q = g & ((1 << log_stride) - 1), blk = g >> log_stride;
        const int base = (blk << (log_stride + M)) + q;
        cf2 x[R];
#pragma unroll
        for (int j = 0; j < R; ++j) { if (RIO == 1) x[j] = xr[j]; else x[j] = X[XP(base + (j << log_stride))]; }
        if (PM) {
#pragma unroll
            for (int j = 0; j < R; ++j) { const int k = (int)(brev32((unsigned)(base + (j << log_stride))) >> (32 - LOGN));
                cf2 h; if (k <= N / 2) h = Hh[k]; else { h = Hh[N - k]; h.y = -h.y; }
                x[j] = cmul(x[j], h); } }
#pragma unroll
        for (int s = 0; s < M; ++s) {
            const int half = INV ? (1 << s) : (R >> (s + 1));
            const int lsp = log_stride + (INV ? s : (M - 1 - s));
#pragma unroll
            for (int j = 0; j < R; ++j) {
                if (j & half) continue;
                const int pos = q + ((j & (half - 1)) << log_stride);
                const cf2 a = x[j], bq = x[j + half];
                if (lsp == 0) {
                    x[j] = cadd(a, bq); x[j + half] = csub(a, bq);
                } else if (lsp == 1) {
                    if (!INV) { const cf2 dlt = csub(a, bq); x[j] = cadd(a, bq); x[j + half] = (pos & 1) ? (cf2){dlt.y, -dlt.x} : dlt; }
                    else { const cf2 t2 = (pos & 1) ? (cf2){-bq.y, bq.x} : bq; x[j] = cadd(a, t2); x[j + half] = csub(a, t2); }
                } else {
                    const cf2 w = W[pos << (LOGN - 1 - lsp)];
                    if (!INV) { x[j] = cadd(a, bq); x[j + half] = cmul(csub(a, bq), w); }
                    else { const cf2 t2 = cmulc(bq, w); x[j] = cadd(a, t2); x[j + half] = csub(a, t2); }
                }
            }
        }
#pragma unroll
        for (int j = 0; j < R; ++j) { if (RIO == 2) xr[j] = x[j]; else X[XP(base + (j << log_stride))] = x[j]; }
    }
    __syncthreads();
}
template <int LOGN, bool INV, bool PM = false, bool RR = false> __device__ __forceinline__ void fft_lds(LAS cf2* X, const LAS cf2* W, const int tid, const LAS cf2* Hh = nullptr, cf2* xr = nullptr) {
    static_assert(LOGN == 13 || LOGN == 9, "pass schedule");
    if (LOGN == 13) {
        if (!INV) { fft_pass<LOGN, 4, false, 0, false, RR ? 1 : 0>(X, W, 9, tid, nullptr, xr); fft_pass<LOGN, 3, false, 0>(X, W, 6, tid); fft_pass<LOGN, 3, false, 0>(X, W, 3, tid); fft_pass<LOGN, 3, false, 0>(X, W, 0, tid); }
        else { fft_pass<LOGN, 3, true, 0, PM>(X, W, 0, tid, Hh); fft_pass<LOGN, 3, true, 0>(X, W, 3, tid); fft_pass<LOGN, 3, true, 0>(X, W, 6, tid); fft_pass<LOGN, 4, true, 0, false, RR ? 2 : 0>(X, W, 9, tid, nullptr, xr); }
    } else {
        if (!INV) { fft_pass<LOGN, 3, false, 0>(X, W, 6, tid); fft_pass<LOGN, 3, false, 0>(X, W, 3, tid); fft_pass<LOGN, 3, false, 0>(X, W, 0, tid); }
        else { fft_pass<LOGN, 3, true, 0, PM>(X, W, 0, tid, Hh); fft_pass<LOGN, 3, true, 0>(X, W, 3, tid); fft_pass<LOGN, 3, true, 0>(X, W, 6, tid); }
    }
}
template <int LOGN>
__device__ __forceinline__ void hy_fft_channel(const PAS Prm& p, int l, int c, LAS unsigned char* lds) {
    constexpr int N = 1 << LOGN, L = N / 2;
    static_assert(L == SEQ, "transform length");
    LAS cf2* X = (LAS cf2*)lds;
    LAS cf2* Hh = X + N + N / 32;
    LAS cf2* W = Hh + N / 2 + 8;
    const int tid = TID;
    const float* F = (const float*)(p.ws + WS_BIG + BG_S + HY_FL);
    float* HV = (float*)(p.ws + WS_BIG + BG_S + HY_VL);
    const float* bias = p.in[17] + l * 512;
    for (int k = tid; k < N / 2; k += NTHR) { float sn, cs; sincospif(-(float)k * (2.0f / (float)N), &sn, &cs); W[k] = (cf2){cs, sn}; }
    __syncthreads();
    const float inv_n = 1.0f / (float)N;
    for (int o = 0; o < 2; ++o) {
        const float* Fo = F + (size_t)(o * 256 + c) * N;
        float ssq = 0.f;
        { constexpr int NIT = N / NTHR; float fvv[NIT];
#pragma unroll
          for (int i = 0; i < NIT; ++i) fvv[i] = Fo[(tid + NTHR * i + L) & (N - 1)];
#pragma unroll
          for (int i = 0; i < NIT; ++i) { ssq += fvv[i] * fvv[i]; X[XP(tid + NTHR * i)] = (cf2){fvv[i], 0.f}; } }
        const float fscale = rsqrtf(block_sum(ssq, (LAS float*)(W + N / 2), tid) + 1e-6f);
        fft_lds<LOGN, false>(X, W, tid);
        for (int pp = tid; pp < N; pp += NTHR) { const int k = (int)(brev32((unsigned)pp) >> (32 - LOGN)); if (k <= N / 2) Hh[k] = X[XP(pp)] * fscale; }
        __syncthreads();
        const float bo = bias[o * 256 + c];
        constexpr int NITZ = (L + NTHR - 1) / NTHR;
        float a0[NITZ], a1[NITZ];
        { float* z0 = HV + ((size_t)(0 * 8) * 256 + c) * L; float* z1 = z0 + (size_t)256 * L;
#pragma unroll
          for (int i = 0; i < NITZ; ++i) { const int t = tid + NTHR * i; if (t < L) { a0[i] = z0[t]; a1[i] = z1[t]; } } }
#pragma unroll 1
        for (int pair = 0; pair < 4; ++pair) {
            float* z0 = HV + ((size_t)(0 * 8 + 2 * pair) * 256 + c) * L; float* z1 = z0 + (size_t)256 * L;
            const float* g0 = HV + ((size_t)((1 + o) * 8 + 2 * pair) * 256 + c) * L; const float* g1 = g0 + (size_t)256 * L;
            constexpr bool RR = (LOGN == 13);
            cf2 xr[16];
            if (RR) {
#pragma unroll
                for (int i = 0; i < 16; ++i) xr[i] = (i < NITZ) ? (cf2){a0[i < NITZ ? i : 0], a1[i < NITZ ? i : 0]} : (cf2){0.f, 0.f};
            } else {
#pragma unroll
                for (int i = 0; i < NITZ; ++i) { const int t = tid + NTHR * i; if (t < L) { X[XP(t)] = (cf2){a0[i], a1[i]}; X[XP(t + L)] = (cf2){0.f, 0.f}; } }
                __syncthreads();
            }
            fft_lds<LOGN, false, false, RR>(X, W, tid, nullptr, xr);
            float q0[NITZ], q1[NITZ], n0[NITZ], n1[NITZ];
            { const int pn = pair < 3 ? pair + 1 : pair; const float* y0 = HV + ((size_t)(0 * 8 + 2 * pn) * 256 + c) * L; const float* y1 = y0 + (size_t)256 * L;
#pragma unroll
              for (int i = 0; i < NITZ; ++i) { const int t = tid + NTHR * i; if (t < L) { q0[i] = g0[t]; q1[i] = g1[t]; n0[i] = y0[t]; n1[i] = y1[t]; } } }
            fft_lds<LOGN, true, true, RR>(X, W, tid, Hh, xr);
#pragma unroll
            for (int i = 0; i < NITZ; ++i) { const int t = tid + NTHR * i; if (t < L) { const cf2 cv = (RR ? xr[i < 16 ? i : 0] : X[XP(t)]) * inv_n;
                z0[t] = q0[i] * (cv.x + bo * a0[i]); z1[t] = q1[i] * (cv.y + bo * a1[i]); a0[i] = n0[i]; a1[i] = n1[i]; } }
            __syncthreads();
        }
    }
}
__device__ __forceinline__ void ph_hy_conv(const PAS Prm& p, int l, bool with_ctx, LAS unsigned char* lds) {
    constexpr int LOGN = (SEQ == 4096) ? 13 : 9;
    for (int c = BID; c < 256; c += NBLK) hy_fft_channel<LOGN>(p, l, c, lds);
    if (with_ctx) for (int it = BID; it < 512; it += NBLK) hy_conv_item<CTXL>(p, l, it >> 1, (it & 1) * 4, lds);
}

constexpr int PPL = 18;
constexpr int NPH = 1 + DEPTH * PPL + 1;

#ifdef HOST_EMU
#define NO_PK_F32
#else
#define NO_PK_F32 __attribute__((target("no-packed-fp32-ops")))
#endif
template <unsigned MASK> __global__ void __launch_bounds__(NTHR, 2) fwd(Prm pk) {
#ifdef HOST_EMU
    unsigned char* lds_raw = g_lds_emu;
#else
    extern __shared__ __attribute__((aligned(16))) unsigned char lds_raw[];
#endif
    LAS unsigned char* lds = (LAS unsigned char*)lds_raw;
    volatile LAS unsigned* misc = (volatile LAS unsigned*)(lds + LDS_BYTES - 256);
#ifndef HOST_EMU
    { const unsigned t0 = threadIdx.x;
      if (t0 < 64u) misc[t0] = 0u;
      if ((t0 & 63u) == 0u) ((volatile LAS unsigned*)(lds + TIDTAB_OFF))[hw_slot()] = t0 >> 6;
      __syncthreads();
      if ((unsigned)tid_opq() != t0) __hip_atomic_store((unsigned*)(pk.ws + WS_CTL + 768 * 1024), 1u, __ATOMIC_RELAXED, __HIP_MEMORY_SCOPE_AGENT); }
#else
    if (TID < 64) misc[TID] = 0u;
    __syncthreads();
#endif
    const int lo = pk.lo, hi = pk.hi;
#ifdef PROBE_G
    if (blockIdx.x == 0 && tid_opq() == 0) misc[15] = (unsigned)__builtin_amdgcn_s_memrealtime();
#endif
    XcdBarrier bar; bar.bar = (unsigned*)(pk.ws + WS_CTL); bar.x = 0; bar.st = misc + 8;
    if (hi - lo > 1) bar = xcd_barrier_post((unsigned*)(pk.ws + WS_CTL), misc + 8);
    int ph = 0;
#ifdef HOST_EMU
#define PH_PRM() const Prm* pl_ = &pk
#else
#define PH_PRM() const PAS Prm* pl_ = (const PAS Prm*)__builtin_amdgcn_kernarg_segment_ptr(); asm volatile("" : "+s"(pl_))
#endif
#define PH_BEGIN(k) if (((MASK >> ((k) & 31)) & 1u) && ph >= lo && ph < hi) { constexpr int PH_CUR = (k); (void)PH_CUR; PH_PRM(); const PAS Prm& p = *pl_; \
    bf16* const WB = (bf16*)(p.ws + WS_W); bf16* const U = (bf16*)(p.ws + WS_U); float* const XC = (float*)(p.ws + WS_XC); bf16* const PB = (bf16*)(p.ws + WS_BIG + BG_P); \
    unsigned char* const SB = p.ws + WS_BIG + BG_S; bf16* const GH = (bf16*)(p.ws + WS_BIG); bf16* const MG = (bf16*)(p.ws + WS_BIG + 136 * MiB); bf16* const ACT = (bf16*)(p.ws + WS_BIG); \
    const float* const MOD = (const float*)(p.ws + WS_MOD); const float* const modl = MOD + (size_t)l * 9 * 6144; \
    const float* xc_src = (l == 0) ? p.in[2] : XC; const float* xl_src = (l == 0) ? p.in[0] : p.out; \
    (void)WB; (void)U; (void)XC; (void)PB; (void)SB; (void)GH; (void)MG; (void)ACT; (void)MOD; (void)modl; (void)xc_src; (void)xl_src;
#ifdef PROBE_G
#define PH_GRP(k) (((k) == 4 || (k) == 8 || (k) == 12 || (k) == 16 || ((k) >= 21 && (k) <= 27) || (k) == 29 || (k) == 30) ? 0 : ((k) == 6) ? 1 : ((k) == 20) ? 2 : ((k) == 5 || (k) == 13) ? 3 : 4)
#define PH_END_K(k) if (ph + 1 < hi) xcd_barrier(bar); if (blockIdx.x == 0 && tid_opq() == 0) { const unsigned tnow = (unsigned)__builtin_amdgcn_s_memrealtime(); misc[16 + PH_GRP(k)] += tnow - misc[15]; misc[15] = tnow; } } ++ph;
#else
#define PH_END_K(k) if (ph + 1 < hi) xcd_barrier(bar); } ++ph;
#endif
#define PH_END PH_END_K(PH_CUR)
    typedef pg8::StaticOrder SO;

    { const int l = 0; PH_BEGIN(1) ph_mod(p, lds); PH_END }

    {
        constexpr int l = 0;
        const bool last = (l == DEPTH - 1), wctx = !last;
        const int ro = last ? RC : 0, Mpost = last ? RL : RT;

        PH_BEGIN(2) ph_cvt(p, l, lds, (l > 0 && NBLK == 256) ? 2 : 0, 0); ph_norm(p, l, 0, xc_src, xl_src, 0); PH_END
        PH_BEGIN(4) { pg8::Gemm g{U, WB + WO_WP + (size_t)1280 * 1024, RT, 2048, 1024}; SO S; S.init(RT, 2048, NBLK, BID); pg8::EpiBf2 E{(bf16*)(p.ws + WS_Y), 1024, PB, 1024, 4};
                   pg8::gemm_phase<pg8::EpiBf2, SO, true, true>(lds, g, S, E); } PH_END
        PH_BEGIN(5) ph_rw_prep(p, l, lds); PH_END
        PH_BEGIN(6) { const int bid = BID;
#ifdef PROBE_G
                   const unsigned tq0 = (unsigned)__builtin_amdgcn_s_memrealtime();
#endif
                   for (int task = bid; task < 256; task += NBLK) {
                       if (task < 128) scan_phase<0>(task, SB, PB, (void*)(SB + RW_Y), p.in[25] + l * 256, nullptr, lds);
                       else scan_phase<1>(task - 128, SB, PB, (void*)(SB + RT_Y), nullptr, p.in[35] + l * 8, lds);
                       __syncthreads(); }
#ifdef PROBE_G
                   if (tid_opq() == 0) { const unsigned tq1 = (unsigned)__builtin_amdgcn_s_memrealtime(); if (bid == 0) misc[16 + 5] += tq1 - tq0; if (bid == 128) misc[16 + 6] += tq1 - tq0; }
#endif
                   } PH_END
        PH_BEGIN(7) ph_rw_post(p, l); ph_ret_post(p); PH_END
        PH_BEGIN(12) { pg8::Gemm g{U, WB + WO_WP, RT, 1280, 1024}; SO S; S.init(RT, 1280, NBLK, BID);
                   pg8::EpiBf2 E{PB, 512, (bf16*)(SB + HY_P), 768, 2};
                   pg8::gemm_phase<pg8::EpiBf2, SO, true, true>(lds, g, S, E); } PH_END
        PH_BEGIN(13) ph_lru_prep(p, l, lds); PH_END
        PH_BEGIN(14) ph_lru_agg(p); ph_hy_filter(p, l, wctx, lds); PH_END
        PH_BEGIN(15) ph_lru_fin(p, lds); PH_END
        PH_BEGIN(19) ph_hy_prep(p, l, wctx, lds); PH_END
        PH_BEGIN(20) ph_hy_conv(p, l, wctx, lds); PH_END
        PH_BEGIN(32) ph_hy_post(p, wctx, lds); PH_END
        PH_BEGIN(21) { pg8::Gemm g{U + (size_t)ro * 1024, WB + WO_WG, Mpost, 4096, 1024}; SO S; S.init(Mpost, 4096, NBLK, BID); pg8::EpiBf<1> E{GH + (size_t)ro * 4096, 4096};
                   pg8::gemm_phase<pg8::EpiBf<1>, SO, true, true>(lds, g, S, E); } PH_END
#ifdef HOST_EMU
#define MERGE_LOCAL_SEAM() __syncthreads()
#else
#define MERGE_LOCAL_SEAM() do { asm volatile("s_waitcnt vmcnt(0)" ::: "memory"); __syncthreads(); __builtin_amdgcn_fence(__ATOMIC_ACQUIRE, "agent"); asm volatile("s_waitcnt vmcnt(0)" ::: "memory"); __syncthreads(); } while (0)
#endif
        PH_BEGIN(22) {
            { pg8::Gemm g{(const bf16*)(p.ws + WS_Y + 0 * SZ17) + (size_t)ro * 256, WB + WO_BR + (size_t)0 * 1024 * 256, Mpost, 1024, 256}; SO S; S.init(Mpost, 1024, NBLK, BID);
              pg8::EpiMerge E{GH + (size_t)ro * 4096, 4096, 0, U + (size_t)ro * 1024, 1}; pg8::gemm_phase<pg8::EpiMerge, SO, true, true>(lds, g, S, E); }
            MERGE_LOCAL_SEAM();
            { pg8::Gemm g{(const bf16*)(p.ws + WS_Y + 1 * SZ17) + (size_t)ro * 256, WB + WO_BR + (size_t)1 * 1024 * 256, Mpost, 1024, 256}; SO S; S.init(Mpost, 1024, NBLK, BID);
              pg8::EpiMerge E{GH + (size_t)ro * 4096, 4096, 1024, U + (size_t)ro * 1024, 0}; pg8::gemm_phase<pg8::EpiMerge, SO, true, true>(lds, g, S, E); }
            MERGE_LOCAL_SEAM();
            { pg8::Gemm g{(const bf16*)(p.ws + WS_Y + 2 * SZ17) + (size_t)ro * 256, WB + WO_BR + (size_t)2 * 1024 * 256, Mpost, 1024, 256}; SO S; S.init(Mpost, 1024, NBLK, BID);
              pg8::EpiMerge E{GH + (size_t)ro * 4096, 4096, 2048, U + (size_t)ro * 1024, 0}; pg8::gemm_phase<pg8::EpiMerge, SO, true, true>(lds, g, S, E); }
            MERGE_LOCAL_SEAM();
            { pg8::Gemm g{(const bf16*)(p.ws + WS_Y + 3 * SZ17) + (size_t)ro * 256, WB + WO_BR + (size_t)3 * 1024 * 256, Mpost, 1024, 256}; SO S; S.init(Mpost, 1024, NBLK, BID);
              pg8::EpiMerge E{GH + (size_t)ro * 4096, 4096, 3072, U + (size_t)ro * 1024, 0}; pg8::gemm_phase<pg8::EpiMerge, SO, true, true>(lds, g, S, E); }
        } PH_END
        PH_BEGIN(27) { pg8::Gemm g{U + (size_t)ro * 1024, WB + WO_WO, Mpost, 1024, 1024}; SO S; S.init(Mpost, 1024, NBLK, BID);
                   pg8::EpiResid E{xc_src, xl_src, XC, p.out, modl, 2 * 1024, ro};
                   pg8::gemm_phase<pg8::EpiResid, SO, true, true>(lds, g, S, E); } PH_END
        PH_BEGIN(28) ph_norm(p, l, 1, XC, p.out, ro); PH_END
        PH_BEGIN(29) { pg8::Gemm g{U + (size_t)ro * 1024, WB + WO_W1, Mpost, 5632, 1024}; SO S; S.init(Mpost, 5632, NBLK, BID); pg8::EpiSwiglu E{ACT + (size_t)ro * 2816, 2816};
                   pg8::gemm_phase<pg8::EpiSwiglu, SO, true, true>(lds, g, S, E); } PH_END
        PH_BEGIN(30) { pg8::Gemm g{ACT + (size_t)ro * 2816, WB + WO_W2, Mpost, 1024, 2816}; SO S; S.init(Mpost, 1024, NBLK, BID);
                   pg8::EpiResid E{XC, p.out, XC, p.out, modl, 5 * 1024, ro};
                   pg8::gemm_phase<pg8::EpiResid, SO, true, true>(lds, g, S, E); }
                   if (!last && NBLK == 256 && BID >= 32) { __syncthreads(); ph_cvt(p, l + 1, lds, 1, 32); }
        PH_END
    }
    {
        constexpr int l = 1;
        const bool last = (l == DEPTH - 1), wctx = !last;
        const int ro = last ? RC : 0, Mpost = last ? RL : RT;

        PH_BEGIN(2) ph_cvt(p, l, lds, (l > 0 && NBLK == 256) ? 2 : 0, 0); ph_norm(p, l, 0, xc_src, xl_src, 0); PH_END
        PH_BEGIN(4) { pg8::Gemm g{U, WB + WO_WP + (size_t)1280 * 1024, RT, 2048, 1024}; SO S; S.init(RT, 2048, NBLK, BID); pg8::EpiBf2 E{(bf16*)(p.ws + WS_Y), 1024, PB, 1024, 4};
                   pg8::gemm_phase<pg8::EpiBf2, SO, true, true>(lds, g, S, E); } PH_END
        PH_BEGIN(5) ph_rw_prep(p, l, lds); PH_END
        PH_BEGIN(6) { const int bid = BID;
#ifdef PROBE_G
                   const unsigned tq0 = (unsigned)__builtin_amdgcn_s_memrealtime();
#endif
                   for (int task = bid; task < 256; task += NBLK) {
                       if (task < 128) scan_phase<0>(task, SB, PB, (void*)(SB + RW_Y), p.in[25] + l * 256, nullptr, lds);
                       else scan_phase<1>(task - 128, SB, PB, (void*)(SB + RT_Y), nullptr, p.in[35] + l * 8, lds);
                       __syncthreads(); }
#ifdef PROBE_G
                   if (tid_opq() == 0) { const unsigned tq1 = (unsigned)__builtin_amdgcn_s_memrealtime(); if (bid == 0) misc[16 + 5] += tq1 - tq0; if (bid == 128) misc[16 + 6] += tq1 - tq0; }
#endif
                   } PH_END
        PH_BEGIN(7) ph_rw_post(p, l); ph_ret_post(p); PH_END
        PH_BEGIN(12) { pg8::Gemm g{U, WB + WO_WP, RT, 1280, 1024}; SO S; S.init(RT, 1280, NBLK, BID);
                   pg8::EpiBf2 E{PB, 512, (bf16*)(SB + HY_P), 768, 2};
                   pg8::gemm_phase<pg8::EpiBf2, SO, true, true>(lds, g, S, E); } PH_END
        PH_BEGIN(13) ph_lru_prep(p, l, lds); PH_END
        PH_BEGIN(14) ph_lru_agg(p); ph_hy_filter(p, l, wctx, lds); PH_END
        PH_BEGIN(15) ph_lru_fin(p, lds); PH_END
        PH_BEGIN(19) ph_hy_prep(p, l, wctx, lds); PH_END
        PH_BEGIN(20) ph_hy_conv(p, l, wctx, lds); PH_END
        PH_BEGIN(32) ph_hy_post(p, wctx, lds); PH_END
        PH_BEGIN(21) { pg8::Gemm g{U + (size_t)ro * 1024, WB + WO_WG, Mpost, 4096, 1024}; SO S; S.init(Mpost, 4096, NBLK, BID); pg8::EpiBf<1> E{GH + (size_t)ro * 4096, 4096};
                   pg8::gemm_phase<pg8::EpiBf<1>, SO, true, true>(lds, g, S, E); } PH_END
#ifdef HOST_EMU
#define MERGE_LOCAL_SEAM() __syncthreads()
#else
#define MERGE_LOCAL_SEAM() do { asm volatile("s_waitcnt vmcnt(0)" ::: "memory"); __syncthreads(); __builtin_amdgcn_fence(__ATOMIC_ACQUIRE, "agent"); asm volatile("s_waitcnt vmcnt(0)" ::: "memory"); __syncthreads(); } while (0)
#endif
        PH_BEGIN(22) {
            { pg8::Gemm g{(const bf16*)(p.ws + WS_Y + 0 * SZ17) + (size_t)ro * 256, WB + WO_BR + (size_t)0 * 1024 * 256, Mpost, 1024, 256}; SO S; S.init(Mpost, 1024, NBLK, BID);
              pg8::EpiMerge E{GH + (size_t)ro * 4096, 4096, 0, U + (size_t)ro * 1024, 1}; pg8::gemm_phase<pg8::EpiMerge, SO, true, true>(lds, g, S, E); }
            MERGE_LOCAL_SEAM();
            { pg8::Gemm g{(const bf16*)(p.ws + WS_Y + 1 * SZ17) + (size_t)ro * 256, WB + WO_BR + (size_t)1 * 1024 * 256, Mpost, 1024, 256}; SO S; S.init(Mpost, 1024, NBLK, BID);
              pg8::EpiMerge E{GH + (size_t)ro * 4096, 4096, 1024, U + (size_t)ro * 1024, 0}; pg8::gemm_phase<pg8::EpiMerge, SO, true, true>(lds, g, S, E); }
            MERGE_LOCAL_SEAM();
            { pg8::Gemm g{(const bf16*)(p.ws + WS_Y + 2 * SZ17) + (size_t)ro * 256, WB + WO_BR + (size_t)2 * 1024 * 256, Mpost, 1024, 256}; SO S; S.init(Mpost, 1024, NBLK, BID);
              pg8::EpiMerge E{GH + (size_t)ro * 4096, 4096, 2048, U + (size_t)ro * 1024, 0}; pg8::gemm_phase<pg8::EpiMerge, SO, true, true>(lds, g, S, E); }
            MERGE_LOCAL_SEAM();
            { pg8::Gemm g{(const bf16*)(p.ws + WS_Y + 3 * SZ17) + (size_t)ro * 256, WB + WO_BR + (size_t)3 * 1024 * 256, Mpost, 1024, 256}; SO S; S.init(Mpost, 1024, NBLK, BID);
              pg8::EpiMerge E{GH + (size_t)ro * 4096, 4096, 3072, U + (size_t)ro * 1024, 0}; pg8::gemm_phase<pg8::EpiMerge, SO, true, true>(lds, g, S, E); }
        } PH_END
        PH_BEGIN(27) { pg8::Gemm g{U + (size_t)ro * 1024, WB + WO_WO, Mpost, 1024, 1024}; SO S; S.init(Mpost, 1024, NBLK, BID);
                   pg8::EpiResid E{xc_src, xl_src, XC, p.out, modl, 2 * 1024, ro};
                   pg8::gemm_phase<pg8::EpiResid, SO, true, true>(lds, g, S, E); } PH_END
        PH_BEGIN(28) ph_norm(p, l, 1, XC, p.out, ro); PH_END
        PH_BEGIN(29) { pg8::Gemm g{U + (size_t)ro * 1024, WB + WO_W1, Mpost, 5632, 1024}; SO S; S.init(Mpost, 5632, NBLK, BID); pg8::EpiSwiglu E{ACT + (size_t)ro * 2816, 2816};
                   pg8::gemm_phase<pg8::EpiSwiglu, SO, true, true>(lds, g, S, E); } PH_END
        PH_BEGIN(30) { pg8::Gemm g{ACT + (size_t)ro * 2816, WB + WO_W2, Mpost, 1024, 2816}; SO S; S.init(Mpost, 1024, NBLK, BID);
                   pg8::EpiResid E{XC, p.out, XC, p.out, modl, 5 * 1024, ro};
                   pg8::gemm_phase<pg8::EpiResid, SO, true, true>(lds, g, S, E); }
                   if (!last && NBLK == 256 && BID >= 32) { __syncthreads(); ph_cvt(p, l + 1, lds, 1, 32); }
        PH_END
    }
    {
        constexpr int l = 2;
        const bool last = (l == DEPTH - 1), wctx = !last;
        const int ro = last ? RC : 0, Mpost = last ? RL : RT;

        PH_BEGIN(2) ph_cvt(p, l, lds, (l > 0 && NBLK == 256) ? 2 : 0, 0); ph_norm(p, l, 0, xc_src, xl_src, 0); PH_END
        PH_BEGIN(4) { pg8::Gemm g{U, WB + WO_WP + (size_t)1280 * 1024, RT, 2048, 1024}; SO S; S.init(RT, 2048, NBLK, BID); pg8::EpiBf2 E{(bf16*)(p.ws + WS_Y), 1024, PB, 1024, 4};
                   pg8::gemm_phase<pg8::EpiBf2, SO, true, true>(lds, g, S, E); } PH_END
        PH_BEGIN(5) ph_rw_prep(p, l, lds); PH_END
        PH_BEGIN(6) { const int bid = BID;
#ifdef PROBE_G
                   const unsigned tq0 = (unsigned)__builtin_amdgcn_s_memrealtime();
#endif
                   for (int task = bid; task < 256; task += NBLK) {
                       if (task < 128) scan_phase<0>(task, SB, PB, (void*)(SB + RW_Y), p.in[25] + l * 256, nullptr, lds);
                       else scan_phase<1>(task - 128, SB, PB, (void*)(SB + RT_Y), nullptr, p.in[35] + l * 8, lds);
                       __syncthreads(); }
#ifdef PROBE_G
                   if (tid_opq() == 0) { const unsigned tq1 = (unsigned)__builtin_amdgcn_s_memrealtime(); if (bid == 0) misc[16 + 5] += tq1 - tq0; if (bid == 128) misc[16 + 6] += tq1 - tq0; }
#endif
                   } PH_END
        PH_BEGIN(7) ph_rw_post(p, l); ph_ret_post(p); PH_END
        PH_BEGIN(12) { pg8::Gemm g{U, WB + WO_WP, RT, 1280, 1024}; SO S; S.init(RT, 1280, NBLK, BID);
                   pg8::EpiBf2 E{PB, 512, (bf16*)(SB + HY_P), 768, 2};
                   pg8::gemm_phase<pg8::EpiBf2, SO, true, true>(lds, g, S, E); } PH_END
        PH_BEGIN(13) ph_lru_prep(p, l, lds); PH_END
        PH_BEGIN(14) ph_lru_agg(p); ph_hy_filter(p, l, wctx, lds); PH_END
        PH_BEGIN(15) ph_lru_fin(p, lds); PH_END
        PH_BEGIN(19) ph_hy_prep(p, l, wctx, lds); PH_END
        PH_BEGIN(20) ph_hy_conv(p, l, wctx, lds); PH_END
        PH_BEGIN(32) ph_hy_post(p, wctx, lds); PH_END
        PH_BEGIN(21) { pg8::Gemm g{U + (size_t)ro * 1024, WB + WO_WG, Mpost, 4096, 1024}; SO S; S.init(Mpost, 4096, NBLK, BID); pg8::EpiBf<1> E{GH + (size_t)ro * 4096, 4096};
                   pg8::gemm_phase<pg8::EpiBf<1>, SO, true, true>(lds, g, S, E); } PH_END
#ifdef HOST_EMU
#define MERGE_LOCAL_SEAM() __syncthreads()
#else
#define MERGE_LOCAL_SEAM() do { asm volatile("s_waitcnt vmcnt(0)" ::: "memory"); __syncthreads(); __builtin_amdgcn_fence(__ATOMIC_ACQUIRE, "agent"); asm volatile("s_waitcnt vmcnt(0)" ::: "memory"); __syncthreads(); } while (0)
#endif
        PH_BEGIN(22) {
            { pg8::Gemm g{(const bf16*)(p.ws + WS_Y + 0 * SZ17) + (size_t)ro * 256, WB + WO_BR + (size_t)0 * 1024 * 256, Mpost, 1024, 256}; SO S; S.init(Mpost, 1024, NBLK, BID);
              pg8::EpiMerge E{GH + (size_t)ro * 4096, 4096, 0, U + (size_t)ro * 1024, 1}; pg8::gemm_phase<pg8::EpiMerge, SO, true, true>(lds, g, S, E); }
            MERGE_LOCAL_SEAM();
            { pg8::Gemm g{(const bf16*)(p.ws + WS_Y + 1 * SZ17) + (size_t)ro * 256, WB + WO_BR + (size_t)1 * 1024 * 256, Mpost, 1024, 256}; SO S; S.init(Mpost, 1024, NBLK, BID);
              pg8::EpiMerge E{GH + (size_t)ro * 4096, 4096, 1024, U + (size_t)ro * 1024, 0}; pg8::gemm_phase<pg8::EpiMerge, SO, true, true>(lds, g, S, E); }
            MERGE_LOCAL_SEAM();
            { pg8::Gemm g{(const bf16*)(p.ws + WS_Y + 2 * SZ17) + (size_t)ro * 256, WB + WO_BR + (size_t)2 * 1024 * 256, Mpost, 1024, 256}; SO S; S.init(Mpost, 1024, NBLK, BID);
              pg8::EpiMerge E{GH + (size_t)ro * 4096, 4096, 2048, U + (size_t)ro * 1024, 0}; pg8::gemm_phase<pg8::EpiMerge, SO, true, true>(lds, g, S, E); }
            MERGE_LOCAL_SEAM();
            { pg8::Gemm g{(const bf16*)(p.ws + WS_Y + 3 * SZ17) + (size_t)ro * 256, WB + WO_BR + (size_t)3 * 1024 * 256, Mpost, 1024, 256}; SO S; S.init(Mpost, 1024, NBLK, BID);
              pg8::EpiMerge E{GH + (size_t)ro * 4096, 4096, 3072, U + (size_t)ro * 1024, 0}; pg8::gemm_phase<pg8::EpiMerge, SO, true, true>(lds, g, S, E); }
        } PH_END
        PH_BEGIN(27) { pg8::Gemm g{U + (size_t)ro * 1024, WB + WO_WO, Mpost, 1024, 1024}; SO S; S.init(Mpost, 1024, NBLK, BID);
                   pg8::EpiResid E{xc_src, xl_src, XC, p.out, modl, 2 * 1024, ro};
                   pg8::gemm_phase<pg8::EpiResid, SO, true, true>(lds, g, S, E); } PH_END
        PH_BEGIN(28) ph_norm(p, l, 1, XC, p.out, ro); PH_END
        PH_BEGIN(29) { pg8::Gemm g{U + (size_t)ro * 1024, WB + WO_W1, Mpost, 5632, 1024}; SO S; S.init(Mpost, 5632, NBLK, BID); pg8::EpiSwiglu E{ACT + (size_t)ro * 2816, 2816};
                   pg8::gemm_phase<pg8::EpiSwiglu, SO, true, true>(lds, g, S, E); } PH_END
        PH_BEGIN(30) { pg8::Gemm g{ACT + (size_t)ro * 2816, WB + WO_W2, Mpost, 1024, 2816}; SO S; S.init(Mpost, 1024, NBLK, BID);
                   pg8::EpiResid E{XC, p.out, XC, p.out, modl, 5 * 1024, ro};
                   pg8::gemm_phase<pg8::EpiResid, SO, true, true>(lds, g, S, E); }
                   if (!last && NBLK == 256 && BID >= 32) { __syncthreads(); ph_cvt(p, l + 1, lds, 1, 32); }
        PH_END
    }
    {
        constexpr int l = 3;
        const bool last = (l == DEPTH - 1), wctx = !last;
        const int ro = last ? RC : 0, Mpost = last ? RL : RT;

        PH_BEGIN(2) ph_cvt(p, l, lds, (l > 0 && NBLK == 256) ? 2 : 0, 0); ph_norm(p, l, 0, xc_src, xl_src, 0); PH_END
        PH_BEGIN(4) { pg8::Gemm g{U, WB + WO_WP + (size_t)1280 * 1024, RT, 2048, 1024}; SO S; S.init(RT, 2048, NBLK, BID); pg8::EpiBf2 E{(bf16*)(p.ws + WS_Y), 1024, PB, 1024, 4};
                   pg8::gemm_phase<pg8::EpiBf2, SO, true, true>(lds, g, S, E); } PH_END
        PH_BEGIN(5) ph_rw_prep(p, l, lds); PH_END
        PH_BEGIN(6) { const int bid = BID;
#ifdef PROBE_G
                   const unsigned tq0 = (unsigned)__builtin_amdgcn_s_memrealtime();
#endif
                   for (int task = bid; task < 256; task += NBLK) {
                       if (task < 128) scan_phase<0>(task, SB, PB, (void*)(SB + RW_Y), p.in[25] + l * 256, nullptr, lds);
                       else scan_phase<1>(task - 128, SB, PB, (void*)(SB + RT_Y), nullptr, p.in[35] + l * 8, lds);
                       __syncthreads(); }
#ifdef PROBE_G
                   if (tid_opq() == 0) { const unsigned tq1 = (unsigned)__builtin_amdgcn_s_memrealtime(); if (bid == 0) misc[16 + 5] += tq1 - tq0; if (bid == 128) misc[16 + 6] += tq1 - tq0; }
#endif
                   } PH_END
        PH_BEGIN(7) ph_rw_post(p, l); ph_ret_post(p); PH_END
        PH_BEGIN(12) { pg8::Gemm g{U, WB + WO_WP, RT, 1280, 1024}; SO S; S.init(RT, 1280, NBLK, BID);
                   pg8::EpiBf2 E{PB, 512, (bf16*)(SB + HY_P), 768, 2};
                   pg8::gemm_phase<pg8::EpiBf2, SO, true, true>(lds, g, S, E); } PH_END
        PH_BEGIN(13) ph_lru_prep(p, l, lds); PH_END
        PH_BEGIN(14) ph_lru_agg(p); ph_hy_filter(p, l, wctx, lds); PH_END
        PH_BEGIN(15) ph_lru_fin(p, lds); PH_END
        PH_BEGIN(19) ph_hy_prep(p, l, wctx, lds); PH_END
        PH_BEGIN(20) ph_hy_conv(p, l, wctx, lds); PH_END
        PH_BEGIN(32) ph_hy_post(p, wctx, lds); PH_END
        PH_BEGIN(21) { pg8::Gemm g{U + (size_t)ro * 1024, WB + WO_WG, Mpost, 4096, 1024}; SO S; S.init(Mpost, 4096, NBLK, BID); pg8::EpiBf<1> E{GH + (size_t)ro * 4096, 4096};
                   pg8::gemm_phase<pg8::EpiBf<1>, SO, true, true>(lds, g, S, E); } PH_END
#ifdef HOST_EMU
#define MERGE_LOCAL_SEAM() __syncthreads()
#else
#define MERGE_LOCAL_SEAM() do { asm volatile("s_waitcnt vmcnt(0)" ::: "memory"); __syncthreads(); __builtin_amdgcn_fence(__ATOMIC_ACQUIRE, "agent"); asm volatile("s_waitcnt vmcnt(0)" ::: "memory"); __syncthreads(); } while (0)
#endif
        PH_BEGIN(22) {
            { pg8::Gemm g{(const bf16*)(p.ws + WS_Y + 0 * SZ17) + (size_t)ro * 256, WB + WO_BR + (size_t)0 * 1024 * 256, Mpost, 1024, 256}; SO S; S.init(Mpost, 1024, NBLK, BID);
              pg8::EpiMerge E{GH + (size_t)ro * 4096, 4096, 0, U + (size_t)ro * 1024, 1}; pg8::gemm_phase<pg8::EpiMerge, SO, true, true>(lds, g, S, E); }
            MERGE_LOCAL_SEAM();
            { pg8::Gemm g{(const bf16*)(p.ws + WS_Y + 1 * SZ17) + (size_t)ro * 256, WB + WO_BR + (size_t)1 * 1024 * 256, Mpost, 1024, 256}; SO S; S.init(Mpost, 1024, NBLK, BID);
              pg8::EpiMerge E{GH + (size_t)ro * 4096, 4096, 1024, U + (size_t)ro * 1024, 0}; pg8::gemm_phase<pg8::EpiMerge, SO, true, true>(lds, g, S, E); }
            MERGE_LOCAL_SEAM();
            { pg8::Gemm g{(const bf16*)(p.ws + WS_Y + 2 * SZ17) + (size_t)ro * 256, WB + WO_BR + (size_t)2 * 1024 * 256, Mpost, 1024, 256}; SO S; S.init(Mpost, 1024, NBLK, BID);
              pg8::EpiMerge E{GH + (size_t)ro * 4096, 4096, 2048, U + (size_t)ro * 1024, 0}; pg8::gemm_phase<pg8::EpiMerge, SO, true, true>(lds, g, S, E); }
            MERGE_LOCAL_SEAM();
            { pg8::Gemm g{(const bf16*)(p.ws + WS_Y + 3 * SZ17) + (size_t)ro * 256, WB + WO_BR + (size_t)3 * 1024 * 256, Mpost, 1024, 256}; SO S; S.init(Mpost, 1024, NBLK, BID);
              pg8::EpiMerge E{GH + (size_t)ro * 4096, 4096, 3072, U + (size_t)ro * 1024, 0}; pg8::gemm_phase<pg8::EpiMerge, SO, true, true>(lds, g, S, E); }
        } PH_END
        PH_BEGIN(27) { pg8::Gemm g{U + (size_t)ro * 1024, WB + WO_WO, Mpost, 1024, 1024}; SO S; S.init(Mpost, 1024, NBLK, BID);
                   pg8::EpiResid E{xc_src, xl_src, XC, p.out, modl, 2 * 1024, ro};
                   pg8::gemm_phase<pg8::EpiResid, SO, true, true>(lds, g, S, E); } PH_END
        PH_BEGIN(28) ph_norm(p, l, 1, XC, p.out, ro); PH_END
        PH_BEGIN(29) { pg8::Gemm g{U + (size_t)ro * 1024, WB + WO_W1, Mpost, 5632, 1024}; SO S; S.init(Mpost, 5632, NBLK, BID); pg8::EpiSwiglu E{ACT + (size_t)ro * 2816, 2816};
                   pg8::gemm_phase<pg8::EpiSwiglu, SO, true, true>(lds, g, S, E); } PH_END
        PH_BEGIN(30) { pg8::Gemm g{ACT + (size_t)ro * 2816, WB + WO_W2, Mpost, 1024, 2816}; SO S; S.init(Mpost, 1024, NBLK, BID);
                   pg8::EpiResid E{XC, p.out, XC, p.out, modl, 5 * 1024, ro};
                   pg8::gemm_phase<pg8::EpiResid, SO, true, true>(lds, g, S, E); }
                   if (!last && NBLK == 256 && BID >= 32) { __syncthreads(); ph_cvt(p, l + 1, lds, 1, 32); }
        PH_END
    }
    { const int l = 1; PH_BEGIN(31) ph_final(p); PH_END }
#ifdef PROBE_G
    if (blockIdx.x == (PROBE_G == 6 ? 128 : 0) && tid_opq() == 0) { const unsigned t0 = (unsigned)__builtin_amdgcn_s_memrealtime(); const unsigned w = misc[16 + PROBE_G] * 4u; while ((unsigned)__builtin_amdgcn_s_memrealtime() - t0 < w) __builtin_amdgcn_s_sleep(8); }
#endif
#undef PH_BEGIN
#undef PH_END
}

#ifndef HOST_EMU
#define SITE(k) (1u << (k))
#if MK_PER_PHASE
constexpr int NG = 19;
constexpr unsigned GM[NG] = {
    SITE(0) | SITE(1) | SITE(2) | SITE(3) | SITE(28) | SITE(31) | SITE(7) | SITE(15) | SITE(18) | SITE(19),
    SITE(5),
    SITE(6),
    SITE(13) | SITE(14),
    SITE(17) | SITE(20),
    SITE(4), SITE(8), SITE(12), SITE(16), SITE(21), SITE(24), SITE(22), SITE(23), SITE(25), SITE(26), SITE(27), SITE(30), SITE(29), 0u };
#else
constexpr int NG = 1;
constexpr unsigned GM[NG] = {0xFFFFFFFFu};
#endif
template <int G> static bool prep_group() { return hipFuncSetAttribute((const void*)fwd<GM[G]>, hipFuncAttributeMaxDynamicSharedMemorySize, LDS_BYTES) == hipSuccess; }
template <int G> static void launch_group(int grid, hipStream_t stream, const Prm& p) { hipLaunchKernelGGL(fwd<GM[G]>, dim3(grid), dim3(NTHR), LDS_BYTES, stream, p); }

extern "C" void kernel_launch(void* const* d_in, const int* in_sizes, int n_in, void* d_out, int out_size, void* d_ws, size_t ws_size, hipStream_t stream) {
    static int grid = 0;
    if (grid == 0) {
        if (n_in != 41 || out_size != RL * D || ws_size < WS_END) { fprintf(stderr, "kernel_launch: unexpected shapes (n_in %d out %d ws %zu); nothing launched\n", n_in, out_size, ws_size); grid = -1; return; }
        int dev = 0, cus = 0;
        if (hipGetDevice(&dev) != hipSuccess || hipDeviceGetAttribute(&cus, hipDeviceAttributeMultiprocessorCount, dev) != hipSuccess) { grid = -1; return; }
        bool ok = true;
#if MK_PER_PHASE
        ok = ok && prep_group<0>() && prep_group<1>() && prep_group<2>() && prep_group<3>() && prep_group<4>() && prep_group<5>() && prep_group<6>() && prep_group<7>() && prep_group<8>() && prep_group<9>()
                && prep_group<10>() && prep_group<11>() && prep_group<12>() && prep_group<13>() && prep_group<14>() && prep_group<15>() && prep_group<16>() && prep_group<17>();
#else
        ok = prep_group<0>();
#endif
        if (!ok) { fprintf(stderr, "kernel_launch: hipFuncSetAttribute failed\n"); grid = -1; return; }
        (void)hipGetLastError();
        grid = cus > 0 ? cus : 256;
    }
    if (grid < 0) return;
    if (hipMemsetAsync((char*)d_ws + WS_CTL, 0, 1 * MiB, stream) != hipSuccess) return;
    Prm p{};
    for (int i = 0; i < 41; ++i) p.in[i] = (const float*)d_in[i];
    p.out = (float*)d_out; p.ws = (unsigned char*)d_ws;
#if MK_PER_PHASE
    for (int ph = 0; ph < NPH; ++ph) {
        p.lo = ph; p.hi = ph + 1;
        static const int layer_sites[PPL] = {2, 4, 5, 6, 7, 12, 13, 14, 15, 19, 20, 0  , 21, 22, 27, 28, 29, 30};
        const int k = (ph == 0) ? 1 : (ph == NPH - 1) ? 31 : layer_sites[(ph - 1) % PPL];
        int g = -1;
        for (int q = 0; q < NG; ++q) if ((GM[q] >> k) & 1u) g = q;
        switch (g) {
            case 0: launch_group<0>(grid, stream, p); break; case 1: launch_group<1>(grid, stream, p); break; case 2: launch_group<2>(grid, stream, p); break;
            case 3: launch_group<3>(grid, stream, p); break; case 4: launch_group<4>(grid, stream, p); break; case 5: launch_group<5>(grid, stream, p); break;
            case 6: launch_group<6>(grid, stream, p); break; case 7: launch_group<7>(grid, stream, p); break; case 8: launch_group<8>(grid, stream, p); break;
            case 9: launch_group<9>(grid, stream, p); break; case 10: launch_group<10>(grid, stream, p); break; case 11: launch_group<11>(grid, stream, p); break;
            case 12: launch_group<12>(grid, stream, p); break; case 13: launch_group<13>(grid, stream, p); break; case 14: launch_group<14>(grid, stream, p); break;
            case 15: launch_group<15>(grid, stream, p); break; case 16: launch_group<16>(grid, stream, p); break; case 17: launch_group<17>(grid, stream, p); break;
            default: break; }
#ifdef DIAG_BUILD
        { static const int dg[8][2] = {{0, 0}, {2, 1}, {10, 2}, {14, 3}, {20, 4}, {22, 5}, {26, 6}, {28, 7}};
          for (int q = 0; q < 8; ++q) if (ph == 1 + dg[q][0]) hipLaunchKernelGGL(diag_k, dim3(32), dim3(NTHR), 0, stream, p, dg[q][1]);
          if (ph == 1 + 19) hipLaunchKernelGGL(diag_k, dim3(32), dim3(NTHR), 0, stream, p, 8);
          if (ph == NPH - 1) hipLaunchKernelGGL(diag_out_k, dim3(grid), dim3(NTHR), 0, stream, p); }
#endif
    }
#else
    p.lo = 0; p.hi = NPH;
    launch_group<0>(grid, stream, p);
#endif
}
#endif
```

```cpp
#include <hip/hip_runtime.h>
#include <cstdio>
#include <cstdint>

#ifndef SEQ_
#define SEQ_ 4096
#define CTXL_ 256
#endif
#ifndef MK_PER_PHASE
#define MK_PER_PHASE 0
#endif

#ifndef HOST_EMU
extern __shared__ __attribute__((aligned(16))) unsigned char g_dyn_lds[];
constexpr int TIDTAB_OFF = 147456 - 2048;
__device__ __forceinline__ unsigned hw_slot() { return (unsigned)__builtin_amdgcn_s_getreg((7 << 11) | 4) & 0xFFu; }
__device__ __forceinline__ int tid_opq() {
    const unsigned w = ((const volatile __attribute__((address_space(3))) unsigned*)((__attribute__((address_space(3))) unsigned char*)g_dyn_lds + TIDTAB_OFF))[hw_slot()];
    unsigned lane; asm volatile("v_mbcnt_lo_u32_b32 %0, -1, 0\n\tv_mbcnt_hi_u32_b32 %0, -1, %0" : "=v"(lane));
    int t = (int)((unsigned)__builtin_amdgcn_readfirstlane((int)w) * 64u + lane); asm volatile("" : "+v"(t)); return t;
}
#endif

namespace pg8 {
#define PG8_LAS __attribute__((address_space(3)))
typedef unsigned short bf16_t;
typedef short bf16x8 __attribute__((ext_vector_type(8)));
typedef float f32x4 __attribute__((ext_vector_type(4)));
typedef unsigned u32x4 __attribute__((ext_vector_type(4)));
constexpr int BM = 256, BK = 64, HALF = 128, HTB = HALF * BK * 2  , STAGE_BYTES = 8 * HTB, NXCD = 8, WGM = 8;

__host__ __device__ __forceinline__ int lds_byte(int r, int c) { const int st = (r >> 4) * 2 + (c >> 5), rr = r & 15, cc = c & 31, ob = rr * 64 + cc * 2; return st * 1024 + (ob ^ (((ob >> 9) & 1) << 5)); }
__host__ __device__ __forceinline__ void stage_rc(int b, int& R, int& C) { const int st = b / 1024, sb = b % 1024, swz = sb ^ (((sb >> 9) & 1) << 5); R = (st >> 1) * 16 + swz / 64; C = (st & 1) * 32 + (swz % 64) / 2; }
__host__ __device__ __forceinline__ int perm32(int rho) { const int n = rho >> 4, i = rho & 15; return 8 * (i >> 2) + 4 * n + (i & 3); }

struct Unit { int pm, pn; };
struct Gemm { const bf16_t* A; const bf16_t* Bt; int M, N, K; };

struct StaticOrder {
    int nM, nN, nwg, G, c;
    __host__ __device__ void init(int M, int N, int G_, int c_) { nM = M / BM; nN = N / BM; nwg = nM * nN; G = G_; c = c_; }
    __host__ __device__ bool next(int i, Unit& u) const {
        const long L = (long)i * G + c; if (L >= nwg) return false;
        int wgid = (int)L; { const int q = nwg / NXCD, r = nwg % NXCD, xcd = wgid % NXCD, off = wgid / NXCD; wgid = (xcd < r ? xcd * (q + 1) : r * (q + 1) + (xcd - r) * q) + off; }
        const int nig = WGM * nN, gid = wgid / nig, fm = gid * WGM, gsz = (nM - fm) < WGM ? (nM - fm) : WGM;
        u.pm = fm + ((wgid % nig) % gsz); u.pn = (wgid % nig) / gsz; return true;
    }
    __device__ __forceinline__ void a_ready(const Unit&) const {}
    __device__ __forceinline__ void done(const Unit&) const {}
};

#ifdef HOST_EMU
__device__ __forceinline__ unsigned cvt_pk_bf16(float lo, float hi) { auto f = [](float x) { unsigned u; memcpy(&u, &x, 4); return (u + 0x7fffu + ((u >> 16) & 1u)) >> 16; }; return f(lo) | (f(hi) << 16); }
#else
typedef __bf16 pg8_bf16x2 __attribute__((ext_vector_type(2)));
typedef float pg8_f32x2 __attribute__((ext_vector_type(2)));
__device__ __forceinline__ unsigned cvt_pk_bf16(float lo, float hi) { pg8_f32x2 v = {lo, hi}; pg8_bf16x2 b = __builtin_convertvector(v, pg8_bf16x2); return __builtin_bit_cast(unsigned, b); }
#endif
typedef float f32x2 __attribute__((ext_vector_type(2)));
__device__ __forceinline__ float bflo(unsigned u) { return __uint_as_float(u << 16); }
__device__ __forceinline__ float bfhi(unsigned u) { return __uint_as_float(u & 0xffff0000u); }
#ifdef HOST_EMU
__device__ __forceinline__ float fsigmoid(float x) { return 1.f / (1.f + expf(-x)); }
#else
__device__ __forceinline__ float fsigmoid(float x) { return __builtin_amdgcn_rcpf(1.f + __expf(-x)); }
#endif

#ifdef HOST_EMU
#define EPI_PIN() do { } while (0)
#define EPI_LATE(fr, fq) do { } while (0)
#define EPI_Z(z) do { } while (0)
#else
#define EPI_Z(z) asm volatile("" : "+v"(z))
#define EPI_LATE(fr, fq) asm volatile("" : "+v"(fr), "+v"(fq))

#define EPI_PIN() asm volatile("" ::: "memory")
#endif
template <int ACT> struct EpiBf {
    static constexpr bool PERM = true, AFTER_DRAIN = false;
    bf16_t* O; int ldc;
    __device__ __forceinline__ void operator()(const f32x4 (&acc)[2][2][4][2], const Unit& u, int wr, int wc, int fr, int fq) const {
        EPI_LATE(fr, fq);
        const int row0 = u.pm * BM + wr * 64 + fr, col0 = u.pn * BM + wc * 32 + 8 * fq;
#pragma unroll
        for (int ai = 0; ai < 2; ++ai)
#pragma unroll
            for (int m = 0; m < 4; ++m) { bf16_t* rowp = O + (size_t)(row0 + ai * HALF + m * 16) * ldc + col0;
#pragma unroll
                for (int bj = 0; bj < 2; ++bj) { f32x4 v0 = acc[ai][bj][m][0], v1 = acc[ai][bj][m][1];
                    if (ACT == 1) {
#pragma unroll
                        for (int j = 0; j < 4; ++j) { v0[j] = fsigmoid(v0[j]); v1[j] = fsigmoid(v1[j]); } }
                    u32x4 w; w.x = cvt_pk_bf16(v0[0], v0[1]); w.y = cvt_pk_bf16(v0[2], v0[3]); w.z = cvt_pk_bf16(v1[0], v1[1]); w.w = cvt_pk_bf16(v1[2], v1[3]);
                    *(u32x4*)(rowp + bj * HALF) = w; } }
    }
};

struct EpiBf2 {
    static constexpr bool PERM = true, AFTER_DRAIN = false;
    bf16_t* O1; int ld1; bf16_t* O2; int ld2; int split;
    __device__ __forceinline__ void operator()(const f32x4 (&acc)[2][2][4][2], const Unit& u, int wr, int wc, int fr, int fq) const {
        EPI_LATE(fr, fq);
        const bool first = u.pn < split;
        bf16_t* O = first ? O1 : O2; const int ldc = first ? ld1 : ld2;
        const int row0 = u.pm * BM + wr * 64 + fr, col0 = (first ? u.pn : u.pn - split) * BM + wc * 32 + 8 * fq;
#pragma unroll
        for (int ai = 0; ai < 2; ++ai)
#pragma unroll
            for (int m = 0; m < 4; ++m) { bf16_t* rowp = O + (size_t)(row0 + ai * HALF + m * 16) * ldc + col0;
#pragma unroll
                for (int bj = 0; bj < 2; ++bj) { const f32x4 v0 = acc[ai][bj][m][0], v1 = acc[ai][bj][m][1];
                    u32x4 w; w.x = cvt_pk_bf16(v0[0], v0[1]); w.y = cvt_pk_bf16(v0[2], v0[3]); w.z = cvt_pk_bf16(v1[0], v1[1]); w.w = cvt_pk_bf16(v1[2], v1[3]);
                    *(u32x4*)(rowp + bj * HALF) = w; } }
    }
};

struct EpiMerge {
    static constexpr bool PERM = true, AFTER_DRAIN = false;
    const bf16_t* G; int ldg; int gcol0; bf16_t* Mg; int first;
    __device__ __forceinline__ void operator()(const f32x4 (&acc)[2][2][4][2], const Unit& u, int wr, int wc, int fr, int fq) const {
        EPI_LATE(fr, fq);
        const int row0 = u.pm * BM + wr * 64 + fr, col0 = u.pn * BM + wc * 32 + 8 * fq;
#pragma unroll
        for (int ai = 0; ai < 2; ++ai)
#pragma unroll
            for (int m = 0; m < 4; ++m) { const size_t row = (size_t)(row0 + ai * HALF + m * 16);
#pragma unroll
                for (int bj = 0; bj < 2; ++bj) { const int col = col0 + bj * HALF;
                    const u32x4 gv = *(const u32x4*)(G + row * ldg + gcol0 + col);
                    bf16_t* mp = Mg + row * 1024 + col;
                    u32x4 pv; if (!first) pv = *(const u32x4*)mp; else { unsigned z0 = 0u; EPI_Z(z0); pv = (u32x4){z0, z0, z0, z0}; }
                    const f32x4 v0 = acc[ai][bj][m][0], v1 = acc[ai][bj][m][1];
                    float o[8];
                    o[0] = bflo(pv.x) + bflo(gv.x) * v0[0]; o[1] = bfhi(pv.x) + bfhi(gv.x) * v0[1];
                    o[2] = bflo(pv.y) + bflo(gv.y) * v0[2]; o[3] = bfhi(pv.y) + bfhi(gv.y) * v0[3];
                    o[4] = bflo(pv.z) + bflo(gv.z) * v1[0]; o[5] = bfhi(pv.z) + bfhi(gv.z) * v1[1];
                    o[6] = bflo(pv.w) + bflo(gv.w) * v1[2]; o[7] = bfhi(pv.w) + bfhi(gv.w) * v1[3];
                    u32x4 w; w.x = cvt_pk_bf16(o[0], o[1]); w.y = cvt_pk_bf16(o[2], o[3]); w.z = cvt_pk_bf16(o[4], o[5]); w.w = cvt_pk_bf16(o[6], o[7]);
                    *(u32x4*)mp = w; }
                EPI_PIN(); }
    }
};

struct EpiResid {
    static constexpr bool PERM = false, AFTER_DRAIN = false;
    const float* src_c; const float* src_l; float* dst_c; float* dst_l; const float* modl; int gate_off; int row_off;
    __device__ __forceinline__ void operator()(const f32x4 (&acc)[2][2][4][2], const Unit& u, int wr, int wc, int fr, int fq) const {
        EPI_LATE(fr, fq);
        const int grow0 = row_off + u.pm * BM;
        const bool isctx = grow0 < 8 * CTXL_;
        const int jb = isctx ? 8 : (grow0 - 8 * CTXL_) / SEQ_;
        const float* gate = modl + (size_t)jb * 6144 + gate_off;
        const float* src = isctx ? src_c + (size_t)grow0 * 1024 : src_l + (size_t)(grow0 - 8 * CTXL_) * 1024;
        float* dst = isctx ? dst_c + (size_t)grow0 * 1024 : dst_l + (size_t)(grow0 - 8 * CTXL_) * 1024;
        const int rr0 = wr * 64 + fr, col0 = u.pn * BM + wc * 32 + 4 * fq;
        f32x4 gv[2][2];
#pragma unroll
        for (int bj = 0; bj < 2; ++bj)
#pragma unroll
            for (int n = 0; n < 2; ++n) gv[bj][n] = *(const f32x4*)(gate + col0 + bj * HALF + n * 16);
#pragma unroll
        for (int ai = 0; ai < 2; ++ai)
#pragma unroll
            for (int m = 0; m < 4; ++m) { const size_t ro = (size_t)(rr0 + ai * HALF + m * 16) * 1024 + col0;
#pragma unroll
                for (int bj = 0; bj < 2; ++bj)
#pragma unroll
                    for (int n = 0; n < 2; ++n) { const f32x4 s = *(const f32x4*)(src + ro + bj * HALF + n * 16);
                        *(f32x4*)(dst + ro + bj * HALF + n * 16) = s + gv[bj][n] * acc[ai][bj][m][n]; }
                EPI_PIN(); }
    }
};

struct EpiSwiglu {
    static constexpr bool PERM = true, AFTER_DRAIN = false;
    bf16_t* O; int ldc;
    __device__ __forceinline__ void operator()(const f32x4 (&acc)[2][2][4][2], const Unit& u, int wr, int wc, int fr, int fq) const {
        EPI_LATE(fr, fq);
        const int row0 = u.pm * BM + wr * 64 + fr, col0 = u.pn * HALF + wc * 32 + 8 * fq;
#pragma unroll
        for (int ai = 0; ai < 2; ++ai)
#pragma unroll
            for (int m = 0; m < 4; ++m) { bf16_t* rowp = O + (size_t)(row0 + ai * HALF + m * 16) * ldc + col0;
                float o[8];
#pragma unroll
                for (int n = 0; n < 2; ++n)
#pragma unroll
                    for (int j = 0; j < 4; ++j) { const float g = acc[ai][0][m][n][j], up = acc[ai][1][m][n][j]; o[n * 4 + j] = g * fsigmoid(g) * up; }
                u32x4 w; w.x = cvt_pk_bf16(o[0], o[1]); w.y = cvt_pk_bf16(o[2], o[3]); w.z = cvt_pk_bf16(o[4], o[5]); w.w = cvt_pk_bf16(o[6], o[7]);
                *(u32x4*)rowp = w; }
    }
};

template <class Epi, class Sched, bool ALIGN_EPI = false, bool SP2 = false>
__device__ __forceinline__ void gemm_phase(PG8_LAS unsigned char* lds, const Gemm g, const Sched& S, const Epi& E) {
    const int tid = tid_opq();
    const int wid = __builtin_amdgcn_readfirstlane(tid >> 6), lane = tid & 63, wr = wid >> 2, wc = wid & 3, fr = lane & 15, fq = lane >> 4;
    const int K = g.K, nt = K / BK;
    unsigned voffA, voffB;
    { int R, C; stage_rc(tid * 16, R, C); const int Rb = Epi::PERM ? ((R & ~31) + perm32(R & 31)) : R;
      voffA = (unsigned)(R * K + C) * 2u; voffB = (unsigned)(Rb * K + C) * 2u; }
    const size_t r64 = (size_t)64 * K * 2;
    const size_t kstep = (size_t)(BK * 2);
    const size_t hstep = (size_t)HALF * K * 2;
    const size_t tstep = 2 * hstep;
    const unsigned ldsw = (unsigned)wid * 1024u;
    const int aoff = lds_byte(wr * 64 + fr, fq * 8), boff = lds_byte(wc * 32 + fr, fq * 8);
#define PG8_SA(b, h) (((b) * 2 + (h)) * HTB)
#define PG8_SB(b, h) ((4 + (b) * 2 + (h)) * HTB)
#define PG8_STAGE(bufoff, gbase, voff) do { _Pragma("unroll") for (int _i = 0; _i < 2; ++_i) \
        __builtin_amdgcn_global_load_lds((const unsigned*)((const char*)(gbase) + (size_t)_i * r64 + (voff)), (PG8_LAS unsigned*)(lds + (bufoff) + ldsw + _i * 8192), 16, 0, 0); } while (0)
#define PG8_LDA(dst, b, h) do { _Pragma("unroll") for (int m = 0; m < 4; ++m) _Pragma("unroll") for (int k = 0; k < 2; ++k) dst[m][k] = *(const PG8_LAS bf16x8*)(lds + PG8_SA(b, h) + aoff + m * 2048 + k * 1024); } while (0)
#define PG8_LDB(dst, b, h) do { _Pragma("unroll") for (int n = 0; n < 2; ++n) _Pragma("unroll") for (int k = 0; k < 2; ++k) dst[n][k] = *(const PG8_LAS bf16x8*)(lds + PG8_SB(b, h) + boff + n * 2048 + k * 1024); } while (0)
#define PG8_MMA(ai, bj, At, Bt) do { __builtin_amdgcn_s_setprio(1); _Pragma("unroll") for (int m = 0; m < 4; ++m) _Pragma("unroll") for (int n = 0; n < 2; ++n) _Pragma("unroll") for (int k = 0; k < 2; ++k) \
        acc[ai][bj][m][n] = __builtin_amdgcn_mfma_f32_16x16x32_bf16(Bt[n][k], At[m][k], acc[ai][bj][m][n], 0, 0, 0); __builtin_amdgcn_s_setprio(0); } while (0)
#define PG8_WAIT_V(n) asm volatile("s_waitcnt vmcnt(" #n ")" ::: "memory")
#define PG8_WAIT_L(n) asm volatile("s_waitcnt lgkmcnt(" #n ")" ::: "memory")
#define PG8_BAR __builtin_amdgcn_s_barrier()
#define PG8_SCHED __builtin_amdgcn_sched_barrier(0)
    Unit cur, nxt; int ui = 0;
    if (!S.next(0, cur)) return;
    f32x4 acc[2][2][4][2];
    { float zf = 0.f; asm volatile("" : "+v"(zf));
#pragma unroll
    for (int a = 0; a < 2; ++a)
#pragma unroll
        for (int b = 0; b < 2; ++b)
#pragma unroll
            for (int m = 0; m < 4; ++m)
#pragma unroll
                for (int n = 0; n < 2; ++n) acc[a][b][m][n] = (f32x4){zf, zf, zf, zf}; }
    bf16x8 At[4][2], B0[2][2], B1[2][2];
    const char* cA = (const char*)g.A + (size_t)cur.pm * tstep; const char* cB = (const char*)g.Bt + (size_t)cur.pn * tstep;
    S.a_ready(cur);
    if constexpr (SP2) {
        PG8_STAGE(PG8_SB(0, 0), cB, voffB); PG8_STAGE(PG8_SB(0, 1), cB + hstep, voffB); PG8_STAGE(PG8_SA(0, 0), cA, voffA); PG8_STAGE(PG8_SA(0, 1), cA + hstep, voffA);
        if (wr == 1) PG8_BAR;
        PG8_WAIT_V(2); PG8_BAR;
        PG8_STAGE(PG8_SB(1, 0), cB + kstep, voffB); PG8_STAGE(PG8_SA(1, 0), cA + kstep, voffA); PG8_STAGE(PG8_SB(1, 1), cB + hstep + kstep, voffB);
        PG8_WAIT_V(6); PG8_BAR;
    } else {
        PG8_STAGE(PG8_SB(0, 0), cB, voffB); PG8_STAGE(PG8_SA(0, 0), cA, voffA); PG8_STAGE(PG8_SB(0, 1), cB + hstep, voffB); PG8_STAGE(PG8_SA(0, 1), cA + hstep, voffA);
        if (wr == 1) PG8_BAR;
        PG8_WAIT_V(4); PG8_BAR;
        PG8_STAGE(PG8_SB(1, 0), cB + kstep, voffB); PG8_STAGE(PG8_SA(1, 0), cA + kstep, voffA); PG8_STAGE(PG8_SB(1, 1), cB + hstep + kstep, voffB);
        PG8_WAIT_V(6); PG8_BAR;
    }
    for (;;) {
        const bool has_next = S.next(ui + 1, nxt);
        const char* nA = has_next ? (const char*)g.A + (size_t)nxt.pm * tstep : cA; const char* nB = has_next ? (const char*)g.Bt + (size_t)nxt.pn * tstep : cB;
        for (int t = 0; t < nt; t += 2) {
            const bool last = (t == nt - 2);
            const char* a1 = cA + (size_t)(t + 1) * kstep;
            const char* a2 = last ? nA : cA + (size_t)(t + 2) * kstep; const char* b2 = last ? nB : cB + (size_t)(t + 2) * kstep;
            const char* a3 = a2 + kstep; const char* b3 = b2 + kstep;
            if (last && has_next) S.a_ready(nxt);
            if constexpr (SP2) {
            PG8_LDB(B0, 0, 0); PG8_LDB(B1, 0, 1); PG8_SCHED; PG8_LDA(At, 0, 0); PG8_STAGE(PG8_SA(1, 1), a1 + hstep, voffA);
            PG8_WAIT_V(8); PG8_WAIT_L(0); PG8_BAR; PG8_MMA(0, 0, At, B0); PG8_MMA(0, 1, At, B1); PG8_BAR; PG8_SCHED;
            PG8_LDA(At, 0, 1); PG8_STAGE(PG8_SB(0, 0), b2, voffB); PG8_STAGE(PG8_SB(0, 1), b2 + hstep, voffB); PG8_STAGE(PG8_SA(0, 0), a2, voffA);
            PG8_WAIT_V(8); PG8_WAIT_L(0); PG8_BAR; PG8_MMA(1, 0, At, B0); PG8_MMA(1, 1, At, B1); PG8_BAR; PG8_SCHED;
            PG8_LDB(B0, 1, 0); PG8_LDB(B1, 1, 1); PG8_SCHED; PG8_LDA(At, 1, 0); PG8_STAGE(PG8_SA(0, 1), a2 + hstep, voffA);
            PG8_WAIT_V(8); PG8_WAIT_L(0); PG8_BAR; PG8_MMA(0, 0, At, B0); PG8_MMA(0, 1, At, B1); PG8_BAR; PG8_SCHED;
            PG8_LDA(At, 1, 1); PG8_STAGE(PG8_SB(1, 0), b3, voffB); PG8_STAGE(PG8_SB(1, 1), b3 + hstep, voffB); PG8_STAGE(PG8_SA(1, 0), a3, voffA);
            PG8_WAIT_V(8); PG8_WAIT_L(0); PG8_BAR; PG8_MMA(1, 0, At, B0); PG8_MMA(1, 1, At, B1); PG8_BAR; PG8_SCHED;
            } else {
            PG8_LDB(B0, 0, 0); PG8_SCHED; PG8_LDA(At, 0, 0); PG8_STAGE(PG8_SA(1, 1), a1 + hstep, voffA);
            PG8_WAIT_L(8); PG8_BAR; PG8_WAIT_L(0); PG8_MMA(0, 0, At, B0); PG8_BAR; PG8_SCHED;
            PG8_LDB(B1, 0, 1); PG8_STAGE(PG8_SB(0, 0), b2, voffB);
            PG8_BAR; PG8_WAIT_L(0); PG8_MMA(0, 1, At, B1); PG8_BAR;
            PG8_LDA(At, 0, 1); PG8_STAGE(PG8_SA(0, 0), a2, voffA);
            PG8_BAR; PG8_WAIT_L(0); PG8_MMA(1, 0, At, B0); PG8_BAR; PG8_SCHED;
            PG8_STAGE(PG8_SB(0, 1), b2 + hstep, voffB);
            PG8_WAIT_V(6); PG8_BAR; PG8_MMA(1, 1, At, B1); PG8_BAR;
            PG8_LDB(B0, 1, 0); PG8_SCHED; PG8_LDA(At, 1, 0); PG8_STAGE(PG8_SA(0, 1), a2 + hstep, voffA);
            PG8_WAIT_L(8); PG8_BAR; PG8_WAIT_L(0); PG8_MMA(0, 0, At, B0); PG8_BAR; PG8_SCHED;
            PG8_LDB(B1, 1, 1); PG8_STAGE(PG8_SB(1, 0), b3, voffB);
            PG8_BAR; PG8_WAIT_L(0); PG8_MMA(0, 1, At, B1); PG8_BAR;
            PG8_LDA(At, 1, 1); PG8_STAGE(PG8_SA(1, 0), a3, voffA);
            PG8_BAR; PG8_WAIT_L(0); PG8_MMA(1, 0, At, B0); PG8_BAR; PG8_SCHED;
            PG8_STAGE(PG8_SB(1, 1), b3 + hstep, voffB);
            PG8_WAIT_V(6); PG8_BAR; PG8_MMA(1, 1, At, B1); PG8_BAR;
            }
        }
        if constexpr (ALIGN_EPI) { if (wr == 0) PG8_BAR; }
        if constexpr (!Epi::AFTER_DRAIN) { E(acc, cur, wr, wc, fr, fq); S.done(cur); }
        if (!has_next) break;
{ float zf = 0.f; asm volatile("" : "+v"(zf));
#pragma unroll
        for (int a = 0; a < 2; ++a)
#pragma unroll
            for (int b = 0; b < 2; ++b)
#pragma unroll
                for (int m = 0; m < 4; ++m)
#pragma unroll
                    for (int n = 0; n < 2; ++n) acc[a][b][m][n] = (f32x4){zf, zf, zf, zf}; }
        cur = nxt; cA = nA; cB = nB; ++ui;
        if constexpr (ALIGN_EPI) { if (wr == 1) PG8_BAR; }
    }
    PG8_WAIT_V(0);
    if constexpr (!ALIGN_EPI) { if (wr == 0) PG8_BAR; }
    PG8_BAR;
    if constexpr (Epi::AFTER_DRAIN) { E.fused(acc, cur, wr, wc, fr, fq, lds, wid, lane); S.done(cur); }
#undef PG8_SA
#undef PG8_SB
#undef PG8_STAGE
#undef PG8_LDA
#undef PG8_LDB
#undef PG8_MMA
#undef PG8_WAIT_V
#undef PG8_WAIT_L
#undef PG8_BAR
#undef PG8_SCHED
}
}

#ifndef LAS
#define LAS __attribute__((address_space(3)))
#endif
#ifdef HOST_EMU
#define PAS
#else
#define PAS __attribute__((address_space(4)))
#endif
typedef unsigned short bf16;
typedef float f32x4 __attribute__((ext_vector_type(4)));
typedef unsigned v4u __attribute__((ext_vector_type(4)));
typedef unsigned v2u __attribute__((ext_vector_type(2)));
typedef float cf2 __attribute__((ext_vector_type(2)));

#ifndef SEQ_
#define SEQ_ 4096
#define CTXL_ 256
#endif
constexpr int D = 1024, NB = 8, SEQ = SEQ_, CTXL = CTXL_, DEPTH = 4;
constexpr int RC = NB * CTXL;
constexpr int RL = NB * SEQ;
constexpr int RT = RC + RL;
constexpr int NIN = 7360, DFF = 2816;
constexpr int NTHR = 512, NWAVES = 8;
constexpr int LDS_BYTES = 147456;

constexpr size_t MiB = (size_t)1 << 20;
constexpr size_t WS_CTL = 0;
constexpr size_t WS_MOD = 1 * MiB;
constexpr size_t WS_W   = 2 * MiB;
constexpr size_t WS_XC  = 37 * MiB;
constexpr size_t WS_U   = 45 * MiB;
constexpr size_t WS_Y   = 113 * MiB;
constexpr size_t WS_BIG = 181 * MiB;
constexpr size_t WS_END = 505 * MiB;
constexpr size_t SZ17 = (size_t)RT * 256 * 2;
constexpr size_t SZ34 = (size_t)RT * 256 * 4;
constexpr size_t WO_WP = 0;
constexpr size_t WO_WG = WO_WP + (size_t)3328 * 1024;
constexpr size_t WO_BR = WO_WG + (size_t)4096 * 1024;
constexpr size_t WO_WO = WO_BR + (size_t)4 * 1024 * 256;
constexpr size_t WO_W1 = WO_WO + (size_t)1024 * 1024;
constexpr size_t WO_W2 = WO_W1 + (size_t)5632 * 1024;
static_assert((WO_W2 + (size_t)1024 * 2816) * 2 <= 35 * MiB, "weights region");
constexpr size_t BG_P = 0;
constexpr size_t BG_S = 68 * MiB;

struct Prm { const float* in[41]; float* out; unsigned char* ws; int lo, hi; };

__device__ __forceinline__ float bf2f(bf16 b) { return __uint_as_float(((unsigned)b) << 16); }
__device__ __forceinline__ bf16 f2bf(float f) { unsigned u = __float_as_uint(f); return (bf16)((u + 0x7fffu + ((u >> 16) & 1u)) >> 16); }
__device__ __forceinline__ unsigned pk2(float lo, float hi) { return (unsigned)f2bf(lo) | ((unsigned)f2bf(hi) << 16); }
__device__ __forceinline__ float blo(unsigned u) { return __uint_as_float(u << 16); }
__device__ __forceinline__ float bhi(unsigned u) { return __uint_as_float(u & 0xffff0000u); }
__device__ __forceinline__ float sigmoidf_(float x) { return 1.f / (1.f + __expf(-x)); }
__device__ __forceinline__ float softplusf_(float x) { return x > 20.f ? x : log1pf(__expf(x)); }
template <int CTRL> __device__ __forceinline__ float dpp_mov(float v) { return __int_as_float(__builtin_amdgcn_update_dpp(0, __float_as_int(v), CTRL, 0xF, 0xF, true)); }
__device__ __forceinline__ float row16_sum(float v) {
    v += dpp_mov<0xB1>(v);
    v += dpp_mov<0x4E>(v);
    v += dpp_mov<0x141>(v);
    v += dpp_mov<0x140>(v);
    return v;
}
#ifdef HOST_EMU
__device__ __forceinline__ float wave_sum(float v) {
#pragma unroll
    for (int o = 1; o < 64; o <<= 1) v += __shfl_xor(v, o);
    return v;
}
#else
__device__ __forceinline__ float wave_sum(float v) {
    v = row16_sum(v);
    v += __int_as_float(__builtin_amdgcn_ds_swizzle(__float_as_int(v), 0x401F));
    return __int_as_float(__builtin_amdgcn_readlane(__float_as_int(v), 0)) + __int_as_float(__builtin_amdgcn_readlane(__float_as_int(v), 32));
}
#endif

#ifdef HOST_EMU
static inline float sfma(float a, float b, float c) { return a * b + c; }
static inline float smul(float a, float b) { return a * b; }
static inline float sadd(float a, float b) { return a + b; }
static inline float ssub(float a, float b) { return a - b; }
#else
__device__ __forceinline__ float sfma(float a, float b, float c) { float d; asm("v_fma_f32 %0, %1, %2, %3" : "=v"(d) : "v"(a), "v"(b), "v"(c)); return d; }
__device__ __forceinline__ float smul(float a, float b) { float d; asm("v_mul_f32_e32 %0, %1, %2" : "=v"(d) : "v"(a), "v"(b)); return d; }
__device__ __forceinline__ float sadd(float a, float b) { float d; asm("v_add_f32_e32 %0, %1, %2" : "=v"(d) : "v"(a), "v"(b)); return d; }
__device__ __forceinline__ float ssub(float a, float b) { float d; asm("v_sub_f32_e32 %0, %1, %2" : "=v"(d) : "v"(a), "v"(b)); return d; }
#endif
#ifdef HOST_EMU
__device__ __forceinline__ float half32_sum(float v) { for (int o = 1; o < 32; o <<= 1) v += __shfl_xor(v, o); return v; }
#else
__device__ __forceinline__ float half32_sum(float v) { v = row16_sum(v); return v + __int_as_float(__builtin_amdgcn_ds_swizzle(__float_as_int(v), 0x401F)); }
#endif
__device__ __forceinline__ float block_sum(float v, LAS float* sc, int tid) {
    v = wave_sum(v);
    if ((tid & 63) == 0) sc[tid >> 6] = v;
    __syncthreads();
    const float r = ((sc[0] + sc[1]) + (sc[2] + sc[3])) + ((sc[4] + sc[5]) + (sc[6] + sc[7]));
    __syncthreads();
    return r;
}
#ifndef HOST_EMU
#define XB_TMO      128
#define XB_XCNT(j)  (256  + 64 * (j))
#define XB_XSUB(j)  (1280 + 64 * (j))
#define XB_XGEN(j)  (2304 + 64 * (j))
#define XB_TOP      3328
#define XB_TOPGEN   3392
#define XCD_BAR_WORDS 3456
#define XB_SPIN_CAP (1u << 18)
__device__ __forceinline__ unsigned xb_ld(unsigned* p)              { return __hip_atomic_load(p, __ATOMIC_RELAXED, __HIP_MEMORY_SCOPE_AGENT); }
__device__ __forceinline__ unsigned xb_add(unsigned* p, unsigned v) { return __hip_atomic_fetch_add(p, v, __ATOMIC_RELAXED, __HIP_MEMORY_SCOPE_AGENT); }
__device__ __forceinline__ unsigned xb_xcc_id() { return (unsigned)__builtin_amdgcn_s_getreg((3 << 11) | 20) & 0xFu; }
#define XB_SPIN(cond, bar) do { unsigned _sp = 0; while (cond) { __builtin_amdgcn_s_sleep(1); \
    if ((++_sp & 255u) == 0u) { if (xb_ld(&(bar)[XB_TMO])) break; if (_sp > XB_SPIN_CAP) { atomicAdd(&(bar)[XB_TMO], 1u); break; } } } } while (0)
struct XcdBarrier { unsigned* bar; unsigned x; volatile LAS unsigned* st; };
__device__ __forceinline__ XcdBarrier xcd_barrier_post(unsigned* bar, volatile LAS unsigned* st) {
    XcdBarrier b; b.bar = bar; b.x = xb_xcc_id(); b.st = st;
    if (threadIdx.x == 0) (void)xb_add(&bar[XB_XCNT(b.x)], 1u);
    return b;
}
__device__ __forceinline__ void xcd_barrier_complete(unsigned* bar, unsigned x, unsigned& nloc, unsigned& nx) {
    const unsigned G = gridDim.x * gridDim.y * gridDim.z;
    unsigned sum, cnt, mine, sp = 0u;
    for (;;) {
        sum = 0u; cnt = 0u; mine = 0u;
#pragma unroll
        for (unsigned j = 0; j < 16; ++j) { const unsigned c = xb_ld(&bar[XB_XCNT(j)]); sum += c; cnt += (c > 0u) ? 1u : 0u; mine = (j == x) ? c : mine; }
        if (sum == G) break;
        __builtin_amdgcn_s_sleep(1);
        if ((++sp & 255u) == 0u) { if (xb_ld(&bar[XB_TMO])) break; if (sp > XB_SPIN_CAP) { atomicAdd(&bar[XB_TMO], 1u); break; } }
    }
    nloc = mine > 0u ? mine : 1u; nx = cnt > 0u ? cnt : 1u;
}
__device__ __forceinline__ void xcd_barrier(const XcdBarrier& b) {
    asm volatile("s_waitcnt vmcnt(0)" ::: "memory");
    __syncthreads();
    if (tid_opq() == 0) {
        unsigned* bar = b.bar; asm volatile("" : "+v"(bar));
        __builtin_amdgcn_s_waitcnt(0);
        unsigned nloc = b.st[0], nx = b.st[1];
        if (nloc == 0u) { xcd_barrier_complete(bar, b.x, nloc, nx); b.st[0] = nloc; b.st[1] = nx; }
        const unsigned old = xb_add(&bar[XB_XSUB(b.x)], 1u);
        const unsigned gen = old / nloc;
        if (old + 1u == (gen + 1u) * nloc) {
            __builtin_amdgcn_fence(__ATOMIC_RELEASE, "agent");
            asm volatile("s_waitcnt vmcnt(0)" ::: "memory");
            const unsigned og = xb_add(&bar[XB_TOP], 1u);
            const unsigned tg = og / nx;
            if (og + 1u == (tg + 1u) * nx) xb_add(&bar[XB_TOPGEN], 1u);
            else XB_SPIN(xb_ld(&bar[XB_TOPGEN]) == tg, bar);
            __builtin_amdgcn_fence(__ATOMIC_ACQUIRE, "agent");
            xb_add(&bar[XB_XGEN(b.x)], 1u);
            asm volatile("s_waitcnt vmcnt(0)" ::: "memory");
        } else {
            XB_SPIN(xb_ld(&bar[XB_XGEN(b.x)]) == gen, bar);
            __builtin_amdgcn_fence(__ATOMIC_ACQUIRE, "agent");
            asm volatile("s_waitcnt vmcnt(0)" ::: "memory");
        }
    }
    __syncthreads();
}

#endif
#ifdef HOST_EMU
#define TID ((int)threadIdx.x)
#define BID ((int)blockIdx.x)
#define NBLK ((int)gridDim.x)
#else
#define TID tid_opq()
#define BID ((int)blockIdx.x)
#define NBLK ((int)gridDim.x)
#endif

__device__ __forceinline__ void ph_mod(const PAS Prm& p, LAS unsigned char* lds) {
    LAS float* sc = (LAS float*)lds;
    LAS float* red = sc + 9 * 1024;
    const float* c = p.in[1]; const float* cctx = p.in[3]; const float* w_mod = p.in[4]; const float* b_mod = p.in[5];
    float* mod = (float*)(p.ws + WS_MOD);
    const int tid = TID, lane = tid & 63, wave = tid >> 6;
    for (int i = tid; i < 9 * 1024; i += NTHR) { const int j = i >> 10, k = i & 1023; const float v = (j < 8) ? c[j * 1024 + k] : cctx[k]; sc[i] = v / (1.f + expf(-v)); }
    __syncthreads();
    for (int it = BID; it < 4 * 96; it += NBLK) {
        const int l = it / 96, cg = it % 96, col = cg * 64 + lane;
        float acc[9];
#pragma unroll
        for (int j = 0; j < 9; ++j) acc[j] = 0.f;
        const float* W = w_mod + (size_t)l * 1024 * 6144 + col;
        for (int k = wave * 128; k < wave * 128 + 128; ++k) { const float w = W[(size_t)k * 6144];
#pragma unroll
            for (int j = 0; j < 9; ++j) acc[j] += sc[j * 1024 + k] * w; }
#pragma unroll
        for (int j = 0; j < 9; ++j) red[(wave * 9 + j) * 64 + lane] = acc[j];
        __syncthreads();
        for (int i = tid; i < 9 * 64; i += NTHR) { const int j = i >> 6, ln = i & 63; float s = b_mod[l * 6144 + cg * 64 + ln];
#pragma unroll
            for (int w = 0; w < 8; ++w) s += red[(w * 9 + j) * 64 + ln];
            mod[((size_t)l * 9 + j) * 6144 + cg * 64 + ln] = s; }
        __syncthreads();
    }
}

#ifdef HOST_EMU
#define PH_ZOPQ(z) do { } while (0)
#else
#define PH_ZOPQ(z) asm volatile("" : "+v"(z))
#endif
#ifdef HOST_EMU
#define LGKM_WAIT() do { (void)emu_xchg(0, threadIdx.x & 63); } while (0)
#else
#define LGKM_WAIT() asm volatile("s_waitcnt lgkmcnt(0)" ::: "memory")
#endif
__device__ __forceinline__ void cvt_item(const float* W, size_t ldw, int k0, int n0, bf16* WT, int K, int drow0, LAS float* scr, int lane) {
#pragma unroll 8
    for (int i = 0; i < 32; ++i) { const int kk = 2 * i + (lane >> 5); scr[kk * 33 + (lane & 31)] = W[(size_t)(k0 + kk) * ldw + n0 + (lane & 31)]; }
    LGKM_WAIT();
    const int c = lane & 7;
#pragma unroll
    for (int j = 0; j < 4; ++j) { const int n = (lane >> 3) + 8 * j; const LAS float* s = scr + (8 * c) * 33 + n;
        v4u o; o.x = pk2(s[0 * 33], s[1 * 33]); o.y = pk2(s[2 * 33], s[3 * 33]); o.z = pk2(s[4 * 33], s[5 * 33]); o.w = pk2(s[6 * 33], s[7 * 33]);
        *(v4u*)(WT + (size_t)(drow0 + n) * K + k0 + 8 * c) = o; }
    LGKM_WAIT();
}
__device__ __forceinline__ void ph_cvt(const PAS Prm& p, int l, LAS unsigned char* lds, const int part = 0, const int blk0 = 0) {
    const int tid = TID, lane = tid & 63, wave = tid >> 6;
    LAS float* scr = (LAS float*)(lds + wave * 16384);
    bf16* WB = (bf16*)(p.ws + WS_W);
    const float* w_in = p.in[8] + (size_t)l * 1024 * NIN;
    const float* brp = p.in[36] + (size_t)l * 4 * 256 * 1024;
    const float* wout = p.in[37] + (size_t)l * 1024 * 1024;
    const float* w1 = p.in[38] + (size_t)l * 1024 * 5632;
    const float* w2 = p.in[39] + (size_t)l * 2816 * 1024;
    constexpr int I_IN = 16 * 230, I_BR = 4 * 4 * 32, I_WO = 16 * 32, I_W1 = 16 * 176, I_W2 = 44 * 32, I_PAD = 16;
    constexpr int NITEMS = I_IN + I_BR + I_WO + I_W1 + I_W2 + I_PAD;
    const int gw = (BID - blk0) * NWAVES + wave, NGW = (NBLK - blk0) * NWAVES;
    constexpr int I_PRE = I_IN + I_BR + I_WO + I_W1;
    const int nit = part == 0 ? NITEMS : part == 1 ? NITEMS - I_W2 : I_W2;
    for (int it = gw; it < nit; it += NGW) {
        int r = part == 0 ? it : part == 1 ? (it < I_PRE ? it : it + I_W2) : it + I_PRE;
        if (r < I_IN) { const int kb = r / 230, nb = r % 230, n0 = nb * 32;
            if (n0 < 3264) { const int drow = n0 < 768 ? n0 + 512 : n0 < 1728 ? n0 + 512 : n0 < 2240 ? n0 - 1728 : n0 + 64;
                cvt_item(w_in, NIN, kb * 64, n0, WB + WO_WP, 1024, drow, scr, lane);
            } else { cvt_item(w_in, NIN, kb * 64, n0, WB + WO_WG, 1024, n0 - 3264, scr, lane); }
            continue; }
        r -= I_IN;
        if (r < I_BR) { const int n = r / 128, q = r % 128, kb = q / 32, nb = q % 32;
            cvt_item(brp + (size_t)n * 256 * 1024, 1024, kb * 64, nb * 32, WB + WO_BR + (size_t)n * 1024 * 256, 256, nb * 32, scr, lane); continue; }
        r -= I_BR;
        if (r < I_WO) { const int kb = r / 32, nb = r % 32; cvt_item(wout, 1024, kb * 64, nb * 32, WB + WO_WO, 1024, nb * 32, scr, lane); continue; }
        r -= I_WO;
        if (r < I_W1) { const int kb = r / 176, nb = r % 176, n0 = nb * 32; const int hh = n0 / 2816, jj = n0 % 2816, pn = jj / 128, j2 = jj % 128;
            cvt_item(w1, 5632, kb * 64, n0, WB + WO_W1, 1024, 256 * pn + 128 * hh + j2, scr, lane); continue; }
        r -= I_W1;
        if (r < I_W2) { const int kb = r / 32, nb = r % 32; cvt_item(w2, 1024, kb * 64, nb * 32, WB + WO_W2, 2816, nb * 32, scr, lane); continue; }
        r -= I_W2;
        {
            unsigned z0 = 0u; PH_ZOPQ(z0); v4u z = (v4u){z0, z0, z0, z0};
            for (int i = lane; i < 4 * 128; i += 64) { const int rr = 2240 + r * 4 + i / 128, cc = (i % 128) * 8; *(v4u*)(WB + WO_WP + (size_t)rr * 1024 + cc) = z; }
        }
    }
}

__device__ __forceinline__ void ph_norm(const PAS Prm& p, int l, int which, const float* xc_src, const float* xl_src, int r_begin) {
    const int tid = TID, lane = tid & 63, wave = tid >> 6;
    const float* mod = (const float*)(p.ws + WS_MOD) + (size_t)l * 9 * 6144;
    const float* g = (which ? p.in[7] : p.in[6]) + l * 1024;
    bf16* U = (bf16*)(p.ws + WS_U);
    const int gw = BID * NWAVES + wave, NGW = NBLK * NWAVES;
    constexpr int NR = 2;
    f32x4 gg[4];
#pragma unroll
    for (int j = 0; j < 4; ++j) gg[j] = *(const f32x4*)(g + 4 * lane + 256 * j);
    for (int r0 = r_begin + gw * NR; r0 < RT; r0 += NGW * NR) {
        f32x4 v[NR][4], sc[NR][4], sh[NR][4]; float s[NR];
#pragma unroll
        for (int q = 0; q < NR; ++q) { const int r = r0 + q;
            const float* xr = (r < RC) ? xc_src + (size_t)r * 1024 : xl_src + (size_t)(r - RC) * 1024; s[q] = 0.f;
#pragma unroll
            for (int j = 0; j < 4; ++j) v[q][j] = *(const f32x4*)(xr + 4 * lane + 256 * j); }
#pragma unroll
        for (int q = 0; q < NR; ++q) { const int r = r0 + q;
            const int jb = (r < RC) ? 8 : (r - RC) / SEQ;
            const float* shift = mod + (size_t)jb * 6144 + (which ? 3 * 1024 : 0);
#pragma unroll
            for (int j = 0; j < 4; ++j) { sh[q][j] = *(const f32x4*)(shift + 4 * lane + 256 * j); sc[q][j] = *(const f32x4*)(shift + 1024 + 4 * lane + 256 * j); } }
#pragma unroll
        for (int q = 0; q < NR; ++q) {
#pragma unroll
            for (int j = 0; j < 4; ++j) s[q] += (v[q][j].x * v[q][j].x + v[q][j].y * v[q][j].y) + (v[q][j].z * v[q][j].z + v[q][j].w * v[q][j].w); }
#pragma unroll
        for (int q = 0; q < NR; ++q) { const int r = r0 + q;
            const float rstd = rsqrtf(wave_sum(s[q]) * (1.f / 1024.f) + 1e-6f);
#pragma unroll
            for (int j = 0; j < 4; ++j) { const int c0 = 4 * lane + 256 * j;
                const f32x4 o = v[q][j] * rstd * gg[j] * (1.f + sc[q][j]) + sh[q][j];
                v2u w; w.x = pk2(o.x, o.y); w.y = pk2(o.z, o.w);
                *(v2u*)(U + (size_t)r * 1024 + c0) = w; } }
    }
}
__device__ __forceinline__ void ph_final(const PAS Prm& p) {
    const int tid = TID, lane = tid & 63, wave = tid >> 6;
    const float* g = p.in[40];
    const float poison = (*(const volatile unsigned*)(p.ws + WS_CTL + 768 * 1024) != 0u) ? __builtin_nanf("") : 0.f;
    const int gw = BID * NWAVES + wave, NGW = NBLK * NWAVES;
    for (int r = gw; r < RL; r += NGW) {
        float* xr = p.out + (size_t)r * 1024;
        f32x4 v[4]; float s = 0.f;
#pragma unroll
        for (int j = 0; j < 4; ++j) { v[j] = *(const f32x4*)(xr + 4 * lane + 256 * j); s += (v[j].x * v[j].x + v[j].y * v[j].y) + (v[j].z * v[j].z + v[j].w * v[j].w); }
        const float rstd = rsqrtf(wave_sum(s) * (1.f / 1024.f) + 1e-6f);
#pragma unroll
        for (int j = 0; j < 4; ++j) { const int c0 = 4 * lane + 256 * j; const f32x4 gg = *(const f32x4*)(g + c0); *(f32x4*)(xr + c0) = v[j] * rstd * gg + poison; }
    }
}

struct RowInfo { int lat, b, t, T, base; };
__device__ __forceinline__ RowInfo row_info(int r) {
    RowInfo q;
    if (r < RC) { q.lat = 0; q.b = r / CTXL; q.t = r % CTXL; q.T = CTXL; q.base = q.b * CTXL; }
    else { const int x = r - RC; q.lat = 1; q.b = x / SEQ; q.t = x % SEQ; q.T = SEQ; q.base = RC + q.b * SEQ; }
    return q;
}
__device__ __forceinline__ int scan_row(int b, int d, int tau) {
    if (tau < CTXL) return b * CTXL + (d ? (CTXL - 1 - tau) : tau);
    const int t = tau - CTXL; return RC + b * SEQ + (d ? (SEQ - 1 - t) : t);
}

constexpr size_t RW_R = 0, RW_K = SZ17, RW_V = 2 * SZ17, RW_KK = 3 * SZ17, RW_OM = 4 * SZ17  , RW_A = 6 * SZ17  , RW_G = 8 * SZ17, RW_Y = 9 * SZ17  , RW_BON = 9 * SZ17 + 2 * SZ34;
static_assert(RW_BON + (size_t)RT * 16 <= 222 * MiB, "rwkv scratch");

typedef short bfx8 __attribute__((ext_vector_type(8)));
__device__ __forceinline__ bfx8 pack8(const float (&v)[8]) { bfx8 r;
#pragma unroll
    for (int i = 0; i < 8; ++i) r[i] = (short)f2bf(v[i]);
    return r; }
__device__ __forceinline__ void ph_rw_prep(const PAS Prm& p, int l, LAS unsigned char* lds) {
    LAS float* xx = (LAS float*)lds;
    LAS float* res = xx + 16 * 960;
    const int tid = TID, lane = tid & 63, wave = tid >> 6;
    const bf16* P = (const bf16*)(p.ws + WS_Y);
    unsigned char* S = p.ws + WS_BIG + BG_S;
    bf16* oR = (bf16*)(S + RW_R); bf16* oK = (bf16*)(S + RW_K); bf16* oV = (bf16*)(S + RW_V); bf16* oKK = (bf16*)(S + RW_KK);
    bf16* oOM = (bf16*)(S + RW_OM); bf16* oA = (bf16*)(S + RW_A); bf16* oG = (bf16*)(S + RW_G); float* oBon = (float*)(S + RW_BON);
    const float* mu = p.in[18] + l * 960;
    const float* w0 = p.in[19] + l * 512; const float* w2 = p.in[20] + (size_t)l * 2 * 64 * 256;
    const float* a0 = p.in[21] + l * 512; const float* a2 = p.in[22] + (size_t)l * 2 * 64 * 256;
    const float* g2 = p.in[23] + (size_t)l * 64 * 256;
    const float* k_k = p.in[24] + l * 256; const float* r_k = p.in[26] + l * 256;
    const int j = tid & 255, half = tid >> 8, h = j >> 6;
    bfx8 Bf[5][2][2];
#pragma unroll
    for (int m = 0; m < 5; ++m) { const float* W = m == 0 ? w2 : m == 1 ? w2 + 64 * 256 : m == 2 ? a2 : m == 3 ? a2 + 64 * 256 : g2;
#pragma unroll
        for (int ct = 0; ct < 2; ++ct)
#pragma unroll
            for (int ks = 0; ks < 2; ++ks) { float v[8];
#pragma unroll
                for (int q = 0; q < 8; ++q) v[q] = W[(size_t)(32 * ks + (lane >> 4) * 8 + q) * 256 + 32 * wave + 16 * ct + (lane & 15)];
                Bf[m][ct][ks] = pack8(v); } }
    const int cpair = 2 * (tid & 127);
    const cf2 kkp = {k_k[cpair], k_k[cpair + 1]}, rkp = {r_k[cpair], r_k[cpair + 1]}, w0p0 = {w0[cpair], w0[cpair + 1]}, w0p1 = {w0[256 + cpair], w0[256 + cpair + 1]}, a0p0 = {a0[cpair], a0[cpair + 1]}, a0p1 = {a0[256 + cpair], a0[256 + cpair + 1]};
    for (int tile = BID; tile < RT / 16; tile += NBLK) {
        const int r0 = tile * 16;
        for (int t = tid; t < 16 * 120; t += NTHR) {
            const int rr = t / 120, c0 = (t % 120) * 8, r = r0 + rr;
            const RowInfo ri = row_info(r);
            int nb[4];
            if (ri.lat) { const int gc = ri.t & 63, gr = ri.t >> 6;
                nb[0] = gc >= 1 ? r - 1 : -1; nb[1] = gc <= 62 ? r + 1 : -1; nb[2] = gr >= 1 ? r - 64 : -1; nb[3] = gr <= SEQ / 64 - 2 ? r + 64 : -1; }
            else { nb[0] = ri.t >= 1 ? r - 1 : -1; nb[1] = ri.t <= CTXL - 2 ? r + 1 : -1; nb[2] = nb[0]; nb[3] = nb[1]; }
            const v4u pv = *(const v4u*)(P + (size_t)r * 1024 + c0);
            v4u nv[4];
#pragma unroll
            for (int q = 0; q < 4; ++q) nv[q] = nb[q] >= 0 ? *(const v4u*)(P + (size_t)nb[q] * 1024 + c0) : (v4u){0u, 0u, 0u, 0u};
            const f32x4 m0 = *(const f32x4*)(mu + c0), m1 = *(const f32x4*)(mu + c0 + 4);
            float o[8];
#pragma unroll
            for (int i = 0; i < 8; ++i) { const unsigned pw = ((const unsigned*)&pv)[i >> 1], sw = ((const unsigned*)&nv[i & 3])[i >> 1];
                const float pf = (i & 1) ? bhi(pw) : blo(pw), sf = (i & 1) ? bhi(sw) : blo(sw), mm = i < 4 ? m0[i] : m1[i - 4];
                float x = pf + (sf - pf) * mm;
                if (c0 >= 768 && c0 < 832) x = tanhf(x); else if (c0 >= 896) x = sigmoidf_(x);
                o[i] = x; }
            *(LAS f32x4*)(xx + rr * 960 + c0) = (f32x4){o[0], o[1], o[2], o[3]}; *(LAS f32x4*)(xx + rr * 960 + c0 + 4) = (f32x4){o[4], o[5], o[6], o[7]};
        }
        __syncthreads();
        {
            f32x4 acc[5][2];
#pragma unroll
            for (int m = 0; m < 5; ++m) { acc[m][0] = (f32x4){0.f, 0.f, 0.f, 0.f}; acc[m][1] = (f32x4){0.f, 0.f, 0.f, 0.f}; }
#pragma unroll
            for (int inp = 0; inp < 3; ++inp)
#pragma unroll
                for (int ks = 0; ks < 2; ++ks) {
                    const LAS float* ap = xx + (lane & 15) * 960 + 768 + 64 * inp + 32 * ks + (lane >> 4) * 8;
                    const f32x4 x0 = *(const LAS f32x4*)ap, x1 = *(const LAS f32x4*)(ap + 4);
                    const float av[8] = {x0.x, x0.y, x0.z, x0.w, x1.x, x1.y, x1.z, x1.w};
                    const bfx8 Af = pack8(av);
#pragma unroll
                    for (int ct = 0; ct < 2; ++ct) {
                        if (inp == 0) { acc[0][ct] = __builtin_amdgcn_mfma_f32_16x16x32_bf16(Af, Bf[0][ct][ks], acc[0][ct], 0, 0, 0); acc[1][ct] = __builtin_amdgcn_mfma_f32_16x16x32_bf16(Af, Bf[1][ct][ks], acc[1][ct], 0, 0, 0); }
                        else if (inp == 1) { acc[2][ct] = __builtin_amdgcn_mfma_f32_16x16x32_bf16(Af, Bf[2][ct][ks], acc[2][ct], 0, 0, 0); acc[3][ct] = __builtin_amdgcn_mfma_f32_16x16x32_bf16(Af, Bf[3][ct][ks], acc[3][ct], 0, 0, 0); }
                        else acc[4][ct] = __builtin_amdgcn_mfma_f32_16x16x32_bf16(Af, Bf[4][ct][ks], acc[4][ct], 0, 0, 0);
                    }
                }
#pragma unroll
            for (int m = 0; m < 5; ++m)
#pragma unroll
                for (int ct = 0; ct < 2; ++ct)
#pragma unroll
                    for (int q = 0; q < 4; ++q) res[((lane >> 4) * 4 + q) * 1280 + m * 256 + 32 * wave + 16 * ct + (lane & 15)] = acc[m][ct][q];
        }
        __syncthreads();
        {
            const int j2 = tid & 127, rq = tid >> 7, c = 2 * j2, hh2 = c >> 6;
#pragma unroll
            for (int q = 0; q < 4; ++q) {
                const int rr = rq * 4 + q; const size_t r = (size_t)(r0 + rr);
                const LAS float* xr = xx + rr * 960; const LAS float* rs = res + rr * 1280;
                const float rv0 = xr[c], rv1 = xr[c + 1], kv0 = xr[256 + c], kv1 = xr[256 + c + 1], vv0 = xr[512 + c], vv1 = xr[512 + c + 1];
                const float kr0 = kv0 * kkp.x, kr1 = kv1 * kkp.y;
                const float ss = half32_sum(kr0 * kr0 + kr1 * kr1);
                const float nrm = rsqrtf(ss + 1e-12f);
                const float bon = half32_sum(rv0 * kv0 * rkp.x + rv1 * kv1 * rkp.y);
                *(unsigned*)(oR + r * 256 + c) = pk2(rv0, rv1); *(unsigned*)(oK + r * 256 + c) = pk2(kv0, kv1); *(unsigned*)(oV + r * 256 + c) = pk2(vv0, vv1);
                *(unsigned*)(oKK + r * 256 + c) = pk2(kr0 * nrm, kr1 * nrm);
                *(unsigned*)(oG + r * 256 + c) = pk2(rs[4 * 256 + c], rs[4 * 256 + c + 1]);
                if ((lane & 31) == 0) oBon[r * 4 + hh2] = bon;
#pragma unroll
                for (int d = 0; d < 2; ++d) {
                    const float wv0 = (d ? w0p1.x : w0p0.x) + rs[d * 256 + c], wv1 = (d ? w0p1.y : w0p0.y) + rs[d * 256 + c + 1];
                    const float om0 = 1.f - __expf(-0.6065306597126334f * sigmoidf_(wv0)), om1 = 1.f - __expf(-0.6065306597126334f * sigmoidf_(wv1));
                    const float av0 = sigmoidf_((d ? a0p1.x : a0p0.x) + rs[(2 + d) * 256 + c]), av1 = sigmoidf_((d ? a0p1.y : a0p0.y) + rs[(2 + d) * 256 + c + 1]);
                    *(unsigned*)(oOM + (size_t)d * RT * 256 + r * 256 + c) = pk2(om0, om1);
                    *(unsigned*)(oA + (size_t)d * RT * 256 + r * 256 + c) = pk2(av0, av1);
                }
            }
        }
        __syncthreads();
    }
}

#ifdef HOST_EMU
#define SC_PIN(x) do { } while (0)
#else
#define SC_PIN(x) asm("" : "+v"(x))
#endif
template <int MODE, int SPREAD = 1>
__device__ __forceinline__ void scan_phase(const int bid  , const unsigned char* Sb  , const bf16* Pv  ,
                                           void* Yout_  , const float* ka  , const float* gam  , LAS unsigned char* lds) {
    constexpr int NF = MODE == 0 ? 5 : 2;
    constexpr int CH = 32, ARRB = CH * 256, VOFF = NF * ARRB, BUFB = VOFF + CH * 128, NCH = (CTXL + SEQ) / CH;
    const int tid = TID, lane = tid & 63, wave = tid >> 6;
    if (bid < 0 || bid >= 128 * SPREAD) return;
    const int prob = bid / (2 * SPREAD), b = prob >> 3, h = (prob >> 1) & 3, d = prob & 1;
    const int rowv = (32 / SPREAD) * (bid & (2 * SPREAD - 1)) + 4 * (wave & (8 / SPREAD - 1)) + (lane >> 4);
    const bool computes = SPREAD == 1 || wave < 4;
    const int stt = SPREAD == 1 ? tid : (tid ^ 256);
    const int kl = lane & 15;
    const int st_s = (stt & 255) >> 3, st_g = stt & 7;
    const bool st_v = stt >= 256;
    float kav[8];
    float gamma = 0.f;
#pragma unroll
    for (int i = 0; i < 8; ++i) kav[i] = (MODE == 0) ? ka[h * 64 + 8 * st_g + i] : 0.f;
    if (MODE == 1) gamma = sigmoidf_(gam[d * 4 + h]);
    const size_t colb = (size_t)(h * 64 + st_g * 8) * 2;
    const unsigned char* src0 = (MODE == 0) ? Sb + colb : (const unsigned char*)Pv + colb;
    const unsigned char* srcp = (const unsigned char*)Pv + (size_t)(h * 64 + (st_g ^ 2) * 8) * 2;
    const unsigned char* srcv = (MODE == 0) ? Sb + 2 * SZ17 + colb : (const unsigned char*)Pv + (size_t)(512 + h * 64 + st_g * 8) * 2;
    const size_t ldv = (MODE == 0) ? 512 : 2048;
    LAS cf2* rtab = (LAS cf2*)(lds + 2 * BUFB);
    if (MODE == 1) { for (int i = tid; i < 64 * 16; i += NTHR) { float sn, cs; sincosf((float)(i >> 4) * exp2f(-(float)(i & 15) * (13.287712379549449f / 16.f)), &sn, &cs); rtab[i] = (cf2){cs, sn}; } __syncthreads(); }
    const bool rsecond = ((8 * st_g) & 31) >= 16, rcolhalf = (8 * st_g) >= 32;
    float S[4] = {0.f, 0.f, 0.f, 0.f};
    v4u pre[2][MODE == 0 ? 5 : 4];
    int st_tq[2] = {-1, -1};
#define SCAN_ISSUE(c, Q) do { const size_t row = (size_t)scan_row(b, d, (c) * CH + st_s); \
        if (st_v) pre[Q][0] = *(const v4u*)(srcv + row * ldv); \
        else if (MODE == 0) { pre[Q][0] = *(const v4u*)(src0 + row * 512); pre[Q][1] = *(const v4u*)(src0 + 1 * SZ17 + row * 512); pre[Q][2] = *(const v4u*)(src0 + 3 * SZ17 + row * 512); \
                              pre[Q][3] = *(const v4u*)(src0 + (size_t)(4 + d) * SZ17 + row * 512); pre[Q][4] = *(const v4u*)(src0 + (size_t)(6 + d) * SZ17 + row * 512); } \
        else { pre[Q][0] = *(const v4u*)(src0 + row * 2048); pre[Q][1] = *(const v4u*)(src0 + 512 + row * 2048); pre[Q][2] = *(const v4u*)(srcp + row * 2048); pre[Q][3] = *(const v4u*)(srcp + 512 + row * 2048); \
               st_tq[Q] = row >= (size_t)RC ? (int)((row - RC) & (SEQ - 1)) : -1; } } while (0)
#define SCAN_COMMIT(buf, Q) do { const int st_t = st_tq[Q]; (void)st_t; LAS unsigned char* bp = lds + (buf) * BUFB; \
        if (st_v) *(LAS v4u*)(bp + VOFF + st_s * 128 + st_g * 16) = pre[Q][0]; \
        else { LAS float* o = (LAS float*)(bp + st_s * 256 + st_g * 32); \
            if (MODE == 0) { _Pragma("unroll") for (int i = 0; i < 4; ++i) { \
                const unsigned ur = ((const unsigned*)&pre[Q][0])[i], uk = ((const unsigned*)&pre[Q][1])[i], ukk = ((const unsigned*)&pre[Q][2])[i], uom = ((const unsigned*)&pre[Q][3])[i], ua = ((const unsigned*)&pre[Q][4])[i]; \
                const float a0 = blo(ua), a1 = bhi(ua), kk0 = blo(ukk), kk1 = bhi(ukk); \
                o[0 * (ARRB / 4) + 2 * i] = blo(ur); o[0 * (ARRB / 4) + 2 * i + 1] = bhi(ur); \
                o[1 * (ARRB / 4) + 2 * i] = 1.f - blo(uom); o[1 * (ARRB / 4) + 2 * i + 1] = 1.f - bhi(uom); \
                o[2 * (ARRB / 4) + 2 * i] = blo(uk) * (1.f + (a0 - 1.f) * kav[2 * i]); o[2 * (ARRB / 4) + 2 * i + 1] = bhi(uk) * (1.f + (a1 - 1.f) * kav[2 * i + 1]); \
                o[3 * (ARRB / 4) + 2 * i] = kk0 * a0; o[3 * (ARRB / 4) + 2 * i + 1] = kk1 * a1; \
                o[4 * (ARRB / 4) + 2 * i] = -kk0; o[4 * (ARRB / 4) + 2 * i + 1] = -kk1; } } \
            else { const int icoord = st_t < 0 ? 0 : (rcolhalf ? (st_t & 63) : (st_t >> 6)); \
                _Pragma("unroll") for (int i = 0; i < 8; ++i) { const unsigned uq = ((const unsigned*)&pre[Q][0])[i >> 1], uk = ((const unsigned*)&pre[Q][1])[i >> 1], pq = ((const unsigned*)&pre[Q][2])[i >> 1], pk = ((const unsigned*)&pre[Q][3])[i >> 1]; \
                    const float q = (i & 1) ? bhi(uq) : blo(uq), k = (i & 1) ? bhi(uk) : blo(uk), qp = (i & 1) ? bhi(pq) : blo(pq), kp = (i & 1) ? bhi(pk) : blo(pk); \
                    float sn = 0.f, cs = 1.f; if (st_t >= 0) { const cf2 t2 = rtab[icoord * 16 + ((8 * st_g + i) & 15)]; cs = t2.x; sn = t2.y; } \
                    o[0 * (ARRB / 4) + i] = rsecond ? (qp * sn + q * cs) : (q * cs - qp * sn); \
                    o[1 * (ARRB / 4) + i] = 0.125f * (rsecond ? (kp * sn + k * cs) : (k * cs - kp * sn)); } } } } while (0)
    static_assert(NCH % 2 == 0, "chunk pairs");
    SCAN_ISSUE(0, 0); SCAN_COMMIT(0, 0); __syncthreads();
    SCAN_ISSUE(1, 1);
    float ycar = 0.f; ptrdiff_t ycar_i = 0; (void)ycar; (void)ycar_i;
    for (int c0 = 0; c0 < NCH; c0 += 2) {
#pragma unroll
    for (int hf = 0; hf < 2; ++hf) {
        const int c = c0 + hf;
        if (c + 2 < NCH) SCAN_ISSUE(c + 2, hf);
        const LAS unsigned char* bufp = lds + hf * BUFB;
        const int row_first = scan_row(b, d, c * CH);
        const size_t yoff = ((size_t)d * RT + row_first) * 256 + h * 64 + rowv;
        const int ystep = d ? -256 : 256;
        float ykeep = 0.f;
#ifndef HOST_EMU
#define DPQ1 " quad_perm:[1,0,3,2] row_mask:0xf bank_mask:0xf\n\t"
#define DPQ2 " quad_perm:[2,3,0,1] row_mask:0xf bank_mask:0xf\n\t"
#define DPHM " row_half_mirror row_mask:0xf bank_mask:0xf\n\t"
#define DPRM " row_mirror row_mask:0xf bank_mask:0xf\n\t"
#define SC_YRED(y) asm volatile("s_nop 1\n\tv_add_f32_dpp %0, %0, %0" DPQ1 "s_nop 1\n\tv_add_f32_dpp %0, %0, %0" DPQ2 "s_nop 1\n\tv_add_f32_dpp %0, %0, %0" DPHM "s_nop 1\n\tv_add_f32_dpp %0, %0, %0" DPRM "s_nop 1" : "+v"(y))
        const unsigned aop = (unsigned)(uintptr_t)(bufp + kl * 16), av = (unsigned)(uintptr_t)(bufp + rowv * 2);
        if (!computes) { }
        else if (MODE == 0) {
#define RWA_READ(KN, KT, BB, WW, RR, VV, s) asm volatile("ds_read_b128 %[kn], %[a] offset:%[o4]\n\tds_read_u16_d16_hi %[vv], %[av] offset:%[ov]\n\tds_read_b128 %[kt], %[a] offset:%[o2]\n\t" \
                "ds_read_b128 %[bb], %[a] offset:%[o3]\n\tds_read_b128 %[ww], %[a] offset:%[o1]\n\tds_read_b128 %[rr], %[a] offset:%[o0]" \
                : [kn] "=&v"(KN), [kt] "=&v"(KT), [bb] "=&v"(BB), [ww] "=&v"(WW), [rr] "=&v"(RR), [vv] "+v"(VV) \
                : [a] "v"(aop), [av] "v"(av), [o0] "i"((s) * 256), [o1] "i"((s) * 256 + ARRB), [o2] "i"((s) * 256 + 2 * ARRB), [o3] "i"((s) * 256 + 3 * ARRB), [o4] "i"((s) * 256 + 4 * ARRB), [ov] "i"(VOFF + (s) * 128) : "memory")
#define RWA_STEP(KN, KT, BB, WW, RR, VV) do { float sa_, m0_, m1_, m2_, m3_, yp_; \
            asm volatile("v_mul_f32 %[sa], %[s0], %[k0]\n\tv_fmac_f32 %[sa], %[s1], %[k1]\n\tv_fmac_f32 %[sa], %[s2], %[k2]\n\tv_fmac_f32 %[sa], %[s3], %[k3]\n\t" \
                "v_mul_f32 %[m0], %[vv], %[t0]\n\t" \
                "v_add_f32_dpp %[yq], %[yq], %[yq]" DPQ1 "v_add_f32_dpp %[sa], %[sa], %[sa]" DPQ1 "v_mul_f32 %[m1], %[vv], %[t1]\n\t" \
                "v_add_f32_dpp %[yq], %[yq], %[yq]" DPQ2 "v_add_f32_dpp %[sa], %[sa], %[sa]" DPQ2 "v_mul_f32 %[m2], %[vv], %[t2]\n\t" \
                "v_add_f32_dpp %[yq], %[yq], %[yq]" DPHM "v_add_f32_dpp %[sa], %[sa], %[sa]" DPHM "v_mul_f32 %[m3], %[vv], %[t3]\n\t" \
                "v_add_f32_dpp %[yq], %[yq], %[yq]" DPRM "v_add_f32_dpp %[sa], %[sa], %[sa] row_mirror row_mask:0xf bank_mask:0xf" \
                : [sa] "=&v"(sa_), [m0] "=&v"(m0_), [m1] "=&v"(m1_), [m2] "=&v"(m2_), [m3] "=&v"(m3_), [yq] "+v"(yq) \
                : [s0] "v"(S[0]), [s1] "v"(S[1]), [s2] "v"(S[2]), [s3] "v"(S[3]), [k0] "v"(KN.x), [k1] "v"(KN.y), [k2] "v"(KN.z), [k3] "v"(KN.w), [vv] "v"(VV), \
                  [t0] "v"(KT.x), [t1] "v"(KT.y), [t2] "v"(KT.z), [t3] "v"(KT.w)); \
            yfull = yq; \
            asm volatile("v_fmac_f32 %[m0], %[sa], %[b0]\n\tv_fmac_f32 %[m1], %[sa], %[b1]\n\tv_fmac_f32 %[m2], %[sa], %[b2]\n\tv_fmac_f32 %[m3], %[sa], %[b3]\n\t" \
                "v_fma_f32 %[s0], %[s0], %[w0], %[m0]\n\tv_fma_f32 %[s1], %[s1], %[w1], %[m1]\n\tv_fma_f32 %[s2], %[s2], %[w2], %[m2]\n\tv_fma_f32 %[s3], %[s3], %[w3], %[m3]\n\t" \
                "v_mul_f32 %[yp], %[s0], %[r0]\n\tv_fmac_f32 %[yp], %[s1], %[r1]\n\tv_fmac_f32 %[yp], %[s2], %[r2]\n\tv_fmac_f32 %[yp], %[s3], %[r3]" \
                : [m0] "+v"(m0_), [m1] "+v"(m1_), [m2] "+v"(m2_), [m3] "+v"(m3_), [s0] "+v"(S[0]), [s1] "+v"(S[1]), [s2] "+v"(S[2]), [s3] "+v"(S[3]), [yp] "=&v"(yp_) \
                : [sa] "v"(sa_), [b0] "v"(BB.x), [b1] "v"(BB.y), [b2] "v"(BB.z), [b3] "v"(BB.w), [w0] "v"(WW.x), [w1] "v"(WW.y), [w2] "v"(WW.z), [w3] "v"(WW.w), \
                  [r0] "v"(RR.x), [r1] "v"(RR.y), [r2] "v"(RR.z), [r3] "v"(RR.w)); \
            yq = yp_; } while (0)
#define RWA_YOUT(sprev) do { ykeep = (((sprev) & 15) == kl) ? yfull : ykeep; \
            if ((sprev) == CH - 1) { ycar = ykeep; ycar_i = (ptrdiff_t)yoff + (ptrdiff_t)(((sprev) & ~15) + kl) * ystep; } \
            else if (((sprev) & 15) == 15) ((bf16*)Yout_)[(ptrdiff_t)yoff + (ptrdiff_t)(((sprev) & ~15) + kl) * ystep] = f2bf(ykeep); } while (0)
            f32x4 knA, ktA, bbA, wwA, rrA, knB, ktB, bbB, wwB, rrB; float vvA = 0.f, vvB = 0.f, yq = 0.f, yfull = 0.f;
            RWA_READ(knA, ktA, bbA, wwA, rrA, vvA, 0);
            if (c > 0) ((bf16*)Yout_)[ycar_i] = f2bf(ycar);
#pragma unroll
            for (int s = 0; s < CH; s += 2) {
                RWA_READ(knB, ktB, bbB, wwB, rrB, vvB, s + 1); asm volatile("s_waitcnt lgkmcnt(6)" ::: "memory");
                RWA_STEP(knA, ktA, bbA, wwA, rrA, vvA);
                if (s > 0) RWA_YOUT(s - 1);
                if (s + 2 < CH) { RWA_READ(knA, ktA, bbA, wwA, rrA, vvA, (s + 2 < CH ? s + 2 : 0)); asm volatile("s_waitcnt lgkmcnt(6)" ::: "memory"); }
                else asm volatile("s_waitcnt lgkmcnt(0)" ::: "memory");
                RWA_STEP(knB, ktB, bbB, wwB, rrB, vvB);
                RWA_YOUT(s);
            }
            SC_YRED(yq); yfull = yq; RWA_YOUT(CH - 1);
#undef RWA_READ
#undef RWA_STEP
#undef RWA_YOUT
        } else {
#define RTA_READ(QQ, KR, VV, s) asm volatile("ds_read_b128 %[kr], %[a] offset:%[o1]\n\tds_read_u16_d16_hi %[vv], %[av] offset:%[ov]\n\tds_read_b128 %[qq], %[a] offset:%[o0]" \
                : [kr] "=&v"(KR), [qq] "=&v"(QQ), [vv] "+v"(VV) : [a] "v"(aop), [av] "v"(av), [o0] "i"((s) * 256), [o1] "i"((s) * 256 + ARRB), [ov] "i"(VOFF + (s) * 128) : "memory")
#define RTA_STEP(QQ, KR, VV) do { float m0_, m1_, m2_, m3_, yp_; \
            asm volatile("v_mul_f32 %[m0], %[vv], %[k0]\n\tv_mul_f32 %[m1], %[vv], %[k1]\n\t" \
                "v_add_f32_dpp %[yq], %[yq], %[yq]" DPQ1 "v_mul_f32 %[m2], %[vv], %[k2]\n\tv_mul_f32 %[m3], %[vv], %[k3]\n\t" \
                "v_add_f32_dpp %[yq], %[yq], %[yq]" DPQ2 "v_fma_f32 %[s0], %[s0], %[g], %[m0]\n\tv_fma_f32 %[s1], %[s1], %[g], %[m1]\n\t" \
                "v_add_f32_dpp %[yq], %[yq], %[yq]" DPHM "v_fma_f32 %[s2], %[s2], %[g], %[m2]\n\tv_fma_f32 %[s3], %[s3], %[g], %[m3]\n\t" \
                "v_add_f32_dpp %[yq], %[yq], %[yq]" DPRM \
                "v_mul_f32 %[yp], %[s0], %[q0]\n\tv_fmac_f32 %[yp], %[s1], %[q1]\n\tv_fmac_f32 %[yp], %[s2], %[q2]\n\tv_fmac_f32 %[yp], %[s3], %[q3]" \
                : [m0] "=&v"(m0_), [m1] "=&v"(m1_), [m2] "=&v"(m2_), [m3] "=&v"(m3_), [yq] "+v"(yq), [s0] "+v"(S[0]), [s1] "+v"(S[1]), [s2] "+v"(S[2]), [s3] "+v"(S[3]), [yp] "=&v"(yp_) \
                : [vv] "v"(VV), [k0] "v"(KR.x), [k1] "v"(KR.y), [k2] "v"(KR.z), [k3] "v"(KR.w), [g] "v"(gamma), [q0] "v"(QQ.x), [q1] "v"(QQ.y), [q2] "v"(QQ.z), [q3] "v"(QQ.w)); \
            yfull = yq; yq = yp_; } while (0)
#define RTA_YOUT(sprev) do { ykeep = (((sprev) & 15) == kl) ? yfull : ykeep; \
            if ((sprev) == CH - 1) { ycar = ykeep; ycar_i = (ptrdiff_t)yoff + (ptrdiff_t)(((sprev) & ~15) + kl) * ystep; } \
            else if (((sprev) & 15) == 15) ((bf16*)Yout_)[(ptrdiff_t)yoff + (ptrdiff_t)(((sprev) & ~15) + kl) * ystep] = f2bf(ykeep); } while (0)
            f32x4 qqA, krA, qqB, krB; float vvA = 0.f, vvB = 0.f, yq = 0.f, yfull = 0.f;
            RTA_READ(qqA, krA, vvA, 0);
            if (c > 0) ((bf16*)Yout_)[ycar_i] = f2bf(ycar);
#pragma unroll
            for (int s = 0; s < CH; s += 2) {
                RTA_READ(qqB, krB, vvB, s + 1); asm volatile("s_waitcnt lgkmcnt(3)" ::: "memory");
                RTA_STEP(qqA, krA, vvA);
                if (s > 0) RTA_YOUT(s - 1);
                if (s + 2 < CH) { RTA_READ(qqA, krA, vvA, (s + 2 < CH ? s + 2 : 0)); asm volatile("s_waitcnt lgkmcnt(3)" ::: "memory"); }
                else asm volatile("s_waitcnt lgkmcnt(0)" ::: "memory");
                RTA_STEP(qqB, krB, vvB);
                RTA_YOUT(s);
            }
            SC_YRED(yq); yfull = yq; RTA_YOUT(CH - 1);
#undef RTA_READ
#undef RTA_STEP
#undef RTA_YOUT
        }
#undef DPQ1
#undef DPQ2
#undef DPHM
#undef DPRM
#undef SC_YRED
#else
        if (!computes) { }
        else if (MODE == 0) {
            const LAS unsigned char* sp0 = bufp + kl * 16;
            f32x4 rrA = *(const LAS f32x4*)(sp0), wwA = *(const LAS f32x4*)(sp0 + ARRB), ktA = *(const LAS f32x4*)(sp0 + 2 * ARRB), bbA = *(const LAS f32x4*)(sp0 + 3 * ARRB), knA = *(const LAS f32x4*)(sp0 + 4 * ARRB);
            float vvA = bf2f(*(const LAS bf16*)(bufp + VOFF + rowv * 2));
            f32x4 rrB, wwB, ktB, bbB, knB; float vvB;
            float ypend = 0.f;
#define RW_STEP(s, rr, ww, kt, bb, kn, vv, rrN, wwN, ktN, bbN, knN, vvN) do { \
                const int sn_ = ((s) + 1 < CH) ? (s) + 1 : (s); const LAS unsigned char* sp = bufp + sn_ * 256 + kl * 16; \
                rrN = *(const LAS f32x4*)(sp); wwN = *(const LAS f32x4*)(sp + ARRB); ktN = *(const LAS f32x4*)(sp + 2 * ARRB); bbN = *(const LAS f32x4*)(sp + 3 * ARRB); knN = *(const LAS f32x4*)(sp + 4 * ARRB); \
                vvN = bf2f(*(const LAS bf16*)(bufp + VOFF + sn_ * 128 + rowv * 2)); \
                float sa = sfma(S[1], kn.y, smul(S[0], kn.x)) + sfma(S[3], kn.w, smul(S[2], kn.z)); \
                float yq = ypend; \
                sa += dpp_mov<0xB1>(sa); yq += dpp_mov<0xB1>(yq); \
                sa += dpp_mov<0x4E>(sa); yq += dpp_mov<0x4E>(yq); \
                sa += dpp_mov<0x141>(sa); yq += dpp_mov<0x141>(yq); \
                sa += dpp_mov<0x140>(sa); yq += dpp_mov<0x140>(yq); \
                if ((s) > 0) { ykeep = ((((s) - 1) & 15) == kl) ? yq : ykeep; \
                    if ((((s) - 1) & 15) == 15) ((bf16*)Yout_)[(ptrdiff_t)yoff + (ptrdiff_t)((((s) - 1) & ~15) + kl) * ystep] = f2bf(ykeep); } \
                S[0] = sfma(S[0], ww.x, sfma(sa, bb.x, smul(vv, kt.x))); S[1] = sfma(S[1], ww.y, sfma(sa, bb.y, smul(vv, kt.y))); \
                S[2] = sfma(S[2], ww.z, sfma(sa, bb.z, smul(vv, kt.z))); S[3] = sfma(S[3], ww.w, sfma(sa, bb.w, smul(vv, kt.w))); \
                ypend = sfma(S[1], rr.y, smul(S[0], rr.x)) + sfma(S[3], rr.w, smul(S[2], rr.z)); } while (0)
#pragma unroll 8
            for (int s = 0; s < CH; s += 2) {
                RW_STEP(s, rrA, wwA, ktA, bbA, knA, vvA, rrB, wwB, ktB, bbB, knB, vvB);
                RW_STEP(s + 1, rrB, wwB, ktB, bbB, knB, vvB, rrA, wwA, ktA, bbA, knA, vvA);
            }
#undef RW_STEP
            { const float yq = row16_sum(ypend); ykeep = (((CH - 1) & 15) == kl) ? yq : ykeep;
              ((bf16*)Yout_)[(ptrdiff_t)yoff + (ptrdiff_t)(((CH - 1) & ~15) + kl) * ystep] = f2bf(ykeep); }
        } else {
#pragma unroll 16
        for (int s = 0; s < CH; ++s) {
            const LAS unsigned char* sp = bufp + s * 256 + kl * 16;
            const float vv = bf2f(*(const LAS bf16*)(bufp + VOFF + s * 128 + rowv * 2));
            const f32x4 qq = *(const LAS f32x4*)(sp), kr = *(const LAS f32x4*)(sp + ARRB);
            S[0] = sfma(S[0], gamma, smul(vv, kr.x)); S[1] = sfma(S[1], gamma, smul(vv, kr.y)); S[2] = sfma(S[2], gamma, smul(vv, kr.z)); S[3] = sfma(S[3], gamma, smul(vv, kr.w));
            const float y = row16_sum(sfma(S[1], qq.y, smul(S[0], qq.x)) + sfma(S[3], qq.w, smul(S[2], qq.z)));
            ykeep = ((s & 15) == kl) ? y : ykeep;
            if ((s & 15) == 15) ((bf16*)Yout_)[(ptrdiff_t)yoff + (ptrdiff_t)((s & ~15) + kl) * ystep] = f2bf(ykeep);
        }
        }
#endif
        if (c + 1 < NCH) SCAN_COMMIT(hf ^ 1, hf ^ 1);
        __syncthreads();
    }
    }
#ifndef HOST_EMU
    if (computes) ((bf16*)Yout_)[ycar_i] = f2bf(ycar);
#endif
#undef SCAN_ISSUE
#undef SCAN_COMMIT
}

__device__ __forceinline__ void ph_rw_post(const PAS Prm& p, int l) {
    const int tid = TID, j2 = tid & 127, c = 2 * j2, h = c >> 6;
    unsigned char* S = p.ws + WS_BIG + BG_S;
    const bf16* Y = (const bf16*)(S + RW_Y); const bf16* V = (const bf16*)(S + RW_V); const bf16* G = (const bf16*)(S + RW_G); const float* Bon = (const float*)(S + RW_BON);
    bf16* yrw = (bf16*)(p.ws + WS_Y + 1 * SZ17);
    const float lng0 = p.in[27][l * 256 + c], lng1 = p.in[27][l * 256 + c + 1];
    constexpr int NR = 4;
    for (int r0 = (BID * 4 + (tid >> 7)) * NR; r0 < RT; r0 += NBLK * 4 * NR) {
        unsigned y0[NR], y1[NR], vv[NR], gg[NR]; float bo[NR];
#pragma unroll
        for (int q = 0; q < NR; ++q) { const size_t o = (size_t)(r0 + q) * 256 + c; y0[q] = *(const unsigned*)(Y + o); y1[q] = *(const unsigned*)(Y + (size_t)RT * 256 + o); vv[q] = *(const unsigned*)(V + o); gg[q] = *(const unsigned*)(G + o); bo[q] = Bon[(size_t)(r0 + q) * 4 + h]; }
#pragma unroll
        for (int q = 0; q < NR; ++q) { const size_t o = (size_t)(r0 + q) * 256 + c;
            const float ya = blo(y0[q]) + blo(y1[q]), yb = bhi(y0[q]) + bhi(y1[q]);
            const float mean = half32_sum(ya + yb) * (1.f / 64.f); const float da = ya - mean, db = yb - mean;
            const float rs = rsqrtf(half32_sum(da * da + db * db) * (1.f / 64.f) + 64e-5f);
            const float va = (da * rs * lng0 + bo[q] * blo(vv[q])) * blo(gg[q]), vb = (db * rs * lng1 + bo[q] * bhi(vv[q])) * bhi(gg[q]);
            *(unsigned*)(yrw + o) = pk2(va, vb); }
    }
}

constexpr size_t RT_Y = 222 * MiB  ;
__device__ __forceinline__ void ph_ret_post(const PAS Prm& p) {
    const int tid = TID, j2 = tid & 127, c = 2 * j2;
    const bf16* P = (const bf16*)(p.ws + WS_BIG + BG_P);
    const bf16* Y = (const bf16*)(p.ws + WS_BIG + BG_S + RT_Y);
    bf16* yret = (bf16*)(p.ws + WS_Y + 3 * SZ17);
    constexpr int NR = 4;
    for (int r0 = (BID * 4 + (tid >> 7)) * NR; r0 < RT; r0 += NBLK * 4 * NR) {
        unsigned y0[NR], y1[NR], gg[NR];
#pragma unroll
        for (int q = 0; q < NR; ++q) { const size_t o = (size_t)(r0 + q) * 256 + c; y0[q] = *(const unsigned*)(Y + o); y1[q] = *(const unsigned*)(Y + (size_t)RT * 256 + o); gg[q] = *(const unsigned*)(P + (size_t)(r0 + q) * 1024 + 768 + c); }
#pragma unroll
        for (int q = 0; q < NR; ++q) { const size_t o = (size_t)(r0 + q) * 256 + c;
            const float ya = blo(y0[q]) + blo(y1[q]), yb = bhi(y0[q]) + bhi(y1[q]);
            const float mean = half32_sum(ya + yb) * (1.f / 64.f); const float da = ya - mean, db = yb - mean;
            const float rs = rsqrtf(half32_sum(da * da + db * db) * (1.f / 64.f) + 1e-5f);
            const float ga = blo(gg[q]), gb = bhi(gg[q]);
            *(unsigned*)(yret + o) = pk2(da * rs * (ga * sigmoidf_(ga)), db * rs * (gb * sigmoidf_(gb))); }
    }
}

constexpr size_t LR_A = 0  , LR_B = 2 * SZ34  ;
__device__ __forceinline__ void ph_lru_prep(const PAS Prm& p, int l, LAS unsigned char* lds) {
    LAS float* xc = (LAS float*)lds;
    LAS float* res = xc + 16 * 256;
    const int tid = TID, lane = tid & 63, wave = tid >> 6;
    const bf16* P = (const bf16*)(p.ws + WS_BIG + BG_P);
    bf16* A = (bf16*)(p.ws + WS_BIG + BG_S + LR_A); bf16* B = (bf16*)(p.ws + WS_BIG + BG_S + LR_B);
    const float* cw = p.in[28] + l * 4 * 256; const float* cb = p.in[29] + l * 256;
    const float* wa = p.in[30] + (size_t)l * 2 * 4 * 64 * 64; const float* ba = p.in[31] + l * 512;
    const float* wx = p.in[32] + (size_t)l * 2 * 4 * 64 * 64; const float* bx = p.in[33] + l * 512;
    const float* lam = p.in[34] + l * 512;
    const int j = tid & 255, half = tid >> 8;
    const float sp0 = softplusf_(-lam[j]), sp1 = softplusf_(-lam[256 + j]);
    const float ba0 = ba[j], ba1 = ba[256 + j], bx0 = bx[j], bx1 = bx[256 + j];
    const int g = wave >> 1;
    bfx8 Bf[4][2][2];
#pragma unroll
    for (int m = 0; m < 4; ++m) { const float* W = (m < 2 ? wa : wx) + (size_t)(((m & 1) * 4 + g) * 64) * 64;
#pragma unroll
        for (int ct = 0; ct < 2; ++ct)
#pragma unroll
            for (int ks = 0; ks < 2; ++ks) { float v[8];
#pragma unroll
                for (int q = 0; q < 8; ++q) v[q] = W[(size_t)(32 * ks + (lane >> 4) * 8 + q) * 64 + ((32 * wave + 16 * ct + (lane & 15)) & 63)];
                Bf[m][ct][ks] = pack8(v); } }
    for (int tile = BID; tile < RT / 16; tile += NBLK) {
        const int r0 = tile * 16;
        {
            const int rr = tid >> 5, c8 = (tid & 31) * 8, r = r0 + rr; const RowInfo ri = row_info(r);
            v4u tv[4];
#pragma unroll
            for (int q = 0; q < 4; ++q) { const int tt = ri.t + q - 2; tv[q] = (tt >= 0 && tt < ri.T) ? *(const v4u*)(P + (size_t)(ri.base + tt) * 512 + c8) : (v4u){0u, 0u, 0u, 0u}; }
            float acc[8];
#pragma unroll
            for (int e = 0; e < 8; ++e) acc[e] = cb[c8 + e];
#pragma unroll
            for (int q = 0; q < 4; ++q)
#pragma unroll
                for (int e = 0; e < 8; ++e) { const unsigned w = ((const unsigned*)&tv[q])[e >> 1]; acc[e] += cw[q * 256 + c8 + e] * ((e & 1) ? bhi(w) : blo(w)); }
#pragma unroll
            for (int e = 0; e < 8; ++e) xc[rr * 256 + c8 + e] = acc[e];
        }
        __syncthreads();
        {
            f32x4 acc[4][2];
#pragma unroll
            for (int m = 0; m < 4; ++m) { acc[m][0] = (f32x4){0.f, 0.f, 0.f, 0.f}; acc[m][1] = (f32x4){0.f, 0.f, 0.f, 0.f}; }
#pragma unroll
            for (int ks = 0; ks < 2; ++ks) {
                const LAS float* ap = xc + (lane & 15) * 256 + g * 64 + 32 * ks + (lane >> 4) * 8;
                const f32x4 x0 = *(const LAS f32x4*)ap, x1 = *(const LAS f32x4*)(ap + 4);
                const float av[8] = {x0.x, x0.y, x0.z, x0.w, x1.x, x1.y, x1.z, x1.w};
                const bfx8 Af = pack8(av);
#pragma unroll
                for (int m = 0; m < 4; ++m)
#pragma unroll
                    for (int ct = 0; ct < 2; ++ct) acc[m][ct] = __builtin_amdgcn_mfma_f32_16x16x32_bf16(Af, Bf[m][ct][ks], acc[m][ct], 0, 0, 0);
            }
#pragma unroll
            for (int m = 0; m < 4; ++m)
#pragma unroll
                for (int ct = 0; ct < 2; ++ct)
#pragma unroll
                    for (int q = 0; q < 4; ++q) res[((lane >> 4) * 4 + q) * 1024 + m * 256 + 32 * wave + 16 * ct + (lane & 15)] = acc[m][ct][q];
        }
        __syncthreads();
#pragma unroll
        for (int q = 0; q < 8; ++q) {
            const int rr = half * 8 + q; const size_t r = (size_t)(r0 + rr); const float xcv = xc[rr * 256 + j];
#pragma unroll
            for (int d = 0; d < 2; ++d) {
                const float rg = sigmoidf_(res[rr * 1024 + d * 256 + j] + (d ? ba1 : ba0));
                const float ig = sigmoidf_(res[rr * 1024 + (2 + d) * 256 + j] + (d ? bx1 : bx0));
                const float a = __expf(-8.f * rg * (d ? sp1 : sp0));
                const float bv = sqrtf(fmaxf(1.f - a * a, 0.f)) * (ig * xcv);
                A[((size_t)d * RT + r) * 256 + j] = f2bf(1.f - a); B[((size_t)d * RT + r) * 256 + j] = f2bf(bv);
            }
        }
        __syncthreads();
    }
}
constexpr int LCH = 64, NVC = CTXL / LCH, NVL = SEQ / LCH, NV = NVC + NVL;
constexpr size_t LR_PA = 4 * SZ34  , LR_QB = LR_PA + (size_t)2 * 8 * NV * 256 * 4;
__device__ __forceinline__ int lru_chunk_row0(int b, int v) { return v < NVC ? b * CTXL + v * LCH : RC + b * SEQ + (v - NVC) * LCH; }
__device__ __forceinline__ void ph_lru_agg(const PAS Prm& p) {
    const int tid = TID, j2 = tid & 127, qt = tid >> 7;
    const bf16* A = (const bf16*)(p.ws + WS_BIG + BG_S + LR_A); const bf16* B = (const bf16*)(p.ws + WS_BIG + BG_S + LR_B);
    float* PA = (float*)(p.ws + WS_BIG + BG_S + LR_PA); float* QB = (float*)(p.ws + WS_BIG + BG_S + LR_QB);
    for (int task = BID * 4 + qt; task < 2 * 8 * NV; task += NBLK * 4) {
        const int d = task / (8 * NV), b = (task / NV) % 8, v = task % NV;
        const int row0 = lru_chunk_row0(b, v);
        const bf16* Ad = A + (size_t)d * RT * 256 + 2 * j2; const bf16* Bd = B + (size_t)d * RT * 256 + 2 * j2;
        float P0 = 1.f, Q0 = 0.f, P1 = 1.f, Q1 = 0.f;
        for (int i0 = 0; i0 < LCH; i0 += 16) {
            unsigned a[16], bb[16];
#pragma unroll
            for (int q = 0; q < 16; ++q) { const int i = i0 + q; const size_t ro = (size_t)(row0 + (d ? LCH - 1 - i : i)) * 256; a[q] = *(const unsigned*)(Ad + ro); bb[q] = *(const unsigned*)(Bd + ro); }
#pragma unroll
            for (int q = 0; q < 16; ++q) { const float a0 = 1.f - blo(a[q]), a1 = 1.f - bhi(a[q]); Q0 = a0 * Q0 + blo(bb[q]); P0 = a0 * P0; Q1 = a1 * Q1 + bhi(bb[q]); P1 = a1 * P1; }
        }
        *(cf2*)(PA + (size_t)task * 256 + 2 * j2) = (cf2){P0, P1}; *(cf2*)(QB + (size_t)task * 256 + 2 * j2) = (cf2){Q0, Q1};
    }
}
__device__ __forceinline__ float gelu_tanh_(float x) { return 0.5f * x * (1.f + tanhf(0.7978845608028654f * (x + 0.044715f * x * x * x))); }
__device__ __forceinline__ void ph_lru_fin(const PAS Prm& p, LAS unsigned char* lds) {
    LAS unsigned* hf = (LAS unsigned*)lds;
    const int tid = TID, j2 = tid & 127, qt = tid >> 7;
    const bf16* P = (const bf16*)(p.ws + WS_BIG + BG_P);
    const bf16* A = (const bf16*)(p.ws + WS_BIG + BG_S + LR_A); const bf16* B = (const bf16*)(p.ws + WS_BIG + BG_S + LR_B);
    const float* PA = (const float*)(p.ws + WS_BIG + BG_S + LR_PA); const float* QB = (const float*)(p.ws + WS_BIG + BG_S + LR_QB);
    bf16* ylru = (bf16*)(p.ws + WS_Y + 2 * SZ17);
    for (int task = BID * 4 + qt; task < 8 * NV; task += NBLK * 4) {
        const int b = task / NV, v = task % NV;
        const int row0 = lru_chunk_row0(b, v);
        float h0 = 0.f, h1 = 0.f;
        { const float* pa = PA + ((size_t)(0 * 8 + b) * NV) * 256 + 2 * j2; const float* qb = QB + ((size_t)(0 * 8 + b) * NV) * 256 + 2 * j2;
          for (int u0 = 0; u0 < v; u0 += 8) { cf2 pp[8], qq[8];
#pragma unroll
              for (int q = 0; q < 8; ++q) { const int u = u0 + q < v ? u0 + q : v - 1; pp[q] = *(const cf2*)(pa + (size_t)u * 256); qq[q] = *(const cf2*)(qb + (size_t)u * 256); }
#pragma unroll
              for (int q = 0; q < 8; ++q) if (u0 + q < v) { h0 = pp[q].x * h0 + qq[q].x; h1 = pp[q].y * h1 + qq[q].y; } } }
        float g0 = 0.f, g1 = 0.f;
        { const float* pa = PA + ((size_t)(1 * 8 + b) * NV) * 256 + 2 * j2; const float* qb = QB + ((size_t)(1 * 8 + b) * NV) * 256 + 2 * j2;
          const int n1 = v < NVC ? NVC - 1 - v : NVC, n2 = v < NVC ? 0 : NV - 1 - v, nt = n1 + n2;
          for (int i0 = 0; i0 < nt; i0 += 8) { cf2 pp[8], qq[8];
#pragma unroll
              for (int q = 0; q < 8; ++q) { const int i = i0 + q < nt ? i0 + q : nt - 1; const int u = i < n1 ? NVC - 1 - i : NV - 1 - (i - n1); pp[q] = *(const cf2*)(pa + (size_t)u * 256); qq[q] = *(const cf2*)(qb + (size_t)u * 256); }
#pragma unroll
              for (int q = 0; q < 8; ++q) if (i0 + q < nt) { g0 = pp[q].x * g0 + qq[q].x; g1 = pp[q].y * g1 + qq[q].y; } } }
        const bf16* A0 = A + 2 * j2; const bf16* B0 = B + 2 * j2; const bf16* A1 = A + (size_t)RT * 256 + 2 * j2; const bf16* B1 = B + (size_t)RT * 256 + 2 * j2;
        for (int i0 = 0; i0 < LCH; i0 += 16) {
            unsigned a[16], bb[16];
#pragma unroll
            for (int q = 0; q < 16; ++q) { const size_t ro = (size_t)(row0 + i0 + q) * 256; a[q] = *(const unsigned*)(A0 + ro); bb[q] = *(const unsigned*)(B0 + ro); }
#pragma unroll
            for (int q = 0; q < 16; ++q) { h0 = (1.f - blo(a[q])) * h0 + blo(bb[q]); h1 = (1.f - bhi(a[q])) * h1 + bhi(bb[q]); hf[(i0 + q) * 512 + tid] = pk2(h0, h1); }
        }
        for (int i0 = LCH - 16; i0 >= 0; i0 -= 16) {
            unsigned a[16], bb[16], gx[16];
#pragma unroll
            for (int q = 0; q < 16; ++q) { const size_t r = (size_t)(row0 + i0 + 15 - q); a[q] = *(const unsigned*)(A1 + r * 256); bb[q] = *(const unsigned*)(B1 + r * 256); gx[q] = *(const unsigned*)(P + r * 512 + 256 + 2 * j2); }
#pragma unroll
            for (int q = 0; q < 16; ++q) { g0 = (1.f - blo(a[q])) * g0 + blo(bb[q]); g1 = (1.f - bhi(a[q])) * g1 + bhi(bb[q]); const int i = i0 + 15 - q;
                const unsigned hp = hf[i * 512 + tid];
                *(unsigned*)(ylru + (size_t)(row0 + i) * 256 + 2 * j2) = pk2((blo(hp) + g0) * gelu_tanh_(blo(gx[q])), (bhi(hp) + g1) * gelu_tanh_(bhi(gx[q]))); }
        }
    }
}

constexpr size_t HY_VL = 0, HY_VC = 96 * MiB, HY_P = 140 * MiB  , HY_FL = 200 * MiB, HY_FC = 216 * MiB;
__device__ __forceinline__ void ph_hy_filter(const PAS Prm& p, int l, bool with_ctx, LAS unsigned char* lds) {
    LAS float* feat = (LAS float*)lds;
    LAS float* h1 = feat + 16 * 17;
    LAS float* h2 = h1 + 16 * 64;
    const int tid = TID;
    const float* w1 = p.in[11] + l * 17 * 64; const float* b1 = p.in[12] + l * 64; const float* w2 = p.in[13] + l * 64 * 64; const float* b2 = p.in[14] + l * 64;
    const float* w3 = p.in[15] + (size_t)l * 64 * 1024; const float* freq = p.in[16] + l * 128;
    float* FL = (float*)(p.ws + WS_BIG + BG_S + HY_FL); float* FC = (float*)(p.ws + WS_BIG + BG_S + HY_FC);
    const int ntile = with_ctx ? (SEQ + CTXL) / 16 : SEQ / 16;
    for (int tile = BID; tile < ntile; tile += NBLK) {
        const bool isctx = tile >= SEQ / 16; const int L = isctx ? CTXL : SEQ; const int pos0 = (isctx ? tile - SEQ / 16 : tile) * 16;
        float* F = isctx ? FC : FL;
        if (tid < 16 * 17) { const int pp = tid / 17, f = tid % 17; const float t = (float)(pos0 + pp) / (float)L;
            float v; if (f == 0) v = t; else if (f <= 8) v = sinf(6.283185307179586f * t * (float)f); else v = cosf(6.283185307179586f * t * (float)(f - 8));
            feat[tid] = v; }
        __syncthreads();
        for (int i = tid; i < 1024; i += NTHR) { const int pp = i >> 6, o = i & 63; float s = b1[o];
            for (int f = 0; f < 17; ++f) s += feat[pp * 17 + f] * w1[f * 64 + o];
            h1[i] = sinf(freq[o] * s); }
        __syncthreads();
        for (int i = tid; i < 1024; i += NTHR) { const int pp = i >> 6, o = i & 63; float s = b2[o];
            for (int q = 0; q < 64; ++q) s += h1[pp * 64 + q] * w2[q * 64 + o];
            h2[i] = sinf(freq[64 + o] * s); }
        __syncthreads();
        for (int cc = tid; cc < 1024; cc += NTHR) {
            float acc[16];
#pragma unroll
            for (int pp = 0; pp < 16; ++pp) acc[pp] = 0.f;
            for (int q = 0; q < 64; ++q) { const float w = w3[q * 1024 + cc];
#pragma unroll
                for (int pp = 0; pp < 16; ++pp) acc[pp] += h2[pp * 64 + q] * w; }
            const int o = cc >> 9, dd = (cc >> 8) & 1, c = cc & 255;
            const float rate = 3.0701134573253945f + (15.350567286626973f - 3.0701134573253945f) * (float)c * (1.f / 255.f);
            float* Fo = F + (size_t)(o * 256 + c) * (2 * L);
#pragma unroll
            for (int pp = 0; pp < 16; ++pp) { const int pos = pos0 + pp; const float t = (float)pos / (float)L;
                const float val = acc[pp] * expf(-t * rate);
                if (dd == 0) Fo[L + pos] = val; else if (pos >= 1) Fo[L - pos] = val; }
            if (pos0 == 0 && dd == 0) Fo[0] = 0.f;
        }
        __syncthreads();
    }
}
__device__ __forceinline__ void ph_hy_fnorm(const PAS Prm& p, bool with_ctx) {
    const int tid = TID, lane = tid & 63, wave = tid >> 6;
    float* FL = (float*)(p.ws + WS_BIG + BG_S + HY_FL); float* FC = (float*)(p.ws + WS_BIG + BG_S + HY_FC);
    const int gw = BID * NWAVES + wave, NGW = NBLK * NWAVES;
    for (int it = gw; it < (with_ctx ? 1024 : 512); it += NGW) {
        const bool isctx = it >= 512; const int L = isctx ? CTXL : SEQ; float* F = (isctx ? FC : FL) + (size_t)(it & 511) * (2 * L);
        float s = 0.f;
        for (int i = lane; i < 2 * L; i += 64) { const float v = F[i]; s += v * v; }
        const float sc = rsqrtf(wave_sum(s) + 1e-6f);
        for (int i = lane; i < 2 * L; i += 64) F[i] *= sc;
    }
}
__device__ __forceinline__ void ph_hy_prep(const PAS Prm& p, int l, bool with_ctx, LAS unsigned char* lds) {
    LAS float* tl = (LAS float*)lds;
    const int tid = TID;
    const bf16* P = (const bf16*)(p.ws + WS_BIG + BG_S + HY_P);
    float* VL = (float*)(p.ws + WS_BIG + BG_S + HY_VL); float* VC = (float*)(p.ws + WS_BIG + BG_S + HY_VC);
    const float* cw = p.in[9] + l * 3 * 768; const float* cb = p.in[10] + l * 768;
    const int NTL = 8 * (SEQ / 64) * 12, NTC = with_ctx ? 8 * (CTXL / 64) * 12 : 0, NT = NTL + NTC;
    v4u pv[2]; const int rr2[2] = {tid >> 3, (tid + NTHR) >> 3}, cg = tid & 7;
#define HYP_DECODE(tile_, isctx_, T_, b_, t0_, c0_, base_) const bool isctx_ = (tile_) >= NTL; const int tt_ = isctx_ ? (tile_) - NTL : (tile_); const int T_ = isctx_ ? CTXL : SEQ, ntt_ = T_ / 64; \
        const int ct_ = tt_ % 12, tb_ = (tt_ / 12) % ntt_, b_ = tt_ / (12 * ntt_); const int base_ = isctx_ ? b_ * CTXL : RC + b_ * SEQ, t0_ = tb_ * 64, c0_ = ct_ * 64; (void)ct_; (void)tb_;
#define HYP_LOAD(tile_) do { if ((tile_) < NT) { HYP_DECODE(tile_, ic_, T_, b_, t0_, c0_, base_) (void)b_; \
        _Pragma("unroll") for (int q = 0; q < 2; ++q) { const int t = t0_ - 1 + rr2[q]; \
            pv[q] = (rr2[q] < 66 && t >= 0 && t < T_) ? *(const v4u*)(P + (size_t)(base_ + t) * 768 + c0_ + cg * 8) : (v4u){0u, 0u, 0u, 0u}; } } } while (0)
    HYP_LOAD(BID);
    for (int tile = BID; tile < NT; tile += NBLK) {
        HYP_DECODE(tile, isctx, T, b, t0, c0, base) (void)base;
#pragma unroll
        for (int q = 0; q < 2; ++q) if (rr2[q] < 66) {
#pragma unroll
            for (int e = 0; e < 4; ++e) { const unsigned w = ((const unsigned*)&pv[q])[e]; tl[rr2[q] * 65 + cg * 8 + 2 * e] = blo(w); tl[rr2[q] * 65 + cg * 8 + 2 * e + 1] = bhi(w); } }
        __syncthreads();
        HYP_LOAD(tile + NBLK);
        const int part = c0 >> 8, cl0 = c0 & 255;
        float* dst = (isctx ? VC : VL) + ((size_t)(part * 8 + b) * 256 + cl0) * T + t0;
        for (int i = tid; i < 64 * 64; i += NTHR) { const int cc = i >> 6, ti = i & 63, col = c0 + cc;
            const float v = cb[col] + cw[col] * tl[ti * 65 + cc] + cw[768 + col] * tl[(ti + 1) * 65 + cc] + cw[1536 + col] * tl[(ti + 2) * 65 + cc];
            dst[(size_t)cc * T + ti] = v; }
        __syncthreads();
    }
#undef HYP_LOAD
#undef HYP_DECODE
}
template <int L>
__device__ __forceinline__ void hy_conv_item(const PAS Prm& p, int l, int c, int b0, LAS unsigned char* lds) {
    constexpr int NI = (L + NTHR - 1) / NTHR;
    LAS float* hh = (LAS float*)lds;
    LAS float* z = hh + 2 * L;
    const int tid = TID;
    const bool isctx = (L == CTXL);
    const float* F = (const float*)(p.ws + WS_BIG + BG_S + (isctx ? HY_FC : HY_FL));
    const float* HV = (const float*)(p.ws + WS_BIG + BG_S + (isctx ? HY_VC : HY_VL));
    const float* bias = p.in[17] + l * 512;
    for (int bb = 0; bb < 4; ++bb) for (int t = tid; t < L; t += NTHR) z[t * 4 + bb] = HV[((size_t)(0 * 8 + b0 + bb) * 256 + c) * L + t];
    for (int o = 0; o < 2; ++o) {
        float ssq = 0.f;
        for (int i = tid; i < 2 * L; i += NTHR) { const float fv = F[(size_t)(o * 256 + c) * (2 * L) + i]; ssq += fv * fv; hh[i] = fv; }
        const float fscale = rsqrtf(block_sum(ssq, z + 4 * L, tid) + 1e-6f);
        float acc[NI][4];
#pragma unroll
        for (int i = 0; i < NI; ++i) { acc[i][0] = 0.f; acc[i][1] = 0.f; acc[i][2] = 0.f; acc[i][3] = 0.f; }
        if (tid < L) {
            for (int s = 0; s < L; ++s) {
                const f32x4 zs = *(const LAS f32x4*)(z + s * 4);
#pragma unroll
                for (int i = 0; i < NI; ++i) { const float hv = hh[L + tid + NTHR * i - s];
                    acc[i][0] += hv * zs.x; acc[i][1] += hv * zs.y; acc[i][2] += hv * zs.z; acc[i][3] += hv * zs.w; }
            }
        }
        __syncthreads();
        const float bo = bias[o * 256 + c];
        if (tid < L) {
#pragma unroll
            for (int i = 0; i < NI; ++i) { const int t = tid + NTHR * i;
#pragma unroll
                for (int bb = 0; bb < 4; ++bb) { const float gate = HV[((size_t)((1 + o) * 8 + b0 + bb) * 256 + c) * L + t];
                    z[t * 4 + bb] = gate * (acc[i][bb] * fscale + bo * z[t * 4 + bb]); } }
        }
        __syncthreads();
    }
    float* HVw = (float*)(p.ws + WS_BIG + BG_S + (isctx ? HY_VC : HY_VL));
    if (tid < L) {
#pragma unroll
        for (int i = 0; i < NI; ++i) { const int t = tid + NTHR * i;
#pragma unroll
            for (int bb = 0; bb < 4; ++bb) HVw[((size_t)(0 * 8 + b0 + bb) * 256 + c) * L + t] = z[t * 4 + bb]; }
    }
    __syncthreads();
}
template <int L>
__device__ __forceinline__ void hy_conv_item8(const PAS Prm& p, int l, int c, LAS unsigned char* lds) {
    static_assert(2 * L == NTHR, "two thread halves of L threads");
    LAS float* hh = (LAS float*)lds;
    const int tid = TID, g = tid >> 8, tl = tid & (L - 1), b0 = 4 * g;
    LAS float* z = hh + 2 * L + g * 4 * L;
    LAS float* red = hh + 2 * L + 8 * L;
    const float* F = (const float*)(p.ws + WS_BIG + BG_S + HY_FC);
    float* HV = (float*)(p.ws + WS_BIG + BG_S + HY_VC);
    const float* bias = p.in[17] + l * 512;
#pragma unroll
    for (int bb = 0; bb < 4; ++bb) z[tl * 4 + bb] = HV[((size_t)(0 * 8 + b0 + bb) * 256 + c) * L + tl];
    for (int o = 0; o < 2; ++o) {
        const float fv = F[(size_t)(o * 256 + c) * (2 * L) + tid];
        hh[tid] = fv;
        const float fscale = rsqrtf(block_sum(fv * fv, red, tid) + 1e-6f);
        float acc0 = 0.f, acc1 = 0.f, acc2 = 0.f, acc3 = 0.f;
        for (int s = 0; s < L; ++s) {
            const f32x4 zs = *(const LAS f32x4*)(z + s * 4);
            const float hv = hh[L + tl - s];
            acc0 += hv * zs.x; acc1 += hv * zs.y; acc2 += hv * zs.z; acc3 += hv * zs.w;
        }
        __syncthreads();
        const float bo = bias[o * 256 + c];
        const float accv[4] = {acc0, acc1, acc2, acc3};
#pragma unroll
        for (int bb = 0; bb < 4; ++bb) { const float gate = HV[((size_t)((1 + o) * 8 + b0 + bb) * 256 + c) * L + tl];
            z[tl * 4 + bb] = gate * (accv[bb] * fscale + bo * z[tl * 4 + bb]); }
        __syncthreads();
    }
#pragma unroll
    for (int bb = 0; bb < 4; ++bb) HV[((size_t)(0 * 8 + b0 + bb) * 256 + c) * L + tl] = z[tl * 4 + bb];
    __syncthreads();
}
__device__ __forceinline__ void ph_hy_post(const PAS Prm& p, bool with_ctx, LAS unsigned char* lds) {
    LAS float* tl = (LAS float*)lds;
    const int tid = TID;
    const float* VL = (const float*)(p.ws + WS_BIG + BG_S + HY_VL); const float* VC = (const float*)(p.ws + WS_BIG + BG_S + HY_VC);
    bf16* yhy = (bf16*)(p.ws + WS_Y);
    const int NTL = 8 * (SEQ / 64) * 4, NTC = with_ctx ? 8 * (CTXL / 64) * 4 : 0;
    for (int tile = BID; tile < NTL + NTC; tile += NBLK) {
        const bool isctx = tile >= NTL; const int tt = isctx ? tile - NTL : tile;
        const int T = isctx ? CTXL : SEQ, ntt = T / 64;
        const int ct = tt % 4, tb = (tt / 4) % ntt, b = tt / (4 * ntt);
        const int base = isctx ? b * CTXL : RC + b * SEQ, t0 = tb * 64, c0 = ct * 64;
        const float* src = (isctx ? VC : VL) + ((size_t)b * 256 + c0) * T + t0;
        for (int i = tid; i < 64 * 64; i += NTHR) { const int cc = i >> 6, ti = i & 63; tl[cc * 65 + ti] = src[(size_t)cc * T + ti]; }
        __syncthreads();
        for (int i = tid; i < 64 * 32; i += NTHR) { const int ti = i >> 5, cp = i & 31;
            *(unsigned*)(yhy + (size_t)(base + t0 + ti) * 256 + c0 + 2 * cp) = pk2(tl[(2 * cp) * 65 + ti], tl[(2 * cp + 1) * 65 + ti]); }
        __syncthreads();
    }
}
__device__ __forceinline__ cf2 cmul(cf2 a, cf2 b) { return (cf2){sfma(a.x, b.x, -smul(a.y, b.y)), sfma(a.x, b.y, smul(a.y, b.x))}; }
__device__ __forceinline__ cf2 cmulc(cf2 a, cf2 b) { return (cf2){sfma(a.x, b.x, smul(a.y, b.y)), sfma(a.y, b.x, -smul(a.x, b.y))}; }
__device__ __forceinline__ cf2 cadd(cf2 a, cf2 b) { return (cf2){sadd(a.x, b.x), sadd(a.y, b.y)}; }
__device__ __forceinline__ cf2 csub(cf2 a, cf2 b) { return (cf2){ssub(a.x, b.x), ssub(a.y, b.y)}; }
#define XP(i) ((i) + ((i) >> 5))
#ifdef HOST_EMU
static inline unsigned brev32(unsigned x) { unsigned r = 0; for (int i = 0; i < 32; ++i) if (x & (1u << i)) r |= 1u << (31 - i); return r; }
#else
__device__ __forceinline__ unsigned brev32(unsigned x) { return __builtin_bitreverse32(x); }
#endif
template <int LOGN, int M, bool INV, int GMAP, bool PM = false, int RIO = 0>
__device__ __forceinline__ void fft_pass(LAS cf2* X, const LAS cf2* W, const int log_stride, const int tid, const LAS cf2* Hh = nullptr, cf2* xr = nullptr) {
    static_assert(RIO == 0 || ((1 << LOGN) >> M) == NTHR, "register hand-over needs one group per thread");
    constexpr int N = 1 << LOGN, R = 1 << M, NGRP = N / R, LG = LOGN - M;
#pragma unroll
    for (int t = tid; t < NGRP; t += NTHR) {
        int g = t;
        if (GMAP == 1) g = ((t << 1) | (t >> (LG - 1))) & (NGRP - 1);
        if (GMAP == 2) { const int bl = t >> 4, nb = LG - 4; g = (t & 15) | ((((bl << 1) | (bl >> (nb - 1))) & ((1 << nb) - 1)) << 4); }
        const int q = g & ((1 << log_stride) - 1), blk = g >> log_stride;
        const int base = (blk << (log_stride + M)) + q;
        cf2 x[R];
#pragma unroll
        for (int j = 0; j < R; ++j) { if (RIO == 1) x[j] = xr[j]; else x[j] = X[XP(base + (j << log_stride))]; }
        if (PM) {
#pragma unroll
            for (int j = 0; j < R; ++j) { const int k = (int)(brev32((unsigned)(base + (j << log_stride))) >> (32 - LOGN));
                cf2 h; if (k <= N / 2) h = Hh[k]; else { h = Hh[N - k]; h.y = -h.y; }
                x[j] = cmul(x[j], h); } }
#pragma unroll
        for (int s = 0; s < M; ++s) {
            const int half = INV ? (1 << s) : (R >> (s + 1));
            const int lsp = log_stride + (INV ? s : (M - 1 - s));
#pragma unroll
            for (int j = 0; j < R; ++j) {
                if (j & half) continue;
                const int pos = q + ((j & (half - 1)) << log_stride);
                const cf2 a = x[j], bq = x[j + half];
                if (lsp == 0) {
                    x[j] = cadd(a, bq); x[j + half] = csub(a, bq);
                } else if (lsp == 1) {
                    if (!INV) { const cf2 dlt = csub(a, bq); x[j] = cadd(a, bq); x[j + half] = (pos & 1) ? (cf2){dlt.y, -dlt.x} : dlt; }
                    else { const cf2 t2 = (pos & 1) ? (cf2){-bq.y, bq.x} : bq; x[j] = cadd(a, t2); x[j + half] = csub(a, t2); }
                } else {
                    const cf2 w = W[pos << (LOGN - 1 - lsp)];
                    if (!INV) { x[j] = cadd(a, bq); x[j + half] = cmul(csub(a, bq), w); }
                    else { const cf2 t2 = cmulc(bq, w); x[j] = cadd(a, t2); x[j + half] = csub(a, t2); }
                }
            }
        }
#pragma unroll
        for (int j = 0; j < R; ++j) { if (RIO == 2) xr[j] = x[j]; else X[XP(base + (j << log_stride))] = x[j]; }
    }
    __syncthreads();
}
template <int LOGN, bool INV, bool PM = false, bool RR = false> __device__ __forceinline__ void fft_lds(LAS cf2* X, const LAS cf2* W, const int tid, const LAS cf2* Hh = nullptr, cf2* xr = nullptr) {
    static_assert(LOGN == 13 || LOGN == 9, "pass schedule");
    if (LOGN == 13) {
        if (!INV) { fft_pass<LOGN, 4, false, 0, false, RR ? 1 : 0>(X, W, 9, tid, nullptr, xr); fft_pass<LOGN, 3, false, 0>(X, W, 6, tid); fft_pass<LOGN, 3, false, 0>(X, W, 3, tid); fft_pass<LOGN, 3, false, 0>(X, W, 0, tid); }
        else { fft_pass<LOGN, 3, true, 0, PM>(X, W, 0, tid, Hh); fft_pass<LOGN, 3, true, 0>(X, W, 3, tid); fft_pass<LOGN, 3, true, 0>(X, W, 6, tid); fft_pass<LOGN, 4, true, 0, false, RR ? 2 : 0>(X, W, 9, tid, nullptr, xr); }
    } else {
        if (!INV) { fft_pass<LOGN, 3, false, 0>(X, W, 6, tid); fft_pass<LOGN, 3, false, 0>(X, W, 3, tid); fft_pass<LOGN, 3, false, 0>(X, W, 0, tid); }
        else { fft_pass<LOGN, 3, true, 0, PM>(X, W, 0, tid, Hh); fft_pass<LOGN, 3, true, 0>(X, W, 3, tid); fft_pass<LOGN, 3, true, 0>(X, W, 6, tid); }
    }
}
template <int LOGN>
__device__ __forceinline__ void hy_fft_channel(const PAS Prm& p, int l, int c, LAS unsigned char* lds) {
    constexpr int N = 1 << LOGN, L = N / 2;
    static_assert(L == SEQ, "transform length");
    LAS cf2* X = (LAS cf2*)lds;
    LAS cf2* Hh = X + N + N / 32;
    LAS cf2* W = Hh + N / 2 + 8;
    const int tid = TID;
    const float* F = (const float*)(p.ws + WS_BIG + BG_S + HY_FL);
    float* HV = (float*)(p.ws + WS_BIG + BG_S + HY_VL);
    const float* bias = p.in[17] + l * 512;
    for (int k = tid; k < N / 2; k += NTHR) { float sn, cs; sincospif(-(float)k * (2.0f / (float)N), &sn, &cs); W[k] = (cf2){cs, sn}; }
    __syncthreads();
    const float inv_n = 1.0f / (float)N;
    for (int o = 0; o < 2; ++o) {
        const float* Fo = F + (size_t)(o * 256 + c) * N;
        float ssq = 0.f;
        { constexpr int NIT = N / NTHR; float fvv[NIT];
#pragma unroll
          for (int i = 0; i < NIT; ++i) fvv[i] = Fo[(tid + NTHR * i + L) & (N - 1)];
#pragma unroll
          for (int i = 0; i < NIT; ++i) { ssq += fvv[i] * fvv[i]; X[XP(tid + NTHR * i)] = (cf2){fvv[i], 0.f}; } }
        const float fscale = rsqrtf(block_sum(ssq, (LAS float*)(W + N / 2), tid) + 1e-6f);
        fft_lds<LOGN, false>(X, W, tid);
        for (int pp = tid; pp < N; pp += NTHR) { const int k = (int)(brev32((unsigned)pp) >> (32 - LOGN)); if (k <= N / 2) Hh[k] = X[XP(pp)] * fscale; }
        __syncthreads();
        const float bo = bias[o * 256 + c];
        constexpr int NITZ = (L + NTHR - 1) / NTHR;
        float a0[NITZ], a1[NITZ];
        { float* z0 = HV + ((size_t)(0 * 8) * 256 + c) * L; float* z1 = z0 + (size_t)256 * L;
#pragma unroll
          for (int i = 0; i < NITZ; ++i) { const int t = tid + NTHR * i; if (t < L) { a0[i] = z0[t]; a1[i] = z1[t]; } } }
#pragma unroll 1
        for (int pair = 0; pair < 4; ++pair) {
            float* z0 = HV + ((size_t)(0 * 8 + 2 * pair) * 256 + c) * L; float* z1 = z0 + (size_t)256 * L;
            const float* g0 = HV + ((size_t)((1 + o) * 8 + 2 * pair) * 256 + c) * L; const float* g1 = g0 + (size_t)256 * L;
            constexpr bool RR = (LOGN == 13);
            cf2 xr[16];
            if (RR) {
#pragma unroll
                for (int i = 0; i < 16; ++i) xr[i] = (i < NITZ) ? (cf2){a0[i < NITZ ? i : 0], a1[i < NITZ ? i : 0]} : (cf2){0.f, 0.f};
            } else {
#pragma unroll
                for (int i = 0; i < NITZ; ++i) { const int t = tid + NTHR * i; if (t < L) { X[XP(t)] = (cf2){a0[i], a1[i]}; X[XP(t + L)] = (cf2){0.f, 0.f}; } }
                __syncthreads();
            }
            fft_lds<LOGN, false, false, RR>(X, W, tid, nullptr, xr);
            float q0[NITZ], q1[NITZ], n0[NITZ], n1[NITZ];
            { const int pn = pair < 3 ? pair + 1 : pair; const float* y0 = HV + ((size_t)(0 * 8 + 2 * pn) * 256 + c) * L; const float* y1 = y0 + (size_t)256 * L;
#pragma unroll
              for (int i = 0; i < NITZ; ++i) { const int t = tid + NTHR * i; if (t < L) { q0[i] = g0[t]; q1[i] = g1[t]; n0[i] = y0[t]; n1[i] = y1[t]; } } }
            fft_lds<LOGN, true, true, RR>(X, W, tid, Hh, xr);
#pragma unroll
            for (int i = 0; i < NITZ; ++i) { const int t = tid + NTHR * i; if (t < L) { const cf2 cv = (RR ? xr[i < 16 ? i : 0] : X[XP(t)]) * inv_n;
                z0[t] = q0[i] * (cv.x + bo * a0[i]); z1[t] = q1[i] * (cv.y + bo * a1[i]); a0[i] = n0[i]; a1[i] = n1[i]; } }
            __syncthreads();
        }
    }
}
__device__ __forceinline__ void ph_hy_conv(const PAS Prm& p, int l, bool with_ctx, LAS unsigned char* lds) {
    constexpr int LOGN = (SEQ == 4096) ? 13 : 9;
    for (int c = BID; c < 256; c += NBLK) hy_fft_channel<LOGN>(p, l, c, lds);
    if (with_ctx) {
        if constexpr (2 * CTXL == NTHR) { for (int it = BID; it < 256; it += NBLK) hy_conv_item8<CTXL>(p, l, it, lds); }
        else { for (int it = BID; it < 512; it += NBLK) hy_conv_item<CTXL>(p, l, it >> 1, (it & 1) * 4, lds); }
    }
}

constexpr int PPL = 18;
constexpr int NPH = 1 + DEPTH * PPL + 1;

#ifdef HOST_EMU
#define NO_PK_F32
#else
#define NO_PK_F32 __attribute__((target("no-packed-fp32-ops")))
#endif
template <unsigned MASK> __global__ void __launch_bounds__(NTHR, 2) fwd(Prm pk) {
#ifdef HOST_EMU
    unsigned char* lds_raw = g_lds_emu;
#else
    extern __shared__ __attribute__((aligned(16))) unsigned char lds_raw[];
#endif
    LAS unsigned char* lds = (LAS unsigned char*)lds_raw;
    volatile LAS unsigned* misc = (volatile LAS unsigned*)(lds + LDS_BYTES - 256);
#ifndef HOST_EMU
    { const unsigned t0 = threadIdx.x;
      if (t0 < 64u) misc[t0] = 0u;
      if ((t0 & 63u) == 0u) ((volatile LAS unsigned*)(lds + TIDTAB_OFF))[hw_slot()] = t0 >> 6;
      __syncthreads();
      if ((unsigned)tid_opq() != t0) __hip_atomic_store((unsigned*)(pk.ws + WS_CTL + 768 * 1024), 1u, __ATOMIC_RELAXED, __HIP_MEMORY_SCOPE_AGENT); }
#else
    if (TID < 64) misc[TID] = 0u;
    __syncthreads();
#endif
    const int lo = pk.lo, hi = pk.hi;
#ifdef PROBE_G
    if (blockIdx.x == 0 && tid_opq() == 0) misc[15] = (unsigned)__builtin_amdgcn_s_memrealtime();
#endif
    XcdBarrier bar; bar.bar = (unsigned*)(pk.ws + WS_CTL); bar.x = 0; bar.st = misc + 8;
    if (hi - lo > 1) bar = xcd_barrier_post((unsigned*)(pk.ws + WS_CTL), misc + 8);
    int ph = 0;
#ifdef HOST_EMU
#define PH_PRM() const Prm* pl_ = &pk
#else
#define PH_PRM() const PAS Prm* pl_ = (const PAS Prm*)__builtin_amdgcn_kernarg_segment_ptr(); asm volatile("" : "+s"(pl_))
#endif
#define PH_BEGIN(k) if (((MASK >> ((k) & 31)) & 1u) && ph >= lo && ph < hi) { constexpr int PH_CUR = (k); (void)PH_CUR; PH_PRM(); const PAS Prm& p = *pl_; \
    bf16* const WB = (bf16*)(p.ws + WS_W); bf16* const U = (bf16*)(p.ws + WS_U); float* const XC = (float*)(p.ws + WS_XC); bf16* const PB = (bf16*)(p.ws + WS_BIG + BG_P); \
    unsigned char* const SB = p.ws + WS_BIG + BG_S; bf16* const GH = (bf16*)(p.ws + WS_BIG); bf16* const MG = (bf16*)(p.ws + WS_BIG + 136 * MiB); bf16* const ACT = (bf16*)(p.ws + WS_BIG); \
    const float* const MOD = (const float*)(p.ws + WS_MOD); const float* const modl = MOD + (size_t)l * 9 * 6144; \
    const float* xc_src = (l == 0) ? p.in[2] : XC; const float* xl_src = (l == 0) ? p.in[0] : p.out; \
    (void)WB; (void)U; (void)XC; (void)PB; (void)SB; (void)GH; (void)MG; (void)ACT; (void)MOD; (void)modl; (void)xc_src; (void)xl_src;
#ifdef PROBE_G
#define PH_GRP(k) (((k) == 4 || (k) == 8 || (k) == 12 || (k) == 16 || ((k) >= 21 && (k) <= 27) || (k) == 29 || (k) == 30) ? 0 : ((k) == 6) ? 1 : ((k) == 20) ? 2 : ((k) == 5 || (k) == 13) ? 3 : 4)
#define PH_END_K(k) if (ph + 1 < hi) xcd_barrier(bar); if (blockIdx.x == 0 && tid_opq() == 0) { const unsigned tnow = (unsigned)__builtin_amdgcn_s_memrealtime(); misc[16 + PH_GRP(k)] += tnow - misc[15]; misc[15] = tnow; } } ++ph;
#else
#define PH_END_K(k) if (ph + 1 < hi) xcd_barrier(bar); } ++ph;
#endif
#define PH_END PH_END_K(PH_CUR)
    typedef pg8::StaticOrder SO;

    { const int l = 0; PH_BEGIN(1) ph_mod(p, lds); PH_END }

    {
        constexpr int l = 0;
        const bool last = (l == DEPTH - 1), wctx = !last;
        const int ro = last ? RC : 0, Mpost = last ? RL : RT;

        PH_BEGIN(2) ph_cvt(p, l, lds, (l > 0 && NBLK == 256) ? 2 : 0, 0); ph_norm(p, l, 0, xc_src, xl_src, 0); PH_END
        PH_BEGIN(4) { pg8::Gemm g{U, WB + WO_WP + (size_t)1280 * 1024, RT, 2048, 1024}; SO S; S.init(RT, 2048, NBLK, BID); pg8::EpiBf2 E{(bf16*)(p.ws + WS_Y), 1024, PB, 1024, 4};
                   pg8::gemm_phase<pg8::EpiBf2, SO, true, true>(lds, g, S, E); } PH_END
        PH_BEGIN(5) ph_rw_prep(p, l, lds); PH_END
        PH_BEGIN(6) { const int bid = BID;
#ifdef PROBE_G
                   const unsigned tq0 = (unsigned)__builtin_amdgcn_s_memrealtime();
#endif
                   for (int task = bid; task < 256; task += NBLK) {
                       if (task < 128) scan_phase<0>(task, SB, PB, (void*)(SB + RW_Y), p.in[25] + l * 256, nullptr, lds);
                       else scan_phase<1>(task - 128, SB, PB, (void*)(SB + RT_Y), nullptr, p.in[35] + l * 8, lds);
                       __syncthreads(); }
#ifdef PROBE_G
                   if (tid_opq() == 0) { const unsigned tq1 = (unsigned)__builtin_amdgcn_s_memrealtime(); if (bid == 0) misc[16 + 5] += tq1 - tq0; if (bid == 128) misc[16 + 6] += tq1 - tq0; }
#endif
                   } PH_END
        PH_BEGIN(7) ph_rw_post(p, l); ph_ret_post(p); PH_END
        PH_BEGIN(12) { pg8::Gemm g{U, WB + WO_WP, RT, 1280, 1024}; SO S; S.init(RT, 1280, NBLK, BID);
                   pg8::EpiBf2 E{PB, 512, (bf16*)(SB + HY_P), 768, 2};
                   pg8::gemm_phase<pg8::EpiBf2, SO, true, true>(lds, g, S, E); } PH_END
        PH_BEGIN(13) ph_lru_prep(p, l, lds); PH_END
        PH_BEGIN(14) ph_lru_agg(p); ph_hy_filter(p, l, wctx, lds); PH_END
        PH_BEGIN(15) ph_lru_fin(p, lds); PH_END
        PH_BEGIN(19) ph_hy_prep(p, l, wctx, lds); PH_END
        PH_BEGIN(20) ph_hy_conv(p, l, wctx, lds); PH_END
        PH_BEGIN(32) ph_hy_post(p, wctx, lds); PH_END
        PH_BEGIN(21) { pg8::Gemm g{U + (size_t)ro * 1024, WB + WO_WG, Mpost, 4096, 1024}; SO S; S.init(Mpost, 4096, NBLK, BID); pg8::EpiBf<1> E{GH + (size_t)ro * 4096, 4096};
                   pg8::gemm_phase<pg8::EpiBf<1>, SO, true, true>(lds, g, S, E); } PH_END
#ifdef HOST_EMU
#define MERGE_LOCAL_SEAM() __syncthreads()
#else
#define MERGE_LOCAL_SEAM() do { asm volatile("s_waitcnt vmcnt(0)" ::: "memory"); __syncthreads(); __builtin_amdgcn_fence(__ATOMIC_ACQUIRE, "agent"); asm volatile("s_waitcnt vmcnt(0)" ::: "memory"); __syncthreads(); } while (0)
#endif
        PH_BEGIN(22) {
            { pg8::Gemm g{(const bf16*)(p.ws + WS_Y + 0 * SZ17) + (size_t)ro * 256, WB + WO_BR + (size_t)0 * 1024 * 256, Mpost, 1024, 256}; SO S; S.init(Mpost, 1024, NBLK, BID);
              pg8::EpiMerge E{GH + (size_t)ro * 4096, 4096, 0, U + (size_t)ro * 1024, 1}; pg8::gemm_phase<pg8::EpiMerge, SO, true, true>(lds, g, S, E); }
            MERGE_LOCAL_SEAM();
            { pg8::Gemm g{(const bf16*)(p.ws + WS_Y + 1 * SZ17) + (size_t)ro * 256, WB + WO_BR + (size_t)1 * 1024 * 256, Mpost, 1024, 256}; SO S; S.init(Mpost, 1024, NBLK, BID);
              pg8::EpiMerge E{GH + (size_t)ro * 4096, 4096, 1024, U + (size_t)ro * 1024, 0}; pg8::gemm_phase<pg8::EpiMerge, SO, true, true>(lds, g, S, E); }
            MERGE_LOCAL_SEAM();
            { pg8::Gemm g{(const bf16*)(p.ws + WS_Y + 2 * SZ17) + (size_t)ro * 256, WB + WO_BR + (size_t)2 * 1024 * 256, Mpost, 1024, 256}; SO S; S.init(Mpost, 1024, NBLK, BID);
              pg8::EpiMerge E{GH + (size_t)ro * 4096, 4096, 2048, U + (size_t)ro * 1024, 0}; pg8::gemm_phase<pg8::EpiMerge, SO, true, true>(lds, g, S, E); }
            MERGE_LOCAL_SEAM();
            { pg8::Gemm g{(const bf16*)(p.ws + WS_Y + 3 * SZ17) + (size_t)ro * 256, WB + WO_BR + (size_t)3 * 1024 * 256, Mpost, 1024, 256}; SO S; S.init(Mpost, 1024, NBLK, BID);
              pg8::EpiMerge E{GH + (size_t)ro * 4096, 4096, 3072, U + (size_t)ro * 1024, 0}; pg8::gemm_phase<pg8::EpiMerge, SO, true, true>(lds, g, S, E); }
        } PH_END
        PH_BEGIN(27) { pg8::Gemm g{U + (size_t)ro * 1024, WB + WO_WO, Mpost, 1024, 1024}; SO S; S.init(Mpost, 1024, NBLK, BID);
                   pg8::EpiResid E{xc_src, xl_src, XC, p.out, modl, 2 * 1024, ro};
                   pg8::gemm_phase<pg8::EpiResid, SO, true, true>(lds, g, S, E); } PH_END
        PH_BEGIN(28) ph_norm(p, l, 1, XC, p.out, ro); PH_END
        PH_BEGIN(29) { pg8::Gemm g{U + (size_t)ro * 1024, WB + WO_W1, Mpost, 5632, 1024}; SO S; S.init(Mpost, 5632, NBLK, BID); pg8::EpiSwiglu E{ACT + (size_t)ro * 2816, 2816};
                   pg8::gemm_phase<pg8::EpiSwiglu, SO, true, true>(lds, g, S, E); } PH_END
        PH_BEGIN(30) { pg8::Gemm g{ACT + (size_t)ro * 2816, WB + WO_W2, Mpost, 1024, 2816}; SO S; S.init(Mpost, 1024, NBLK, BID);
                   pg8::EpiResid E{XC, p.out, XC, p.out, modl, 5 * 1024, ro};
                   pg8::gemm_phase<pg8::EpiResid, SO, true, true>(lds, g, S, E); }
                   if (!last && NBLK == 256 && BID >= 32) { __syncthreads(); ph_cvt(p, l + 1, lds, 1, 32); }
        PH_END
    }
    {
        constexpr int l = 1;
        const bool last = (l == DEPTH - 1), wctx = !last;
        const int ro = last ? RC : 0, Mpost = last ? RL : RT;

        PH_BEGIN(2) ph_cvt(p, l, lds, (l > 0 && NBLK == 256) ? 2 : 0, 0); ph_norm(p, l, 0, xc_src, xl_src, 0); PH_END
        PH_BEGIN(4) { pg8::Gemm g{U, WB + WO_WP + (size_t)1280 * 1024, RT, 2048, 1024}; SO S; S.init(RT, 2048, NBLK, BID); pg8::EpiBf2 E{(bf16*)(p.ws + WS_Y), 1024, PB, 1024, 4};
                   pg8::gemm_phase<pg8::EpiBf2, SO, true, true>(lds, g, S, E); } PH_END
        PH_BEGIN(5) ph_rw_prep(p, l, lds); PH_END
        PH_BEGIN(6) { const int bid = BID;
#ifdef PROBE_G
                   const unsigned tq0 = (unsigned)__builtin_amdgcn_s_memrealtime();
#endif
                   for (int task = bid; task < 256; task += NBLK) {
                       if (task < 128) scan_phase<0>(task, SB, PB, (void*)(SB + RW_Y), p.in[25] + l * 256, nullptr, lds);
                       else scan_phase<1>(task - 128, SB, PB, (void*)(SB + RT_Y), nullptr, p.in[35] + l * 8, lds);
                       __syncthreads(); }
#ifdef PROBE_G
                   if (tid_opq() == 0) { const unsigned tq1 = (unsigned)__builtin_amdgcn_s_memrealtime(); if (bid == 0) misc[16 + 5] += tq1 - tq0; if (bid == 128) misc[16 + 6] += tq1 - tq0; }
#endif
                   } PH_END
        PH_BEGIN(7) ph_rw_post(p, l); ph_ret_post(p); PH_END
        PH_BEGIN(12) { pg8::Gemm g{U, WB + WO_WP, RT, 1280, 1024}; SO S; S.init(RT, 1280, NBLK, BID);
                   pg8::EpiBf2 E{PB, 512, (bf16*)(SB + HY_P), 768, 2};
                   pg8::gemm_phase<pg8::EpiBf2, SO, true, true>(lds, g, S, E); } PH_END
        PH_BEGIN(13) ph_lru_prep(p, l, lds); PH_END
        PH_BEGIN(14) ph_lru_agg(p); ph_hy_filter(p, l, wctx, lds); PH_END
        PH_BEGIN(15) ph_lru_fin(p, lds); PH_END
        PH_BEGIN(19) ph_hy_prep(p, l, wctx, lds); PH_END
        PH_BEGIN(20) ph_hy_conv(p, l, wctx, lds); PH_END
        PH_BEGIN(32) ph_hy_post(p, wctx, lds); PH_END
        PH_BEGIN(21) { pg8::Gemm g{U + (size_t)ro * 1024, WB + WO_WG, Mpost, 4096, 1024}; SO S; S.init(Mpost, 4096, NBLK, BID); pg8::EpiBf<1> E{GH + (size_t)ro * 4096, 4096};
                   pg8::gemm_phase<pg8::EpiBf<1>, SO, true, true>(lds, g, S, E); } PH_END
#ifdef HOST_EMU
#define MERGE_LOCAL_SEAM() __syncthreads()
#else
#define MERGE_LOCAL_SEAM() do { asm volatile("s_waitcnt vmcnt(0)" ::: "memory"); __syncthreads(); __builtin_amdgcn_fence(__ATOMIC_ACQUIRE, "agent"); asm volatile("s_waitcnt vmcnt(0)" ::: "memory"); __syncthreads(); } while (0)
#endif
        PH_BEGIN(22) {
            { pg8::Gemm g{(const bf16*)(p.ws + WS_Y + 0 * SZ17) + (size_t)ro * 256, WB + WO_BR + (size_t)0 * 1024 * 256, Mpost, 1024, 256}; SO S; S.init(Mpost, 1024, NBLK, BID);
              pg8::EpiMerge E{GH + (size_t)ro * 4096, 4096, 0, U + (size_t)ro * 1024, 1}; pg8::gemm_phase<pg8::EpiMerge, SO, true, true>(lds, g, S, E); }
            MERGE_LOCAL_SEAM();
            { pg8::Gemm g{(const bf16*)(p.ws + WS_Y + 1 * SZ17) + (size_t)ro * 256, WB + WO_BR + (size_t)1 * 1024 * 256, Mpost, 1024, 256}; SO S; S.init(Mpost, 1024, NBLK, BID);
              pg8::EpiMerge E{GH + (size_t)ro * 4096, 4096, 1024, U + (size_t)ro * 1024, 0}; pg8::gemm_phase<pg8::EpiMerge, SO, true, true>(lds, g, S, E); }
            MERGE_LOCAL_SEAM();
            { pg8::Gemm g{(const bf16*)(p.ws + WS_Y + 2 * SZ17) + (size_t)ro * 256, WB + WO_BR + (size_t)2 * 1024 * 256, Mpost, 1024, 256}; SO S; S.init(Mpost, 1024, NBLK, BID);
              pg8::EpiMerge E{GH + (size_t)ro * 4096, 4096, 2048, U + (size_t)ro * 1024, 0}; pg8::gemm_phase<pg8::EpiMerge, SO, true, true>(lds, g, S, E); }
            MERGE_LOCAL_SEAM();
            { pg8::Gemm g{(const bf16*)(p.ws + WS_Y + 3 * SZ17) + (size_t)ro * 256, WB + WO_BR + (size_t)3 * 1024 * 256, Mpost, 1024, 256}; SO S; S.init(Mpost, 1024, NBLK, BID);
              pg8::EpiMerge E{GH + (size_t)ro * 4096, 4096, 3072, U + (size_t)ro * 1024, 0}; pg8::gemm_phase<pg8::EpiMerge, SO, true, true>(lds, g, S, E); }
        } PH_END
        PH_BEGIN(27) { pg8::Gemm g{U + (size_t)ro * 1024, WB + WO_WO, Mpost, 1024, 1024}; SO S; S.init(Mpost, 1024, NBLK, BID);
                   pg8::EpiResid E{xc_src, xl_src, XC, p.out, modl, 2 * 1024, ro};
                   pg8::gemm_phase<pg8::EpiResid, SO, true, true>(lds, g, S, E); } PH_END
        PH_BEGIN(28) ph_norm(p, l, 1, XC, p.out, ro); PH_END
        PH_BEGIN(29) { pg8::Gemm g{U + (size_t)ro * 1024, WB + WO_W1, Mpost, 5632, 1024}; SO S; S.init(Mpost, 5632, NBLK, BID); pg8::EpiSwiglu E{ACT + (size_t)ro * 2816, 2816};
                   pg8::gemm_phase<pg8::EpiSwiglu, SO, true, true>(lds, g, S, E); } PH_END
        PH_BEGIN(30) { pg8::Gemm g{ACT + (size_t)ro * 2816, WB + WO_W2, Mpost, 1024, 2816}; SO S; S.init(Mpost, 1024, NBLK, BID);
                   pg8::EpiResid E{XC, p.out, XC, p.out, modl, 5 * 1024, ro};
                   pg8::gemm_phase<pg8::EpiResid, SO, true, true>(lds, g, S, E); }
                   if (!last && NBLK == 256 && BID >= 32) { __syncthreads(); ph_cvt(p, l + 1, lds, 1, 32); }
        PH_END
    }
    {
        constexpr int l = 2;
        const bool last = (l == DEPTH - 1), wctx = !last;
        const int ro = last ? RC : 0, Mpost = last ? RL : RT;

        PH_BEGIN(2) ph_cvt(p, l, lds, (l > 0 && NBLK == 256) ? 2 : 0, 0); ph_norm(p, l, 0, xc_src, xl_src, 0); PH_END
        PH_BEGIN(4) { pg8::Gemm g{U, WB + WO_WP + (size_t)1280 * 1024, RT, 2048, 1024}; SO S; S.init(RT, 2048, NBLK, BID); pg8::EpiBf2 E{(bf16*)(p.ws + WS_Y), 1024, PB, 1024, 4};
                   pg8::gemm_phase<pg8::EpiBf2, SO, true, true>(lds, g, S, E); } PH_END
        PH_BEGIN(5) ph_rw_prep(p, l, lds); PH_END
        PH_BEGIN(6) { const int bid = BID;
#ifdef PROBE_G
                   const unsigned tq0 = (unsigned)__builtin_amdgcn_s_memrealtime();
#endif
                   for (int task = bid; task < 256; task += NBLK) {
                       if (task < 128) scan_phase<0>(task, SB, PB, (void*)(SB + RW_Y), p.in[25] + l * 256, nullptr, lds);
                       else scan_phase<1>(task - 128, SB, PB, (void*)(SB + RT_Y), nullptr, p.in[35] + l * 8, lds);
                       __syncthreads(); }
#ifdef PROBE_G
                   if (tid_opq() == 0) { const unsigned tq1 = (unsigned)__builtin_amdgcn_s_memrealtime(); if (bid == 0) misc[16 + 5] += tq1 - tq0; if (bid == 128) misc[16 + 6] += tq1 - tq0; }
#endif
                   } PH_END
        PH_BEGIN(7) ph_rw_post(p, l); ph_ret_post(p); PH_END
        PH_BEGIN(12) { pg8::Gemm g{U, WB + WO_WP, RT, 1280, 1024}; SO S; S.init(RT, 1280, NBLK, BID);
                   pg8::EpiBf2 E{PB, 512, (bf16*)(SB + HY_P), 768, 2};
                   pg8::gemm_phase<pg8::EpiBf2, SO, true, true>(lds, g, S, E); } PH_END
        PH_BEGIN(13) ph_lru_prep(p, l, lds); PH_END
        PH_BEGIN(14) ph_lru_agg(p); ph_hy_filter(p, l, wctx, lds); PH_END
        PH_BEGIN(15) ph_lru_fin(p, lds); PH_END
        PH_BEGIN(19) ph_hy_prep(p, l, wctx, lds); PH_END
        PH_BEGIN(20) ph_hy_conv(p, l, wctx, lds); PH_END
        PH_BEGIN(32) ph_hy_post(p, wctx, lds); PH_END
        PH_BEGIN(21) { pg8::Gemm g{U + (size_t)ro * 1024, WB + WO_WG, Mpost, 4096, 1024}; SO S; S.init(Mpost, 4096, NBLK, BID); pg8::EpiBf<1> E{GH + (size_t)ro * 4096, 4096};
                   pg8::gemm_phase<pg8::EpiBf<1>, SO, true, true>(lds, g, S, E); } PH_END
#ifdef HOST_EMU
#define MERGE_LOCAL_SEAM() __syncthreads()
#else
#define MERGE_LOCAL_SEAM() do { asm volatile("s_waitcnt vmcnt(0)" ::: "memory"); __syncthreads(); __builtin_amdgcn_fence(__ATOMIC_ACQUIRE, "agent"); asm volatile("s_waitcnt vmcnt(0)" ::: "memory"); __syncthreads(); } while (0)
#endif
        PH_BEGIN(22) {
            { pg8::Gemm g{(const bf16*)(p.ws + WS_Y + 0 * SZ17) + (size_t)ro * 256, WB + WO_BR + (size_t)0 * 1024 * 256, Mpost, 1024, 256}; SO S; S.init(Mpost, 1024, NBLK, BID);
              pg8::EpiMerge E{GH + (size_t)ro * 4096, 4096, 0, U + (size_t)ro * 1024, 1}; pg8::gemm_phase<pg8::EpiMerge, SO, true, true>(lds, g, S, E); }
            MERGE_LOCAL_SEAM();
            { pg8::Gemm g{(const bf16*)(p.ws + WS_Y + 1 * SZ17) + (size_t)ro * 256, WB + WO_BR + (size_t)1 * 1024 * 256, Mpost, 1024, 256}; SO S; S.init(Mpost, 1024, NBLK, BID);
              pg8::EpiMerge E{GH + (size_t)ro * 4096, 4096, 1024, U + (size_t)ro * 1024, 0}; pg8::gemm_phase<pg8::EpiMerge, SO, true, true>(lds, g, S, E); }
            MERGE_LOCAL_SEAM();
            { pg8::Gemm g{(const bf16*)(p.ws + WS_Y + 2 * SZ17) + (size_t)ro * 256, WB + WO_BR + (size_t)2 * 1024 * 256, Mpost, 1024, 256}; SO S; S.init(Mpost, 1024, NBLK, BID);
              pg8::EpiMerge E{GH + (size_t)ro * 4096, 4096, 2048, U + (size_t)ro * 1024, 0}; pg8::gemm_phase<pg8::EpiMerge, SO, true, true>(lds, g, S, E); }
            MERGE_LOCAL_SEAM();
            { pg8::Gemm g{(const bf16*)(p.ws + WS_Y + 3 * SZ17) + (size_t)ro * 256, WB + WO_BR + (size_t)3 * 1024 * 256, Mpost, 1024, 256}; SO S; S.init(Mpost, 1024, NBLK, BID);
              pg8::EpiMerge E{GH + (size_t)ro * 4096, 4096, 3072, U + (size_t)ro * 1024, 0}; pg8::gemm_phase<pg8::EpiMerge, SO, true, true>(lds, g, S, E); }
        } PH_END
        PH_BEGIN(27) { pg8::Gemm g{U + (size_t)ro * 1024, WB + WO_WO, Mpost, 1024, 1024}; SO S; S.init(Mpost, 1024, NBLK, BID);
                   pg8::EpiResid E{xc_src, xl_src, XC, p.out, modl, 2 * 1024, ro};
                   pg8::gemm_phase<pg8::EpiResid, SO, true, true>(lds, g, S, E); } PH_END
        PH_BEGIN(28) ph_norm(p, l, 1, XC, p.out, ro); PH_END
        PH_BEGIN(29) { pg8::Gemm g{U + (size_t)ro * 1024, WB + WO_W1, Mpost, 5632, 1024}; SO S; S.init(Mpost, 5632, NBLK, BID); pg8::EpiSwiglu E{ACT + (size_t)ro * 2816, 2816};
                   pg8::gemm_phase<pg8::EpiSwiglu, SO, true, true>(lds, g, S, E); } PH_END
        PH_BEGIN(30) { pg8::Gemm g{ACT + (size_t)ro * 2816, WB + WO_W2, Mpost, 1024, 2816}; SO S; S.init(Mpost, 1024, NBLK, BID);
                   pg8::EpiResid E{XC, p.out, XC, p.out, modl, 5 * 1024, ro};
                   pg8::gemm_phase<pg8::EpiResid, SO, true, true>(lds, g, S, E); }
                   if (!last && NBLK == 256 && BID >= 32) { __syncthreads(); ph_cvt(p, l + 1, lds, 1, 32); }
        PH_END
    }
    {
        constexpr int l = 3;
        const bool last = (l == DEPTH - 1), wctx = !last;
        const int ro = last ? RC : 0, Mpost = last ? RL : RT;

        PH_BEGIN(2) ph_cvt(p, l, lds, (l > 0 && NBLK == 256) ? 2 : 0, 0); ph_norm(p, l, 0, xc_src, xl_src, 0); PH_END
        PH_BEGIN(4) { pg8::Gemm g{U, WB + WO_WP + (size_t)1280 * 1024, RT, 2048, 1024}; SO S; S.init(RT, 2048, NBLK, BID); pg8::EpiBf2 E{(bf16*)(p.ws + WS_Y), 1024, PB, 1024, 4};
                   pg8::gemm_phase<pg8::EpiBf2, SO, true, true>(lds, g, S, E); } PH_END
        PH_BEGIN(5) ph_rw_prep(p, l, lds); PH_END
        PH_BEGIN(6) { const int bid = BID;
#ifdef PROBE_G
                   const unsigned tq0 = (unsigned)__builtin_amdgcn_s_memrealtime();
#endif
                   for (int task = bid; task < 256; task += NBLK) {
                       if (task < 128) scan_phase<0>(task, SB, PB, (void*)(SB + RW_Y), p.in[25] + l * 256, nullptr, lds);
                       else scan_phase<1>(task - 128, SB, PB, (void*)(SB + RT_Y), nullptr, p.in[35] + l * 8, lds);
                       __syncthreads(); }
#ifdef PROBE_G
                   if (tid_opq() == 0) { const unsigned tq1 = (unsigned)__builtin_amdgcn_s_memrealtime(); if (bid == 0) misc[16 + 5] += tq1 - tq0; if (bid == 128) misc[16 + 6] += tq1 - tq0; }
#endif
                   } PH_END
        PH_BEGIN(7) ph_rw_post(p, l); ph_ret_post(p); PH_END
        PH_BEGIN(12) { pg8::Gemm g{U, WB + WO_WP, RT, 1280, 1024}; SO S; S.init(RT, 1280, NBLK, BID);
                   pg8::EpiBf2 E{PB, 512, (bf16*)(SB + HY_P), 768, 2};
                   pg8::gemm_phase<pg8::EpiBf2, SO, true, true>(lds, g, S, E); } PH_END
        PH_BEGIN(13) ph_lru_prep(p, l, lds); PH_END
        PH_BEGIN(14) ph_lru_agg(p); ph_hy_filter(p, l, wctx, lds); PH_END
        PH_BEGIN(15) ph_lru_fin(p, lds); PH_END
        PH_BEGIN(19) ph_hy_prep(p, l, wctx, lds); PH_END
        PH_BEGIN(20) ph_hy_conv(p, l, wctx, lds); PH_END
        PH_BEGIN(32) ph_hy_post(p, wctx, lds); PH_END
        PH_BEGIN(21) { pg8::Gemm g{U + (size_t)ro * 1024, WB + WO_WG, Mpost, 4096, 1024}; SO S; S.init(Mpost, 4096, NBLK, BID); pg8::EpiBf<1> E{GH + (size_t)ro * 4096, 4096};
                   pg8::gemm_phase<pg8::EpiBf<1>, SO, true, true>(lds, g, S, E); } PH_END
#ifdef HOST_EMU
#define MERGE_LOCAL_SEAM() __syncthreads()
#else
#define MERGE_LOCAL_SEAM() do { asm volatile("s_waitcnt vmcnt(0)" ::: "memory"); __syncthreads(); __builtin_amdgcn_fence(__ATOMIC_ACQUIRE, "agent"); asm volatile("s_waitcnt vmcnt(0)" ::: "memory"); __syncthreads(); } while (0)
#endif
        PH_BEGIN(22) {
            { pg8::Gemm g{(const bf16*)(p.ws + WS_Y + 0 * SZ17) + (size_t)ro * 256, WB + WO_BR + (size_t)0 * 1024 * 256, Mpost, 1024, 256}; SO S; S.init(Mpost, 1024, NBLK, BID);
              pg8::EpiMerge E{GH + (size_t)ro * 4096, 4096, 0, U + (size_t)ro * 1024, 1}; pg8::gemm_phase<pg8::EpiMerge, SO, true, true>(lds, g, S, E); }
            MERGE_LOCAL_SEAM();
            { pg8::Gemm g{(const bf16*)(p.ws + WS_Y + 1 * SZ17) + (size_t)ro * 256, WB + WO_BR + (size_t)1 * 1024 * 256, Mpost, 1024, 256}; SO S; S.init(Mpost, 1024, NBLK, BID);
              pg8::EpiMerge E{GH + (size_t)ro * 4096, 4096, 1024, U + (size_t)ro * 1024, 0}; pg8::gemm_phase<pg8::EpiMerge, SO, true, true>(lds, g, S, E); }
            MERGE_LOCAL_SEAM();
            { pg8::Gemm g{(const bf16*)(p.ws + WS_Y + 2 * SZ17) + (size_t)ro * 256, WB + WO_BR + (size_t)2 * 1024 * 256, Mpost, 1024, 256}; SO S; S.init(Mpost, 1024, NBLK, BID);
              pg8::EpiMerge E{GH + (size_t)ro * 4096, 4096, 2048, U + (size_t)ro * 1024, 0}; pg8::gemm_phase<pg8::EpiMerge, SO, true, true>(lds, g, S, E); }
            MERGE_LOCAL_SEAM();
            { pg8::Gemm g{(const bf16*)(p.ws + WS_Y + 3 * SZ17) + (size_t)ro * 256, WB + WO_BR + (size_t)3 * 1024 * 256, Mpost, 1024, 256}; SO S; S.init(Mpost, 1024, NBLK, BID);
              pg8::EpiMerge E{GH + (size_t)ro * 4096, 4096, 3072, U + (size_t)ro * 1024, 0}; pg8::gemm_phase<pg8::EpiMerge, SO, true, true>(lds, g, S, E); }
        } PH_END
        PH_BEGIN(27) { pg8::Gemm g{U + (size_t)ro * 1024, WB + WO_WO, Mpost, 1024, 1024}; SO S; S.init(Mpost, 1024, NBLK, BID);
                   pg8::EpiResid E{xc_src, xl_src, XC, p.out, modl, 2 * 1024, ro};
                   pg8::gemm_phase<pg8::EpiResid, SO, true, true>(lds, g, S, E); } PH_END
        PH_BEGIN(28) ph_norm(p, l, 1, XC, p.out, ro); PH_END
        PH_BEGIN(29) { pg8::Gemm g{U + (size_t)ro * 1024, WB + WO_W1, Mpost, 5632, 1024}; SO S; S.init(Mpost, 5632, NBLK, BID); pg8::EpiSwiglu E{ACT + (size_t)ro * 2816, 2816};
                   pg8::gemm_phase<pg8::EpiSwiglu, SO, true, true>(lds, g, S, E); } PH_END
        PH_BEGIN(30) { pg8::Gemm g{ACT + (size_t)ro * 2816, WB + WO_W2, Mpost, 1024, 2816}; SO S; S.init(Mpost, 1024, NBLK, BID);
                   pg8::EpiResid E{XC, p.out, XC, p.out, modl, 5 * 1024, ro};
                   pg8::gemm_phase<pg8::EpiResid, SO, true, true>(lds, g, S, E); }
                   if (!last && NBLK == 256 && BID >= 32) { __syncthreads(); ph_cvt(p, l + 1, lds, 1, 32); }
        PH_END
    }
    { const int l = 1; PH_BEGIN(31) ph_final(p); PH_END }
#ifdef PROBE_G
    if (blockIdx.x == (PROBE_G == 6 ? 128 : 0) && tid_opq() == 0) { const unsigned t0 = (unsigned)__builtin_amdgcn_s_memrealtime(); const unsigned w = misc[16 + PROBE_G] * 4u; while ((unsigned)__builtin_amdgcn_s_memrealtime() - t0 < w) __builtin_amdgcn_s_sleep(8); }
#endif
#undef PH_BEGIN
#undef PH_END
}

#ifndef HOST_EMU
#define SITE(k) (1u << (k))
#if MK_PER_PHASE
constexpr int NG = 19;
constexpr unsigned GM[NG] = {
    SITE(0) | SITE(1) | SITE(2) | SITE(3) | SITE(28) | SITE(31) | SITE(7) | SITE(15) | SITE(18) | SITE(19),
    SITE(5),
    SITE(6),
    SITE(13) | SITE(14),
    SITE(17) | SITE(20),
    SITE(4), SITE(8), SITE(12), SITE(16), SITE(21), SITE(24), SITE(22), SITE(23), SITE(25), SITE(26), SITE(27), SITE(30), SITE(29), 0u };
#else
constexpr int NG = 1;
constexpr unsigned GM[NG] = {0xFFFFFFFFu};
#endif
template <int G> static bool prep_group() { return hipFuncSetAttribute((const void*)fwd<GM[G]>, hipFuncAttributeMaxDynamicSharedMemorySize, LDS_BYTES) == hipSuccess; }
template <int G> static void launch_group(int grid, hipStream_t stream, const Prm& p) { hipLaunchKernelGGL(fwd<GM[G]>, dim3(grid), dim3(NTHR), LDS_BYTES, stream, p); }

extern "C" void kernel_launch(void* const* d_in, const int* in_sizes, int n_in, void* d_out, int out_size, void* d_ws, size_t ws_size, hipStream_t stream) {
    static int grid = 0;
    if (grid == 0) {
        if (n_in != 41 || out_size != RL * D || ws_size < WS_END) { fprintf(stderr, "kernel_launch: unexpected shapes (n_in %d out %d ws %zu); nothing launched\n", n_in, out_size, ws_size); grid = -1; return; }
        int dev = 0, cus = 0;
        if (hipGetDevice(&dev) != hipSuccess || hipDeviceGetAttribute(&cus, hipDeviceAttributeMultiprocessorCount, dev) != hipSuccess) { grid = -1; return; }
        bool ok = true;
#if MK_PER_PHASE
        ok = ok && prep_group<0>() && prep_group<1>() && prep_group<2>() && prep_group<3>() && prep_group<4>() && prep_group<5>() && prep_group<6>() && prep_group<7>() && prep_group<8>() && prep_group<9>()
                && prep_group<10>() && prep_group<11>() && prep_group<12>() && prep_group<13>() && prep_group<14>() && prep_group<15>() && prep_group<16>() && prep_group<17>();
#else
        ok = prep_group<0>();
#endif
        if (!ok) { fprintf(stderr, "kernel_launch: hipFuncSetAttribute failed\n"); grid = -1; return; }
        (void)hipGetLastError();
        grid = cus > 0 ? cus : 256;
    }
    if (grid < 0) return;
    if (hipMemsetAsync((char*)d_ws + WS_CTL, 0, 1 * MiB, stream) != hipSuccess) return;
    Prm p{};
    for (int i = 0; i < 41; ++i) p.in[i] = (const float*)d_in[i];
    p.out = (float*)d_out; p.ws = (unsigned char*)d_ws;
#if MK_PER_PHASE
    for (int ph = 0; ph < NPH; ++ph) {
        p.lo = ph; p.hi = ph + 1;
        static const int layer_sites[PPL] = {2, 4, 5, 6, 7, 12, 13, 14, 15, 19, 20, 0  , 21, 22, 27, 28, 29, 30};
        const int k = (ph == 0) ? 1 : (ph == NPH - 1) ? 31 : layer_sites[(ph - 1) % PPL];
        int g = -1;
        for (int q = 0; q < NG; ++q) if ((GM[q] >> k) & 1u) g = q;
        switch (g) {
            case 0: launch_group<0>(grid, stream, p); break; case 1: launch_group<1>(grid, stream, p); break; case 2: launch_group<2>(grid, stream, p); break;
            case 3: launch_group<3>(grid, stream, p); break; case 4: launch_group<4>(grid, stream, p); break; case 5: launch_group<5>(grid, stream, p); break;
            case 6: launch_group<6>(grid, stream, p); break; case 7: launch_group<7>(grid, stream, p); break; case 8: launch_group<8>(grid, stream, p); break;
            case 9: launch_group<9>(grid, stream, p); break; case 10: launch_group<10>(grid, stream, p); break; case 11: launch_group<11>(grid, stream, p); break;
            case 12: launch_group<12>(grid, stream, p); break; case 13: launch_group<13>(grid, stream, p); break; case 14: launch_group<14>(grid, stream, p); break;
            case 15: launch_group<15>(grid, stream, p); break; case 16: launch_group<16>(grid, stream, p); break; case 17: launch_group<17>(grid, stream, p); break;
            default: break; }
#ifdef DIAG_BUILD
        { static const int dg[8][2] = {{0, 0}, {2, 1}, {10, 2}, {14, 3}, {20, 4}, {22, 5}, {26, 6}, {28, 7}};
          for (int q = 0; q < 8; ++q) if (ph == 1 + dg[q][0]) hipLaunchKernelGGL(diag_k, dim3(32), dim3(NTHR), 0, stream, p, dg[q][1]);
          if (ph == 1 + 19) hipLaunchKernelGGL(diag_k, dim3(32), dim3(NTHR), 0, stream, p, 8);
          if (ph == NPH - 1) hipLaunchKernelGGL(diag_out_k, dim3(grid), dim3(NTHR), 0, stream, p); }
#endif
    }
#else
    p.lo = 0; p.hi = NPH;
    launch_group<0>(grid, stream, p);
#endif
}
#endif
```

```cpp
#include <hip/hip_runtime.h>
#include <cstdio>
#include <cstdint>

#ifndef SEQ_
#define SEQ_ 4096
#define CTXL_ 256
#endif
#ifndef MK_PER_PHASE
#define MK_PER_PHASE 0
#endif

#ifndef HOST_EMU
extern __shared__ __attribute__((aligned(16))) unsigned char g_dyn_lds[];
constexpr int TIDTAB_OFF = 147456 - 2048;
__device__ __forceinline__ unsigned hw_slot() { return (unsigned)__builtin_amdgcn_s_getreg((7 << 11) | 4) & 0xFFu; }
__device__ __forceinline__ int tid_opq() {
    const unsigned w = ((const volatile __attribute__((address_space(3))) unsigned*)((__attribute__((address_space(3))) unsigned char*)g_dyn_lds + TIDTAB_OFF))[hw_slot()];
    unsigned lane; asm volatile("v_mbcnt_lo_u32_b32 %0, -1, 0\n\tv_mbcnt_hi_u32_b32 %0, -1, %0" : "=v"(lane));
    int t = (int)((unsigned)__builtin_amdgcn_readfirstlane((int)w) * 64u + lane); asm volatile("" : "+v"(t)); return t;
}
#endif

namespace pg8 {
#define PG8_LAS __attribute__((address_space(3)))
typedef unsigned short bf16_t;
typedef short bf16x8 __attribute__((ext_vector_type(8)));
typedef float f32x4 __attribute__((ext_vector_type(4)));
typedef unsigned u32x4 __attribute__((ext_vector_type(4)));
constexpr int BM = 256, BK = 64, HALF = 128, HTB = HALF * BK * 2  , STAGE_BYTES = 8 * HTB, NXCD = 8, WGM = 8;

__host__ __device__ __forceinline__ int lds_byte(int r, int c) { const int st = (r >> 4) * 2 + (c >> 5), rr = r & 15, cc = c & 31, ob = rr * 64 + cc * 2; return st * 1024 + (ob ^ (((ob >> 9) & 1) << 5)); }
__host__ __device__ __forceinline__ void stage_rc(int b, int& R, int& C) { const int st = b / 1024, sb = b % 1024, swz = sb ^ (((sb >> 9) & 1) << 5); R = (st >> 1) * 16 + swz / 64; C = (st & 1) * 32 + (swz % 64) / 2; }
__host__ __device__ __forceinline__ int perm32(int rho) { const int n = rho >> 4, i = rho & 15; return 8 * (i >> 2) + 4 * n + (i & 3); }

struct Unit { int pm, pn; };
struct Gemm { const bf16_t* A; const bf16_t* Bt; int M, N, K; };

struct StaticOrder {
    int nM, nN, nwg, G, c;
    __host__ __device__ void init(int M, int N, int G_, int c_) { nM = M / BM; nN = N / BM; nwg = nM * nN; G = G_; c = c_; }
    __host__ __device__ bool next(int i, Unit& u) const {
        const long L = (long)i * G + c; if (L >= nwg) return false;
        int wgid = (int)L; { const int q = nwg / NXCD, r = nwg % NXCD, xcd = wgid % NXCD, off = wgid / NXCD; wgid = (xcd < r ? xcd * (q + 1) : r * (q + 1) + (xcd - r) * q) + off; }
        const int nig = WGM * nN, gid = wgid / nig, fm = gid * WGM, gsz = (nM - fm) < WGM ? (nM - fm) : WGM;
        u.pm = fm + ((wgid % nig) % gsz); u.pn = (wgid % nig) / gsz; return true;
    }
    __device__ __forceinline__ void a_ready(const Unit&) const {}
    __device__ __forceinline__ void done(const Unit&) const {}
};

#ifdef HOST_EMU
__device__ __forceinline__ unsigned cvt_pk_bf16(float lo, float hi) { auto f = [](float x) { unsigned u; memcpy(&u, &x, 4); return (u + 0x7fffu + ((u >> 16) & 1u)) >> 16; }; return f(lo) | (f(hi) << 16); }
#else
typedef __bf16 pg8_bf16x2 __attribute__((ext_vector_type(2)));
typedef float pg8_f32x2 __attribute__((ext_vector_type(2)));
__device__ __forceinline__ unsigned cvt_pk_bf16(float lo, float hi) { pg8_f32x2 v = {lo, hi}; pg8_bf16x2 b = __builtin_convertvector(v, pg8_bf16x2); return __builtin_bit_cast(unsigned, b); }
#endif
typedef float f32x2 __attribute__((ext_vector_type(2)));
__device__ __forceinline__ float bflo(unsigned u) { return __uint_as_float(u << 16); }
__device__ __forceinline__ float bfhi(unsigned u) { return __uint_as_float(u & 0xffff0000u); }
#ifdef HOST_EMU
__device__ __forceinline__ float fsigmoid(float x) { return 1.f / (1.f + expf(-x)); }
#else
__device__ __forceinline__ float fsigmoid(float x) { return __builtin_amdgcn_rcpf(1.f + __expf(-x)); }
#endif

#ifdef HOST_EMU
#define EPI_PIN() do { } while (0)
#define EPI_LATE(fr, fq) do { } while (0)
#define EPI_Z(z) do { } while (0)
#else
#define EPI_Z(z) asm volatile("" : "+v"(z))
#define EPI_LATE(fr, fq) asm volatile("" : "+v"(fr), "+v"(fq))

#define EPI_PIN() asm volatile("" ::: "memory")
#endif
template <int ACT> struct EpiBf {
    static constexpr bool PERM = true, AFTER_DRAIN = false;
    bf16_t* O; int ldc;
    __device__ __forceinline__ void operator()(const f32x4 (&acc)[2][2][4][2], const Unit& u, int wr, int wc, int fr, int fq) const {
        EPI_LATE(fr, fq);
        const int row0 = u.pm * BM + wr * 64 + fr, col0 = u.pn * BM + wc * 32 + 8 * fq;
#pragma unroll
        for (int ai = 0; ai < 2; ++ai)
#pragma unroll
            for (int m = 0; m < 4; ++m) { bf16_t* rowp = O + (size_t)(row0 + ai * HALF + m * 16) * ldc + col0;
#pragma unroll
                for (int bj = 0; bj < 2; ++bj) { f32x4 v0 = acc[ai][bj][m][0], v1 = acc[ai][bj][m][1];
                    if (ACT == 1) {
#pragma unroll
                        for (int j = 0; j < 4; ++j) { v0[j] = fsigmoid(v0[j]); v1[j] = fsigmoid(v1[j]); } }
                    u32x4 w; w.x = cvt_pk_bf16(v0[0], v0[1]); w.y = cvt_pk_bf16(v0[2], v0[3]); w.z = cvt_pk_bf16(v1[0], v1[1]); w.w = cvt_pk_bf16(v1[2], v1[3]);
                    *(u32x4*)(rowp + bj * HALF) = w; } }
    }
};

struct EpiBf2 {
    static constexpr bool PERM = true, AFTER_DRAIN = false;
    bf16_t* O1; int ld1; bf16_t* O2; int ld2; int split;
    __device__ __forceinline__ void operator()(const f32x4 (&acc)[2][2][4][2], const Unit& u, int wr, int wc, int fr, int fq) const {
        EPI_LATE(fr, fq);
        const bool first = u.pn < split;
        bf16_t* O = first ? O1 : O2; const int ldc = first ? ld1 : ld2;
        const int row0 = u.pm * BM + wr * 64 + fr, col0 = (first ? u.pn : u.pn - split) * BM + wc * 32 + 8 * fq;
#pragma unroll
        for (int ai = 0; ai < 2; ++ai)
#pragma unroll
            for (int m = 0; m < 4; ++m) { bf16_t* rowp = O + (size_t)(row0 + ai * HALF + m * 16) * ldc + col0;
#pragma unroll
                for (int bj = 0; bj < 2; ++bj) { const f32x4 v0 = acc[ai][bj][m][0], v1 = acc[ai][bj][m][1];
                    u32x4 w; w.x = cvt_pk_bf16(v0[0], v0[1]); w.y = cvt_pk_bf16(v0[2], v0[3]); w.z = cvt_pk_bf16(v1[0], v1[1]); w.w = cvt_pk_bf16(v1[2], v1[3]);
                    *(u32x4*)(rowp + bj * HALF) = w; } }
    }
};

struct EpiMerge {
    static constexpr bool PERM = true, AFTER_DRAIN = false;
    const bf16_t* G; int ldg; int gcol0; bf16_t* Mg; int first;
    __device__ __forceinline__ void operator()(const f32x4 (&acc)[2][2][4][2], const Unit& u, int wr, int wc, int fr, int fq) const {
        EPI_LATE(fr, fq);
        const int row0 = u.pm * BM + wr * 64 + fr, col0 = u.pn * BM + wc * 32 + 8 * fq;
#pragma unroll
        for (int ai = 0; ai < 2; ++ai)
#pragma unroll
            for (int m = 0; m < 4; ++m) { const size_t row = (size_t)(row0 + ai * HALF + m * 16);
#pragma unroll
                for (int bj = 0; bj < 2; ++bj) { const int col = col0 + bj * HALF;
                    const u32x4 gv = *(const u32x4*)(G + row * ldg + gcol0 + col);
                    bf16_t* mp = Mg + row * 1024 + col;
                    u32x4 pv; if (!first) pv = *(const u32x4*)mp; else { unsigned z0 = 0u; EPI_Z(z0); pv = (u32x4){z0, z0, z0, z0}; }
                    const f32x4 v0 = acc[ai][bj][m][0], v1 = acc[ai][bj][m][1];
                    float o[8];
                    o[0] = bflo(pv.x) + bflo(gv.x) * v0[0]; o[1] = bfhi(pv.x) + bfhi(gv.x) * v0[1];
                    o[2] = bflo(pv.y) + bflo(gv.y) * v0[2]; o[3] = bfhi(pv.y) + bfhi(gv.y) * v0[3];
                    o[4] = bflo(pv.z) + bflo(gv.z) * v1[0]; o[5] = bfhi(pv.z) + bfhi(gv.z) * v1[1];
                    o[6] = bflo(pv.w) + bflo(gv.w) * v1[2]; o[7] = bfhi(pv.w) + bfhi(gv.w) * v1[3];
                    u32x4 w; w.x = cvt_pk_bf16(o[0], o[1]); w.y = cvt_pk_bf16(o[2], o[3]); w.z = cvt_pk_bf16(o[4], o[5]); w.w = cvt_pk_bf16(o[6], o[7]);
                    *(u32x4*)mp = w; }
                EPI_PIN(); }
    }
};

struct EpiResid {
    static constexpr bool PERM = false, AFTER_DRAIN = false;
    const float* src_c; const float* src_l; float* dst_c; float* dst_l; const float* modl; int gate_off; int row_off;
    __device__ __forceinline__ void operator()(const f32x4 (&acc)[2][2][4][2], const Unit& u, int wr, int wc, int fr, int fq) const {
        EPI_LATE(fr, fq);
        const int grow0 = row_off + u.pm * BM;
        const bool isctx = grow0 < 8 * CTXL_;
        const int jb = isctx ? 8 : (grow0 - 8 * CTXL_) / SEQ_;
        const float* gate = modl + (size_t)jb * 6144 + gate_off;
        const float* src = isctx ? src_c + (size_t)grow0 * 1024 : src_l + (size_t)(grow0 - 8 * CTXL_) * 1024;
        float* dst = isctx ? dst_c + (size_t)grow0 * 1024 : dst_l + (size_t)(grow0 - 8 * CTXL_) * 1024;
        const int rr0 = wr * 64 + fr, col0 = u.pn * BM + wc * 32 + 4 * fq;
        f32x4 gv[2][2];
#pragma unroll
        for (int bj = 0; bj < 2; ++bj)
#pragma unroll
            for (int n = 0; n < 2; ++n) gv[bj][n] = *(const f32x4*)(gate + col0 + bj * HALF + n * 16);
#pragma unroll
        for (int ai = 0; ai < 2; ++ai)
#pragma unroll
            for (int m = 0; m < 4; ++m) { const size_t ro = (size_t)(rr0 + ai * HALF + m * 16) * 1024 + col0;
#pragma unroll
                for (int bj = 0; bj < 2; ++bj)
#pragma unroll
                    for (int n = 0; n < 2; ++n) { const f32x4 s = *(const f32x4*)(src + ro + bj * HALF + n * 16);
                        *(f32x4*)(dst + ro + bj * HALF + n * 16) = s + gv[bj][n] * acc[ai][bj][m][n]; }
                EPI_PIN(); }
    }
};

struct EpiSwiglu {
    static constexpr bool PERM = true, AFTER_DRAIN = false;
    bf16_t* O; int ldc;
    __device__ __forceinline__ void operator()(const f32x4 (&acc)[2][2][4][2], const Unit& u, int wr, int wc, int fr, int fq) const {
        EPI_LATE(fr, fq);
        const int row0 = u.pm * BM + wr * 64 + fr, col0 = u.pn * HALF + wc * 32 + 8 * fq;
#pragma unroll
        for (int ai = 0; ai < 2; ++ai)
#pragma unroll
            for (int m = 0; m < 4; ++m) { bf16_t* rowp = O + (size_t)(row0 + ai * HALF + m * 16) * ldc + col0;
                float o[8];
#pragma unroll
                for (int n = 0; n < 2; ++n)
#pragma unroll
                    for (int j = 0; j < 4; ++j) { const float g = acc[ai][0][m][n][j], up = acc[ai][1][m][n][j]; o[n * 4 + j] = g * fsigmoid(g) * up; }
                u32x4 w; w.x = cvt_pk_bf16(o[0], o[1]); w.y = cvt_pk_bf16(o[2], o[3]); w.z = cvt_pk_bf16(o[4], o[5]); w.w = cvt_pk_bf16(o[6], o[7]);
                *(u32x4*)rowp = w; }
    }
};

template <class Epi, class Sched, bool ALIGN_EPI = false, bool SP2 = false>
__device__ __forceinline__ void gemm_phase(PG8_LAS unsigned char* lds, const Gemm g, const Sched& S, const Epi& E) {
    const int tid = tid_opq();
    const int wid = __builtin_amdgcn_readfirstlane(tid >> 6), lane = tid & 63, wr = wid >> 2, wc = wid & 3, fr = lane & 15, fq = lane >> 4;
    const int K = g.K, nt = K / BK;
    unsigned voffA, voffB;
    { int R, C; stage_rc(tid * 16, R, C); const int Rb = Epi::PERM ? ((R & ~31) + perm32(R & 31)) : R;
      voffA = (unsigned)(R * K + C) * 2u; voffB = (unsigned)(Rb * K + C) * 2u; }
    const size_t r64 = (size_t)64 * K * 2;
    const size_t kstep = (size_t)(BK * 2);
    const size_t hstep = (size_t)HALF * K * 2;
    const size_t tstep = 2 * hstep;
    const unsigned ldsw = (unsigned)wid * 1024u;
    const int aoff = lds_byte(wr * 64 + fr, fq * 8), boff = lds_byte(wc * 32 + fr, fq * 8);
#define PG8_SA(b, h) (((b) * 2 + (h)) * HTB)
#define PG8_SB(b, h) ((4 + (b) * 2 + (h)) * HTB)
#define PG8_STAGE(bufoff, gbase, voff) do { _Pragma("unroll") for (int _i = 0; _i < 2; ++_i) \
        __builtin_amdgcn_global_load_lds((const unsigned*)((const char*)(gbase) + (size_t)_i * r64 + (voff)), (PG8_LAS unsigned*)(lds + (bufoff) + ldsw + _i * 8192), 16, 0, 0); } while (0)
#define PG8_LDA(dst, b, h) do { _Pragma("unroll") for (int m = 0; m < 4; ++m) _Pragma("unroll") for (int k = 0; k < 2; ++k) dst[m][k] = *(const PG8_LAS bf16x8*)(lds + PG8_SA(b, h) + aoff + m * 2048 + k * 1024); } while (0)
#define PG8_LDB(dst, b, h) do { _Pragma("unroll") for (int n = 0; n < 2; ++n) _Pragma("unroll") for (int k = 0; k < 2; ++k) dst[n][k] = *(const PG8_LAS bf16x8*)(lds + PG8_SB(b, h) + boff + n * 2048 + k * 1024); } while (0)
#define PG8_MMA(ai, bj, At, Bt) do { __builtin_amdgcn_s_setprio(1); _Pragma("unroll") for (int m = 0; m < 4; ++m) _Pragma("unroll") for (int n = 0; n < 2; ++n) _Pragma("unroll") for (int k = 0; k < 2; ++k) \
        acc[ai][bj][m][n] = __builtin_amdgcn_mfma_f32_16x16x32_bf16(Bt[n][k], At[m][k], acc[ai][bj][m][n], 0, 0, 0); __builtin_amdgcn_s_setprio(0); } while (0)
#define PG8_WAIT_V(n) asm volatile("s_waitcnt vmcnt(" #n ")" ::: "memory")
#define PG8_WAIT_L(n) asm volatile("s_waitcnt lgkmcnt(" #n ")" ::: "memory")
#define PG8_BAR __builtin_amdgcn_s_barrier()
#define PG8_SCHED __builtin_amdgcn_sched_barrier(0)
    Unit cur, nxt; int ui = 0;
    if (!S.next(0, cur)) return;
    f32x4 acc[2][2][4][2];
    { float zf = 0.f; asm volatile("" : "+v"(zf));
#pragma unroll
    for (int a = 0; a < 2; ++a)
#pragma unroll
        for (int b = 0; b < 2; ++b)
#pragma unroll
            for (int m = 0; m < 4; ++m)
#pragma unroll
                for (int n = 0; n < 2; ++n) acc[a][b][m][n] = (f32x4){zf, zf, zf, zf}; }
    bf16x8 At[4][2], B0[2][2], B1[2][2];
    const char* cA = (const char*)g.A + (size_t)cur.pm * tstep; const char* cB = (const char*)g.Bt + (size_t)cur.pn * tstep;
    S.a_ready(cur);
    if constexpr (SP2) {
        PG8_STAGE(PG8_SB(0, 0), cB, voffB); PG8_STAGE(PG8_SB(0, 1), cB + hstep, voffB); PG8_STAGE(PG8_SA(0, 0), cA, voffA); PG8_STAGE(PG8_SA(0, 1), cA + hstep, voffA);
        if (wr == 1) PG8_BAR;
        PG8_WAIT_V(2); PG8_BAR;
        PG8_STAGE(PG8_SB(1, 0), cB + kstep, voffB); PG8_STAGE(PG8_SA(1, 0), cA + kstep, voffA); PG8_STAGE(PG8_SB(1, 1), cB + hstep + kstep, voffB);
        PG8_WAIT_V(6); PG8_BAR;
    } else {
        PG8_STAGE(PG8_SB(0, 0), cB, voffB); PG8_STAGE(PG8_SA(0, 0), cA, voffA); PG8_STAGE(PG8_SB(0, 1), cB + hstep, voffB); PG8_STAGE(PG8_SA(0, 1), cA + hstep, voffA);
        if (wr == 1) PG8_BAR;
        PG8_WAIT_V(4); PG8_BAR;
        PG8_STAGE(PG8_SB(1, 0), cB + kstep, voffB); PG8_STAGE(PG8_SA(1, 0), cA + kstep, voffA); PG8_STAGE(PG8_SB(1, 1), cB + hstep + kstep, voffB);
        PG8_WAIT_V(6); PG8_BAR;
    }
    for (;;) {
        const bool has_next = S.next(ui + 1, nxt);
        const char* nA = has_next ? (const char*)g.A + (size_t)nxt.pm * tstep : cA; const char* nB = has_next ? (const char*)g.Bt + (size_t)nxt.pn * tstep : cB;
        for (int t = 0; t < nt; t += 2) {
            const bool last = (t == nt - 2);
            const char* a1 = cA + (size_t)(t + 1) * kstep;
            const char* a2 = last ? nA : cA + (size_t)(t + 2) * kstep; const char* b2 = last ? nB : cB + (size_t)(t + 2) * kstep;
            const char* a3 = a2 + kstep; const char* b3 = b2 + kstep;
            if (last && has_next) S.a_ready(nxt);
            if constexpr (SP2) {
            PG8_LDB(B0, 0, 0); PG8_LDB(B1, 0, 1); PG8_SCHED; PG8_LDA(At, 0, 0); PG8_STAGE(PG8_SA(1, 1), a1 + hstep, voffA);
            PG8_WAIT_V(8); PG8_WAIT_L(0); PG8_BAR; PG8_MMA(0, 0, At, B0); PG8_MMA(0, 1, At, B1); PG8_BAR; PG8_SCHED;
            PG8_LDA(At, 0, 1); PG8_STAGE(PG8_SB(0, 0), b2, voffB); PG8_STAGE(PG8_SB(0, 1), b2 + hstep, voffB); PG8_STAGE(PG8_SA(0, 0), a2, voffA);
            PG8_WAIT_V(8); PG8_WAIT_L(0); PG8_BAR; PG8_MMA(1, 0, At, B0); PG8_MMA(1, 1, At, B1); PG8_BAR; PG8_SCHED;
            PG8_LDB(B0, 1, 0); PG8_LDB(B1, 1, 1); PG8_SCHED; PG8_LDA(At, 1, 0); PG8_STAGE(PG8_SA(0, 1), a2 + hstep, voffA);
            PG8_WAIT_V(8); PG8_WAIT_L(0); PG8_BAR; PG8_MMA(0, 0, At, B0); PG8_MMA(0, 1, At, B1); PG8_BAR; PG8_SCHED;
            PG8_LDA(At, 1, 1); PG8_STAGE(PG8_SB(1, 0), b3, voffB); PG8_STAGE(PG8_SB(1, 1), b3 + hstep, voffB); PG8_STAGE(PG8_SA(1, 0), a3, voffA);
            PG8_WAIT_V(8); PG8_WAIT_L(0); PG8_BAR; PG8_MMA(1, 0, At, B0); PG8_MMA(1, 1, At, B1); PG8_BAR; PG8_SCHED;
            } else {
            PG8_LDB(B0, 0, 0); PG8_SCHED; PG8_LDA(At, 0, 0); PG8_STAGE(PG8_SA(1, 1), a1 + hstep, voffA);
            PG8_WAIT_L(8); PG8_BAR; PG8_WAIT_L(0); PG8_MMA(0, 0, At, B0); PG8_BAR; PG8_SCHED;
            PG8_LDB(B1, 0, 1); PG8_STAGE(PG8_SB(0, 0), b2, voffB);
            PG8_BAR; PG8_WAIT_L(0); PG8_MMA(0, 1, At, B1); PG8_BAR;
            PG8_LDA(At, 0, 1); PG8_STAGE(PG8_SA(0, 0), a2, voffA);
            PG8_BAR; PG8_WAIT_L(0); PG8_MMA(1, 0, At, B0); PG8_BAR; PG8_SCHED;
            PG8_STAGE(PG8_SB(0, 1), b2 + hstep, voffB);
            PG8_WAIT_V(6); PG8_BAR; PG8_MMA(1, 1, At, B1); PG8_BAR;
            PG8_LDB(B0, 1, 0); PG8_SCHED; PG8_LDA(At, 1, 0); PG8_STAGE(PG8_SA(0, 1), a2 + hstep, voffA);
            PG8_WAIT_L(8); PG8_BAR; PG8_WAIT_L(0); PG8_MMA(0, 0, At, B0); PG8_BAR; PG8_SCHED;
            PG8_LDB(B1, 1, 1); PG8_STAGE(PG8_SB(1, 0), b3, voffB);
            PG8_BAR; PG8_WAIT_L(0); PG8_MMA(0, 1, At, B1); PG8_BAR;
            PG8_LDA(At, 1, 1); PG8_STAGE(PG8_SA(1, 0), a3, voffA);
            PG8_BAR; PG8_WAIT_L(0); PG8_MMA(1, 0, At, B0); PG8_BAR; PG8_SCHED;
            PG8_STAGE(PG8_SB(1, 1), b3 + hstep, voffB);
            PG8_WAIT_V(6); PG8_BAR; PG8_MMA(1, 1, At, B1); PG8_BAR;
            }
        }
        if constexpr (ALIGN_EPI) { if (wr == 0) PG8_BAR; }
        if constexpr (!Epi::AFTER_DRAIN) { E(acc, cur, wr, wc, fr, fq); S.done(cur); }
        if (!has_next) break;
{ float zf = 0.f; asm volatile("" : "+v"(zf));
#pragma unroll
        for (int a = 0; a < 2; ++a)
#pragma unroll
            for (int b = 0; b < 2; ++b)
#pragma unroll
                for (int m = 0; m < 4; ++m)
#pragma unroll
                    for (int n = 0; n < 2; ++n) acc[a][b][m][n] = (f32x4){zf, zf, zf, zf}; }
        cur = nxt; cA = nA; cB = nB; ++ui;
        if constexpr (ALIGN_EPI) { if (wr == 1) PG8_BAR; }
    }
    PG8_WAIT_V(0);
    if constexpr (!ALIGN_EPI) { if (wr == 0) PG8_BAR; }
    PG8_BAR;
    if constexpr (Epi::AFTER_DRAIN) { E.fused(acc, cur, wr, wc, fr, fq, lds, wid, lane); S.done(cur); }
#undef PG8_SA
#undef PG8_SB
#undef PG8_STAGE
#undef PG8_LDA
#undef PG8_LDB
#undef PG8_MMA
#undef PG8_WAIT_V
#undef PG8_WAIT_L
#undef PG8_BAR
#undef PG8_SCHED
}
}

#ifndef LAS
#define LAS __attribute__((address_space(3)))
#endif
#ifdef HOST_EMU
#define PAS
#else
#define PAS __attribute__((address_space(4)))
#endif
typedef unsigned short bf16;
typedef float f32x4 __attribute__((ext_vector_type(4)));
typedef unsigned v4u __attribute__((ext_vector_type(4)));
typedef unsigned v2u __attribute__((ext_vector_type(2)));
typedef float cf2 __attribute__((ext_vector_type(2)));

#ifndef SEQ_
#define SEQ_ 4096
#define CTXL_ 256
#endif
constexpr int D = 1024, NB = 8, SEQ = SEQ_, CTXL = CTXL_, DEPTH = 4;
constexpr int RC = NB * CTXL;
constexpr int RL = NB * SEQ;
constexpr int RT = RC + RL;
constexpr int NIN = 7360, DFF = 2816;
constexpr int NTHR = 512, NWAVES = 8;
constexpr int LDS_BYTES = 147456;

constexpr size_t MiB = (size_t)1 << 20;
constexpr size_t WS_CTL = 0;
constexpr size_t WS_MOD = 1 * MiB;
constexpr size_t WS_W   = 2 * MiB;
constexpr size_t WS_XC  = 37 * MiB;
constexpr size_t WS_U   = 45 * MiB;
constexpr size_t WS_Y   = 113 * MiB;
constexpr size_t WS_BIG = 181 * MiB;
constexpr size_t WS_END = 505 * MiB;
constexpr size_t SZ17 = (size_t)RT * 256 * 2;
constexpr size_t SZ34 = (size_t)RT * 256 * 4;
constexpr size_t WO_WP = 0;
constexpr size_t WO_WG = WO_WP + (size_t)3328 * 1024;
constexpr size_t WO_BR = WO_WG + (size_t)4096 * 1024;
constexpr size_t WO_WO = WO_BR + (size_t)4 * 1024 * 256;
constexpr size_t WO_W1 = WO_WO + (size_t)1024 * 1024;
constexpr size_t WO_W2 = WO_W1 + (size_t)5632 * 1024;
static_assert((WO_W2 + (size_t)1024 * 2816) * 2 <= 35 * MiB, "weights region");
constexpr size_t BG_P = 0;
constexpr size_t BG_S = 68 * MiB;

struct Prm { const float* in[41]; float* out; unsigned char* ws; int lo, hi; };

__device__ __forceinline__ float bf2f(bf16 b) { return __uint_as_float(((unsigned)b) << 16); }
__device__ __forceinline__ bf16 f2bf(float f) { unsigned u = __float_as_uint(f); return (bf16)((u + 0x7fffu + ((u >> 16) & 1u)) >> 16); }
__device__ __forceinline__ unsigned pk2(float lo, float hi) { return (unsigned)f2bf(lo) | ((unsigned)f2bf(hi) << 16); }
__device__ __forceinline__ float blo(unsigned u) { return __uint_as_float(u << 16); }
__device__ __forceinline__ float bhi(unsigned u) { return __uint_as_float(u & 0xffff0000u); }
__device__ __forceinline__ float sigmoidf_(float x) { return 1.f / (1.f + __expf(-x)); }
__device__ __forceinline__ float softplusf_(float x) { return x > 20.f ? x : log1pf(__expf(x)); }
template <int CTRL> __device__ __forceinline__ float dpp_mov(float v) { return __int_as_float(__builtin_amdgcn_update_dpp(0, __float_as_int(v), CTRL, 0xF, 0xF, true)); }
__device__ __forceinline__ float row16_sum(float v) {
    v += dpp_mov<0xB1>(v);
    v += dpp_mov<0x4E>(v);
    v += dpp_mov<0x141>(v);
    v += dpp_mov<0x140>(v);
    return v;
}
#ifdef HOST_EMU
__device__ __forceinline__ float wave_sum(float v) {
#pragma unroll
    for (int o = 1; o < 64; o <<= 1) v += __shfl_xor(v, o);
    return v;
}
#else
__device__ __forceinline__ float wave_sum(float v) {
    v = row16_sum(v);
    v += __int_as_float(__builtin_amdgcn_ds_swizzle(__float_as_int(v), 0x401F));
    return __int_as_float(__builtin_amdgcn_readlane(__float_as_int(v), 0)) + __int_as_float(__builtin_amdgcn_readlane(__float_as_int(v), 32));
}
#endif

#ifdef HOST_EMU
static inline float sfma(float a, float b, float c) { return a * b + c; }
static inline float smul(float a, float b) { return a * b; }
static inline float sadd(float a, float b) { return a + b; }
static inline float ssub(float a, float b) { return a - b; }
#else
__device__ __forceinline__ float sfma(float a, float b, float c) { float d; asm("v_fma_f32 %0, %1, %2, %3" : "=v"(d) : "v"(a), "v"(b), "v"(c)); return d; }
__device__ __forceinline__ float smul(float a, float b) { float d; asm("v_mul_f32_e32 %0, %1, %2" : "=v"(d) : "v"(a), "v"(b)); return d; }
__device__ __forceinline__ float sadd(float a, float b) { float d; asm("v_add_f32_e32 %0, %1, %2" : "=v"(d) : "v"(a), "v"(b)); return d; }
__device__ __forceinline__ float ssub(float a, float b) { float d; asm("v_sub_f32_e32 %0, %1, %2" : "=v"(d) : "v"(a), "v"(b)); return d; }
#endif
#ifdef HOST_EMU
__device__ __forceinline__ float half32_sum(float v) { for (int o = 1; o < 32; o <<= 1) v += __shfl_xor(v, o); return v; }
#else
__device__ __forceinline__ float half32_sum(float v) { v = row16_sum(v); return v + __int_as_float(__builtin_amdgcn_ds_swizzle(__float_as_int(v), 0x401F)); }
#endif
__device__ __forceinline__ float block_sum(float v, LAS float* sc, int tid) {
    v = wave_sum(v);
    if ((tid & 63) == 0) sc[tid >> 6] = v;
    __syncthreads();
    const float r = ((sc[0] + sc[1]) + (sc[2] + sc[3])) + ((sc[4] + sc[5]) + (sc[6] + sc[7]));
    __syncthreads();
    return r;
}
#ifndef HOST_EMU
#define XB_TMO      128
#define XB_XCNT(j)  (256  + 64 * (j))
#define XB_XSUB(j)  (1280 + 64 * (j))
#define XB_XGEN(j)  (2304 + 64 * (j))
#define XB_TOP      3328
#define XB_TOPGEN   3392
#define XCD_BAR_WORDS 3456
#define XB_SPIN_CAP (1u << 18)
__device__ __forceinline__ unsigned xb_ld(unsigned* p)              { return __hip_atomic_load(p, __ATOMIC_RELAXED, __HIP_MEMORY_SCOPE_AGENT); }
__device__ __forceinline__ unsigned xb_add(unsigned* p, unsigned v) { return __hip_atomic_fetch_add(p, v, __ATOMIC_RELAXED, __HIP_MEMORY_SCOPE_AGENT); }
__device__ __forceinline__ unsigned xb_xcc_id() { return (unsigned)__builtin_amdgcn_s_getreg((3 << 11) | 20) & 0xFu; }
#define XB_SPIN(cond, bar) do { unsigned _sp = 0; while (cond) { __builtin_amdgcn_s_sleep(1); \
    if ((++_sp & 255u) == 0u) { if (xb_ld(&(bar)[XB_TMO])) break; if (_sp > XB_SPIN_CAP) { atomicAdd(&(bar)[XB_TMO], 1u); break; } } } } while (0)
struct XcdBarrier { unsigned* bar; unsigned x; volatile LAS unsigned* st; };
__device__ __forceinline__ XcdBarrier xcd_barrier_post(unsigned* bar, volatile LAS unsigned* st) {
    XcdBarrier b; b.bar = bar; b.x = xb_xcc_id(); b.st = st;
    if (threadIdx.x == 0) (void)xb_add(&bar[XB_XCNT(b.x)], 1u);
    return b;
}
__device__ __forceinline__ void xcd_barrier_complete(unsigned* bar, unsigned x, unsigned& nloc, unsigned& nx) {
    const unsigned G = gridDim.x * gridDim.y * gridDim.z;
    unsigned sum, cnt, mine, sp = 0u;
    for (;;) {
        sum = 0u; cnt = 0u; mine = 0u;
#pragma unroll
        for (unsigned j = 0; j < 16; ++j) { const unsigned c = xb_ld(&bar[XB_XCNT(j)]); sum += c; cnt += (c > 0u) ? 1u : 0u; mine = (j == x) ? c : mine; }
        if (sum == G) break;
        __builtin_amdgcn_s_sleep(1);
        if ((++sp & 255u) == 0u) { if (xb_ld(&bar[XB_TMO])) break; if (sp > XB_SPIN_CAP) { atomicAdd(&bar[XB_TMO], 1u); break; } }
    }
    nloc = mine > 0u ? mine : 1u; nx = cnt > 0u ? cnt : 1u;
}
__device__ __forceinline__ void xcd_barrier(const XcdBarrier& b) {
    asm volatile("s_waitcnt vmcnt(0)" ::: "memory");
    __syncthreads();
    if (tid_opq() == 0) {
        unsigned* bar = b.bar; asm volatile("" : "+v"(bar));
        __builtin_amdgcn_s_waitcnt(0);
        unsigned nloc = b.st[0], nx = b.st[1];
        if (nloc == 0u) { xcd_barrier_complete(bar, b.x, nloc, nx); b.st[0] = nloc; b.st[1] = nx; }
        const unsigned old = xb_add(&bar[XB_XSUB(b.x)], 1u);
        const unsigned gen = old / nloc;
        if (old + 1u == (gen + 1u) * nloc) {
            __builtin_amdgcn_fence(__ATOMIC_RELEASE, "agent");
            asm volatile("s_waitcnt vmcnt(0)" ::: "memory");
            const unsigned og = xb_add(&bar[XB_TOP], 1u);
            const unsigned tg = og / nx;
            if (og + 1u == (tg + 1u) * nx) xb_add(&bar[XB_TOPGEN], 1u);
            else XB_SPIN(xb_ld(&bar[XB_TOPGEN]) == tg, bar);
            __builtin_amdgcn_fence(__ATOMIC_ACQUIRE, "agent");
            xb_add(&bar[XB_XGEN(b.x)], 1u);
            asm volatile("s_waitcnt vmcnt(0)" ::: "memory");
        } else {
            XB_SPIN(xb_ld(&bar[XB_XGEN(b.x)]) == gen, bar);
            __builtin_amdgcn_fence(__ATOMIC_ACQUIRE, "agent");
            asm volatile("s_waitcnt vmcnt(0)" ::: "memory");
        }
    }
    __syncthreads();
}

#endif
#ifdef HOST_EMU
#define TID ((int)threadIdx.x)
#define BID ((int)blockIdx.x)
#define NBLK ((int)gridDim.x)
#else
#define TID tid_opq()
#define BID ((int)blockIdx.x)
#define NBLK ((int)gridDim.x)
#endif

__device__ __forceinline__ void ph_mod(const PAS Prm& p, LAS unsigned char* lds) {
    LAS float* sc = (LAS float*)lds;
    LAS float* red = sc + 9 * 1024;
    const float* c = p.in[1]; const float* cctx = p.in[3]; const float* w_mod = p.in[4]; const float* b_mod = p.in[5];
    float* mod = (float*)(p.ws + WS_MOD);
    const int tid = TID, lane = tid & 63, wave = tid >> 6;
    for (int i = tid; i < 9 * 1024; i += NTHR) { const int j = i >> 10, k = i & 1023; const float v = (j < 8) ? c[j * 1024 + k] : cctx[k]; sc[i] = v / (1.f + expf(-v)); }
    __syncthreads();
    for (int it = BID; it < 4 * 96; it += NBLK) {
        const int l = it / 96, cg = it % 96, col = cg * 64 + lane;
        float acc[9];
#pragma unroll
        for (int j = 0; j < 9; ++j) acc[j] = 0.f;
        const float* W = w_mod + (size_t)l * 1024 * 6144 + col;
        for (int k = wave * 128; k < wave * 128 + 128; ++k) { const float w = W[(size_t)k * 6144];
#pragma unroll
            for (int j = 0; j < 9; ++j) acc[j] += sc[j * 1024 + k] * w; }
#pragma unroll
        for (int j = 0; j < 9; ++j) red[(wave * 9 + j) * 64 + lane] = acc[j];
        __syncthreads();
        for (int i = tid; i < 9 * 64; i += NTHR) { const int j = i >> 6, ln = i & 63; float s = b_mod[l * 6144 + cg * 64 + ln];
#pragma unroll
            for (int w = 0; w < 8; ++w) s += red[(w * 9 + j) * 64 + ln];
            mod[((size_t)l * 9 + j) * 6144 + cg * 64 + ln] = s; }
        __syncthreads();
    }
}

#ifdef HOST_EMU
#define PH_ZOPQ(z) do { } while (0)
#else
#define PH_ZOPQ(z) asm volatile("" : "+v"(z))
#endif
#ifdef HOST_EMU
#define LGKM_WAIT() do { (void)emu_xchg(0, threadIdx.x & 63); } while (0)
#else
#define LGKM_WAIT() asm volatile("s_waitcnt lgkmcnt(0)" ::: "memory")
#endif
__device__ __forceinline__ void cvt_item(const float* W, size_t ldw, int k0, int n0, bf16* WT, int K, int drow0, LAS float* scr, int lane) {
#pragma unroll 8
    for (int i = 0; i < 32; ++i) { const int kk = 2 * i + (lane >> 5); scr[kk * 33 + (lane & 31)] = W[(size_t)(k0 + kk) * ldw + n0 + (lane & 31)]; }
    LGKM_WAIT();
    const int c = lane & 7;
#pragma unroll
    for (int j = 0; j < 4; ++j) { const int n = (lane >> 3) + 8 * j; const LAS float* s = scr + (8 * c) * 33 + n;
        v4u o; o.x = pk2(s[0 * 33], s[1 * 33]); o.y = pk2(s[2 * 33], s[3 * 33]); o.z = pk2(s[4 * 33], s[5 * 33]); o.w = pk2(s[6 * 33], s[7 * 33]);
        *(v4u*)(WT + (size_t)(drow0 + n) * K + k0 + 8 * c) = o; }
    LGKM_WAIT();
}
__device__ __forceinline__ void ph_cvt(const PAS Prm& p, int l, LAS unsigned char* lds, const int part = 0, const int blk0 = 0) {
    const int tid = TID, lane = tid & 63, wave = tid >> 6;
    LAS float* scr = (LAS float*)(lds + wave * 16384);
    bf16* WB = (bf16*)(p.ws + WS_W);
    const float* w_in = p.in[8] + (size_t)l * 1024 * NIN;
    const float* brp = p.in[36] + (size_t)l * 4 * 256 * 1024;
    const float* wout = p.in[37] + (size_t)l * 1024 * 1024;
    const float* w1 = p.in[38] + (size_t)l * 1024 * 5632;
    const float* w2 = p.in[39] + (size_t)l * 2816 * 1024;
    constexpr int I_IN = 16 * 230, I_BR = 4 * 4 * 32, I_WO = 16 * 32, I_W1 = 16 * 176, I_W2 = 44 * 32, I_PAD = 16;
    constexpr int NITEMS = I_IN + I_BR + I_WO + I_W1 + I_W2 + I_PAD;
    const int gw = (BID - blk0) * NWAVES + wave, NGW = (NBLK - blk0) * NWAVES;
    constexpr int I_PRE = I_IN + I_BR + I_WO + I_W1;
    const int nit = part == 0 ? NITEMS : part == 1 ? NITEMS - I_W2 : I_W2;
    for (int it = gw; it < nit; it += NGW) {
        int r = part == 0 ? it : part == 1 ? (it < I_PRE ? it : it + I_W2) : it + I_PRE;
        if (r < I_IN) { const int kb = r / 230, nb = r % 230, n0 = nb * 32;
            if (n0 < 3264) { const int drow = n0 < 768 ? n0 + 512 : n0 < 1728 ? n0 + 512 : n0 < 2240 ? n0 - 1728 : n0 + 64;
                cvt_item(w_in, NIN, kb * 64, n0, WB + WO_WP, 1024, drow, scr, lane);
            } else { cvt_item(w_in, NIN, kb * 64, n0, WB + WO_WG, 1024, n0 - 3264, scr, lane); }
            continue; }
        r -= I_IN;
        if (r < I_BR) { const int n = r / 128, q = r % 128, kb = q / 32, nb = q % 32;
            cvt_item(brp + (size_t)n * 256 * 1024, 1024, kb * 64, nb * 32, WB + WO_BR + (size_t)n * 1024 * 256, 256, nb * 32, scr, lane); continue; }
        r -= I_BR;
        if (r < I_WO) { const int kb = r / 32, nb = r % 32; cvt_item(wout, 1024, kb * 64, nb * 32, WB + WO_WO, 1024, nb * 32, scr, lane); continue; }
        r -= I_WO;
        if (r < I_W1) { const int kb = r / 176, nb = r % 176, n0 = nb * 32; const int hh = n0 / 2816, jj = n0 % 2816, pn = jj / 128, j2 = jj % 128;
            cvt_item(w1, 5632, kb * 64, n0, WB + WO_W1, 1024, 256 * pn + 128 * hh + j2, scr, lane); continue; }
        r -= I_W1;
        if (r < I_W2) { const int kb = r / 32, nb = r % 32; cvt_item(w2, 1024, kb * 64, nb * 32, WB + WO_W2, 2816, nb * 32, scr, lane); continue; }
        r -= I_W2;
        {
            unsigned z0 = 0u; PH_ZOPQ(z0); v4u z = (v4u){z0, z0, z0, z0};
            for (int i = lane; i < 4 * 128; i += 64) { const int rr = 2240 + r * 4 + i / 128, cc = (i % 128) * 8; *(v4u*)(WB + WO_WP + (size_t)rr * 1024 + cc) = z; }
        }
    }
}

__device__ __forceinline__ void ph_norm(const PAS Prm& p, int l, int which, const float* xc_src, const float* xl_src, int r_begin) {
    const int tid = TID, lane = tid & 63, wave = tid >> 6;
    const float* mod = (const float*)(p.ws + WS_MOD) + (size_t)l * 9 * 6144;
    const float* g = (which ? p.in[7] : p.in[6]) + l * 1024;
    bf16* U = (bf16*)(p.ws + WS_U);
    const int gw = BID * NWAVES + wave, NGW = NBLK * NWAVES;
    constexpr int NR = 2;
    f32x4 gg[4];
#pragma unroll
    for (int j = 0; j < 4; ++j) gg[j] = *(const f32x4*)(g + 4 * lane + 256 * j);
    for (int r0 = r_begin + gw * NR; r0 < RT; r0 += NGW * NR) {
        f32x4 v[NR][4], sc[NR][4], sh[NR][4]; float s[NR];
#pragma unroll
        for (int q = 0; q < NR; ++q) { const int r = r0 + q;
            const float* xr = (r < RC) ? xc_src + (size_t)r * 1024 : xl_src + (size_t)(r - RC) * 1024; s[q] = 0.f;
#pragma unroll
            for (int j = 0; j < 4; ++j) v[q][j] = *(const f32x4*)(xr + 4 * lane + 256 * j); }
#pragma unroll
        for (int q = 0; q < NR; ++q) { const int r = r0 + q;
            const int jb = (r < RC) ? 8 : (r - RC) / SEQ;
            const float* shift = mod + (size_t)jb * 6144 + (which ? 3 * 1024 : 0);
#pragma unroll
            for (int j = 0; j < 4; ++j) { sh[q][j] = *(const f32x4*)(shift + 4 * lane + 256 * j); sc[q][j] = *(const f32x4*)(shift + 1024 + 4 * lane + 256 * j); } }
#pragma unroll
        for (int q = 0; q < NR; ++q) {
#pragma unroll
            for (int j = 0; j < 4; ++j) s[q] += (v[q][j].x * v[q][j].x + v[q][j].y * v[q][j].y) + (v[q][j].z * v[q][j].z + v[q][j].w * v[q][j].w); }
#pragma unroll
        for (int q = 0; q < NR; ++q) { const int r = r0 + q;
            const float rstd = rsqrtf(wave_sum(s[q]) * (1.f / 1024.f) + 1e-6f);
#pragma unroll
            for (int j = 0; j < 4; ++j) { const int c0 = 4 * lane + 256 * j;
                const f32x4 o = v[q][j] * rstd * gg[j] * (1.f + sc[q][j]) + sh[q][j];
                v2u w; w.x = pk2(o.x, o.y); w.y = pk2(o.z, o.w);
                *(v2u*)(U + (size_t)r * 1024 + c0) = w; } }
    }
}
__device__ __forceinline__ void ph_final(const PAS Prm& p) {
    const int tid = TID, lane = tid & 63, wave = tid >> 6;
    const float* g = p.in[40];
    const float poison = (*(const volatile unsigned*)(p.ws + WS_CTL + 768 * 1024) != 0u) ? __builtin_nanf("") : 0.f;
    const int gw = BID * NWAVES + wave, NGW = NBLK * NWAVES;
    for (int r = gw; r < RL; r += NGW) {
        float* xr = p.out + (size_t)r * 1024;
        f32x4 v[4]; float s = 0.f;
#pragma unroll
        for (int j = 0; j < 4; ++j) { v[j] = *(const f32x4*)(xr + 4 * lane + 256 * j); s += (v[j].x * v[j].x + v[j].y * v[j].y) + (v[j].z * v[j].z + v[j].w * v[j].w); }
        const float rstd = rsqrtf(wave_sum(s) * (1.f / 1024.f) + 1e-6f);
#pragma unroll
        for (int j = 0; j < 4; ++j) { const int c0 = 4 * lane + 256 * j; const f32x4 gg = *(const f32x4*)(g + c0); *(f32x4*)(xr + c0) = v[j] * rstd * gg + poison; }
    }
}

struct RowInfo { int lat, b, t, T, base; };
__device__ __forceinline__ RowInfo row_info(int r) {
    RowInfo q;
    if (r < RC) { q.lat = 0; q.b = r / CTXL; q.t = r % CTXL; q.T = CTXL; q.base = q.b * CTXL; }
    else { const int x = r - RC; q.lat = 1; q.b = x / SEQ; q.t = x % SEQ; q.T = SEQ; q.base = RC + q.b * SEQ; }
    return q;
}
__device__ __forceinline__ int scan_row(int b, int d, int tau) {
    if (tau < CTXL) return b * CTXL + (d ? (CTXL - 1 - tau) : tau);
    const int t = tau - CTXL; return RC + b * SEQ + (d ? (SEQ - 1 - t) : t);
}

constexpr size_t RW_R = 0, RW_K = SZ17, RW_V = 2 * SZ17, RW_KK = 3 * SZ17, RW_OM = 4 * SZ17  , RW_A = 6 * SZ17  , RW_G = 8 * SZ17, RW_Y = 9 * SZ17  , RW_BON = 9 * SZ17 + 2 * SZ34;
static_assert(RW_BON + (size_t)RT * 16 <= 222 * MiB, "rwkv scratch");

typedef short bfx8 __attribute__((ext_vector_type(8)));
__device__ __forceinline__ bfx8 pack8(const float (&v)[8]) { bfx8 r;
#pragma unroll
    for (int i = 0; i < 8; ++i) r[i] = (short)f2bf(v[i]);
    return r; }
__device__ __forceinline__ void ph_rw_prep(const PAS Prm& p, int l, LAS unsigned char* lds) {
    LAS float* xx = (LAS float*)lds;
    LAS float* res = xx + 16 * 960;
    const int tid = TID, lane = tid & 63, wave = tid >> 6;
    const bf16* P = (const bf16*)(p.ws + WS_Y);
    unsigned char* S = p.ws + WS_BIG + BG_S;
    bf16* oR = (bf16*)(S + RW_R); bf16* oK = (bf16*)(S + RW_K); bf16* oV = (bf16*)(S + RW_V); bf16* oKK = (bf16*)(S + RW_KK);
    bf16* oOM = (bf16*)(S + RW_OM); bf16* oA = (bf16*)(S + RW_A); bf16* oG = (bf16*)(S + RW_G); float* oBon = (float*)(S + RW_BON);
    const float* mu = p.in[18] + l * 960;
    const float* w0 = p.in[19] + l * 512; const float* w2 = p.in[20] + (size_t)l * 2 * 64 * 256;
    const float* a0 = p.in[21] + l * 512; const float* a2 = p.in[22] + (size_t)l * 2 * 64 * 256;
    const float* g2 = p.in[23] + (size_t)l * 64 * 256;
    const float* k_k = p.in[24] + l * 256; const float* r_k = p.in[26] + l * 256;
    const int j = tid & 255, half = tid >> 8, h = j >> 6;
    bfx8 Bf[5][2][2];
#pragma unroll
    for (int m = 0; m < 5; ++m) { const float* W = m == 0 ? w2 : m == 1 ? w2 + 64 * 256 : m == 2 ? a2 : m == 3 ? a2 + 64 * 256 : g2;
#pragma unroll
        for (int ct = 0; ct < 2; ++ct)
#pragma unroll
            for (int ks = 0; ks < 2; ++ks) { float v[8];
#pragma unroll
                for (int q = 0; q < 8; ++q) v[q] = W[(size_t)(32 * ks + (lane >> 4) * 8 + q) * 256 + 32 * wave + 16 * ct + (lane & 15)];
                Bf[m][ct][ks] = pack8(v); } }
    const int cpair = 2 * (tid & 127);
    const cf2 kkp = {k_k[cpair], k_k[cpair + 1]}, rkp = {r_k[cpair], r_k[cpair + 1]}, w0p0 = {w0[cpair], w0[cpair + 1]}, w0p1 = {w0[256 + cpair], w0[256 + cpair + 1]}, a0p0 = {a0[cpair], a0[cpair + 1]}, a0p1 = {a0[256 + cpair], a0[256 + cpair + 1]};
    for (int tile = BID; tile < RT / 16; tile += NBLK) {
        const int r0 = tile * 16;
        for (int t = tid; t < 16 * 120; t += NTHR) {
            const int rr = t / 120, c0 = (t % 120) * 8, r = r0 + rr;
            const RowInfo ri = row_info(r);
            int nb[4];
            if (ri.lat) { const int gc = ri.t & 63, gr = ri.t >> 6;
                nb[0] = gc >= 1 ? r - 1 : -1; nb[1] = gc <= 62 ? r + 1 : -1; nb[2] = gr >= 1 ? r - 64 : -1; nb[3] = gr <= SEQ / 64 - 2 ? r + 64 : -1; }
            else { nb[0] = ri.t >= 1 ? r - 1 : -1; nb[1] = ri.t <= CTXL - 2 ? r + 1 : -1; nb[2] = nb[0]; nb[3] = nb[1]; }
            const v4u pv = *(const v4u*)(P + (size_t)r * 1024 + c0);
            v4u nv[4];
#pragma unroll
            for (int q = 0; q < 4; ++q) nv[q] = nb[q] >= 0 ? *(const v4u*)(P + (size_t)nb[q] * 1024 + c0) : (v4u){0u, 0u, 0u, 0u};
            const f32x4 m0 = *(const f32x4*)(mu + c0), m1 = *(const f32x4*)(mu + c0 + 4);
            float o[8];
#pragma unroll
            for (int i = 0; i < 8; ++i) { const unsigned pw = ((const unsigned*)&pv)[i >> 1], sw = ((const unsigned*)&nv[i & 3])[i >> 1];
                const float pf = (i & 1) ? bhi(pw) : blo(pw), sf = (i & 1) ? bhi(sw) : blo(sw), mm = i < 4 ? m0[i] : m1[i - 4];
                float x = pf + (sf - pf) * mm;
                if (c0 >= 768 && c0 < 832) x = tanhf(x); else if (c0 >= 896) x = sigmoidf_(x);
                o[i] = x; }
            *(LAS f32x4*)(xx + rr * 960 + c0) = (f32x4){o[0], o[1], o[2], o[3]}; *(LAS f32x4*)(xx + rr * 960 + c0 + 4) = (f32x4){o[4], o[5], o[6], o[7]};
        }
        __syncthreads();
        {
            f32x4 acc[5][2];
#pragma unroll
            for (int m = 0; m < 5; ++m) { acc[m][0] = (f32x4){0.f, 0.f, 0.f, 0.f}; acc[m][1] = (f32x4){0.f, 0.f, 0.f, 0.f}; }
#pragma unroll
            for (int inp = 0; inp < 3; ++inp)
#pragma unroll
                for (int ks = 0; ks < 2; ++ks) {
                    const LAS float* ap = xx + (lane & 15) * 960 + 768 + 64 * inp + 32 * ks + (lane >> 4) * 8;
                    const f32x4 x0 = *(const LAS f32x4*)ap, x1 = *(const LAS f32x4*)(ap + 4);
                    const float av[8] = {x0.x, x0.y, x0.z, x0.w, x1.x, x1.y, x1.z, x1.w};
                    const bfx8 Af = pack8(av);
#pragma unroll
                    for (int ct = 0; ct < 2; ++ct) {
                        if (inp == 0) { acc[0][ct] = __builtin_amdgcn_mfma_f32_16x16x32_bf16(Af, Bf[0][ct][ks], acc[0][ct], 0, 0, 0); acc[1][ct] = __builtin_amdgcn_mfma_f32_16x16x32_bf16(Af, Bf[1][ct][ks], acc[1][ct], 0, 0, 0); }
                        else if (inp == 1) { acc[2][ct] = __builtin_amdgcn_mfma_f32_16x16x32_bf16(Af, Bf[2][ct][ks], acc[2][ct], 0, 0, 0); acc[3][ct] = __builtin_amdgcn_mfma_f32_16x16x32_bf16(Af, Bf[3][ct][ks], acc[3][ct], 0, 0, 0); }
                        else acc[4][ct] = __builtin_amdgcn_mfma_f32_16x16x32_bf16(Af, Bf[4][ct][ks], acc[4][ct], 0, 0, 0);
                    }
                }
#pragma unroll
            for (int m = 0; m < 5; ++m)
#pragma unroll
                for (int ct = 0; ct < 2; ++ct)
#pragma unroll
                    for (int q = 0; q < 4; ++q) res[((lane >> 4) * 4 + q) * 1280 + m * 256 + 32 * wave + 16 * ct + (lane & 15)] = acc[m][ct][q];
        }
        __syncthreads();
        {
            const int j2 = tid & 127, rq = tid >> 7, c = 2 * j2, hh2 = c >> 6;
#pragma unroll
            for (int q = 0; q < 4; ++q) {
                const int rr = rq * 4 + q; const size_t r = (size_t)(r0 + rr);
                const LAS float* xr = xx + rr * 960; const LAS float* rs = res + rr * 1280;
                const float rv0 = xr[c], rv1 = xr[c + 1], kv0 = xr[256 + c], kv1 = xr[256 + c + 1], vv0 = xr[512 + c], vv1 = xr[512 + c + 1];
                const float kr0 = kv0 * kkp.x, kr1 = kv1 * kkp.y;
                const float ss = half32_sum(kr0 * kr0 + kr1 * kr1);
                const float nrm = rsqrtf(ss + 1e-12f);
                const float bon = half32_sum(rv0 * kv0 * rkp.x + rv1 * kv1 * rkp.y);
                *(unsigned*)(oR + r * 256 + c) = pk2(rv0, rv1); *(unsigned*)(oK + r * 256 + c) = pk2(kv0, kv1); *(unsigned*)(oV + r * 256 + c) = pk2(vv0, vv1);
                *(unsigned*)(oKK + r * 256 + c) = pk2(kr0 * nrm, kr1 * nrm);
                *(unsigned*)(oG + r * 256 + c) = pk2(rs[4 * 256 + c], rs[4 * 256 + c + 1]);
                if ((lane & 31) == 0) oBon[r * 4 + hh2] = bon;
#pragma unroll
                for (int d = 0; d < 2; ++d) {
                    const float wv0 = (d ? w0p1.x : w0p0.x) + rs[d * 256 + c], wv1 = (d ? w0p1.y : w0p0.y) + rs[d * 256 + c + 1];
                    const float om0 = 1.f - __expf(-0.6065306597126334f * sigmoidf_(wv0)), om1 = 1.f - __expf(-0.6065306597126334f * sigmoidf_(wv1));
                    const float av0 = sigmoidf_((d ? a0p1.x : a0p0.x) + rs[(2 + d) * 256 + c]), av1 = sigmoidf_((d ? a0p1.y : a0p0.y) + rs[(2 + d) * 256 + c + 1]);
                    *(unsigned*)(oOM + (size_t)d * RT * 256 + r * 256 + c) = pk2(om0, om1);
                    *(unsigned*)(oA + (size_t)d * RT * 256 + r * 256 + c) = pk2(av0, av1);
                }
            }
        }
        __syncthreads();
    }
}

#ifdef HOST_EMU
#define SC_PIN(x) do { } while (0)
#else
#define SC_PIN(x) asm("" : "+v"(x))
#endif
template <int MODE, int SPREAD = 1>
__device__ __forceinline__ void scan_phase(const int bid  , const unsigned char* Sb  , const bf16* Pv  ,
                                           void* Yout_  , const float* ka  , const float* gam  , LAS unsigned char* lds) {
    constexpr int NF = MODE == 0 ? 5 : 2;
    constexpr int CH = 32, ARRB = CH * 256, VOFF = NF * ARRB, BUFB = VOFF + CH * 128, NCH = (CTXL + SEQ) / CH;
    const int tid = TID, lane = tid & 63, wave = tid >> 6;
    if (bid < 0 || bid >= 128 * SPREAD) return;
    const int prob = bid / (2 * SPREAD), b = prob >> 3, h = (prob >> 1) & 3, d = prob & 1;
    const int rowv = (32 / SPREAD) * (bid & (2 * SPREAD - 1)) + 4 * (wave & (8 / SPREAD - 1)) + (lane >> 4);
    const bool computes = SPREAD == 1 || wave < 4;
    const int stt = SPREAD == 1 ? tid : (tid ^ 256);
    const int kl = lane & 15;
    const int st_s = (stt & 255) >> 3, st_g = stt & 7;
    const bool st_v = stt >= 256;
    float kav[8];
    float gamma = 0.f;
#pragma unroll
    for (int i = 0; i < 8; ++i) kav[i] = (MODE == 0) ? ka[h * 64 + 8 * st_g + i] : 0.f;
    if (MODE == 1) gamma = sigmoidf_(gam[d * 4 + h]);
    const size_t colb = (size_t)(h * 64 + st_g * 8) * 2;
    const unsigned char* src0 = (MODE == 0) ? Sb + colb : (const unsigned char*)Pv + colb;
    const unsigned char* srcp = (const unsigned char*)Pv + (size_t)(h * 64 + (st_g ^ 2) * 8) * 2;
    const unsigned char* srcv = (MODE == 0) ? Sb + 2 * SZ17 + colb : (const unsigned char*)Pv + (size_t)(512 + h * 64 + st_g * 8) * 2;
    const size_t ldv = (MODE == 0) ? 512 : 2048;
    LAS cf2* rtab = (LAS cf2*)(lds + 2 * BUFB);
    if (MODE == 1) { for (int i = tid; i < 64 * 16; i += NTHR) { float sn, cs; sincosf((float)(i >> 4) * exp2f(-(float)(i & 15) * (13.287712379549449f / 16.f)), &sn, &cs); rtab[i] = (cf2){cs, sn}; } __syncthreads(); }
    const bool rsecond = ((8 * st_g) & 31) >= 16, rcolhalf = (8 * st_g) >= 32;
    float S[4] = {0.f, 0.f, 0.f, 0.f};
    v4u pre[2][MODE == 0 ? 5 : 4];
    int st_tq[2] = {-1, -1};
#define SCAN_ISSUE(c, Q) do { const size_t row = (size_t)scan_row(b, d, (c) * CH + st_s); \
        if (st_v) pre[Q][0] = *(const v4u*)(srcv + row * ldv); \
        else if (MODE == 0) { pre[Q][0] = *(const v4u*)(src0 + row * 512); pre[Q][1] = *(const v4u*)(src0 + 1 * SZ17 + row * 512); pre[Q][2] = *(const v4u*)(src0 + 3 * SZ17 + row * 512); \
                              pre[Q][3] = *(const v4u*)(src0 + (size_t)(4 + d) * SZ17 + row * 512); pre[Q][4] = *(const v4u*)(src0 + (size_t)(6 + d) * SZ17 + row * 512); } \
        else { pre[Q][0] = *(const v4u*)(src0 + row * 2048); pre[Q][1] = *(const v4u*)(src0 + 512 + row * 2048); pre[Q][2] = *(const v4u*)(srcp + row * 2048); pre[Q][3] = *(const v4u*)(srcp + 512 + row * 2048); \
               st_tq[Q] = row >= (size_t)RC ? (int)((row - RC) & (SEQ - 1)) : -1; } } while (0)
#define SCAN_COMMIT(buf, Q) do { const int st_t = st_tq[Q]; (void)st_t; LAS unsigned char* bp = lds + (buf) * BUFB; \
        if (st_v) *(LAS v4u*)(bp + VOFF + st_s * 128 + st_g * 16) = pre[Q][0]; \
        else { LAS float* o = (LAS float*)(bp + st_s * 256 + st_g * 32); \
            if (MODE == 0) { _Pragma("unroll") for (int i = 0; i < 4; ++i) { \
                const unsigned ur = ((const unsigned*)&pre[Q][0])[i], uk = ((const unsigned*)&pre[Q][1])[i], ukk = ((const unsigned*)&pre[Q][2])[i], uom = ((const unsigned*)&pre[Q][3])[i], ua = ((const unsigned*)&pre[Q][4])[i]; \
                const float a0 = blo(ua), a1 = bhi(ua), kk0 = blo(ukk), kk1 = bhi(ukk); \
                o[0 * (ARRB / 4) + 2 * i] = blo(ur); o[0 * (ARRB / 4) + 2 * i + 1] = bhi(ur); \
                o[1 * (ARRB / 4) + 2 * i] = 1.f - blo(uom); o[1 * (ARRB / 4) + 2 * i + 1] = 1.f - bhi(uom); \
                o[2 * (ARRB / 4) + 2 * i] = blo(uk) * (1.f + (a0 - 1.f) * kav[2 * i]); o[2 * (ARRB / 4) + 2 * i + 1] = bhi(uk) * (1.f + (a1 - 1.f) * kav[2 * i + 1]); \
                o[3 * (ARRB / 4) + 2 * i] = kk0 * a0; o[3 * (ARRB / 4) + 2 * i + 1] = kk1 * a1; \
                o[4 * (ARRB / 4) + 2 * i] = -kk0; o[4 * (ARRB / 4) + 2 * i + 1] = -kk1; } } \
            else { const int icoord = st_t < 0 ? 0 : (rcolhalf ? (st_t & 63) : (st_t >> 6)); \
                _Pragma("unroll") for (int i = 0; i < 8; ++i) { const unsigned uq = ((const unsigned*)&pre[Q][0])[i >> 1], uk = ((const unsigned*)&pre[Q][1])[i >> 1], pq = ((const unsigned*)&pre[Q][2])[i >> 1], pk = ((const unsigned*)&pre[Q][3])[i >> 1]; \
                    const float q = (i & 1) ? bhi(uq) : blo(uq), k = (i & 1) ? bhi(uk) : blo(uk), qp = (i & 1) ? bhi(pq) : blo(pq), kp = (i & 1) ? bhi(pk) : blo(pk); \
                    float sn = 0.f, cs = 1.f; if (st_t >= 0) { const cf2 t2 = rtab[icoord * 16 + ((8 * st_g + i) & 15)]; cs = t2.x; sn = t2.y; } \
                    o[0 * (ARRB / 4) + i] = rsecond ? (qp * sn + q * cs) : (q * cs - qp * sn); \
                    o[1 * (ARRB / 4) + i] = 0.125f * (rsecond ? (kp * sn + k * cs) : (k * cs - kp * sn)); } } } } while (0)
    static_assert(NCH % 2 == 0, "chunk pairs");
    SCAN_ISSUE(0, 0); SCAN_COMMIT(0, 0); __syncthreads();
    SCAN_ISSUE(1, 1);
    float ycar = 0.f; ptrdiff_t ycar_i = 0; (void)ycar; (void)ycar_i;
    for (int c0 = 0; c0 < NCH; c0 += 2) {
#pragma unroll
    for (int hf = 0; hf < 2; ++hf) {
        const int c = c0 + hf;
        if (c + 2 < NCH) SCAN_ISSUE(c + 2, hf);
        const LAS unsigned char* bufp = lds + hf * BUFB;
        const int row_first = scan_row(b, d, c * CH);
        const size_t yoff = ((size_t)d * RT + row_first) * 256 + h * 64 + rowv;
        const int ystep = d ? -256 : 256;
        float ykeep = 0.f;
#ifndef HOST_EMU
#define DPQ1 " quad_perm:[1,0,3,2] row_mask:0xf bank_mask:0xf\n\t"
#define DPQ2 " quad_perm:[2,3,0,1] row_mask:0xf bank_mask:0xf\n\t"
#define DPHM " row_half_mirror row_mask:0xf bank_mask:0xf\n\t"
#define DPRM " row_mirror row_mask:0xf bank_mask:0xf\n\t"
#define SC_YRED(y) asm volatile("s_nop 1\n\tv_add_f32_dpp %0, %0, %0" DPQ1 "s_nop 1\n\tv_add_f32_dpp %0, %0, %0" DPQ2 "s_nop 1\n\tv_add_f32_dpp %0, %0, %0" DPHM "s_nop 1\n\tv_add_f32_dpp %0, %0, %0" DPRM "s_nop 1" : "+v"(y))
        const unsigned aop = (unsigned)(uintptr_t)(bufp + kl * 16), av = (unsigned)(uintptr_t)(bufp + rowv * 2);
        if (!computes) { }
        else if (MODE == 0) {
#define RWA_READ(KN, KT, BB, WW, RR, VV, s) asm volatile("ds_read_b128 %[kn], %[a] offset:%[o4]\n\tds_read_u16_d16_hi %[vv], %[av] offset:%[ov]\n\tds_read_b128 %[kt], %[a] offset:%[o2]\n\t" \
                "ds_read_b128 %[bb], %[a] offset:%[o3]\n\tds_read_b128 %[ww], %[a] offset:%[o1]\n\tds_read_b128 %[rr], %[a] offset:%[o0]" \
                : [kn] "=&v"(KN), [kt] "=&v"(KT), [bb] "=&v"(BB), [ww] "=&v"(WW), [rr] "=&v"(RR), [vv] "+v"(VV) \
                : [a] "v"(aop), [av] "v"(av), [o0] "i"((s) * 256), [o1] "i"((s) * 256 + ARRB), [o2] "i"((s) * 256 + 2 * ARRB), [o3] "i"((s) * 256 + 3 * ARRB), [o4] "i"((s) * 256 + 4 * ARRB), [ov] "i"(VOFF + (s) * 128) : "memory")
#define RWA_STEP(KN, KT, BB, WW, RR, VV) do { float sa_, m0_, m1_, m2_, m3_, yp_; \
            asm volatile("v_mul_f32 %[sa], %[s0], %[k0]\n\tv_fmac_f32 %[sa], %[s1], %[k1]\n\tv_fmac_f32 %[sa], %[s2], %[k2]\n\tv_fmac_f32 %[sa], %[s3], %[k3]\n\t" \
                "v_mul_f32 %[m0], %[vv], %[t0]\n\t" \
                "v_add_f32_dpp %[yq], %[yq], %[yq]" DPQ1 "v_add_f32_dpp %[sa], %[sa], %[sa]" DPQ1 "v_mul_f32 %[m1], %[vv], %[t1]\n\t" \
                "v_add_f32_dpp %[yq], %[yq], %[yq]" DPQ2 "v_add_f32_dpp %[sa], %[sa], %[sa]" DPQ2 "v_mul_f32 %[m2], %[vv], %[t2]\n\t" \
                "v_add_f32_dpp %[yq], %[yq], %[yq]" DPHM "v_add_f32_dpp %[sa], %[sa], %[sa]" DPHM "v_mul_f32 %[m3], %[vv], %[t3]\n\t" \
                "v_add_f32_dpp %[yq], %[yq], %[yq]" DPRM "v_add_f32_dpp %[sa], %[sa], %[sa] row_mirror row_mask:0xf bank_mask:0xf" \
                : [sa] "=&v"(sa_), [m0] "=&v"(m0_), [m1] "=&v"(m1_), [m2] "=&v"(m2_), [m3] "=&v"(m3_), [yq] "+v"(yq) \
                : [s0] "v"(S[0]), [s1] "v"(S[1]), [s2] "v"(S[2]), [s3] "v"(S[3]), [k0] "v"(KN.x), [k1] "v"(KN.y), [k2] "v"(KN.z), [k3] "v"(KN.w), [vv] "v"(VV), \
                  [t0] "v"(KT.x), [t1] "v"(KT.y), [t2] "v"(KT.z), [t3] "v"(KT.w)); \
            yfull = yq; \
            asm volatile("v_fmac_f32 %[m0], %[sa], %[b0]\n\tv_fmac_f32 %[m1], %[sa], %[b1]\n\tv_fmac_f32 %[m2], %[sa], %[b2]\n\tv_fmac_f32 %[m3], %[sa], %[b3]\n\t" \
                "v_fma_f32 %[s0], %[s0], %[w0], %[m0]\n\tv_fma_f32 %[s1], %[s1], %[w1], %[m1]\n\tv_fma_f32 %[s2], %[s2], %[w2], %[m2]\n\tv_fma_f32 %[s3], %[s3], %[w3], %[m3]\n\t" \
                "v_mul_f32 %[yp], %[s0], %[r0]\n\tv_fmac_f32 %[yp], %[s1], %[r1]\n\tv_fmac_f32 %[yp], %[s2], %[r2]\n\tv_fmac_f32 %[yp], %[s3], %[r3]" \
                : [m0] "+v"(m0_), [m1] "+v"(m1_), [m2] "+v"(m2_), [m3] "+v"(m3_), [s0] "+v"(S[0]), [s1] "+v"(S[1]), [s2] "+v"(S[2]), [s3] "+v"(S[3]), [yp] "=&v"(yp_) \
                : [sa] "v"(sa_), [b0] "v"(BB.x), [b1] "v"(BB.y), [b2] "v"(BB.z), [b3] "v"(BB.w), [w0] "v"(WW.x), [w1] "v"(WW.y), [w2] "v"(WW.z), [w3] "v"(WW.w), \
                  [r0] "v"(RR.x), [r1] "v"(RR.y), [r2] "v"(RR.z), [r3] "v"(RR.w)); \
            yq = yp_; } while (0)
#define RWA_YOUT(sprev) do { ykeep = (((sprev) & 15) == kl) ? yfull : ykeep; \
            if ((sprev) == CH - 1) { ycar = ykeep; ycar_i = (ptrdiff_t)yoff + (ptrdiff_t)(((sprev) & ~15) + kl) * ystep; } \
            else if (((sprev) & 15) == 15) ((bf16*)Yout_)[(ptrdiff_t)yoff + (ptrdiff_t)(((sprev) & ~15) + kl) * ystep] = f2bf(ykeep); } while (0)
            f32x4 knA, ktA, bbA, wwA, rrA, knB, ktB, bbB, wwB, rrB; float vvA = 0.f, vvB = 0.f, yq = 0.f, yfull = 0.f;
            RWA_READ(knA, ktA, bbA, wwA, rrA, vvA, 0);
            if (c > 0) ((bf16*)Yout_)[ycar_i] = f2bf(ycar);
#pragma unroll
            for (int s = 0; s < CH; s += 2) {
                RWA_READ(knB, ktB, bbB, wwB, rrB, vvB, s + 1); asm volatile("s_waitcnt lgkmcnt(6)" ::: "memory");
                RWA_STEP(knA, ktA, bbA, wwA, rrA, vvA);
                if (s > 0) RWA_YOUT(s - 1);
                if (s + 2 < CH) { RWA_READ(knA, ktA, bbA, wwA, rrA, vvA, (s + 2 < CH ? s + 2 : 0)); asm volatile("s_waitcnt lgkmcnt(6)" ::: "memory"); }
                else asm volatile("s_waitcnt lgkmcnt(0)" ::: "memory");
                RWA_STEP(knB, ktB, bbB, wwB, rrB, vvB);
                RWA_YOUT(s);
            }
            SC_YRED(yq); yfull = yq; RWA_YOUT(CH - 1);
#undef RWA_READ
#undef RWA_STEP
#undef RWA_YOUT
        } else {
#define RTA_READ(QQ, KR, VV, s) asm volatile("ds_read_b128 %[kr], %[a] offset:%[o1]\n\tds_read_u16_d16_hi %[vv], %[av] offset:%[ov]\n\tds_read_b128 %[qq], %[a] offset:%[o0]" \
                : [kr] "=&v"(KR), [qq] "=&v"(QQ), [vv] "+v"(VV) : [a] "v"(aop), [av] "v"(av), [o0] "i"((s) * 256), [o1] "i"((s) * 256 + ARRB), [ov] "i"(VOFF + (s) * 128) : "memory")
#define RTA_STEP(QQ, KR, VV) do { float m0_, m1_, m2_, m3_, yp_; \
            asm volatile("v_mul_f32 %[m0], %[vv], %[k0]\n\tv_mul_f32 %[m1], %[vv], %[k1]\n\t" \
                "v_add_f32_dpp %[yq], %[yq], %[yq]" DPQ1 "v_mul_f32 %[m2], %[vv], %[k2]\n\tv_mul_f32 %[m3], %[vv], %[k3]\n\t" \
                "v_add_f32_dpp %[yq], %[yq], %[yq]" DPQ2 "v_fma_f32 %[s0], %[s0], %[g], %[m0]\n\tv_fma_f32 %[s1], %[s1], %[g], %[m1]\n\t" \
                "v_add_f32_dpp %[yq], %[yq], %[yq]" DPHM "v_fma_f32 %[s2], %[s2], %[g], %[m2]\n\tv_fma_f32 %[s3], %[s3], %[g], %[m3]\n\t" \
                "v_add_f32_dpp %[yq], %[yq], %[yq]" DPRM \
                "v_mul_f32 %[yp], %[s0], %[q0]\n\tv_fmac_f32 %[yp], %[s1], %[q1]\n\tv_fmac_f32 %[yp], %[s2], %[q2]\n\tv_fmac_f32 %[yp], %[s3], %[q3]" \
                : [m0] "=&v"(m0_), [m1] "=&v"(m1_), [m2] "=&v"(m2_), [m3] "=&v"(m3_), [yq] "+v"(yq), [s0] "+v"(S[0]), [s1] "+v"(S[1]), [s2] "+v"(S[2]), [s3] "+v"(S[3]), [yp] "=&v"(yp_) \
                : [vv] "v"(VV), [k0] "v"(KR.x), [k1] "v"(KR.y), [k2] "v"(KR.z), [k3] "v"(KR.w), [g] "v"(gamma), [q0] "v"(QQ.x), [q1] "v"(QQ.y), [q2] "v"(QQ.z), [q3] "v"(QQ.w)); \
            yfull = yq; yq = yp_; } while (0)
#define RTA_YOUT(sprev) do { ykeep = (((sprev) & 15) == kl) ? yfull : ykeep; \
            if ((sprev) == CH - 1) { ycar = ykeep; ycar_i = (ptrdiff_t)yoff + (ptrdiff_t)(((sprev) & ~15) + kl) * ystep; } \
            else if (((sprev) & 15) == 15) ((bf16*)Yout_)[(ptrdiff_t)yoff + (ptrdiff_t)(((sprev) & ~15) + kl) * ystep] = f2bf(ykeep); } while (0)
            f32x4 qqA, krA, qqB, krB; float vvA = 0.f, vvB = 0.f, yq = 0.f, yfull = 0.f;
            RTA_READ(qqA, krA, vvA, 0);
            if (c > 0) ((bf16*)Yout_)[ycar_i] = f2bf(ycar);
#pragma unroll
            for (int s = 0; s < CH; s += 2) {
                RTA_READ(qqB, krB, vvB, s + 1); asm volatile("s_waitcnt lgkmcnt(3)" ::: "memory");
                RTA_STEP(qqA, krA, vvA);
                if (s > 0) RTA_YOUT(s - 1);
                if (s + 2 < CH) { RTA_READ(qqA, krA, vvA, (s + 2 < CH ? s + 2 : 0)); asm volatile("s_waitcnt lgkmcnt(3)" ::: "memory"); }
                else asm volatile("s_waitcnt lgkmcnt(0)" ::: "memory");
                RTA_STEP(qqB, krB, vvB);
                RTA_YOUT(s);
            }
            SC_YRED(yq); yfull = yq; RTA_YOUT(CH - 1);
#undef RTA_READ
#undef RTA_STEP
#undef RTA_YOUT
        }
#undef DPQ1
#undef DPQ2
#undef DPHM
#undef DPRM
#undef SC_YRED
#else
        if (!computes) { }
        else if (MODE == 0) {
            const LAS unsigned char* sp0 = bufp + kl * 16;
            f32x4 rrA = *(const LAS f32x4*)(sp0), wwA = *(const LAS f32x4*)(sp0 + ARRB), ktA = *(const LAS f32x4*)(sp0 + 2 * ARRB), bbA = *(const LAS f32x4*)(sp0 + 3 * ARRB), knA = *(const LAS f32x4*)(sp0 + 4 * ARRB);
            float vvA = bf2f(*(const LAS bf16*)(bufp + VOFF + rowv * 2));
            f32x4 rrB, wwB, ktB, bbB, knB; float vvB;
            float ypend = 0.f;
#define RW_STEP(s, rr, ww, kt, bb, kn, vv, rrN, wwN, ktN, bbN, knN, vvN) do { \
                const int sn_ = ((s) + 1 < CH) ? (s) + 1 : (s); const LAS unsigned char* sp = bufp + sn_ * 256 + kl * 16; \
                rrN = *(const LAS f32x4*)(sp); wwN = *(const LAS f32x4*)(sp + ARRB); ktN = *(const LAS f32x4*)(sp + 2 * ARRB); bbN = *(const LAS f32x4*)(sp + 3 * ARRB); knN = *(const LAS f32x4*)(sp + 4 * ARRB); \
                vvN = bf2f(*(const LAS bf16*)(bufp + VOFF + sn_ * 128 + rowv * 2)); \
                float sa = sfma(S[1], kn.y, smul(S[0], kn.x)) + sfma(S[3], kn.w, smul(S[2], kn.z)); \
                float yq = ypend; \
                sa += dpp_mov<0xB1>(sa); yq += dpp_mov<0xB1>(yq); \
                sa += dpp_mov<0x4E>(sa); yq += dpp_mov<0x4E>(yq); \
                sa += dpp_mov<0x141>(sa); yq += dpp_mov<0x141>(yq); \
                sa += dpp_mov<0x140>(sa); yq += dpp_mov<0x140>(yq); \
                if ((s) > 0) { ykeep = ((((s) - 1) & 15) == kl) ? yq : ykeep; \
                    if ((((s) - 1) & 15) == 15) ((bf16*)Yout_)[(ptrdiff_t)yoff + (ptrdiff_t)((((s) - 1) & ~15) + kl) * ystep] = f2bf(ykeep); } \
                S[0] = sfma(S[0], ww.x, sfma(sa, bb.x, smul(vv, kt.x))); S[1] = sfma(S[1], ww.y, sfma(sa, bb.y, smul(vv, kt.y))); \
                S[2] = sfma(S[2], ww.z, sfma(sa, bb.z, smul(vv, kt.z))); S[3] = sfma(S[3], ww.w, sfma(sa, bb.w, smul(vv, kt.w))); \
                ypend = sfma(S[1], rr.y, smul(S[0], rr.x)) + sfma(S[3], rr.w, smul(S[2], rr.z)); } while (0)
#pragma unroll 8
            for (int s = 0; s < CH; s += 2) {
                RW_STEP(s, rrA, wwA, ktA, bbA, knA, vvA, rrB, wwB, ktB, bbB, knB, vvB);
                RW_STEP(s + 1, rrB, wwB, ktB, bbB, knB, vvB, rrA, wwA, ktA, bbA, knA, vvA);
            }
#undef RW_STEP
            { const float yq = row16_sum(ypend); ykeep = (((CH - 1) & 15) == kl) ? yq : ykeep;
              ((bf16*)Yout_)[(ptrdiff_t)yoff + (ptrdiff_t)(((CH - 1) & ~15) + kl) * ystep] = f2bf(ykeep); }
        } else {
#pragma unroll 16
        for (int s = 0; s < CH; ++s) {
            const LAS unsigned char* sp = bufp + s * 256 + kl * 16;
            const float vv = bf2f(*(const LAS bf16*)(bufp + VOFF + s * 128 + rowv * 2));
            const f32x4 qq = *(const LAS f32x4*)(sp), kr = *(const LAS f32x4*)(sp + ARRB);
            S[0] = sfma(S[0], gamma, smul(vv, kr.x)); S[1] = sfma(S[1], gamma, smul(vv, kr.y)); S[2] = sfma(S[2], gamma, smul(vv, kr.z)); S[3] = sfma(S[3], gamma, smul(vv, kr.w));
            const float y = row16_sum(sfma(S[1], qq.y, smul(S[0], qq.x)) + sfma(S[3], qq.w, smul(S[2], qq.z)));
            ykeep = ((s & 15) == kl) ? y : ykeep;
            if ((s & 15) == 15) ((bf16*)Yout_)[(ptrdiff_t)yoff + (ptrdiff_t)((s & ~15) + kl) * ystep] = f2bf(ykeep);
        }
        }
#endif
        if (c + 1 < NCH) SCAN_COMMIT(hf ^ 1, hf ^ 1);
        __syncthreads();
    }
    }
#ifndef HOST_EMU
    if (computes) ((bf16*)Yout_)[ycar_i] = f2bf(ycar);
#endif
#undef SCAN_ISSUE
#undef SCAN_COMMIT
}

__device__ __forceinline__ void ph_rw_post(const PAS Prm& p, int l) {
    const int tid = TID, j2 = tid & 127, c = 2 * j2, h = c >> 6;
    unsigned char* S = p.ws + WS_BIG + BG_S;
    const bf16* Y = (const bf16*)(S + RW_Y); const bf16* V = (const bf16*)(S + RW_V); const bf16* G = (const bf16*)(S + RW_G); const float* Bon = (const float*)(S + RW_BON);
    bf16* yrw = (bf16*)(p.ws + WS_Y + 1 * SZ17);
    const float lng0 = p.in[27][l * 256 + c], lng1 = p.in[27][l * 256 + c + 1];
    constexpr int NR = 4;
    for (int r0 = (BID * 4 + (tid >> 7)) * NR; r0 < RT; r0 += NBLK * 4 * NR) {
        unsigned y0[NR], y1[NR], vv[NR], gg[NR]; float bo[NR];
#pragma unroll
        for (int q = 0; q < NR; ++q) { const size_t o = (size_t)(r0 + q) * 256 + c; y0[q] = *(const unsigned*)(Y + o); y1[q] = *(const unsigned*)(Y + (size_t)RT * 256 + o); vv[q] = *(const unsigned*)(V + o); gg[q] = *(const unsigned*)(G + o); bo[q] = Bon[(size_t)(r0 + q) * 4 + h]; }
#pragma unroll
        for (int q = 0; q < NR; ++q) { const size_t o = (size_t)(r0 + q) * 256 + c;
            const float ya = blo(y0[q]) + blo(y1[q]), yb = bhi(y0[q]) + bhi(y1[q]);
            const float mean = half32_sum(ya + yb) * (1.f / 64.f); const float da = ya - mean, db = yb - mean;
            const float rs = rsqrtf(half32_sum(da * da + db * db) * (1.f / 64.f) + 64e-5f);
            const float va = (da * rs * lng0 + bo[q] * blo(vv[q])) * blo(gg[q]), vb = (db * rs * lng1 + bo[q] * bhi(vv[q])) * bhi(gg[q]);
            *(unsigned*)(yrw + o) = pk2(va, vb); }
    }
}

constexpr size_t RT_Y = 222 * MiB  ;
__device__ __forceinline__ void ph_ret_post(const PAS Prm& p) {
    const int tid = TID, j2 = tid & 127, c = 2 * j2;
    const bf16* P = (const bf16*)(p.ws + WS_BIG + BG_P);
    const bf16* Y = (const bf16*)(p.ws + WS_BIG + BG_S + RT_Y);
    bf16* yret = (bf16*)(p.ws + WS_Y + 3 * SZ17);
    constexpr int NR = 4;
    for (int r0 = (BID * 4 + (tid >> 7)) * NR; r0 < RT; r0 += NBLK * 4 * NR) {
        unsigned y0[NR], y1[NR], gg[NR];
#pragma unroll
        for (int q = 0; q < NR; ++q) { const size_t o = (size_t)(r0 + q) * 256 + c; y0[q] = *(const unsigned*)(Y + o); y1[q] = *(const unsigned*)(Y + (size_t)RT * 256 + o); gg[q] = *(const unsigned*)(P + (size_t)(r0 + q) * 1024 + 768 + c); }
#pragma unroll
        for (int q = 0; q < NR; ++q) { const size_t o = (size_t)(r0 + q) * 256 + c;
            const float ya = blo(y0[q]) + blo(y1[q]), yb = bhi(y0[q]) + bhi(y1[q]);
            const float mean = half32_sum(ya + yb) * (1.f / 64.f); const float da = ya - mean, db = yb - mean;
            const float rs = rsqrtf(half32_sum(da * da + db * db) * (1.f / 64.f) + 1e-5f);
            const float ga = blo(gg[q]), gb = bhi(gg[q]);
            *(unsigned*)(yret + o) = pk2(da * rs * (ga * sigmoidf_(ga)), db * rs * (gb * sigmoidf_(gb))); }
    }
}

constexpr size_t LR_A = 0  , LR_B = 2 * SZ34  ;
__device__ __forceinline__ void ph_lru_prep(const PAS Prm& p, int l, LAS unsigned char* lds) {
    LAS float* xc = (LAS float*)lds;
    LAS float* res = xc + 16 * 256;
    const int tid = TID, lane = tid & 63, wave = tid >> 6;
    const bf16* P = (const bf16*)(p.ws + WS_BIG + BG_P);
    bf16* A = (bf16*)(p.ws + WS_BIG + BG_S + LR_A); bf16* B = (bf16*)(p.ws + WS_BIG + BG_S + LR_B);
    const float* cw = p.in[28] + l * 4 * 256; const float* cb = p.in[29] + l * 256;
    const float* wa = p.in[30] + (size_t)l * 2 * 4 * 64 * 64; const float* ba = p.in[31] + l * 512;
    const float* wx = p.in[32] + (size_t)l * 2 * 4 * 64 * 64; const float* bx = p.in[33] + l * 512;
    const float* lam = p.in[34] + l * 512;
    const int j = tid & 255, half = tid >> 8;
    const float sp0 = softplusf_(-lam[j]), sp1 = softplusf_(-lam[256 + j]);
    const float ba0 = ba[j], ba1 = ba[256 + j], bx0 = bx[j], bx1 = bx[256 + j];
    const int g = wave >> 1;
    bfx8 Bf[4][2][2];
#pragma unroll
    for (int m = 0; m < 4; ++m) { const float* W = (m < 2 ? wa : wx) + (size_t)(((m & 1) * 4 + g) * 64) * 64;
#pragma unroll
        for (int ct = 0; ct < 2; ++ct)
#pragma unroll
            for (int ks = 0; ks < 2; ++ks) { float v[8];
#pragma unroll
                for (int q = 0; q < 8; ++q) v[q] = W[(size_t)(32 * ks + (lane >> 4) * 8 + q) * 64 + ((32 * wave + 16 * ct + (lane & 15)) & 63)];
                Bf[m][ct][ks] = pack8(v); } }
    for (int tile = BID; tile < RT / 16; tile += NBLK) {
        const int r0 = tile * 16;
        {
            const int rr = tid >> 5, c8 = (tid & 31) * 8, r = r0 + rr; const RowInfo ri = row_info(r);
            v4u tv[4];
#pragma unroll
            for (int q = 0; q < 4; ++q) { const int tt = ri.t + q - 2; tv[q] = (tt >= 0 && tt < ri.T) ? *(const v4u*)(P + (size_t)(ri.base + tt) * 512 + c8) : (v4u){0u, 0u, 0u, 0u}; }
            float acc[8];
#pragma unroll
            for (int e = 0; e < 8; ++e) acc[e] = cb[c8 + e];
#pragma unroll
            for (int q = 0; q < 4; ++q)
#pragma unroll
                for (int e = 0; e < 8; ++e) { const unsigned w = ((const unsigned*)&tv[q])[e >> 1]; acc[e] += cw[q * 256 + c8 + e] * ((e & 1) ? bhi(w) : blo(w)); }
#pragma unroll
            for (int e = 0; e < 8; ++e) xc[rr * 256 + c8 + e] = acc[e];
        }
        __syncthreads();
        {
            f32x4 acc[4][2];
#pragma unroll
            for (int m = 0; m < 4; ++m) { acc[m][0] = (f32x4){0.f, 0.f, 0.f, 0.f}; acc[m][1] = (f32x4){0.f, 0.f, 0.f, 0.f}; }
#pragma unroll
            for (int ks = 0; ks < 2; ++ks) {
                const LAS float* ap = xc + (lane & 15) * 256 + g * 64 + 32 * ks + (lane >> 4) * 8;
                const f32x4 x0 = *(const LAS f32x4*)ap, x1 = *(const LAS f32x4*)(ap + 4);
                const float av[8] = {x0.x, x0.y, x0.z, x0.w, x1.x, x1.y, x1.z, x1.w};
                const bfx8 Af = pack8(av);
#pragma unroll
                for (int m = 0; m < 4; ++m)
#pragma unroll
                    for (int ct = 0; ct < 2; ++ct) acc[m][ct] = __builtin_amdgcn_mfma_f32_16x16x32_bf16(Af, Bf[m][ct][ks], acc[m][ct], 0, 0, 0);
            }
#pragma unroll
            for (int m = 0; m < 4; ++m)
#pragma unroll
                for (int ct = 0; ct < 2; ++ct)
#pragma unroll
                    for (int q = 0; q < 4; ++q) res[((lane >> 4) * 4 + q) * 1024 + m * 256 + 32 * wave + 16 * ct + (lane & 15)] = acc[m][ct][q];
        }
        __syncthreads();
#pragma unroll
        for (int q = 0; q < 8; ++q) {
            const int rr = half * 8 + q; const size_t r = (size_t)(r0 + rr); const float xcv = xc[rr * 256 + j];
#pragma unroll
            for (int d = 0; d < 2; ++d) {
                const float rg = sigmoidf_(res[rr * 1024 + d * 256 + j] + (d ? ba1 : ba0));
                const float ig = sigmoidf_(res[rr * 1024 + (2 + d) * 256 + j] + (d ? bx1 : bx0));
                const float a = __expf(-8.f * rg * (d ? sp1 : sp0));
                const float bv = sqrtf(fmaxf(1.f - a * a, 0.f)) * (ig * xcv);
                A[((size_t)d * RT + r) * 256 + j] = f2bf(1.f - a); B[((size_t)d * RT + r) * 256 + j] = f2bf(bv);
            }
        }
        __syncthreads();
    }
}
constexpr int LCH = 64, NVC = CTXL / LCH, NVL = SEQ / LCH, NV = NVC + NVL;
constexpr size_t LR_PA = 4 * SZ34  , LR_QB = LR_PA + (size_t)2 * 8 * NV * 256 * 4;
__device__ __forceinline__ int lru_chunk_row0(int b, int v) { return v < NVC ? b * CTXL + v * LCH : RC + b * SEQ + (v - NVC) * LCH; }
__device__ __forceinline__ void ph_lru_agg(const PAS Prm& p) {
    const int tid = TID, j4 = tid & 63, qt = tid >> 6;
    const bf16* A = (const bf16*)(p.ws + WS_BIG + BG_S + LR_A); const bf16* B = (const bf16*)(p.ws + WS_BIG + BG_S + LR_B);
    float* PA = (float*)(p.ws + WS_BIG + BG_S + LR_PA); float* QB = (float*)(p.ws + WS_BIG + BG_S + LR_QB);
    for (int task = BID * 8 + qt; task < 2 * 8 * NV; task += NBLK * 8) {
        const int d = task / (8 * NV), b = (task / NV) % 8, v = task % NV;
        const int row0 = lru_chunk_row0(b, v);
        const bf16* Ad = A + (size_t)d * RT * 256 + 4 * j4; const bf16* Bd = B + (size_t)d * RT * 256 + 4 * j4;
        f32x4 P = {1.f, 1.f, 1.f, 1.f}, Q = {0.f, 0.f, 0.f, 0.f};
        for (int i0 = 0; i0 < LCH; i0 += 16) {
            v2u a[16], bb[16];
#pragma unroll
            for (int q = 0; q < 16; ++q) { const int i = i0 + q; const size_t ro = (size_t)(row0 + (d ? LCH - 1 - i : i)) * 256; a[q] = *(const v2u*)(Ad + ro); bb[q] = *(const v2u*)(Bd + ro); }
#pragma unroll
            for (int q = 0; q < 16; ++q) { const f32x4 av = {1.f - blo(a[q].x), 1.f - bhi(a[q].x), 1.f - blo(a[q].y), 1.f - bhi(a[q].y)}, bv = {blo(bb[q].x), bhi(bb[q].x), blo(bb[q].y), bhi(bb[q].y)};
                Q = av * Q + bv; P = av * P; }
        }
        *(f32x4*)(PA + (size_t)task * 256 + 4 * j4) = P; *(f32x4*)(QB + (size_t)task * 256 + 4 * j4) = Q;
    }
}
__device__ __forceinline__ float gelu_tanh_(float x) { return 0.5f * x * (1.f + tanhf(0.7978845608028654f * (x + 0.044715f * x * x * x))); }
__device__ __forceinline__ void ph_lru_fin(const PAS Prm& p, LAS unsigned char* lds) {
    LAS unsigned* hf = (LAS unsigned*)lds;
    const int tid = TID, j2 = tid & 127, qt = tid >> 7;
    const bf16* P = (const bf16*)(p.ws + WS_BIG + BG_P);
    const bf16* A = (const bf16*)(p.ws + WS_BIG + BG_S + LR_A); const bf16* B = (const bf16*)(p.ws + WS_BIG + BG_S + LR_B);
    const float* PA = (const float*)(p.ws + WS_BIG + BG_S + LR_PA); const float* QB = (const float*)(p.ws + WS_BIG + BG_S + LR_QB);
    bf16* ylru = (bf16*)(p.ws + WS_Y + 2 * SZ17);
    for (int task = BID * 4 + qt; task < 8 * NV; task += NBLK * 4) {
        const int b = task / NV, v = task % NV;
        const int row0 = lru_chunk_row0(b, v);
        float h0 = 0.f, h1 = 0.f;
        { const float* pa = PA + ((size_t)(0 * 8 + b) * NV) * 256 + 2 * j2; const float* qb = QB + ((size_t)(0 * 8 + b) * NV) * 256 + 2 * j2;
          for (int u0 = 0; u0 < v; u0 += 8) { cf2 pp[8], qq[8];
#pragma unroll
              for (int q = 0; q < 8; ++q) { const int u = u0 + q < v ? u0 + q : v - 1; pp[q] = *(const cf2*)(pa + (size_t)u * 256); qq[q] = *(const cf2*)(qb + (size_t)u * 256); }
#pragma unroll
              for (int q = 0; q < 8; ++q) if (u0 + q < v) { h0 = pp[q].x * h0 + qq[q].x; h1 = pp[q].y * h1 + qq[q].y; } } }
        float g0 = 0.f, g1 = 0.f;
        { const float* pa = PA + ((size_t)(1 * 8 + b) * NV) * 256 + 2 * j2; const float* qb = QB + ((size_t)(1 * 8 + b) * NV) * 256 + 2 * j2;
          const int n1 = v < NVC ? NVC - 1 - v : NVC, n2 = v < NVC ? 0 : NV - 1 - v, nt = n1 + n2;
          for (int i0 = 0; i0 < nt; i0 += 8) { cf2 pp[8], qq[8];
#pragma unroll
              for (int q = 0; q < 8; ++q) { const int i = i0 + q < nt ? i0 + q : nt - 1; const int u = i < n1 ? NVC - 1 - i : NV - 1 - (i - n1); pp[q] = *(const cf2*)(pa + (size_t)u * 256); qq[q] = *(const cf2*)(qb + (size_t)u * 256); }
#pragma unroll
              for (int q = 0; q < 8; ++q) if (i0 + q < nt) { g0 = pp[q].x * g0 + qq[q].x; g1 = pp[q].y * g1 + qq[q].y; } } }
        const bf16* A0 = A + 2 * j2; const bf16* B0 = B + 2 * j2; const bf16* A1 = A + (size_t)RT * 256 + 2 * j2; const bf16* B1 = B + (size_t)RT * 256 + 2 * j2;
        for (int i0 = 0; i0 < LCH; i0 += 16) {
            unsigned a[16], bb[16];
#pragma unroll
            for (int q = 0; q < 16; ++q) { const size_t ro = (size_t)(row0 + i0 + q) * 256; a[q] = *(const unsigned*)(A0 + ro); bb[q] = *(const unsigned*)(B0 + ro); }
#pragma unroll
            for (int q = 0; q < 16; ++q) { h0 = (1.f - blo(a[q])) * h0 + blo(bb[q]); h1 = (1.f - bhi(a[q])) * h1 + bhi(bb[q]); hf[(i0 + q) * 512 + tid] = pk2(h0, h1); }
        }
        for (int i0 = LCH - 16; i0 >= 0; i0 -= 16) {
            unsigned a[16], bb[16], gx[16];
#pragma unroll
            for (int q = 0; q < 16; ++q) { const size_t r = (size_t)(row0 + i0 + 15 - q); a[q] = *(const unsigned*)(A1 + r * 256); bb[q] = *(const unsigned*)(B1 + r * 256); gx[q] = *(const unsigned*)(P + r * 512 + 256 + 2 * j2); }
#pragma unroll
            for (int q = 0; q < 16; ++q) { g0 = (1.f - blo(a[q])) * g0 + blo(bb[q]); g1 = (1.f - bhi(a[q])) * g1 + bhi(bb[q]); const int i = i0 + 15 - q;
                const unsigned hp = hf[i * 512 + tid];
                *(unsigned*)(ylru + (size_t)(row0 + i) * 256 + 2 * j2) = pk2((blo(hp) + g0) * gelu_tanh_(blo(gx[q])), (bhi(hp) + g1) * gelu_tanh_(bhi(gx[q]))); }
        }
    }
}

constexpr size_t HY_VL = 0, HY_VC = 96 * MiB, HY_P = 140 * MiB  , HY_FL = 200 * MiB, HY_FC = 216 * MiB;
__device__ __forceinline__ void ph_hy_filter(const PAS Prm& p, int l, bool with_ctx, LAS unsigned char* lds) {
    LAS float* feat = (LAS float*)lds;
    LAS float* h1 = feat + 16 * 17;
    LAS float* h2 = h1 + 16 * 64;
    const int tid = TID;
    const float* w1 = p.in[11] + l * 17 * 64; const float* b1 = p.in[12] + l * 64; const float* w2 = p.in[13] + l * 64 * 64; const float* b2 = p.in[14] + l * 64;
    const float* w3 = p.in[15] + (size_t)l * 64 * 1024; const float* freq = p.in[16] + l * 128;
    float* FL = (float*)(p.ws + WS_BIG + BG_S + HY_FL); float* FC = (float*)(p.ws + WS_BIG + BG_S + HY_FC);
    const int ntile = with_ctx ? (SEQ + CTXL) / 16 : SEQ / 16;
    for (int tile = (BID + NBLK / 2) % NBLK; tile < ntile; tile += NBLK) {
        const bool isctx = tile >= SEQ / 16; const int L = isctx ? CTXL : SEQ; const int pos0 = (isctx ? tile - SEQ / 16 : tile) * 16;
        float* F = isctx ? FC : FL;
        if (tid < 16 * 17) { const int pp = tid / 17, f = tid % 17; const float t = (float)(pos0 + pp) / (float)L;
            float v; if (f == 0) v = t; else if (f <= 8) v = sinf(6.283185307179586f * t * (float)f); else v = cosf(6.283185307179586f * t * (float)(f - 8));
            feat[tid] = v; }
        __syncthreads();
        for (int i = tid; i < 1024; i += NTHR) { const int pp = i >> 6, o = i & 63; float s = b1[o];
            for (int f = 0; f < 17; ++f) s += feat[pp * 17 + f] * w1[f * 64 + o];
            h1[i] = sinf(freq[o] * s); }
        __syncthreads();
        for (int i = tid; i < 1024; i += NTHR) { const int pp = i >> 6, o = i & 63; float s = b2[o];
            for (int q = 0; q < 64; ++q) s += h1[pp * 64 + q] * w2[q * 64 + o];
            h2[i] = sinf(freq[64 + o] * s); }
        __syncthreads();
        for (int cc = tid; cc < 1024; cc += NTHR) {
            float acc[16];
#pragma unroll
            for (int pp = 0; pp < 16; ++pp) acc[pp] = 0.f;
            for (int q = 0; q < 64; ++q) { const float w = w3[q * 1024 + cc];
#pragma unroll
                for (int pp = 0; pp < 16; ++pp) acc[pp] += h2[pp * 64 + q] * w; }
            const int o = cc >> 9, dd = (cc >> 8) & 1, c = cc & 255;
            const float rate = 3.0701134573253945f + (15.350567286626973f - 3.0701134573253945f) * (float)c * (1.f / 255.f);
            float* Fo = F + (size_t)(o * 256 + c) * (2 * L);
#pragma unroll
            for (int pp = 0; pp < 16; ++pp) { const int pos = pos0 + pp; const float t = (float)pos / (float)L;
                const float val = acc[pp] * expf(-t * rate);
                if (dd == 0) Fo[L + pos] = val; else if (pos >= 1) Fo[L - pos] = val; }
            if (pos0 == 0 && dd == 0) Fo[0] = 0.f;
        }
        __syncthreads();
    }
}
__device__ __forceinline__ void ph_hy_fnorm(const PAS Prm& p, bool with_ctx) {
    const int tid = TID, lane = tid & 63, wave = tid >> 6;
    float* FL = (float*)(p.ws + WS_BIG + BG_S + HY_FL); float* FC = (float*)(p.ws + WS_BIG + BG_S + HY_FC);
    const int gw = BID * NWAVES + wave, NGW = NBLK * NWAVES;
    for (int it = gw; it < (with_ctx ? 1024 : 512); it += NGW) {
        const bool isctx = it >= 512; const int L = isctx ? CTXL : SEQ; float* F = (isctx ? FC : FL) + (size_t)(it & 511) * (2 * L);
        float s = 0.f;
        for (int i = lane; i < 2 * L; i += 64) { const float v = F[i]; s += v * v; }
        const float sc = rsqrtf(wave_sum(s) + 1e-6f);
        for (int i = lane; i < 2 * L; i += 64) F[i] *= sc;
    }
}
__device__ __forceinline__ void ph_hy_prep(const PAS Prm& p, int l, bool with_ctx, LAS unsigned char* lds) {
    LAS float* tl = (LAS float*)lds;
    const int tid = TID;
    const bf16* P = (const bf16*)(p.ws + WS_BIG + BG_S + HY_P);
    float* VL = (float*)(p.ws + WS_BIG + BG_S + HY_VL); float* VC = (float*)(p.ws + WS_BIG + BG_S + HY_VC);
    const float* cw = p.in[9] + l * 3 * 768; const float* cb = p.in[10] + l * 768;
    const int NTL = 8 * (SEQ / 64) * 12, NTC = with_ctx ? 8 * (CTXL / 64) * 12 : 0, NT = NTL + NTC;
    v4u pv[2]; const int rr2[2] = {tid >> 3, (tid + NTHR) >> 3}, cg = tid & 7;
#define HYP_DECODE(tile_, isctx_, T_, b_, t0_, c0_, base_) const bool isctx_ = (tile_) >= NTL; const int tt_ = isctx_ ? (tile_) - NTL : (tile_); const int T_ = isctx_ ? CTXL : SEQ, ntt_ = T_ / 64; \
        const int ct_ = tt_ % 12, tb_ = (tt_ / 12) % ntt_, b_ = tt_ / (12 * ntt_); const int base_ = isctx_ ? b_ * CTXL : RC + b_ * SEQ, t0_ = tb_ * 64, c0_ = ct_ * 64; (void)ct_; (void)tb_;
#define HYP_LOAD(tile_) do { if ((tile_) < NT) { HYP_DECODE(tile_, ic_, T_, b_, t0_, c0_, base_) (void)b_; \
        _Pragma("unroll") for (int q = 0; q < 2; ++q) { const int t = t0_ - 1 + rr2[q]; \
            pv[q] = (rr2[q] < 66 && t >= 0 && t < T_) ? *(const v4u*)(P + (size_t)(base_ + t) * 768 + c0_ + cg * 8) : (v4u){0u, 0u, 0u, 0u}; } } } while (0)
    HYP_LOAD(BID);
    for (int tile = BID; tile < NT; tile += NBLK) {
        HYP_DECODE(tile, isctx, T, b, t0, c0, base) (void)base;
#pragma unroll
        for (int q = 0; q < 2; ++q) if (rr2[q] < 66) {
#pragma unroll
            for (int e = 0; e < 4; ++e) { const unsigned w = ((const unsigned*)&pv[q])[e]; tl[rr2[q] * 65 + cg * 8 + 2 * e] = blo(w); tl[rr2[q] * 65 + cg * 8 + 2 * e + 1] = bhi(w); } }
        __syncthreads();
        HYP_LOAD(tile + NBLK);
        const int part = c0 >> 8, cl0 = c0 & 255;
        float* dst = (isctx ? VC : VL) + ((size_t)(part * 8 + b) * 256 + cl0) * T + t0;
        for (int i = tid; i < 64 * 64; i += NTHR) { const int cc = i >> 6, ti = i & 63, col = c0 + cc;
            const float v = cb[col] + cw[col] * tl[ti * 65 + cc] + cw[768 + col] * tl[(ti + 1) * 65 + cc] + cw[1536 + col] * tl[(ti + 2) * 65 + cc];
            dst[(size_t)cc * T + ti] = v; }
        __syncthreads();
    }
#undef HYP_LOAD
#undef HYP_DECODE
}
template <int L>
__device__ __forceinline__ void hy_conv_item(const PAS Prm& p, int l, int c, int b0, LAS unsigned char* lds) {
    constexpr int NI = (L + NTHR - 1) / NTHR;
    LAS float* hh = (LAS float*)lds;
    LAS float* z = hh + 2 * L;
    const int tid = TID;
    const bool isctx = (L == CTXL);
    const float* F = (const float*)(p.ws + WS_BIG + BG_S + (isctx ? HY_FC : HY_FL));
    const float* HV = (const float*)(p.ws + WS_BIG + BG_S + (isctx ? HY_VC : HY_VL));
    const float* bias = p.in[17] + l * 512;
    for (int bb = 0; bb < 4; ++bb) for (int t = tid; t < L; t += NTHR) z[t * 4 + bb] = HV[((size_t)(0 * 8 + b0 + bb) * 256 + c) * L + t];
    for (int o = 0; o < 2; ++o) {
        float ssq = 0.f;
        for (int i = tid; i < 2 * L; i += NTHR) { const float fv = F[(size_t)(o * 256 + c) * (2 * L) + i]; ssq += fv * fv; hh[i] = fv; }
        const float fscale = rsqrtf(block_sum(ssq, z + 4 * L, tid) + 1e-6f);
        float acc[NI][4];
#pragma unroll
        for (int i = 0; i < NI; ++i) { acc[i][0] = 0.f; acc[i][1] = 0.f; acc[i][2] = 0.f; acc[i][3] = 0.f; }
        if (tid < L) {
            for (int s = 0; s < L; ++s) {
                const f32x4 zs = *(const LAS f32x4*)(z + s * 4);
#pragma unroll
                for (int i = 0; i < NI; ++i) { const float hv = hh[L + tid + NTHR * i - s];
                    acc[i][0] += hv * zs.x; acc[i][1] += hv * zs.y; acc[i][2] += hv * zs.z; acc[i][3] += hv * zs.w; }
            }
        }
        __syncthreads();
        const float bo = bias[o * 256 + c];
        if (tid < L) {
#pragma unroll
            for (int i = 0; i < NI; ++i) { const int t = tid + NTHR * i;
#pragma unroll
                for (int bb = 0; bb < 4; ++bb) { const float gate = HV[((size_t)((1 + o) * 8 + b0 + bb) * 256 + c) * L + t];
                    z[t * 4 + bb] = gate * (acc[i][bb] * fscale + bo * z[t * 4 + bb]); } }
        }
        __syncthreads();
    }
    float* HVw = (float*)(p.ws + WS_BIG + BG_S + (isctx ? HY_VC : HY_VL));
    if (tid < L) {
#pragma unroll
        for (int i = 0; i < NI; ++i) { const int t = tid + NTHR * i;
#pragma unroll
            for (int bb = 0; bb < 4; ++bb) HVw[((size_t)(0 * 8 + b0 + bb) * 256 + c) * L + t] = z[t * 4 + bb]; }
    }
    __syncthreads();
}
template <int L>
__device__ __forceinline__ void hy_conv_item8(const PAS Prm& p, int l, int c, LAS unsigned char* lds) {
    static_assert(2 * L == NTHR, "two thread halves of L threads");
    LAS float* hh = (LAS float*)lds;
    const int tid = TID, g = tid >> 8, tl = tid & (L - 1), b0 = 4 * g;
    LAS float* z = hh + 2 * L + g * 4 * L;
    LAS float* red = hh + 2 * L + 8 * L;
    const float* F = (const float*)(p.ws + WS_BIG + BG_S + HY_FC);
    float* HV = (float*)(p.ws + WS_BIG + BG_S + HY_VC);
    const float* bias = p.in[17] + l * 512;
#pragma unroll
    for (int bb = 0; bb < 4; ++bb) z[tl * 4 + bb] = HV[((size_t)(0 * 8 + b0 + bb) * 256 + c) * L + tl];
    for (int o = 0; o < 2; ++o) {
        const float fv = F[(size_t)(o * 256 + c) * (2 * L) + tid];
        hh[tid] = fv;
        const float fscale = rsqrtf(block_sum(fv * fv, red, tid) + 1e-6f);
        float acc0 = 0.f, acc1 = 0.f, acc2 = 0.f, acc3 = 0.f;
        for (int s = 0; s < L; ++s) {
            const f32x4 zs = *(const LAS f32x4*)(z + s * 4);
            const float hv = hh[L + tl - s];
            acc0 += hv * zs.x; acc1 += hv * zs.y; acc2 += hv * zs.z; acc3 += hv * zs.w;
        }
        __syncthreads();
        const float bo = bias[o * 256 + c];
        const float accv[4] = {acc0, acc1, acc2, acc3};
#pragma unroll
        for (int bb = 0; bb < 4; ++bb) { const float gate = HV[((size_t)((1 + o) * 8 + b0 + bb) * 256 + c) * L + tl];
            z[tl * 4 + bb] = gate * (accv[bb] * fscale + bo * z[tl * 4 + bb]); }
        __syncthreads();
    }
#pragma unroll
    for (int bb = 0; bb < 4; ++bb) HV[((size_t)(0 * 8 + b0 + bb) * 256 + c) * L + tl] = z[tl * 4 + bb];
    __syncthreads();
}
__device__ __forceinline__ void ph_hy_post(const PAS Prm& p, bool with_ctx, LAS unsigned char* lds) {
    LAS float* tl = (LAS float*)lds;
    const int tid = TID;
    const float* VL = (const float*)(p.ws + WS_BIG + BG_S + HY_VL); const float* VC = (const float*)(p.ws + WS_BIG + BG_S + HY_VC);
    bf16* yhy = (bf16*)(p.ws + WS_Y);
    const int NTL = 8 * (SEQ / 64) * 4, NTC = with_ctx ? 8 * (CTXL / 64) * 4 : 0;
    for (int tile = BID; tile < NTL + NTC; tile += NBLK) {
        const bool isctx = tile >= NTL; const int tt = isctx ? tile - NTL : tile;
        const int T = isctx ? CTXL : SEQ, ntt = T / 64;
        const int ct = tt % 4, tb = (tt / 4) % ntt, b = tt / (4 * ntt);
        const int base = isctx ? b * CTXL : RC + b * SEQ, t0 = tb * 64, c0 = ct * 64;
        const float* src = (isctx ? VC : VL) + ((size_t)b * 256 + c0) * T + t0;
        for (int i = tid; i < 64 * 64; i += NTHR) { const int cc = i >> 6, ti = i & 63; tl[cc * 65 + ti] = src[(size_t)cc * T + ti]; }
        __syncthreads();
        for (int i = tid; i < 64 * 32; i += NTHR) { const int ti = i >> 5, cp = i & 31;
            *(unsigned*)(yhy + (size_t)(base + t0 + ti) * 256 + c0 + 2 * cp) = pk2(tl[(2 * cp) * 65 + ti], tl[(2 * cp + 1) * 65 + ti]); }
        __syncthreads();
    }
}
__device__ __forceinline__ cf2 cmul(cf2 a, cf2 b) { return (cf2){sfma(a.x, b.x, -smul(a.y, b.y)), sfma(a.x, b.y, smul(a.y, b.x))}; }
__device__ __forceinline__ cf2 cmulc(cf2 a, cf2 b) { return (cf2){sfma(a.x, b.x, smul(a.y, b.y)), sfma(a.y, b.x, -smul(a.x, b.y))}; }
__device__ __forceinline__ cf2 cadd(cf2 a, cf2 b) { return (cf2){sadd(a.x, b.x), sadd(a.y, b.y)}; }
__device__ __forceinline__ cf2 csub(cf2 a, cf2 b) { return (cf2){ssub(a.x, b.x), ssub(a.y, b.y)}; }
#define XP(i) ((i) + ((i) >> 5))
#ifdef HOST_EMU
static inline unsigned brev32(unsigned x) { unsigned r = 0; for (int i = 0; i < 32; ++i) if (x & (1u << i)) r |= 1u << (31 - i); return r; }
#else
__device__ __forceinline__ unsigned brev32(unsigned x) { return __builtin_bitreverse32(x); }
#endif
template <int LOGN, int M, bool INV, int GMAP, bool PM = false, int RIO = 0>
__device__ __forceinline__ void fft_pass(LAS cf2* X, const LAS cf2* W, const int log_stride, const int tid, const LAS cf2* Hh = nullptr, cf2* xr = nullptr) {
    static_assert(RIO == 0 || ((1 << LOGN) >> M) == NTHR, "register hand-over needs one group per thread");
    constexpr int N = 1 << LOGN, R = 1 << M, NGRP = N / R, LG = LOGN - M;
#pragma unroll
    for (int t = tid; t < NGRP; t += NTHR) {
        int g = t;
        if (GMAP == 1) g = ((t << 1) | (t >> (LG - 1))) & (NGRP - 1);
        if (GMAP == 2) { const int bl = t >> 4, nb = LG - 4; g = (t & 15) | ((((bl << 1) | (bl >> (nb - 1))) & ((1 << nb) - 1)) << 4); }
        const int q = g & ((1 << log_stride) - 1), blk = g >> log_stride;
        const int base = (blk << (log_stride + M)) + q;
        cf2 x[R];
#pragma unroll
        for (int j = 0; j < R; ++j) { if (RIO == 1) x[j] = xr[j]; else x[j] = X[XP(base + (j << log_stride))]; }
        if (PM) {
#pragma unroll
            for (int j = 0; j < R; ++j) { const int k = (int)(brev32((unsigned)(base + (j << log_stride))) >> (32 - LOGN));
                cf2 h; if (k <= N / 2) h = Hh[k]; else { h = Hh[N - k]; h.y = -h.y; }
                x[j] = cmul(x[j], h); } }
#pragma unroll
        for (int s = 0; s < M; ++s) {
            const int half = INV ? (1 << s) : (R >> (s + 1));
            const int lsp = log_stride + (INV ? s : (M - 1 - s));
#pragma unroll
            for (int j = 0; j < R; ++j) {
                if (j & half) continue;
                const int pos = q + ((j & (half - 1)) << log_stride);
                const cf2 a = x[j], bq = x[j + half];
                if (lsp == 0) {
                    x[j] = cadd(a, bq); x[j + half] = csub(a, bq);
                } else if (lsp == 1) {
                    if (!INV) { const cf2 dlt = csub(a, bq); x[j] = cadd(a, bq); x[j + half] = (pos & 1) ? (cf2){dlt.y, -dlt.x} : dlt; }
                    else { const cf2 t2 = (pos & 1) ? (cf2){-bq.y, bq.x} : bq; x[j] = cadd(a, t2); x[j + half] = csub(a, t2); }
                } else {
                    const cf2 w = W[pos << (LOGN - 1 - lsp)];
                    if (!INV) { x[j] = cadd(a, bq); x[j + half] = cmul(csub(a, bq), w); }
                    else { const cf2 t2 = cmulc(bq, w); x[j] = cadd(a, t2); x[j + half] = csub(a, t2); }
                }
            }
        }
#pragma unroll
        for (int j = 0; j < R; ++j) { if (RIO == 2) xr[j] = x[j]; else X[XP(base + (j << log_stride))] = x[j]; }
    }
    __syncthreads();
}
template <int LOGN, bool INV, bool PM = false, bool RR = false> __device__ __forceinline__ void fft_lds(LAS cf2* X, const LAS cf2* W, const int tid, const LAS cf2* Hh = nullptr, cf2* xr = nullptr) {
    static_assert(LOGN == 13 || LOGN == 9, "pass schedule");
    if (LOGN == 13) {
        if (!INV) { fft_pass<LOGN, 4, false, 0, false, RR ? 1 : 0>(X, W, 9, tid, nullptr, xr); fft_pass<LOGN, 3, false, 0>(X, W, 6, tid); fft_pass<LOGN, 3, false, 0>(X, W, 3, tid); fft_pass<LOGN, 3, false, 0>(X, W, 0, tid); }
        else { fft_pass<LOGN, 3, true, 0, PM>(X, W, 0, tid, Hh); fft_pass<LOGN, 3, true, 0>(X, W, 3, tid); fft_pass<LOGN, 3, true, 0>(X, W, 6, tid); fft_pass<LOGN, 4, true, 0, false, RR ? 2 : 0>(X, W, 9, tid, nullptr, xr); }
    } else {
        if (!INV) { fft_pass<LOGN, 3, false, 0>(X, W, 6, tid); fft_pass<LOGN, 3, false, 0>(X, W, 3, tid); fft_pass<LOGN, 3, false, 0>(X, W, 0, tid); }
        else { fft_pass<LOGN, 3, true, 0, PM>(X, W, 0, tid, Hh); fft_pass<LOGN, 3, true, 0>(X, W, 3, tid); fft_pass<LOGN, 3, true, 0>(X, W, 6, tid); }
    }
}
template <int LOGN>
__device__ __forceinline__ void hy_fft_channel(const PAS Prm& p, int l, int c, LAS unsigned char* lds) {
    constexpr int N = 1 << LOGN, L = N / 2;
    static_assert(L == SEQ, "transform length");
    LAS cf2* X = (LAS cf2*)lds;
    LAS cf2* Hh = X + N + N / 32;
    LAS cf2* W = Hh + N / 2 + 8;
    const int tid = TID;
    const float* F = (const float*)(p.ws + WS_BIG + BG_S + HY_FL);
    float* HV = (float*)(p.ws + WS_BIG + BG_S + HY_VL);
    const float* bias = p.in[17] + l * 512;
    for (int k = tid; k < N / 2; k += NTHR) { float sn, cs; sincospif(-(float)k * (2.0f / (float)N), &sn, &cs); W[k] = (cf2){cs, sn}; }
    __syncthreads();
    const float inv_n = 1.0f / (float)N;
    for (int o = 0; o < 2; ++o) {
        const float* Fo = F + (size_t)(o * 256 + c) * N;
        float ssq = 0.f;
        { constexpr int NIT = N / NTHR; float fvv[NIT];
#pragma unroll
          for (int i = 0; i < NIT; ++i) fvv[i] = Fo[(tid + NTHR * i + L) & (N - 1)];
#pragma unroll
          for (int i = 0; i < NIT; ++i) { ssq += fvv[i] * fvv[i]; X[XP(tid + NTHR * i)] = (cf2){fvv[i], 0.f}; } }
        const float fscale = rsqrtf(block_sum(ssq, (LAS float*)(W + N / 2), tid) + 1e-6f);
        fft_lds<LOGN, false>(X, W, tid);
        for (int pp = tid; pp < N; pp += NTHR) { const int k = (int)(brev32((unsigned)pp) >> (32 - LOGN)); if (k <= N / 2) Hh[k] = X[XP(pp)] * fscale; }
        __syncthreads();
        const float bo = bias[o * 256 + c];
        constexpr int NITZ = (L + NTHR - 1) / NTHR;
        float a0[NITZ], a1[NITZ];
        { float* z0 = HV + ((size_t)(0 * 8) * 256 + c) * L; float* z1 = z0 + (size_t)256 * L;
#pragma unroll
          for (int i = 0; i < NITZ; ++i) { const int t = tid + NTHR * i; if (t < L) { a0[i] = z0[t]; a1[i] = z1[t]; } } }
#pragma unroll 1
        for (int pair = 0; pair < 4; ++pair) {
            float* z0 = HV + ((size_t)(0 * 8 + 2 * pair) * 256 + c) * L; float* z1 = z0 + (size_t)256 * L;
            const float* g0 = HV + ((size_t)((1 + o) * 8 + 2 * pair) * 256 + c) * L; const float* g1 = g0 + (size_t)256 * L;
            constexpr bool RR = (LOGN == 13);
            cf2 xr[16];
            if (RR) {
#pragma unroll
                for (int i = 0; i < 16; ++i) xr[i] = (i < NITZ) ? (cf2){a0[i < NITZ ? i : 0], a1[i < NITZ ? i : 0]} : (cf2){0.f, 0.f};
            } else {
#pragma unroll
                for (int i = 0; i < NITZ; ++i) { const int t = tid + NTHR * i; if (t < L) { X[XP(t)] = (cf2){a0[i], a1[i]}; X[XP(t + L)] = (cf2){0.f, 0.f}; } }
                __syncthreads();
            }
            fft_lds<LOGN, false, false, RR>(X, W, tid, nullptr, xr);
            float q0[NITZ], q1[NITZ], n0[NITZ], n1[NITZ];
            { const int pn = pair < 3 ? pair + 1 : pair; const float* y0 = HV + ((size_t)(0 * 8 + 2 * pn) * 256 + c) * L; const float* y1 = y0 + (size_t)256 * L;
#pragma unroll
              for (int i = 0; i < NITZ; ++i) { const int t = tid + NTHR * i; if (t < L) { q0[i] = g0[t]; q1[i] = g1[t]; n0[i] = y0[t]; n1[i] = y1[t]; } } }
            fft_lds<LOGN, true, true, RR>(X, W, tid, Hh, xr);
#pragma unroll
            for (int i = 0; i < NITZ; ++i) { const int t = tid + NTHR * i; if (t < L) { const cf2 cv = (RR ? xr[i < 16 ? i : 0] : X[XP(t)]) * inv_n;
                z0[t] = q0[i] * (cv.x + bo * a0[i]); z1[t] = q1[i] * (cv.y + bo * a1[i]); a0[i] = n0[i]; a1[i] = n1[i]; } }
            __syncthreads();
        }
    }
}
__device__ __forceinline__ void ph_hy_conv(const PAS Prm& p, int l, bool with_ctx, LAS unsigned char* lds) {
    constexpr int LOGN = (SEQ == 4096) ? 13 : 9;
    for (int c = BID; c < 256; c += NBLK) hy_fft_channel<LOGN>(p, l, c, lds);
    if (with_ctx) {
        if constexpr (2 * CTXL == NTHR) { for (int it = BID; it < 256; it += NBLK) hy_conv_item8<CTXL>(p, l, it, lds); }
        else { for (int it = BID; it < 512; it += NBLK) hy_conv_item<CTXL>(p, l, it >> 1, (it & 1) * 4, lds); }
    }
}

constexpr int PPL = 18;
constexpr int NPH = 1 + DEPTH * PPL + 1;

#ifdef HOST_EMU
#define NO_PK_F32
#else
#define NO_PK_F32 __attribute__((target("no-packed-fp32-ops")))
#endif
template <unsigned MASK> __global__ void __launch_bounds__(NTHR, 2) fwd(Prm pk) {
#ifdef HOST_EMU
    unsigned char* lds_raw = g_lds_emu;
#else
    extern __shared__ __attribute__((aligned(16))) unsigned char lds_raw[];
#endif
    LAS unsigned char* lds = (LAS unsigned char*)lds_raw;
    volatile LAS unsigned* misc = (volatile LAS unsigned*)(lds + LDS_BYTES - 256);
#ifndef HOST_EMU
    { const unsigned t0 = threadIdx.x;
      if (t0 < 64u) misc[t0] = 0u;
      if ((t0 & 63u) == 0u) ((volatile LAS unsigned*)(lds + TIDTAB_OFF))[hw_slot()] = t0 >> 6;
      __syncthreads();
      if ((unsigned)tid_opq() != t0) __hip_atomic_store((unsigned*)(pk.ws + WS_CTL + 768 * 1024), 1u, __ATOMIC_RELAXED, __HIP_MEMORY_SCOPE_AGENT); }
#else
    if (TID < 64) misc[TID] = 0u;
    __syncthreads();
#endif
    const int lo = pk.lo, hi = pk.hi;
#ifdef PROBE_G
    if (blockIdx.x == 0 && tid_opq() == 0) misc[15] = (unsigned)__builtin_amdgcn_s_memrealtime();
#endif
    XcdBarrier bar; bar.bar = (unsigned*)(pk.ws + WS_CTL); bar.x = 0; bar.st = misc + 8;
    if (hi - lo > 1) bar = xcd_barrier_post((unsigned*)(pk.ws + WS_CTL), misc + 8);
    int ph = 0;
#ifdef HOST_EMU
#define PH_PRM() const Prm* pl_ = &pk
#else
#define PH_PRM() const PAS Prm* pl_ = (const PAS Prm*)__builtin_amdgcn_kernarg_segment_ptr(); asm volatile("" : "+s"(pl_))
#endif
#define PH_BEGIN(k) if (((MASK >> ((k) & 31)) & 1u) && ph >= lo && ph < hi) { constexpr int PH_CUR = (k); (void)PH_CUR; PH_PRM(); const PAS Prm& p = *pl_; \
    bf16* const WB = (bf16*)(p.ws + WS_W); bf16* const U = (bf16*)(p.ws + WS_U); float* const XC = (float*)(p.ws + WS_XC); bf16* const PB = (bf16*)(p.ws + WS_BIG + BG_P); \
    unsigned char* const SB = p.ws + WS_BIG + BG_S; bf16* const GH = (bf16*)(p.ws + WS_BIG); bf16* const MG = (bf16*)(p.ws + WS_BIG + 136 * MiB); bf16* const ACT = (bf16*)(p.ws + WS_BIG); \
    const float* const MOD = (const float*)(p.ws + WS_MOD); const float* const modl = MOD + (size_t)l * 9 * 6144; \
    const float* xc_src = (l == 0) ? p.in[2] : XC; const float* xl_src = (l == 0) ? p.in[0] : p.out; \
    (void)WB; (void)U; (void)XC; (void)PB; (void)SB; (void)GH; (void)MG; (void)ACT; (void)MOD; (void)modl; (void)xc_src; (void)xl_src;
#ifdef PROBE_G
#define PH_GRP(k) (((k) == 4 || (k) == 8 || (k) == 12 || (k) == 16 || ((k) >= 21 && (k) <= 27) || (k) == 29 || (k) == 30) ? 0 : ((k) == 6) ? 1 : ((k) == 20) ? 2 : ((k) == 5 || (k) == 13) ? 3 : 4)
#define PH_END_K(k) if (ph + 1 < hi) xcd_barrier(bar); if (blockIdx.x == 0 && tid_opq() == 0) { const unsigned tnow = (unsigned)__builtin_amdgcn_s_memrealtime(); misc[16 + PH_GRP(k)] += tnow - misc[15]; misc[15] = tnow; } } ++ph;
#else
#define PH_END_K(k) if (ph + 1 < hi) xcd_barrier(bar); } ++ph;
#endif
#define PH_END PH_END_K(PH_CUR)
    typedef pg8::StaticOrder SO;

    { const int l = 0; PH_BEGIN(1) ph_mod(p, lds); PH_END }

    {
        constexpr int l = 0;
        const bool last = (l == DEPTH - 1), wctx = !last;
        const int ro = last ? RC : 0, Mpost = last ? RL : RT;

        PH_BEGIN(2) ph_cvt(p, l, lds, (l > 0 && NBLK == 256) ? 2 : 0, 0); ph_norm(p, l, 0, xc_src, xl_src, 0); PH_END
        PH_BEGIN(4) { pg8::Gemm g{U, WB + WO_WP + (size_t)1280 * 1024, RT, 2048, 1024}; SO S; S.init(RT, 2048, NBLK, BID); pg8::EpiBf2 E{(bf16*)(p.ws + WS_Y), 1024, PB, 1024, 4};
                   pg8::gemm_phase<pg8::EpiBf2, SO, true, true>(lds, g, S, E); } PH_END
        PH_BEGIN(5) ph_rw_prep(p, l, lds); PH_END
        PH_BEGIN(6) { const int bid = BID;
#ifdef PROBE_G
                   const unsigned tq0 = (unsigned)__builtin_amdgcn_s_memrealtime();
#endif
                   for (int task = bid; task < 256; task += NBLK) {
                       if (task < 128) scan_phase<0>(task, SB, PB, (void*)(SB + RW_Y), p.in[25] + l * 256, nullptr, lds);
                       else scan_phase<1>(task - 128, SB, PB, (void*)(SB + RT_Y), nullptr, p.in[35] + l * 8, lds);
                       __syncthreads(); }
#ifdef PROBE_G
                   if (tid_opq() == 0) { const unsigned tq1 = (unsigned)__builtin_amdgcn_s_memrealtime(); if (bid == 0) misc[16 + 5] += tq1 - tq0; if (bid == 128) misc[16 + 6] += tq1 - tq0; }
#endif
                   } PH_END
        PH_BEGIN(7) ph_rw_post(p, l); ph_ret_post(p); PH_END
        PH_BEGIN(12) { pg8::Gemm g{U, WB + WO_WP, RT, 1280, 1024}; SO S; S.init(RT, 1280, NBLK, BID);
                   pg8::EpiBf2 E{PB, 512, (bf16*)(SB + HY_P), 768, 2};
                   pg8::gemm_phase<pg8::EpiBf2, SO, true, true>(lds, g, S, E); } PH_END
        PH_BEGIN(13) ph_lru_prep(p, l, lds); PH_END
        PH_BEGIN(14) ph_lru_agg(p); ph_hy_filter(p, l, wctx, lds); PH_END
        PH_BEGIN(15) ph_lru_fin(p, lds); PH_END
        PH_BEGIN(19) ph_hy_prep(p, l, wctx, lds); PH_END
        PH_BEGIN(20) ph_hy_conv(p, l, wctx, lds); PH_END
        PH_BEGIN(32) ph_hy_post(p, wctx, lds); PH_END
        PH_BEGIN(21) { pg8::Gemm g{U + (size_t)ro * 1024, WB + WO_WG, Mpost, 4096, 1024}; SO S; S.init(Mpost, 4096, NBLK, BID); pg8::EpiBf<1> E{GH + (size_t)ro * 4096, 4096};
                   pg8::gemm_phase<pg8::EpiBf<1>, SO, true, true>(lds, g, S, E); } PH_END
#ifdef HOST_EMU
#define MERGE_LOCAL_SEAM() __syncthreads()
#else
#define MERGE_LOCAL_SEAM() do { asm volatile("s_waitcnt vmcnt(0)" ::: "memory"); __syncthreads(); __builtin_amdgcn_fence(__ATOMIC_ACQUIRE, "agent"); asm volatile("s_waitcnt vmcnt(0)" ::: "memory"); __syncthreads(); } while (0)
#endif
        PH_BEGIN(22) {
            { pg8::Gemm g{(const bf16*)(p.ws + WS_Y + 0 * SZ17) + (size_t)ro * 256, WB + WO_BR + (size_t)0 * 1024 * 256, Mpost, 1024, 256}; SO S; S.init(Mpost, 1024, NBLK, BID);
              pg8::EpiMerge E{GH + (size_t)ro * 4096, 4096, 0, U + (size_t)ro * 1024, 1}; pg8::gemm_phase<pg8::EpiMerge, SO, true, true>(lds, g, S, E); }
            MERGE_LOCAL_SEAM();
            { pg8::Gemm g{(const bf16*)(p.ws + WS_Y + 1 * SZ17) + (size_t)ro * 256, WB + WO_BR + (size_t)1 * 1024 * 256, Mpost, 1024, 256}; SO S; S.init(Mpost, 1024, NBLK, BID);
              pg8::EpiMerge E{GH + (size_t)ro * 4096, 4096, 1024, U + (size_t)ro * 1024, 0}; pg8::gemm_phase<pg8::EpiMerge, SO, true, true>(lds, g, S, E); }
            MERGE_LOCAL_SEAM();
            { pg8::Gemm g{(const bf16*)(p.ws + WS_Y + 2 * SZ17) + (size_t)ro * 256, WB + WO_BR + (size_t)2 * 1024 * 256, Mpost, 1024, 256}; SO S; S.init(Mpost, 1024, NBLK, BID);
              pg8::EpiMerge E{GH + (size_t)ro * 4096, 4096, 2048, U + (size_t)ro * 1024, 0}; pg8::gemm_phase<pg8::EpiMerge, SO, true, true>(lds, g, S, E); }
            MERGE_LOCAL_SEAM();
            { pg8::Gemm g{(const bf16*)(p.ws + WS_Y + 3 * SZ17) + (size_t)ro * 256, WB + WO_BR + (size_t)3 * 1024 * 256, Mpost, 1024, 256}; SO S; S.init(Mpost, 1024, NBLK, BID);
              pg8::EpiMerge E{GH + (size_t)ro * 4096, 4096, 3072, U + (size_t)ro * 1024, 0}; pg8::gemm_phase<pg8::EpiMerge, SO, true, true>(lds, g, S, E); }
        } PH_END
        PH_BEGIN(27) { pg8::Gemm g{U + (size_t)ro * 1024, WB + WO_WO, Mpost, 1024, 1024}; SO S; S.init(Mpost, 1024, NBLK, BID);
                   pg8::EpiResid E{xc_src, xl_src, XC, p.out, modl, 2 * 1024, ro};
                   pg8::gemm_phase<pg8::EpiResid, SO, true, true>(lds, g, S, E); } PH_END
        PH_BEGIN(28) ph_norm(p, l, 1, XC, p.out, ro); PH_END
        PH_BEGIN(29) { pg8::Gemm g{U + (size_t)ro * 1024, WB + WO_W1, Mpost, 5632, 1024}; SO S; S.init(Mpost, 5632, NBLK, BID); pg8::EpiSwiglu E{ACT + (size_t)ro * 2816, 2816};
                   pg8::gemm_phase<pg8::EpiSwiglu, SO, true, true>(lds, g, S, E); } PH_END
        PH_BEGIN(30) { pg8::Gemm g{ACT + (size_t)ro * 2816, WB + WO_W2, Mpost, 1024, 2816}; SO S; S.init(Mpost, 1024, NBLK, BID);
                   pg8::EpiResid E{XC, p.out, XC, p.out, modl, 5 * 1024, ro};
                   pg8::gemm_phase<pg8::EpiResid, SO, true, true>(lds, g, S, E); }
                   if (!last && NBLK == 256 && BID >= 32) { __syncthreads(); ph_cvt(p, l + 1, lds, 1, 32); }
        PH_END
    }
    {
        constexpr int l = 1;
        const bool last = (l == DEPTH - 1), wctx = !last;
        const int ro = last ? RC : 0, Mpost = last ? RL : RT;

        PH_BEGIN(2) ph_cvt(p, l, lds, (l > 0 && NBLK == 256) ? 2 : 0, 0); ph_norm(p, l, 0, xc_src, xl_src, 0); PH_END
        PH_BEGIN(4) { pg8::Gemm g{U, WB + WO_WP + (size_t)1280 * 1024, RT, 2048, 1024}; SO S; S.init(RT, 2048, NBLK, BID); pg8::EpiBf2 E{(bf16*)(p.ws + WS_Y), 1024, PB, 1024, 4};
                   pg8::gemm_phase<pg8::EpiBf2, SO, true, true>(lds, g, S, E); } PH_END
        PH_BEGIN(5) ph_rw_prep(p, l, lds); PH_END
        PH_BEGIN(6) { const int bid = BID;
#ifdef PROBE_G
                   const unsigned tq0 = (unsigned)__builtin_amdgcn_s_memrealtime();
#endif
                   for (int task = bid; task < 256; task += NBLK) {
                       if (task < 128) scan_phase<0>(task, SB, PB, (void*)(SB + RW_Y), p.in[25] + l * 256, nullptr, lds);
                       else scan_phase<1>(task - 128, SB, PB, (void*)(SB + RT_Y), nullptr, p.in[35] + l * 8, lds);
                       __syncthreads(); }
#ifdef PROBE_G
                   if (tid_opq() == 0) { const unsigned tq1 = (unsigned)__builtin_amdgcn_s_memrealtime(); if (bid == 0) misc[16 + 5] += tq1 - tq0; if (bid == 128) misc[16 + 6] += tq1 - tq0; }
#endif
                   } PH_END
        PH_BEGIN(7) ph_rw_post(p, l); ph_ret_post(p); PH_END
        PH_BEGIN(12) { pg8::Gemm g{U, WB + WO_WP, RT, 1280, 1024}; SO S; S.init(RT, 1280, NBLK, BID);
                   pg8::EpiBf2 E{PB, 512, (bf16*)(SB + HY_P), 768, 2};
                   pg8::gemm_phase<pg8::EpiBf2, SO, true, true>(lds, g, S, E); } PH_END
        PH_BEGIN(13) ph_lru_prep(p, l, lds); PH_END
        PH_BEGIN(14) ph_lru_agg(p); ph_hy_filter(p, l, wctx, lds); PH_END
        PH_BEGIN(15) ph_lru_fin(p, lds); PH_END
        PH_BEGIN(19) ph_hy_prep(p, l, wctx, lds); PH_END
        PH_BEGIN(20) ph_hy_conv(p, l, wctx, lds); PH_END
        PH_BEGIN(32) ph_hy_post(p, wctx, lds); PH_END
        PH_BEGIN(21) { pg8::Gemm g{U + (size_t)ro * 1024, WB + WO_WG, Mpost, 4096, 1024}; SO S; S.init(Mpost, 4096, NBLK, BID); pg8::EpiBf<1> E{GH + (size_t)ro * 4096, 4096};
                   pg8::gemm_phase<pg8::EpiBf<1>, SO, true, true>(lds, g, S, E); } PH_END
#ifdef HOST_EMU
#define MERGE_LOCAL_SEAM() __syncthreads()
#else
#define MERGE_LOCAL_SEAM() do { asm volatile("s_waitcnt vmcnt(0)" ::: "memory"); __syncthreads(); __builtin_amdgcn_fence(__ATOMIC_ACQUIRE, "agent"); asm volatile("s_waitcnt vmcnt(0)" ::: "memory"); __syncthreads(); } while (0)
#endif
        PH_BEGIN(22) {
            { pg8::Gemm g{(const bf16*)(p.ws + WS_Y + 0 * SZ17) + (size_t)ro * 256, WB + WO_BR + (size_t)0 * 1024 * 256, Mpost, 1024, 256}; SO S; S.init(Mpost, 1024, NBLK, BID);
              pg8::EpiMerge E{GH + (size_t)ro * 4096, 4096, 0, U + (size_t)ro * 1024, 1}; pg8::gemm_phase<pg8::EpiMerge, SO, true, true>(lds, g, S, E); }
            MERGE_LOCAL_SEAM();
            { pg8::Gemm g{(const bf16*)(p.ws + WS_Y + 1 * SZ17) + (size_t)ro * 256, WB + WO_BR + (size_t)1 * 1024 * 256, Mpost, 1024, 256}; SO S; S.init(Mpost, 1024, NBLK, BID);
              pg8::EpiMerge E{GH + (size_t)ro * 4096, 4096, 1024, U + (size_t)ro * 1024, 0}; pg8::gemm_phase<pg8::EpiMerge, SO, true, true>(lds, g, S, E); }
            MERGE_LOCAL_SEAM();
            { pg8::Gemm g{(const bf16*)(p.ws + WS_Y + 2 * SZ17) + (size_t)ro * 256, WB + WO_BR + (size_t)2 * 1024 * 256, Mpost, 1024, 256}; SO S; S.init(Mpost, 1024, NBLK, BID);
              pg8::EpiMerge E{GH + (size_t)ro * 4096, 4096, 2048, U + (size_t)ro * 1024, 0}; pg8::gemm_phase<pg8::EpiMerge, SO, true, true>(lds, g, S, E); }
            MERGE_LOCAL_SEAM();
            { pg8::Gemm g{(const bf16*)(p.ws + WS_Y + 3 * SZ17) + (size_t)ro * 256, WB + WO_BR + (size_t)3 * 1024 * 256, Mpost, 1024, 256}; SO S; S.init(Mpost, 1024, NBLK, BID);
              pg8::EpiMerge E{GH + (size_t)ro * 4096, 4096, 3072, U + (size_t)ro * 1024, 0}; pg8::gemm_phase<pg8::EpiMerge, SO, true, true>(lds, g, S, E); }
        } PH_END
        PH_BEGIN(27) { pg8::Gemm g{U + (size_t)ro * 1024, WB + WO_WO, Mpost, 1024, 1024}; SO S; S.init(Mpost, 1024, NBLK, BID);
                   pg8::EpiResid E{xc_src, xl_src, XC, p.out, modl, 2 * 1024, ro};
                   pg8::gemm_phase<pg8::EpiResid, SO, true, true>(lds, g, S, E); } PH_END
        PH_BEGIN(28) ph_norm(p, l, 1, XC, p.out, ro); PH_END
        PH_BEGIN(29) { pg8::Gemm g{U + (size_t)ro * 1024, WB + WO_W1, Mpost, 5632, 1024}; SO S; S.init(Mpost, 5632, NBLK, BID); pg8::EpiSwiglu E{ACT + (size_t)ro * 2816, 2816};
                   pg8::gemm_phase<pg8::EpiSwiglu, SO, true, true>(lds, g, S, E); } PH_END
        PH_BEGIN(30) { pg8::Gemm g{ACT + (size_t)ro * 2816, WB + WO_W2, Mpost, 1024, 2816}; SO S; S.init(Mpost, 1024, NBLK, BID);
                   pg8::EpiResid E{XC, p.out, XC, p.out, modl, 5 * 1024, ro};
                   pg8::gemm_phase<pg8::EpiResid, SO, true, true>(lds, g, S, E); }
                   if (!last && NBLK == 256 && BID >= 32) { __syncthreads(); ph_cvt(p, l + 1, lds, 1, 32); }
        PH_END
    }
    {
        constexpr int l = 2;
        const bool last = (l == DEPTH - 1), wctx = !last;
        const int ro = last ? RC : 0, Mpost = last ? RL : RT;

        PH_BEGIN(2) ph_cvt(p, l, lds, (l > 0 && NBLK == 256) ? 2 : 0, 0); ph_norm(p, l, 0, xc_src, xl_src, 0); PH_END
        PH_BEGIN(4) { pg8::Gemm g{U, WB + WO_WP + (size_t)1280 * 1024, RT, 2048, 1024}; SO S; S.init(RT, 2048, NBLK, BID); pg8::EpiBf2 E{(bf16*)(p.ws + WS_Y), 1024, PB, 1024, 4};
                   pg8::gemm_phase<pg8::EpiBf2, SO, true, true>(lds, g, S, E); } PH_END
        PH_BEGIN(5) ph_rw_prep(p, l, lds); PH_END
        PH_BEGIN(6) { const int bid = BID;
#ifdef PROBE_G
                   const unsigned tq0 = (unsigned)__builtin_amdgcn_s_memrealtime();
#endif
                   for (int task = bid; task < 256; task += NBLK) {
                       if (task < 128) scan_phase<0>(task, SB, PB, (void*)(SB + RW_Y), p.in[25] + l * 256, nullptr, lds);
                       else scan_phase<1>(task - 128, SB, PB, (void*)(SB + RT_Y), nullptr, p.in[35] + l * 8, lds);
                       __syncthreads(); }
#ifdef PROBE_G
                   if (tid_opq() == 0) { const unsigned tq1 = (unsigned)__builtin_amdgcn_s_memrealtime(); if (bid == 0) misc[16 + 5] += tq1 - tq0; if (bid == 128) misc[16 + 6] += tq1 - tq0; }
#endif
                   } PH_END
        PH_BEGIN(7) ph_rw_post(p, l); ph_ret_post(p); PH_END
        PH_BEGIN(12) { pg8::Gemm g{U, WB + WO_WP, RT, 1280, 1024}; SO S; S.init(RT, 1280, NBLK, BID);
                   pg8::EpiBf2 E{PB, 512, (bf16*)(SB + HY_P), 768, 2};
                   pg8::gemm_phase<pg8::EpiBf2, SO, true, true>(lds, g, S, E); } PH_END
        PH_BEGIN(13) ph_lru_prep(p, l, lds); PH_END
        PH_BEGIN(14) ph_lru_agg(p); ph_hy_filter(p, l, wctx, lds); PH_END
        PH_BEGIN(15) ph_lru_fin(p, lds); PH_END
        PH_BEGIN(19) ph_hy_prep(p, l, wctx, lds); PH_END
        PH_BEGIN(20) ph_hy_conv(p, l, wctx, lds); PH_END
        PH_BEGIN(32) ph_hy_post(p, wctx, lds); PH_END
        PH_BEGIN(21) { pg8::Gemm g{U + (size_t)ro * 1024, WB + WO_WG, Mpost, 4096, 1024}; SO S; S.init(Mpost, 4096, NBLK, BID); pg8::EpiBf<1> E{GH + (size_t)ro * 4096, 4096};
                   pg8::gemm_phase<pg8::EpiBf<1>, SO, true, true>(lds, g, S, E); } PH_END
#ifdef HOST_EMU
#define MERGE_LOCAL_SEAM() __syncthreads()
#else
#define MERGE_LOCAL_SEAM() do { asm volatile("s_waitcnt vmcnt(0)" ::: "memory"); __syncthreads(); __builtin_amdgcn_fence(__ATOMIC_ACQUIRE, "agent"); asm volatile("s_waitcnt vmcnt(0)" ::: "memory"); __syncthreads(); } while (0)
#endif
        PH_BEGIN(22) {
            { pg8::Gemm g{(const bf16*)(p.ws + WS_Y + 0 * SZ17) + (size_t)ro * 256, WB + WO_BR + (size_t)0 * 1024 * 256, Mpost, 1024, 256}; SO S; S.init(Mpost, 1024, NBLK, BID);
              pg8::EpiMerge E{GH + (size_t)ro * 4096, 4096, 0, U + (size_t)ro * 1024, 1}; pg8::gemm_phase<pg8::EpiMerge, SO, true, true>(lds, g, S, E); }
            MERGE_LOCAL_SEAM();
            { pg8::Gemm g{(const bf16*)(p.ws + WS_Y + 1 * SZ17) + (size_t)ro * 256, WB + WO_BR + (size_t)1 * 1024 * 256, Mpost, 1024, 256}; SO S; S.init(Mpost, 1024, NBLK, BID);
              pg8::EpiMerge E{GH + (size_t)ro * 4096, 4096, 1024, U + (size_t)ro * 1024, 0}; pg8::gemm_phase<pg8::EpiMerge, SO, true, true>(lds, g, S, E); }
            MERGE_LOCAL_SEAM();
            { pg8::Gemm g{(const bf16*)(p.ws + WS_Y + 2 * SZ17) + (size_t)ro * 256, WB + WO_BR + (size_t)2 * 1024 * 256, Mpost, 1024, 256}; SO S; S.init(Mpost, 1024, NBLK, BID);
              pg8::EpiMerge E{GH + (size_t)ro * 4096, 4096, 2048, U + (size_t)ro * 1024, 0}; pg8::gemm_phase<pg8::EpiMerge, SO, true, true>(lds, g, S, E); }
            MERGE_LOCAL_SEAM();
            { pg8::Gemm g{(const bf16*)(p.ws + WS_Y + 3 * SZ17) + (size_t)ro * 256, WB + WO_BR + (size_t)3 * 1024 * 256, Mpost, 1024, 256}; SO S; S.init(Mpost, 1024, NBLK, BID);
              pg8::EpiMerge E{GH + (size_t)ro * 4096, 4096, 3072, U + (size_t)ro * 1024, 0}; pg8::gemm_phase<pg8::EpiMerge, SO, true, true>(lds, g, S, E); }
        } PH_END
        PH_BEGIN(27) { pg8::Gemm g{U + (size_t)ro * 1024, WB + WO_WO, Mpost, 1024, 1024}; SO S; S.init(Mpost, 1024, NBLK, BID);
                   pg8::EpiResid E{xc_src, xl_src, XC, p.out, modl, 2 * 1024, ro};
                   pg8::gemm_phase<pg8::EpiResid, SO, true, true>(lds, g, S, E); } PH_END
        PH_BEGIN(28) ph_norm(p, l, 1, XC, p.out, ro); PH_END
        PH_BEGIN(29) { pg8::Gemm g{U + (size_t)ro * 1024, WB + WO_W1, Mpost, 5632, 1024}; SO S; S.init(Mpost, 5632, NBLK, BID); pg8::EpiSwiglu E{ACT + (size_t)ro * 2816, 2816};
                   pg8::gemm_phase<pg8::EpiSwiglu, SO, true, true>(lds, g, S, E); } PH_END
        PH_BEGIN(30) { pg8::Gemm g{ACT + (size_t)ro * 2816, WB + WO_W2, Mpost, 1024, 2816}; SO S; S.init(Mpost, 1024, NBLK, BID);
                   pg8::EpiResid E{XC, p.out, XC, p.out, modl, 5 * 1024, ro};
                   pg8::gemm_phase<pg8::EpiResid, SO, true, true>(lds, g, S, E); }
                   if (!last && NBLK == 256 && BID >= 32) { __syncthreads(); ph_cvt(p, l + 1, lds, 1, 32); }
        PH_END
    }
    {
        constexpr int l = 3;
        const bool last = (l == DEPTH - 1), wctx = !last;
        const int ro = last ? RC : 0, Mpost = last ? RL : RT;

        PH_BEGIN(2) ph_cvt(p, l, lds, (l > 0 && NBLK == 256) ? 2 : 0, 0); ph_norm(p, l, 0, xc_src, xl_src, 0); PH_END
        PH_BEGIN(4) { pg8::Gemm g{U, WB + WO_WP + (size_t)1280 * 1024, RT, 2048, 1024}; SO S; S.init(RT, 2048, NBLK, BID); pg8::EpiBf2 E{(bf16*)(p.ws + WS_Y), 1024, PB, 1024, 4};
                   pg8::gemm_phase<pg8::EpiBf2, SO, true, true>(lds, g, S, E); } PH_END
        PH_BEGIN(5) ph_rw_prep(p, l, lds); PH_END
        PH_BEGIN(6) { const int bid = BID;
#ifdef PROBE_G
                   const unsigned tq0 = (unsigned)__builtin_amdgcn_s_memrealtime();
#endif
                   for (int task = bid; task < 256; task += NBLK) {
                       if (task < 128) scan_phase<0>(task, SB, PB, (void*)(SB + RW_Y), p.in[25] + l * 256, nullptr, lds);
                       else scan_phase<1>(task - 128, SB, PB, (void*)(SB + RT_Y), nullptr, p.in[35] + l * 8, lds);
                       __syncthreads(); }
#ifdef PROBE_G
                   if (tid_opq() == 0) { const unsigned tq1 = (unsigned)__builtin_amdgcn_s_memrealtime(); if (bid == 0) misc[16 + 5] += tq1 - tq0; if (bid == 128) misc[16 + 6] += tq1 - tq0; }
#endif
                   } PH_END
        PH_BEGIN(7) ph_rw_post(p, l); ph_ret_post(p); PH_END
        PH_BEGIN(12) { pg8::Gemm g{U, WB + WO_WP, RT, 1280, 1024}; SO S; S.init(RT, 1280, NBLK, BID);
                   pg8::EpiBf2 E{PB, 512, (bf16*)(SB + HY_P), 768, 2};
                   pg8::gemm_phase<pg8::EpiBf2, SO, true, true>(lds, g, S, E); } PH_END
        PH_BEGIN(13) ph_lru_prep(p, l, lds); PH_END
        PH_BEGIN(14) ph_lru_agg(p); ph_hy_filter(p, l, wctx, lds); PH_END
        PH_BEGIN(15) ph_lru_fin(p, lds); PH_END
        PH_BEGIN(19) ph_hy_prep(p, l, wctx, lds); PH_END
        PH_BEGIN(20) ph_hy_conv(p, l, wctx, lds); PH_END
        PH_BEGIN(32) ph_hy_post(p, wctx, lds); PH_END
        PH_BEGIN(21) { pg8::Gemm g{U + (size_t)ro * 1024, WB + WO_WG, Mpost, 4096, 1024}; SO S; S.init(Mpost, 4096, NBLK, BID); pg8::EpiBf<1> E{GH + (size_t)ro * 4096, 4096};
                   pg8::gemm_phase<pg8::EpiBf<1>, SO, true, true>(lds, g, S, E); } PH_END
#ifdef HOST_EMU
#define MERGE_LOCAL_SEAM() __syncthreads()
#else
#define MERGE_LOCAL_SEAM() do { asm volatile("s_waitcnt vmcnt(0)" ::: "memory"); __syncthreads(); __builtin_amdgcn_fence(__ATOMIC_ACQUIRE, "agent"); asm volatile("s_waitcnt vmcnt(0)" ::: "memory"); __syncthreads(); } while (0)
#endif
        PH_BEGIN(22) {
            { pg8::Gemm g{(const bf16*)(p.ws + WS_Y + 0 * SZ17) + (size_t)ro * 256, WB + WO_BR + (size_t)0 * 1024 * 256, Mpost, 1024, 256}; SO S; S.init(Mpost, 1024, NBLK, BID);
              pg8::EpiMerge E{GH + (size_t)ro * 4096, 4096, 0, U + (size_t)ro * 1024, 1}; pg8::gemm_phase<pg8::EpiMerge, SO, true, true>(lds, g, S, E); }
            MERGE_LOCAL_SEAM();
            { pg8::Gemm g{(const bf16*)(p.ws + WS_Y + 1 * SZ17) + (size_t)ro * 256, WB + WO_BR + (size_t)1 * 1024 * 256, Mpost, 1024, 256}; SO S; S.init(Mpost, 1024, NBLK, BID);
              pg8::EpiMerge E{GH + (size_t)ro * 4096, 4096, 1024, U + (size_t)ro * 1024, 0}; pg8::gemm_phase<pg8::EpiMerge, SO, true, true>(lds, g, S, E); }
            MERGE_LOCAL_SEAM();
            { pg8::Gemm g{(const bf16*)(p.ws + WS_Y + 2 * SZ17) + (size_t)ro * 256, WB + WO_BR + (size_t)2 * 1024 * 256, Mpost, 1024, 256}; SO S; S.init(Mpost, 1024, NBLK, BID);
              pg8::EpiMerge E{GH + (size_t)ro * 4096, 4096, 2048, U + (size_t)ro * 1024, 0}; pg8::gemm_phase<pg8::EpiMerge, SO, true, true>(lds, g, S, E); }
            MERGE_LOCAL_SEAM();
            { pg8::Gemm g{(const bf16*)(p.ws + WS_Y + 3 * SZ17) + (size_t)ro * 256, WB + WO_BR + (size_t)3 * 1024 * 256, Mpost, 1024, 256}; SO S; S.init(Mpost, 1024, NBLK, BID);
              pg8::EpiMerge E{GH + (size_t)ro * 4096, 4096, 3072, U + (size_t)ro * 1024, 0}; pg8::gemm_phase<pg8::EpiMerge, SO, true, true>(lds, g, S, E); }
        } PH_END
        PH_BEGIN(27) { pg8::Gemm g{U + (size_t)ro * 1024, WB + WO_WO, Mpost, 1024, 1024}; SO S; S.init(Mpost, 1024, NBLK, BID);
                   pg8::EpiResid E{xc_src, xl_src, XC, p.out, modl, 2 * 1024, ro};
                   pg8::gemm_phase<pg8::EpiResid, SO, true, true>(lds, g, S, E); } PH_END
        PH_BEGIN(28) ph_norm(p, l, 1, XC, p.out, ro); PH_END
        PH_BEGIN(29) { pg8::Gemm g{U + (size_t)ro * 1024, WB + WO_W1, Mpost, 5632, 1024}; SO S; S.init(Mpost, 5632, NBLK, BID); pg8::EpiSwiglu E{ACT + (size_t)ro * 2816, 2816};
                   pg8::gemm_phase<pg8::EpiSwiglu, SO, true, true>(lds, g, S, E); } PH_END
        PH_BEGIN(30) { pg8::Gemm g{ACT + (size_t)ro * 2816, WB + WO_W2, Mpost, 1024, 2816}; SO S; S.init(Mpost, 1024, NBLK, BID);
                   pg8::EpiResid E{XC, p.out, XC, p.out, modl, 5 * 1024, ro};
                   pg8::gemm_phase<pg8::EpiResid, SO, true, true>(lds, g, S, E); }
                   if (!last && NBLK == 256 && BID >= 32) { __syncthreads(); ph_cvt(p, l + 1, lds, 1, 32); }
        PH_END
    }
    { const int l = 1; PH_BEGIN(31) ph_final(p); PH_END }
#ifdef PROBE_G
    if (blockIdx.x == (PROBE_G == 6 ? 128 : 0) && tid_opq() == 0) { const unsigned t0 = (unsigned)__builtin_amdgcn_s_memrealtime(); const unsigned w = misc[16 + PROBE_G] * 4u; while ((unsigned)__builtin_amdgcn_s_memrealtime() - t0 < w) __builtin_amdgcn_s_sleep(8); }
#endif
#undef PH_BEGIN
#undef PH_END
}

#ifndef HOST_EMU
#define SITE(k) (1u << (k))
#if MK_PER_PHASE
constexpr int NG = 19;
constexpr unsigned GM[NG] = {
    SITE(0) | SITE(1) | SITE(2) | SITE(3) | SITE(28) | SITE(31) | SITE(7) | SITE(15) | SITE(18) | SITE(19),
    SITE(5),
    SITE(6),
    SITE(13) | SITE(14),
    SITE(17) | SITE(20),
    SITE(4), SITE(8), SITE(12), SITE(16), SITE(21), SITE(24), SITE(22), SITE(23), SITE(25), SITE(26), SITE(27), SITE(30), SITE(29), 0u };
#else
constexpr int NG = 1;
constexpr unsigned GM[NG] = {0xFFFFFFFFu};
#endif
template <int G> static bool prep_group() { return hipFuncSetAttribute((const void*)fwd<GM[G]>, hipFuncAttributeMaxDynamicSharedMemorySize, LDS_BYTES) == hipSuccess; }
template <int G> static void launch_group(int grid, hipStream_t stream, const Prm& p) { hipLaunchKernelGGL(fwd<GM[G]>, dim3(grid), dim3(NTHR), LDS_BYTES, stream, p); }

extern "C" void kernel_launch(void* const* d_in, const int* in_sizes, int n_in, void* d_out, int out_size, void* d_ws, size_t ws_size, hipStream_t stream) {
    static int grid = 0;
    if (grid == 0) {
        if (n_in != 41 || out_size != RL * D || ws_size < WS_END) { fprintf(stderr, "kernel_launch: unexpected shapes (n_in %d out %d ws %zu); nothing launched\n", n_in, out_size, ws_size); grid = -1; return; }
        int dev = 0, cus = 0;
        if (hipGetDevice(&dev) != hipSuccess || hipDeviceGetAttribute(&cus, hipDeviceAttributeMultiprocessorCount, dev) != hipSuccess) { grid = -1; return; }
        bool ok = true;
#if MK_PER_PHASE
        ok = ok && prep_group<0>() && prep_group<1>() && prep_group<2>() && prep_group<3>() && prep_group<4>() && prep_group<5>() && prep_group<6>() && prep_group<7>() && prep_group<8>() && prep_group<9>()
                && prep_group<10>() && prep_group<11>() && prep_group<12>() && prep_group<13>() && prep_group<14>() && prep_group<15>() && prep_group<16>() && prep_group<17>();
#else
        ok = prep_group<0>();
#endif
        if (!ok) { fprintf(stderr, "kernel_launch: hipFuncSetAttribute failed\n"); grid = -1; return; }
        (void)hipGetLastError();
        grid = cus > 0 ? cus : 256;
    }
    if (grid < 0) return;
    if (hipMemsetAsync((char*)d_ws + WS_CTL, 0, 1 * MiB, stream) != hipSuccess) return;
    Prm p{};
    for (int i = 0; i < 41; ++i) p.in[i] = (const float*)d_in[i];
    p.out = (float*)d_out; p.ws = (unsigned char*)d_ws;
#if MK_PER_PHASE
    for (int ph = 0; ph < NPH; ++ph) {
        p.lo = ph; p.hi = ph + 1;
        static const int layer_sites[PPL] = {2, 4, 5, 6, 7, 12, 13, 14, 15, 19, 20, 0  , 21, 22, 27, 28, 29, 30};
        const int k = (ph == 0) ? 1 : (ph == NPH - 1) ? 31 : layer_sites[(ph - 1) % PPL];
        int g = -1;
        for (int q = 0; q < NG; ++q) if ((GM[q] >> k) & 1u) g = q;
        switch (g) {
            case 0: launch_group<0>(grid, stream, p); break; case 1: launch_group<1>(grid, stream, p); break; case 2: launch_group<2>(grid, stream, p); break;
            case 3: launch_group<3>(grid, stream, p); break; case 4: launch_group<4>(grid, stream, p); break; case 5: launch_group<5>(grid, stream, p); break;
            case 6: launch_group<6>(grid, stream, p); break; case 7: launch_group<7>(grid, stream, p); break; case 8: launch_group<8>(grid, stream, p); break;
            case 9: launch_group<9>(grid, stream, p); break; case 10: launch_group<10>(grid, stream, p); break; case 11: launch_group<11>(grid, stream, p); break;
            case 12: launch_group<12>(grid, stream, p); break; case 13: launch_group<13>(grid, stream, p); break; case 14: launch_group<14>(grid, stream, p); break;
            case 15: launch_group<15>(grid, stream, p); break; case 16: launch_group<16>(grid, stream, p); break; case 17: launch_group<17>(grid, stream, p); break;
            default: break; }
#ifdef DIAG_BUILD
        { static const int dg[8][2] = {{0, 0}, {2, 1}, {10, 2}, {14, 3}, {20, 4}, {22, 5}, {26, 6}, {28, 7}};
          for (int q = 0; q < 8; ++q) if (ph == 1 + dg[q][0]) hipLaunchKernelGGL(diag_k, dim3(32), dim3(NTHR), 0, stream, p, dg[q][1]);
          if (ph == 1 + 19) hipLaunchKernelGGL(diag_k, dim3(32), dim3(NTHR), 0, stream, p, 8);
          if (ph == NPH - 1) hipLaunchKernelGGL(diag_out_k, dim3(grid), dim3(NTHR), 0, stream, p); }
#endif
    }
#else
    p.lo = 0; p.hi = NPH;
    launch_group<0>(grid, stream, p);
#endif
}
#endif
```
